# Optimizing an MI355X kernel written in HIP

```python
import math
import jax, jax.numpy as jnp
from jax import lax
import numpy as np

D_MODEL = 1024
BATCH = 4
SEQ = 8192
DEPTH = 2
DEC_BATCH = 8
DEC_SEQ = 32
PAST_LEN = 2048

CHUNK = 64
N_MEM = 256
Q_BLOCK = 128
EPS = 1e-6
N_EVEN = (DEPTH + 1) // 2
N_ODD = DEPTH // 2
H_A = 4
DK_A = 128
DV_A = 128
W_A = H_A * DV_A
H_B = 4
DK_B = 64
DV_B = 2 * DK_B
W_B = H_B * DV_B
H_X = 4
DH_X = 128
W_X = H_X * DH_X
W_C = D_MODEL
CONV_W = 31
ALIBI_SLOPES = tuple(2.0 ** (-8.0 * (h + 1) / H_B) for h in range(H_B))
SPLIT_EVEN = (H_A * DK_A, H_A * DK_A, W_A, W_A, W_A, H_A, H_A, 2 * H_B * DK_B, 2 * H_B * DK_B, W_B, W_B, W_X, W_X)
N_IN_EVEN = sum(SPLIT_EVEN)
SPLIT_ODD = (W_C, W_C, W_C, W_X, W_X)
N_IN_ODD = sum(SPLIT_ODD)

kernel_name = 'hybrid_mlstm_diffattn_conformer_stream_step'


def lambda_init(layer):
    return 0.8 - 0.6 * math.exp(-0.3 * layer)


def rmsnorm(x, g):
    xf = x.astype(jnp.float32)
    y = xf * lax.rsqrt(jnp.mean(xf * xf, axis=-1, keepdims=True) + EPS)
    return (y * g.astype(jnp.float32)).astype(x.dtype)


def layernorm(x, g, b):
    xf = x.astype(jnp.float32)
    mu = jnp.mean(xf, axis=-1, keepdims=True)
    var = jnp.mean(jnp.square(xf - mu), axis=-1, keepdims=True)
    y = (xf - mu) * lax.rsqrt(var + EPS) * g.astype(jnp.float32) + b.astype(jnp.float32)
    return y.astype(x.dtype)


def split_cols(y, sizes):
    idx = [int(i) for i in np.cumsum(sizes)[:-1]]
    return jnp.split(y, idx, axis=-1)


def mlstm_chunk(state, inp):
    C0, n0, m0 = state
    q, k, v, ig, lf = inp
    L = q.shape[1]
    b = jnp.cumsum(lf, axis=1).transpose(0, 2, 1)
    it = ig.transpose(0, 2, 1)
    causal = jnp.tril(jnp.ones((L, L), dtype=bool))
    logw = jnp.where(causal, b[..., :, None] - b[..., None, :] + it[..., None, :], -jnp.inf)
    g = b + m0[..., None]
    m = jnp.maximum(g, jnp.max(logw, axis=-1))
    w_intra = jnp.exp(logw - m[..., None])
    w_inter = jnp.exp(g - m)
    s = jnp.einsum('blhd,bshd->bhls', q, k) * w_intra
    num = w_inter[..., None] * jnp.einsum('blhd,bhde->bhle', q, C0) + jnp.einsum('bhls,bshe->bhle', s, v)
    den = w_inter * jnp.einsum('blhd,bhd->bhl', q, n0) + jnp.sum(s, axis=-1)
    h = num / jnp.maximum(jnp.abs(den), jnp.exp(-m))[..., None]
    m_last = m[..., -1]
    decay = jnp.exp(g[..., -1] - m_last)
    w_end = jnp.exp(b[..., -1:] - b + it - m_last[..., None])
    C1 = decay[..., None, None] * C0 + jnp.einsum('bhs,bshd,bshe->bhde', w_end, k, v)
    n1 = decay[..., None] * n0 + jnp.einsum('bhs,bshd->bhd', w_end, k)
    return (C1, n1, m_last), h.transpose(0, 2, 1, 3)


def diff_attn_core(q, k, v, qpos, kpos, lam):
    s = jnp.einsum('bqhcd,bkhcd->bhcqk', q, k).astype(jnp.float32) * (DK_B ** -0.5)
    slopes = jnp.array(ALIBI_SLOPES, dtype=jnp.float32)
    dist = jnp.abs(qpos[:, None] - kpos[None, :]).astype(jnp.float32)
    s = s - slopes[:, None, None, None] * dist
    visible = (kpos // CHUNK)[None, :] <= (qpos // CHUNK)[:, None]
    s = jnp.where(visible, s, -jnp.inf)
    p = jax.nn.softmax(s, axis=-1)
    w = p[:, :, 0] - lam * p[:, :, 1]
    return jnp.einsum('bhqk,bkhd->bqhd', w.astype(v.dtype), v)


def diff_attn_prompt(q, k, v, lam):
    bsz, S = q.shape[0], q.shape[1]
    nb = S // Q_BLOCK
    qb = q.reshape(bsz, nb, Q_BLOCK, H_B, 2, DK_B).swapaxes(0, 1)
    kpos = jnp.arange(S)

    def block(args):
        qblk, j = args
        qpos = j * Q_BLOCK + jnp.arange(Q_BLOCK)
        return diff_attn_core(qblk, k, v, qpos, kpos, lam)

    o = lax.map(block, (qb, jnp.arange(nb)))
    return o.swapaxes(0, 1).reshape(bsz, S, H_B, DV_B)


def memory_kv(mem, g, w_kv, kg):
    bsz, M = mem.shape[0], mem.shape[1]
    kv = rmsnorm(mem, g) @ w_kv
    k, v = jnp.split(kv, 2, axis=-1)
    k = rmsnorm(k.reshape(bsz, M, H_X, DH_X), kg)
    return k, v.reshape(bsz, M, H_X, DH_X)


def cross_attn(q, mem_k, mem_v):
    bsz, L = q.shape[0], q.shape[1]
    s = jnp.einsum('blhd,bmhd->bhlm', q, mem_k.astype(q.dtype)).astype(jnp.float32) * (DH_X ** -0.5)
    p = jax.nn.softmax(s, axis=-1).astype(mem_v.dtype)
    return jnp.einsum('bhlm,bmhd->blhd', p, mem_v).reshape(bsz, L, W_X)


def even_layer(x, mem_k, mem_v, hist, norm_g, w_in, b_ig, b_fg, mlstm_g, qn_g, kn_g,
               lq1, lk1, lq2, lk2, subln_g, w_out, xq_g, lam_init):
    f32 = jnp.float32
    bsz, L = x.shape[0], x.shape[1]
    y = rmsnorm(x, norm_g) @ w_in
    aq, ak, av, ao, az, ai, af, bq, bk, bv, bz, xq, xz = split_cols(y, SPLIT_EVEN)
    qa = aq.reshape(bsz, L, H_A, DK_A).astype(f32)
    ka = ak.reshape(bsz, L, H_A, DK_A).astype(f32) * (DK_A ** -0.5)
    va = av.reshape(bsz, L, H_A, DV_A).astype(f32)
    ig = ai.astype(f32) + b_ig.astype(f32)
    lf = jax.nn.log_sigmoid(af.astype(f32) + b_fg.astype(f32))
    qb = rmsnorm(bq.reshape(bsz, L, H_B, 2, DK_B), qn_g)
    kb = rmsnorm(bk.reshape(bsz, L, H_B, 2, DK_B), kn_g)
    vb = bv.reshape(bsz, L, H_B, DV_B)
    lam = (jnp.exp(jnp.sum(lq1.astype(f32) * lk1.astype(f32)))
           - jnp.exp(jnp.sum(lq2.astype(f32) * lk2.astype(f32))) + lam_init)
    if hist is None:
        state0 = (jnp.zeros((bsz, H_A, DK_A, DV_A), f32), jnp.zeros((bsz, H_A, DK_A), f32),
                  jnp.zeros((bsz, H_A), f32))
        n_chunks = L // CHUNK

        def to_chunks(a):
            return a.reshape(bsz, n_chunks, CHUNK, *a.shape[2:]).swapaxes(0, 1)

        state1, ha = lax.scan(mlstm_chunk, state0, tuple(to_chunks(a) for a in (qa, ka, va, ig, lf)))
        ha = ha.swapaxes(0, 1).reshape(bsz, L, H_A, DV_A)
        ob = diff_attn_prompt(qb, kb, vb, lam)
    else:
        k_past, v_past, C0, n0, m0 = hist
        state1, ha = mlstm_chunk((C0.astype(f32), n0.astype(f32), m0.astype(f32)), (qa, ka, va, ig, lf))
        P = k_past.shape[1]
        k_all = jnp.concatenate([k_past.reshape(bsz, P, H_B, 2, DK_B).astype(kb.dtype), kb], axis=1)
        v_all = jnp.concatenate([v_past.astype(vb.dtype), vb], axis=1)
        ob = diff_attn_core(qb, k_all, v_all, P + jnp.arange(L), jnp.arange(P + L), lam)
    oa = rmsnorm(ha, mlstm_g) * jax.nn.sigmoid(ao.astype(f32)).reshape(bsz, L, H_A, DV_A)
    ob = rmsnorm(ob, subln_g) * (1.0 - lam_init)
    ox = cross_attn(rmsnorm(xq.reshape(bsz, L, H_X, DH_X), xq_g), mem_k, mem_v)
    mixed = jnp.concatenate([
        oa.reshape(bsz, L, W_A).astype(x.dtype) * jax.nn.silu(az),
        ob.reshape(bsz, L, W_B) * jax.nn.silu(bz),
        ox.astype(x.dtype) * jax.nn.silu(xz)], axis=-1)
    C1, n1, m1 = state1
    return x + mixed @ w_out, kb.reshape(bsz, L, H_B, 2 * DK_B), vb, C1, n1, m1


def odd_layer(x, mem_k, mem_v, conv_hist, norm_g, w_in, conv_w, conv_b, ln_g, ln_b, w_out, xq_g):
    bsz, L = x.shape[0], x.shape[1]
    y = rmsnorm(x, norm_g) @ w_in
    cu, cg, cz, xq, xz = split_cols(y, SPLIT_ODD)
    u = cu * jax.nn.sigmoid(cg)
    if conv_hist is None:
        u_pad = jnp.pad(u, ((0, 0), (CONV_W - 1, 0), (0, 0)))
    else:
        u_pad = jnp.concatenate([conv_hist.astype(u.dtype), u], axis=1)
    c = lax.conv_general_dilated(u_pad, conv_w.astype(u.dtype)[:, None, :], (1,), 'VALID',
                                 dimension_numbers=('NWC', 'WIO', 'NWC'),
                                 feature_group_count=W_C) + conv_b
    c = jax.nn.silu(layernorm(c, ln_g, ln_b))
    ox = cross_attn(rmsnorm(xq.reshape(bsz, L, H_X, DH_X), xq_g), mem_k, mem_v)
    mixed = jnp.concatenate([c * jax.nn.silu(cz), ox.astype(x.dtype) * jax.nn.silu(xz)], axis=-1)
    return x + mixed @ w_out, u_pad[:, -(CONV_W - 1):]


def setup_inputs(seed: int = 0) -> dict:
    key = jax.random.key(seed)
    keys = iter(jax.random.split(key, 48))

    def nrm(shape, scale):
        return jax.random.normal(next(keys), shape, jnp.float32) * scale

    def gain(shape):
        return 1.0 + nrm(shape, 0.02)

    d_in_a = W_A + W_B + W_X
    d_in_c = W_C + W_X
    return {
        'x_prompt': nrm((BATCH, SEQ, D_MODEL), 1.0),
        'x_sample': nrm((DEC_BATCH, DEC_SEQ, D_MODEL), 1.0),
        'mem_prompt': nrm((BATCH, N_MEM, D_MODEL), 1.0),
        'cache_xk': nrm((DEPTH, DEC_BATCH, N_MEM, H_X, DH_X), 1.0),
        'cache_xv': nrm((DEPTH, DEC_BATCH, N_MEM, H_X, DH_X), 1.0),
        'cache_k': nrm((N_EVEN, DEC_BATCH, PAST_LEN, H_B, 2 * DK_B), 1.0),
        'cache_v': nrm((N_EVEN, DEC_BATCH, PAST_LEN, H_B, DV_B), 1.0),
        'state_C': nrm((N_EVEN, DEC_BATCH, H_A, DK_A, DV_A), 0.5),
        'state_n': nrm((N_EVEN, DEC_BATCH, H_A, DK_A), 0.3),
        'state_m': nrm((N_EVEN, DEC_BATCH, H_A), 0.5),
        'state_conv': nrm((N_ODD, DEC_BATCH, CONV_W - 1, W_C), 0.5),
        'norm_g': gain((DEPTH, D_MODEL)),
        'w_in_a': nrm((N_EVEN, D_MODEL, N_IN_EVEN), D_MODEL ** -0.5),
        'b_ig': nrm((N_EVEN, H_A), 0.1),
        'b_fg': jnp.linspace(3.0, 6.0, H_A, dtype=jnp.float32)[None, :] + nrm((N_EVEN, H_A), 0.1),
        'mlstm_norm_g': gain((N_EVEN, H_A, DV_A)),
        'qn_g': gain((N_EVEN, DK_B)),
        'kn_g': gain((N_EVEN, DK_B)),
        'lam_q1': nrm((N_EVEN, DK_B), 0.1),
        'lam_k1': nrm((N_EVEN, DK_B), 0.1),
        'lam_q2': nrm((N_EVEN, DK_B), 0.1),
        'lam_k2': nrm((N_EVEN, DK_B), 0.1),
        'subln_g': gain((N_EVEN, DV_B)),
        'w_out_a': nrm((N_EVEN, d_in_a, D_MODEL), d_in_a ** -0.5),
        'w_in_c': nrm((N_ODD, D_MODEL, N_IN_ODD), D_MODEL ** -0.5),
        'conv_w': nrm((N_ODD, CONV_W, W_C), CONV_W ** -0.5),
        'conv_b': nrm((N_ODD, W_C), 0.02),
        'conv_ln_g': gain((N_ODD, W_C)),
        'conv_ln_b': nrm((N_ODD, W_C), 0.02),
        'w_out_c': nrm((N_ODD, d_in_c, D_MODEL), d_in_c ** -0.5),
        'mem_norm_g': gain((DEPTH, D_MODEL)),
        'w_mem_kv': nrm((DEPTH, D_MODEL, 2 * W_X), D_MODEL ** -0.5),
        'xq_norm_g': gain((DEPTH, DH_X)),
        'xk_norm_g': gain((DEPTH, DH_X)),
    }


def reference(x_prompt, x_sample, mem_prompt, cache_xk, cache_xv, cache_k, cache_v, state_C, state_n,
              state_m, state_conv, norm_g, w_in_a, b_ig, b_fg, mlstm_norm_g, qn_g, kn_g, lam_q1, lam_k1,
              lam_q2, lam_k2, subln_g, w_out_a, w_in_c, conv_w, conv_b, conv_ln_g, conv_ln_b, w_out_c,
              mem_norm_g, w_mem_kv, xq_norm_g, xk_norm_g):
    yp, ys = x_prompt, x_sample
    p_xk, p_xv, p_k, p_v, p_C, p_n, p_m, p_conv = [], [], [], [], [], [], [], []
    s_k, s_v, s_C, s_n, s_m, s_conv = [], [], [], [], [], []
    for layer in range(DEPTH):
        mk, mv = memory_kv(mem_prompt, mem_norm_g[layer], w_mem_kv[layer], xk_norm_g[layer])
        p_xk.append(mk)
        p_xv.append(mv)
        if layer % 2 == 0:
            e = layer // 2
            wts = (norm_g[layer], w_in_a[e], b_ig[e], b_fg[e], mlstm_norm_g[e], qn_g[e], kn_g[e],
                   lam_q1[e], lam_k1[e], lam_q2[e], lam_k2[e], subln_g[e], w_out_a[e], xq_norm_g[layer],
                   lambda_init(layer))
            yp, k_new, v_new, C1, n1, m1 = even_layer(yp, mk, mv, None, *wts)
            p_k.append(k_new)
            p_v.append(v_new)
            p_C.append(C1)
            p_n.append(n1)
            p_m.append(m1)
            hist = (cache_k[e], cache_v[e], state_C[e], state_n[e], state_m[e])
            ys, k_new, v_new, C1, n1, m1 = even_layer(ys, cache_xk[layer], cache_xv[layer], hist, *wts)
            s_k.append(k_new)
            s_v.append(v_new)
            s_C.append(C1)
            s_n.append(n1)
            s_m.append(m1)
        else:
            o = layer // 2
            wts = (norm_g[layer], w_in_c[o], conv_w[o], conv_b[o], conv_ln_g[o], conv_ln_b[o], w_out_c[o],
                   xq_norm_g[layer])
            yp, cv = odd_layer(yp, mk, mv, None, *wts)
            p_conv.append(cv)
            ys, cv = odd_layer(ys, cache_xk[layer], cache_xv[layer], state_conv[o], *wts)
            s_conv.append(cv)
    new_p_xk = jnp.stack(p_xk)
    new_p_xv = jnp.stack(p_xv)
    new_p_k = jnp.stack(p_k)
    new_p_v = jnp.stack(p_v)
    new_p_C = jnp.stack(p_C)
    new_p_n = jnp.stack(p_n)
    new_p_m = jnp.stack(p_m)
    new_p_conv = jnp.stack(p_conv)
    new_s_k = jnp.stack(s_k)
    new_s_v = jnp.stack(s_v)
    new_s_C = jnp.stack(s_C)
    new_s_n = jnp.stack(s_n)
    new_s_m = jnp.stack(s_m)
    new_s_conv = jnp.stack(s_conv)
    return (yp, ys, new_p_xk, new_p_xv, new_p_k, new_p_v, new_p_C, new_p_n, new_p_m, new_p_conv,
            new_s_k, new_s_v, new_s_C, new_s_n, new_s_m, new_s_conv)
```

```cpp
#include <hip/hip_runtime.h>
#include <hip/hip_cooperative_groups.h>
#include <stdint.h>
#include <stdio.h>
namespace cg = cooperative_groups;

typedef unsigned short u16;
using bf16x8 = __attribute__((ext_vector_type(8))) short;
using f32x4  = __attribute__((ext_vector_type(4))) float;
using f32x16 = __attribute__((ext_vector_type(16))) float;
using u32x4  = __attribute__((ext_vector_type(4))) unsigned;
using u32x2  = __attribute__((ext_vector_type(2))) unsigned;
#define LAS __attribute__((address_space(3)))
#define DEVI __device__ __forceinline__

constexpr int NTOKP = 32768, NTOKS = 256, NTOK = 33024;
constexpr int SEQ = 8192, LSAMP = 32, PAST = 2048, SKP = 2112;
constexpr size_t SEG = (size_t)NTOK * 512;
constexpr int NPAD_A = 5760;
constexpr float EPS = 1e-6f;
constexpr float LOG2E = 1.4426950408889634f;
constexpr size_t O_YP = 0, O_PXK = 33816576, O_PXV = 34865152, O_PK = 35913728, O_PV = 52690944,
  O_PC = 69468160, O_PN = 69730304, O_PM = 69732352, O_PCONV = 69732368, O_SK = 69855248, O_SV = 69986320,
  O_SC = 70117392, O_SN = 70641680, O_SM = 70645776, O_SCONV = 70645808;

constexpr int LDS_BYTES = 128 * 132 * 4;

struct Params {
  const float* in[34];
  float* out;
  u16 *WtInA, *WtOutA, *WtInC, *WtOutC, *WtMem;
  u16 *xb, *memb;
  u16 *Qa, *Ka, *KaT, *VaT, *Ga, *Qb, *Kb, *VbT, *Gb, *Qx, *Gx;
  u16 *Ks, *VsT, *XK, *XVT, *C0sT;
  float *rs0, *ssq1, *rsmem, *gates, *tabA, *tabB, *mtab, *nhat, *nstate;
};

DEVI unsigned cvtpk(float lo, float hi) { unsigned r; asm volatile("v_cvt_pk_bf16_f32 %0, %1, %2" : "=v"(r) : "v"(lo), "v"(hi)); return r; }
DEVI float bflo(unsigned u) { return __uint_as_float(u << 16); }
DEVI float bfhi(unsigned u) { return __uint_as_float(u & 0xffff0000u); }
DEVI float bf2f(u16 h) { return __uint_as_float(((unsigned)h) << 16); }
DEVI u16 f2bf(float f) { return (u16)(cvtpk(f, 0.f) & 0xffffu); }
DEVI float sigmoidf_(float x) { return 1.f / (1.f + __expf(-x)); }
DEVI float siluf_(float x) { return x / (1.f + __expf(-x)); }
DEVI float logsigmoidf_(float x) { return fminf(x, 0.f) - log1pf(__expf(-fabsf(x))); }
DEVI float wsum(float v) { for (int o = 32; o; o >>= 1) v += __shfl_xor(v, o); return v; }
DEVI float wmax(float v) { for (int o = 32; o; o >>= 1) v = fmaxf(v, __shfl_xor(v, o)); return v; }
DEVI int pi32(int r) { return (r & ~12) | ((r & 4) << 1) | ((r & 8) >> 1); }
DEVI int klocal(int reg, int h) { return (reg & 3) + 4 * ((reg >> 2) & 1) + 8 * h + 16 * (reg >> 3); }
DEVI int crow(int reg, int h) { return (reg & 3) + 8 * (reg >> 2) + 4 * h; }
DEVI bf16x8 ldg8(const u16* p) { return *reinterpret_cast<const bf16x8*>(p); }
DEVI f32x16 mfma32(bf16x8 a, bf16x8 b, f32x16 c) { return __builtin_amdgcn_mfma_f32_32x32x16_bf16(a, b, c, 0, 0, 0); }
DEVI bf16x8 pack8(const f32x16& x, int s) {
  u32x4 w = {cvtpk(x[8 * s + 0], x[8 * s + 1]), cvtpk(x[8 * s + 2], x[8 * s + 3]), cvtpk(x[8 * s + 4], x[8 * s + 5]), cvtpk(x[8 * s + 6], x[8 * s + 7])};
  return *reinterpret_cast<bf16x8*>(&w);
}
DEVI void glds16(const void* g, LAS void* l) { __builtin_amdgcn_global_load_lds((const unsigned*)g, (LAS unsigned*)l, 16, 0, 0); }

template <class F>
DEVI void wtrans(u16* dst, const float* src, const float* g, int K, int Npad, int ldn, F srccol, int gtid, int gsz) {
  const int total = Npad * (K / 8);
  for (int i = gtid; i < total; i += gsz) {
    const int n = i % Npad, kb = i / Npad;
    const int sc = srccol(n);
    float v[8];
#pragma unroll
    for (int j = 0; j < 8; ++j) {
      const int k = kb * 8 + j;
      v[j] = (sc >= 0) ? src[(size_t)k * ldn + sc] * (g ? g[k] : 1.f) : 0.f;
    }
    u32x4 w = {cvtpk(v[0], v[1]), cvtpk(v[2], v[3]), cvtpk(v[4], v[5]), cvtpk(v[6], v[7])};
    *reinterpret_cast<u32x4*>(dst + (size_t)n * K + kb * 8) = w;
  }
}

DEVI int srccol_in_a(int n) {
  const int t = n >> 7, c = n & 127;
  if (t < 12) return n;
  if (t < 20) { const int j = t - 12; return c < 64 ? 1536 + 64 * j + c : 2048 + 64 * j + (c - 64); }
  if (t < 44) return 2568 + (t - 20) * 128 + c;
  return c < 8 ? 2560 + c : -1;
}
DEVI int srccol_in_c(int n) {
  const int t = n >> 7, c = n & 127;
  if (t < 16) return c < 64 ? 64 * t + c : 1024 + 64 * t + (c - 64);
  return n;
}

__device__ void phase_prep(const Params& p) {
  const int tid = threadIdx.x, lane = tid & 63;
  const int gtid = blockIdx.x * 256 + tid, gsz = gridDim.x * 256;
  const int gwave = gtid >> 6, nwaves = gsz >> 6;
  wtrans(p.WtInA, p.in[12], p.in[11], 1024, NPAD_A, 5640, [](int n) { return srccol_in_a(n); }, gtid, gsz);
  wtrans(p.WtOutA, p.in[23], nullptr, 1536, 1024, 1024, [](int n) { return n; }, gtid, gsz);
  wtrans(p.WtInC, p.in[24], p.in[11] + 1024, 1024, 4096, 4096, [](int n) { return srccol_in_c(n); }, gtid, gsz);
  wtrans(p.WtOutC, p.in[29], nullptr, 1536, 1024, 1024, [](int n) { return n; }, gtid, gsz);
  for (int l = 0; l < 2; ++l)
    wtrans(p.WtMem + (size_t)l * 1024 * 1024, p.in[31] + (size_t)l * 1024 * 1024, p.in[30] + l * 1024, 1024, 1024, 1024,
           [](int n) { return n; }, gtid, gsz);
  for (int row = gwave; row < NTOK + 1024; row += nwaves) {
    const float* xr; u16* dst; float* rsd;
    if (row < NTOK) { xr = (row < NTOKP ? p.in[0] + (size_t)row * 1024 : p.in[1] + (size_t)(row - NTOKP) * 1024); dst = p.xb + (size_t)row * 1024; rsd = p.rs0 + row; }
    else { const int r = row - NTOK; xr = p.in[2] + (size_t)r * 1024; dst = p.memb + (size_t)r * 1024; rsd = p.rsmem + r; }
    float4 v[4]; float ss = 0.f;
#pragma unroll
    for (int i = 0; i < 4; ++i) { v[i] = reinterpret_cast<const float4*>(xr)[lane + 64 * i]; ss += v[i].x * v[i].x + v[i].y * v[i].y + v[i].z * v[i].z + v[i].w * v[i].w; }
    ss = wsum(ss);
    if (lane == 0) *rsd = rsqrtf(ss * (1.f / 1024.f) + EPS);
#pragma unroll
    for (int i = 0; i < 4; ++i) { u32x2 w = {cvtpk(v[i].x, v[i].y), cvtpk(v[i].z, v[i].w)}; reinterpret_cast<u32x2*>(dst)[lane + 64 * i] = w; }
  }
  for (int i = gtid; i < 8 * PAST * 64; i += gsz) {
    const int c8 = i & 63, pp = (i >> 6) & (PAST - 1), b = i >> 17;
    const float4* s = reinterpret_cast<const float4*>(p.in[5] + ((size_t)(b * PAST + pp) * 512 + c8 * 8));
    const float4 a = s[0], c = s[1];
    u32x4 w = {cvtpk(a.x, a.y), cvtpk(a.z, a.w), cvtpk(c.x, c.y), cvtpk(c.z, c.w)};
    *reinterpret_cast<u32x4*>(p.Ks + ((size_t)(b * SKP + pp) * 512 + c8 * 8)) = w;
    float ss = a.x * a.x + a.y * a.y + a.z * a.z + a.w * a.w + c.x * c.x + c.y * c.y + c.z * c.z + c.w * c.w;
    ss += __shfl_xor(ss, 1); ss += __shfl_xor(ss, 2); ss += __shfl_xor(ss, 4);
    ss = wmax(ss);
    if (lane == 0) atomicMax(reinterpret_cast<int*>(p.rsmem + 1024), __float_as_int(ss));
  }
  for (int i = gtid; i < 8 * 4 * 256 * 128; i += gsz) {
    const int dv = i & 127, p8 = (i >> 7) & 255, h = (i >> 15) & 3, b = i >> 17;
    float v[8];
#pragma unroll
    for (int j = 0; j < 8; ++j) v[j] = p.in[6][((size_t)(b * PAST + p8 * 8 + j) * 4 + h) * 128 + dv];
    u32x4 w = {cvtpk(v[0], v[1]), cvtpk(v[2], v[3]), cvtpk(v[4], v[5]), cvtpk(v[6], v[7])};
    *reinterpret_cast<u32x4*>(p.VsT + ((size_t)((b * 4 + h) * 128 + dv) * SKP + p8 * 8)) = w;
  }
  for (int i = gtid; i < 4096 * 4; i += gsz) {
    u32x4 z = {0, 0, 0, 0};
    *reinterpret_cast<u32x4*>(p.VsT + ((size_t)(i >> 2) * SKP + 2080 + (i & 3) * 8)) = z;
  }
  for (int i = gtid; i < 8 * 32 * 64; i += gsz) {
    u32x4 z = {0, 0, 0, 0};
    const int c8 = i & 63, r = (i >> 6) & 31, b = i >> 11;
    *reinterpret_cast<u32x4*>(p.Ks + ((size_t)(b * SKP + 2080 + r) * 512 + c8 * 8)) = z;
  }
  for (int i = gtid; i < 2 * 8 * 256 * 64; i += gsz) {
    const int c8 = i & 63, m = (i >> 6) & 255, b = (i >> 14) & 7, l = i >> 17;
    const float4* s = reinterpret_cast<const float4*>(p.in[3] + ((size_t)((l * 8 + b) * 256 + m) * 512 + c8 * 8));
    const float4 a = s[0], c = s[1];
    u32x4 w = {cvtpk(a.x, a.y), cvtpk(a.z, a.w), cvtpk(c.x, c.y), cvtpk(c.z, c.w)};
    *reinterpret_cast<u32x4*>(p.XK + ((size_t)((l * 12 + 4 + b) * 256 + m) * 512 + c8 * 8)) = w;
    float ss = a.x * a.x + a.y * a.y + a.z * a.z + a.w * a.w + c.x * c.x + c.y * c.y + c.z * c.z + c.w * c.w;
    ss += __shfl_xor(ss, 1); ss += __shfl_xor(ss, 2); ss += __shfl_xor(ss, 4); ss += __shfl_xor(ss, 8);
    ss = wmax(ss);
    if (lane == 0) atomicMax(reinterpret_cast<int*>(p.rsmem + 1025 + l), __float_as_int(ss));
  }
  for (int i = gtid; i < 2 * 8 * 4 * 32 * 128; i += gsz) {
    const int dv = i & 127, m8 = (i >> 7) & 31, h = (i >> 12) & 3, b = (i >> 14) & 7, l = i >> 17;
    float v[8];
#pragma unroll
    for (int j = 0; j < 8; ++j) v[j] = p.in[4][((size_t)((l * 8 + b) * 256 + m8 * 8 + j) * 4 + h) * 128 + dv];
    u32x4 w = {cvtpk(v[0], v[1]), cvtpk(v[2], v[3]), cvtpk(v[4], v[5]), cvtpk(v[6], v[7])};
    *reinterpret_cast<u32x4*>(p.XVT + ((size_t)(((l * 12 + 4 + b) * 4 + h) * 128 + dv) * 256 + m8 * 8)) = w;
  }
  for (int i = gtid; i < 32 * 16 * 128; i += gsz) {
    const int e = i & 127, d8 = (i >> 7) & 15, bh = i >> 11;
    float v[8];
#pragma unroll
    for (int j = 0; j < 8; ++j) v[j] = p.in[7][((size_t)bh * 128 + d8 * 8 + j) * 128 + e];
    u32x4 w = {cvtpk(v[0], v[1]), cvtpk(v[2], v[3]), cvtpk(v[4], v[5]), cvtpk(v[6], v[7])};
    *reinterpret_cast<u32x4*>(p.C0sT + ((size_t)bh * 128 + e) * 128 + d8 * 8) = w;
  }
  for (int i = gtid; i < NTOK; i += gsz) p.ssq1[i] = 0.f;
}

DEVI void gemm_core(LAS char* lds, const u16* A0, const u16* A1, const u16* A2, int lda0, int lda1, int lda2, int segK,
                    const u16* Bt, int K, int brow, int bcol, f32x4 (&acc)[4][4]) {
  const int tid = threadIdx.x, lane = tid & 63, wid = tid >> 6, wr = wid >> 1, wc = wid & 1, fr = lane & 15, fq = lane >> 4;
  LAS char* SA = lds; LAS char* SB = lds + 8192;
#pragma unroll
  for (int m = 0; m < 4; ++m)
#pragma unroll
    for (int n = 0; n < 4; ++n) acc[m][n] = f32x4{0.f, 0.f, 0.f, 0.f};
  const int nkt = K / 32;
  for (int kt = 0; kt < nkt; ++kt) {
    const int k0 = kt * 32;
    const int seg = k0 / segK;
    const u16* Ab = (seg == 0 ? A0 : (seg == 1 ? A1 : A2)) + (k0 - seg * segK);
    const int lda = (seg == 0 ? lda0 : (seg == 1 ? lda1 : lda2));
#pragma unroll
    for (int i = 0; i < 2; ++i) {
      const int b = tid * 16 + i * 4096, r = b >> 6, c = (b & 63) >> 1;
      glds16(Ab + (size_t)(brow + r) * lda + c, SA + b);
      glds16(Bt + (size_t)(bcol + r) * K + k0 + c, SB + b);
    }
    asm volatile("s_waitcnt vmcnt(0)" ::: "memory");
    __syncthreads();
    bf16x8 af[4], bfr[4];
#pragma unroll
    for (int m = 0; m < 4; ++m) af[m] = *reinterpret_cast<const LAS bf16x8*>(SA + (wr * 64 + m * 16 + fr) * 64 + fq * 16);
#pragma unroll
    for (int n = 0; n < 4; ++n) bfr[n] = *reinterpret_cast<const LAS bf16x8*>(SB + (wc * 64 + n * 16 + fr) * 64 + fq * 16);
#pragma unroll
    for (int m = 0; m < 4; ++m)
#pragma unroll
      for (int n = 0; n < 4; ++n) acc[m][n] = __builtin_amdgcn_mfma_f32_16x16x32_bf16(af[m], bfr[n], acc[m][n], 0, 0, 0);
    __syncthreads();
  }
}

DEVI void gemm_stage_c(LAS char* lds, const f32x4 (&acc)[4][4], const float* rowscale, int mode, int brow) {
  const int tid = threadIdx.x, lane = tid & 63, wid = tid >> 6, wr = wid >> 1, wc = wid & 1, fr = lane & 15, fq = lane >> 4;
  LAS float* Cs = (LAS float*)lds;
#pragma unroll
  for (int m = 0; m < 4; ++m)
#pragma unroll
    for (int j = 0; j < 4; ++j) {
      const int r = wr * 64 + m * 16 + fq * 4 + j;
      float s = 1.f;
      if (mode == 1) s = rowscale[brow + r];
      else if (mode == 2) s = rsqrtf(rowscale[brow + r] * (1.f / 1024.f) + EPS);
#pragma unroll
      for (int n = 0; n < 4; ++n) Cs[r * 132 + wc * 64 + n * 16 + fr] = acc[m][n][j] * s;
    }
  __syncthreads();
}

DEVI void st_bf8(u16* dst, const float (&v)[8]) {
  u32x4 w = {cvtpk(v[0], v[1]), cvtpk(v[2], v[3]), cvtpk(v[4], v[5]), cvtpk(v[6], v[7])};
  *reinterpret_cast<u32x4*>(dst) = w;
}
DEVI void st_f8(float* dst, const float (&v)[8]) {
  reinterpret_cast<float4*>(dst)[0] = float4{v[0], v[1], v[2], v[3]};
  reinterpret_cast<float4*>(dst)[1] = float4{v[4], v[5], v[6], v[7]};
}
DEVI void store_transposed(LAS char* lds, u16* dst, size_t ldt, float scale) {
  const LAS float* Cs = (const LAS float*)lds;
  const int c = threadIdx.x & 127, rh = (threadIdx.x >> 7) * 64;
#pragma unroll
  for (int it = 0; it < 8; ++it) {
    const int r0 = rh + it * 8;
    float v[8];
#pragma unroll
    for (int j = 0; j < 8; ++j) v[j] = Cs[(r0 + j) * 132 + c] * scale;
    st_bf8(dst + (size_t)c * ldt + r0, v);
  }
}

__device__ void epi_in_a(const Params& p, LAS char* lds, int brow, int n) {
  const LAS float* Cs = (const LAS float*)lds;
  const int tid = threadIdx.x, cgp = tid & 15, c0 = cgp * 8;
  const bool samp = brow >= NTOKP;
  const int seg = n >> 2, hd = n & 3;
  if (n >= 4 && n < 12) {
    u16* base = (n < 8 ? p.KaT : p.VaT);
    const float sc = (n < 8 ? 0.08838834764831845f : 1.f);
    if (!samp) { const int b = brow >> 13, t0 = brow & 8191; store_transposed(lds, base + ((size_t)(b * 4 + hd) * 128) * SEQ + t0, SEQ, sc); }
    else {
      const int c = tid & 127, rh = (tid >> 7) * 64;
#pragma unroll
      for (int it = 0; it < 8; ++it) {
        const int r0 = rh + it * 8; const int bs = ((brow - NTOKP) + r0) >> 5, t0 = r0 & 31;
        float v[8];
#pragma unroll
        for (int j = 0; j < 8; ++j) v[j] = Cs[(r0 + j) * 132 + c] * sc;
        st_bf8(base + (size_t)NTOKP * 512 + ((size_t)(bs * 4 + hd) * 128 + c) * 32 + t0, v);
      }
    }
  }
  if (seg == 7) {
    if (!samp) { const int b = brow >> 13, t0 = brow & 8191; store_transposed(lds, p.VbT + ((size_t)(b * 4 + hd) * 128) * SEQ + t0, SEQ, 1.f); }
    else {
      const int c = tid & 127, rh = (tid >> 7) * 64;
#pragma unroll
      for (int it = 0; it < 8; ++it) {
        const int r0 = rh + it * 8; const int bs = ((brow - NTOKP) + r0) >> 5, t0 = r0 & 31;
        float v[8];
#pragma unroll
        for (int j = 0; j < 8; ++j) v[j] = Cs[(r0 + j) * 132 + c];
        st_bf8(p.VsT + ((size_t)(bs * 4 + hd) * 128 + c) * SKP + PAST + t0, v);
      }
    }
  }
#pragma unroll 1
  for (int it = 0; it < 8; ++it) {
    const int r = it * 16 + (tid >> 4);
    const size_t grow = (size_t)brow + r;
    float v[8];
#pragma unroll
    for (int j = 0; j < 8; ++j) v[j] = Cs[r * 132 + c0 + j];
    if (n < 4) { st_bf8(p.Qa + grow * 512 + hd * 128 + c0, v); }
    else if (n < 8) {
#pragma unroll
      for (int j = 0; j < 8; ++j) v[j] *= 0.08838834764831845f;
      st_bf8(p.Ka + grow * 512 + hd * 128 + c0, v);
    }
    else if (n < 12) {   }
    else if (n < 20) {
      if (cgp < 8) {
        float g[8];
#pragma unroll
        for (int j = 0; j < 8; ++j) g[j] = sigmoidf_(v[j]) * siluf_(Cs[r * 132 + 64 + c0 + j]);
        st_bf8(p.Ga + grow * 512 + (n - 12) * 64 + c0, g);
      }
    }
    else if (n < 28) {
      float ss = 0.f;
#pragma unroll
      for (int j = 0; j < 8; ++j) ss += v[j] * v[j];
      ss += __shfl_xor(ss, 1); ss += __shfl_xor(ss, 2); ss += __shfl_xor(ss, 4);
      const float rs = rsqrtf(ss * (1.f / 64.f) + EPS);
      const float* g = (n < 24 ? p.in[16] : p.in[17]) + (c0 & 63);
      if (n < 24) {
#pragma unroll
        for (int j = 0; j < 8; ++j) v[j] = v[j] * rs * g[j] * (0.125f * LOG2E);
        st_bf8(p.Qb + grow * 512 + hd * 128 + c0, v);
      } else {
#pragma unroll
        for (int j = 0; j < 8; ++j) v[j] = v[j] * rs * g[j];
        if (!samp) { st_f8(p.out + O_PK + grow * 512 + hd * 128 + c0, v); st_bf8(p.Kb + grow * 512 + hd * 128 + c0, v); }
        else {
          const int sr = (int)grow - NTOKP, bs = sr >> 5, t = sr & 31;
          st_f8(p.out + O_SK + (size_t)sr * 512 + hd * 128 + c0, v);
          st_bf8(p.Ks + ((size_t)(bs * SKP + PAST + t)) * 512 + hd * 128 + c0, v);
        }
      }
    }
    else if (n < 32) {
      if (!samp) st_f8(p.out + O_PV + grow * 512 + hd * 128 + c0, v);
      else st_f8(p.out + O_SV + (size_t)((int)grow - NTOKP) * 512 + hd * 128 + c0, v);
    }
    else if (n < 36) {
#pragma unroll
      for (int j = 0; j < 8; ++j) v[j] = siluf_(v[j]);
      st_bf8(p.Gb + grow * 512 + hd * 128 + c0, v);
    }
    else if (n < 40) {
      float ss = 0.f;
#pragma unroll
      for (int j = 0; j < 8; ++j) ss += v[j] * v[j];
      ss += __shfl_xor(ss, 1); ss += __shfl_xor(ss, 2); ss += __shfl_xor(ss, 4); ss += __shfl_xor(ss, 8);
      const float rs = rsqrtf(ss * (1.f / 128.f) + EPS);
      const float* g = p.in[32] + c0;
#pragma unroll
      for (int j = 0; j < 8; ++j) v[j] = v[j] * rs * g[j] * (0.08838834764831845f * LOG2E);
      st_bf8(p.Qx + grow * 512 + hd * 128 + c0, v);
    }
    else if (n < 44) {
#pragma unroll
      for (int j = 0; j < 8; ++j) v[j] = siluf_(v[j]);
      st_bf8(p.Gx + grow * 512 + hd * 128 + c0, v);
    }
    else {
      if (cgp == 0) {
        float g[8];
#pragma unroll
        for (int j = 0; j < 4; ++j) { g[j] = v[j] + p.in[13][j]; g[4 + j] = logsigmoidf_(v[4 + j] + p.in[14][j]); }
        st_f8(p.gates + grow * 8, g);
      }
    }
  }
}

__device__ void epi_mem(const Params& p, LAS char* lds, int l, int brow, int n) {
  const LAS float* Cs = (const LAS float*)lds;
  const int tid = threadIdx.x, cgp = tid & 15, c0 = cgp * 8;
  const int hd = n & 3;
  if (n >= 4) {
    const int b = brow >> 8, m0 = brow & 255;
    store_transposed(lds, p.XVT + ((size_t)((l * 12 + b) * 4 + hd) * 128) * 256 + m0, 256, 1.f);
  }
#pragma unroll 1
  for (int it = 0; it < 8; ++it) {
    const int r = it * 16 + (tid >> 4);
    const size_t grow = (size_t)brow + r;
    float v[8];
#pragma unroll
    for (int j = 0; j < 8; ++j) v[j] = Cs[r * 132 + c0 + j];
    if (n < 4) {
      float ss = 0.f;
#pragma unroll
      for (int j = 0; j < 8; ++j) ss += v[j] * v[j];
      ss += __shfl_xor(ss, 1); ss += __shfl_xor(ss, 2); ss += __shfl_xor(ss, 4); ss += __shfl_xor(ss, 8);
      const float rs = rsqrtf(ss * (1.f / 128.f) + EPS);
      const float* g = p.in[33] + l * 128 + c0;
#pragma unroll
      for (int j = 0; j < 8; ++j) v[j] = v[j] * rs * g[j];
      st_f8(p.out + O_PXK + ((size_t)l * 1024 + grow) * 512 + hd * 128 + c0, v);
      const int b = (int)grow >> 8, m = (int)grow & 255;
      st_bf8(p.XK + ((size_t)((l * 12 + b) * 256 + m)) * 512 + hd * 128 + c0, v);
    } else {
      st_f8(p.out + O_PXV + ((size_t)l * 1024 + grow) * 512 + hd * 128 + c0, v);
    }
  }
}

__device__ void epi_out(const Params& p, LAS char* lds, int layer, int brow, int n) {
  const LAS float* Cs = (const LAS float*)lds;
  const int tid = threadIdx.x, cgp = tid & 15, c0 = cgp * 8;
#pragma unroll 1
  for (int it = 0; it < 8; ++it) {
    const int r = it * 16 + (tid >> 4);
    const size_t grow = (size_t)brow + r;
    const float* res;
    if (layer == 0) res = (grow < NTOKP ? p.in[0] + grow * 1024 : p.in[1] + (grow - NTOKP) * 1024) + n * 128 + c0;
    else res = p.out + grow * 1024 + n * 128 + c0;
    const float4 ra = reinterpret_cast<const float4*>(res)[0], rb = reinterpret_cast<const float4*>(res)[1];
    float v[8];
#pragma unroll
    for (int j = 0; j < 8; ++j) v[j] = Cs[r * 132 + c0 + j];
    v[0] += ra.x; v[1] += ra.y; v[2] += ra.z; v[3] += ra.w; v[4] += rb.x; v[5] += rb.y; v[6] += rb.z; v[7] += rb.w;
    st_f8(p.out + grow * 1024 + n * 128 + c0, v);
    if (layer == 0) {
      st_bf8(p.xb + grow * 1024 + n * 128 + c0, v);
      float ss = 0.f;
#pragma unroll
      for (int j = 0; j < 8; ++j) ss += v[j] * v[j];
      ss += __shfl_xor(ss, 1); ss += __shfl_xor(ss, 2); ss += __shfl_xor(ss, 4); ss += __shfl_xor(ss, 8);
      if (cgp == 0) atomicAdd(p.ssq1 + grow, ss);
    }
  }
}

__device__ void epi_in_c(const Params& p, LAS char* lds, int brow, int n) {
  const LAS float* Cs = (const LAS float*)lds;
  const int tid = threadIdx.x, cgp = tid & 15, c0 = cgp * 8;
  u16* U = p.Qa;
  u16* Gc = p.KaT;
#pragma unroll 1
  for (int it = 0; it < 8; ++it) {
    const int r = it * 16 + (tid >> 4);
    const size_t grow = (size_t)brow + r;
    float v[8];
#pragma unroll
    for (int j = 0; j < 8; ++j) v[j] = Cs[r * 132 + c0 + j];
    if (n < 16) {
      if (cgp < 8) {
        float u[8];
#pragma unroll
        for (int j = 0; j < 8; ++j) u[j] = v[j] * sigmoidf_(Cs[r * 132 + 64 + c0 + j]);
        st_bf8(U + grow * 1024 + n * 64 + c0, u);
        if (grow < NTOKP) { const int t = (int)grow & 8191, b = (int)grow >> 13; if (t >= SEQ - 30) st_f8(p.out + O_PCONV + ((size_t)(b * 30 + t - (SEQ - 30))) * 1024 + n * 64 + c0, u); }
        else { const int sr = (int)grow - NTOKP, t = sr & 31, b = sr >> 5; if (t >= 2) st_f8(p.out + O_SCONV + ((size_t)(b * 30 + t - 2)) * 1024 + n * 64 + c0, u); }
      }
    } else if (n < 24) {
#pragma unroll
      for (int j = 0; j < 8; ++j) v[j] = siluf_(v[j]);
      st_bf8(Gc + grow * 1024 + (n - 16) * 128 + c0, v);
    } else if (n < 28) {
      float ss = 0.f;
#pragma unroll
      for (int j = 0; j < 8; ++j) ss += v[j] * v[j];
      ss += __shfl_xor(ss, 1); ss += __shfl_xor(ss, 2); ss += __shfl_xor(ss, 4); ss += __shfl_xor(ss, 8);
      const float rs = rsqrtf(ss * (1.f / 128.f) + EPS);
      const float* g = p.in[32] + 128 + c0;
#pragma unroll
      for (int j = 0; j < 8; ++j) v[j] = v[j] * rs * g[j] * (0.08838834764831845f * LOG2E);
      st_bf8(p.Qx + grow * 512 + (n - 24) * 128 + c0, v);
    } else {
#pragma unroll
      for (int j = 0; j < 8; ++j) v[j] = siluf_(v[j]);
      st_bf8(p.Gx + grow * 512 + (n - 28) * 128 + c0, v);
    }
  }
}

DEVI bool tile_map(int q, int xcd, int nM, int nN, int& m, int& n) {
  const int per_group = 8 * nN;
  const int gi = q / per_group;
  const int g = xcd + 8 * gi;
  if (g * 8 >= nM) return false;
  const int gm = min(8, nM - 8 * g);
  const int r = q - gi * per_group;
  if (r >= gm * nN) return false;
  const int nc = r / (gm * 8);
  const int rr = r - nc * gm * 8;
  const int ncnt = min(8, nN - 8 * nc);
  const int mi = rr / ncnt, ni = rr - mi * ncnt;
  m = 8 * g + mi; n = 8 * nc + ni;
  return true;
}

__device__ void phase_gemm(const Params& p, LAS char* lds, int which) {
  const int nM = NTOK / 128;
  const int nN = (which == 0 ? 45 : (which == 2 ? 32 : 8));
  const int nx = gridDim.x >> 3;
  const int xcd = blockIdx.x & 7, lb = blockIdx.x >> 3;
  f32x4 acc[4][4];
  if ((int)blockIdx.x < nx * 8) {
    for (int q = lb;; q += nx) {
      int m, n;
      if (!tile_map(q, xcd, nM, nN, m, n)) {
        break;
      }
      const int brow = m * 128, bcol = n * 128;
      if (which == 0) {
        gemm_core(lds, p.xb, p.xb, p.xb, 1024, 1024, 1024, 1024, p.WtInA, 1024, brow, bcol, acc);
        gemm_stage_c(lds, acc, p.rs0, 1, brow);
        epi_in_a(p, lds, brow, n);
      } else if (which == 1) {
        gemm_core(lds, p.Ga, p.Gb, p.Gx, 512, 512, 512, 512, p.WtOutA, 1536, brow, bcol, acc);
        gemm_stage_c(lds, acc, nullptr, 0, brow);
        epi_out(p, lds, 0, brow, n);
      } else if (which == 2) {
        gemm_core(lds, p.xb, p.xb, p.xb, 1024, 1024, 1024, 1024, p.WtInC, 1024, brow, bcol, acc);
        gemm_stage_c(lds, acc, p.ssq1, 2, brow);
        epi_in_c(p, lds, brow, n);
      } else {
        gemm_core(lds, p.KaT, p.KaT + 512, p.Gx, 1024, 1024, 512, 512, p.WtOutC, 1536, brow, bcol, acc);
        gemm_stage_c(lds, acc, nullptr, 0, brow);
        epi_out(p, lds, 1, brow, n);
      }
      __syncthreads();
    }
  }
  if (which == 0) {
    for (int t = blockIdx.x; t < 2 * 8 * 8; t += gridDim.x) {
      const int l = t >> 6, m = (t >> 3) & 7, n = t & 7;
      gemm_core(lds, p.memb, p.memb, p.memb, 1024, 1024, 1024, 1024, p.WtMem + (size_t)l * 1024 * 1024, 1024, m * 128, n * 128, acc);
      gemm_stage_c(lds, acc, p.rsmem, 1, m * 128);
      epi_mem(p, lds, l, m * 128, n);
      __syncthreads();
    }
  }
}

template <bool DIFF>
DEVI void attn_block(LAS char* lds, const u16* Q, const u16* Kg, const u16* VT, int ldv, int ntiles, int nwact,
                           int qpos0, int nkeys, float slope2, float M2, float lam, const float* subg, u16* G) {
  const int tid = threadIdx.x, lane = tid & 63, w = tid >> 6, r = lane & 31, h = lane >> 5;
  const bool act = w < nwact;
  const int qpos = qpos0 + 32 * w + r;
  const int cw = (qpos0 + 32 * w) >> 6;
  bf16x8 qf[8];
#pragma unroll
  for (int i = 0; i < 8; ++i) qf[i] = ldg8(Q + (size_t)(32 * w + r) * 512 + 16 * i + 8 * h);
  f32x16 O0[4], O1[4];
#pragma unroll
  for (int e = 0; e < 4; ++e)
#pragma unroll
    for (int i = 0; i < 16; ++i) { O0[e][i] = 0.f; O1[e][i] = 0.f; }
  float l0 = 0.f, l1 = 0.f;
  f32x16 cinit, zero16;
#pragma unroll
  for (int i = 0; i < 16; ++i) { cinit[i] = slope2 * (float)klocal(i, h); zero16[i] = 0.f; }
  const float tq = -slope2 * (float)qpos - M2;
  const int prow = pi32(r);

  auto stage = [&](int j, int buf) {
    LAS char* kb = lds + buf * 32768;
#pragma unroll
    for (int i = 0; i < 4; ++i) {
      const int pch = i * 256 + tid;
      { const int row = pch >> 4, ph = pch & 15, lg = ph ^ (row & 15);
        glds16(Kg + (size_t)(j * 64 + row) * 512 + lg * 8, kb + pch * 16); }
      { const int row = pch >> 3, ph = pch & 7, lg = ph ^ ((row >> 1) & 7);
        glds16(VT + (size_t)row * ldv + j * 64 + lg * 8, kb + 16384 + pch * 16); }
    }
  };
  __syncthreads();
  stage(0, 0);
  asm volatile("s_waitcnt vmcnt(0)" ::: "memory");
  __syncthreads();
  for (int j = 0; j < ntiles; ++j) {
    const int buf = j & 1;
    if (j + 1 < ntiles) stage(j + 1, buf ^ 1);
    {
      const LAS char* kb = lds + buf * 32768;
      const LAS char* vb = kb + 16384;
      const bool fast = DIFF && (j < cw);
#pragma unroll
      for (int kt = 0; kt < 2; ++kt) {
        const int krow = 32 * kt + prow;
        const LAS char* krp = kb + krow * 256;
        bf16x8 P0[2], P1[2];
        if (DIFF) {
#pragma unroll
          for (int c = 0; c < 2; ++c) {
            f32x16 s;
            if (fast) {
              s = cinit;
#pragma unroll
              for (int ks = 0; ks < 4; ++ks) {
                const int ch = (2 * (4 * c + ks) + h) ^ (krow & 15);
                s = mfma32(*reinterpret_cast<const LAS bf16x8*>(krp + ch * 16), qf[4 * c + ks], s);
              }
              const float t = tq + slope2 * (float)(j * 64 + kt * 32);
#pragma unroll
              for (int i = 0; i < 16; ++i) s[i] = __builtin_amdgcn_exp2f(s[i] + t);
            } else {
              s = zero16;
#pragma unroll
              for (int ks = 0; ks < 4; ++ks) {
                const int ch = (2 * (4 * c + ks) + h) ^ (krow & 15);
                s = mfma32(*reinterpret_cast<const LAS bf16x8*>(krp + ch * 16), qf[4 * c + ks], s);
              }
#pragma unroll
              for (int i = 0; i < 16; ++i) {
                const int kp = j * 64 + kt * 32 + klocal(i, h);
                const float bias = -slope2 * fabsf((float)(qpos - kp)) - M2;
                s[i] = (kp < nkeys && j <= cw) ? __builtin_amdgcn_exp2f(s[i] + bias) : 0.f;
              }
            }
            float ls = 0.f;
#pragma unroll
            for (int i = 0; i < 16; ++i) ls += s[i];
            if (c == 0) { l0 += ls; P0[0] = pack8(s, 0); P0[1] = pack8(s, 1); }
            else        { l1 += ls; P1[0] = pack8(s, 0); P1[1] = pack8(s, 1); }
          }
        } else {
          f32x16 s = zero16;
#pragma unroll
          for (int ks = 0; ks < 8; ++ks) {
            const int ch = (2 * ks + h) ^ (krow & 15);
            s = mfma32(*reinterpret_cast<const LAS bf16x8*>(krp + ch * 16), qf[ks], s);
          }
          float ls = 0.f;
#pragma unroll
          for (int i = 0; i < 16; ++i) { s[i] = __builtin_amdgcn_exp2f(s[i] - M2); ls += s[i]; }
          l0 += ls; P0[0] = pack8(s, 0); P0[1] = pack8(s, 1);
        }
#pragma unroll
        for (int et = 0; et < 4; ++et) {
          const int vrow = 32 * et + r;
#pragma unroll
          for (int sp = 0; sp < 2; ++sp) {
            const int ch = (2 * (2 * kt + sp) + h) ^ ((vrow >> 1) & 7);
            const bf16x8 vf = *reinterpret_cast<const LAS bf16x8*>(vb + vrow * 128 + ch * 16);
            O0[et] = mfma32(vf, P0[sp], O0[et]);
            if (DIFF) O1[et] = mfma32(vf, P1[sp], O1[et]);
          }
        }
      }
    }
    asm volatile("s_waitcnt vmcnt(0)" ::: "memory");
    __syncthreads();
  }
  if (act) {
    l0 += __shfl_xor(l0, 32);
    const float i0 = 1.f / l0;
    float i1 = 0.f;
    if (DIFF) { l1 += __shfl_xor(l1, 32); i1 = lam / l1; }
    float ss = 0.f;
#pragma unroll
    for (int et = 0; et < 4; ++et)
#pragma unroll
      for (int i = 0; i < 16; ++i) {
        float o = O0[et][i] * i0;
        if (DIFF) o -= O1[et][i] * i1;
        O0[et][i] = o; ss += o * o;
      }
    float rs = 1.f;
    if (DIFF) { ss += __shfl_xor(ss, 32); rs = rsqrtf(ss * (1.f / 128.f) + EPS) * 0.8f; }
    u16* grow = G + (size_t)(32 * w + r) * 512;
#pragma unroll
    for (int et = 0; et < 4; ++et)
#pragma unroll
      for (int g = 0; g < 4; ++g) {
        const int e0 = 32 * et + 8 * g + 4 * h;
        const u32x2 gt = *reinterpret_cast<const u32x2*>(grow + e0);
        float sg0 = 1.f, sg1 = 1.f, sg2 = 1.f, sg3 = 1.f;
        if (DIFF) { const float4 sv = *reinterpret_cast<const float4*>(subg + e0); sg0 = sv.x; sg1 = sv.y; sg2 = sv.z; sg3 = sv.w; }
        const float a0 = O0[et][4 * g + 0] * rs * sg0 * bflo(gt[0]);
        const float a1 = O0[et][4 * g + 1] * rs * sg1 * bfhi(gt[0]);
        const float a2 = O0[et][4 * g + 2] * rs * sg2 * bflo(gt[1]);
        const float a3 = O0[et][4 * g + 3] * rs * sg3 * bfhi(gt[1]);
        u32x2 o = {cvtpk(a0, a1), cvtpk(a2, a3)};
        *reinterpret_cast<u32x2*>(grow + e0) = o;
      }
  }
}

DEVI float max_abs64(const float* g, int n, int lane) { float v = 0.f; for (int i = lane; i < n; i += 64) v = fmaxf(v, fabsf(g[i])); return wmax(v); }

DEVI float scan_add(float v, int lane) { for (int o = 1; o < 64; o <<= 1) { const float t = __shfl_up(v, o); if (lane >= o) v += t; } return v; }
DEVI float scan_max(float v, int lane) { for (int o = 1; o < 64; o <<= 1) { const float t = __shfl_up(v, o); if (lane >= o) v = fmaxf(v, t); } return v; }
DEVI float bfe(const bf16x8& v, int j) { return __uint_as_float(((unsigned)(u16)v[j]) << 16); }

template <int NT>
__device__ void mlstm_local(LAS char* lds, const float* gates, int hd, const u16* KT, const u16* VT, int ldt,
                            f32x16 (&acc)[4], float& nh, float& bL, float& amax) {
  const int tid = threadIdx.x, lane = tid & 63, w = tid >> 6, r = lane & 31, h = lane >> 5;
  constexpr int L = 32 * NT;
  const float lf = lane < L ? gates[lane * 8 + 4 + hd] : 0.f;
  const float ig = lane < L ? gates[lane * 8 + hd] : -INFINITY;
  const float b = scan_add(lf, lane);
  const float a = ig - b;
  amax = wmax(a);
  bL = __shfl(b, L - 1);
  LAS float* wt = (LAS float*)(lds + 4096) + w * 64;
  wt[lane] = __expf(a - amax);
#pragma unroll
  for (int e = 0; e < 4; ++e)
#pragma unroll
    for (int i = 0; i < 16; ++i) acc[e][i] = 0.f;
  nh = 0.f;
#pragma unroll
  for (int ks = 0; ks < 2 * NT; ++ks) {
    const bf16x8 kf = ldg8(KT + (size_t)(32 * w + r) * ldt + 16 * ks + 8 * h);
    float wv[8];
#pragma unroll
    for (int j = 0; j < 8; ++j) { wv[j] = wt[16 * ks + 8 * h + j]; nh += bfe(kf, j) * wv[j]; }
#pragma unroll
    for (int et = 0; et < 4; ++et) {
      const bf16x8 vf = ldg8(VT + (size_t)(32 * et + r) * ldt + 16 * ks + 8 * h);
      u32x4 sv = {cvtpk(bfe(vf, 0) * wv[0], bfe(vf, 1) * wv[1]), cvtpk(bfe(vf, 2) * wv[2], bfe(vf, 3) * wv[3]),
                  cvtpk(bfe(vf, 4) * wv[4], bfe(vf, 5) * wv[5]), cvtpk(bfe(vf, 6) * wv[6], bfe(vf, 7) * wv[7])};
      acc[et] = mfma32(kf, *reinterpret_cast<bf16x8*>(&sv), acc[et]);
    }
  }
  nh += __shfl_xor(nh, 32);
}

template <int NT>
__device__ void mlstm_out(LAS char* lds, const float* gates, int hd, const u16* Qg, const u16* Kg, const u16* VT, int ldv,
                          const u16* CT, const float* n0, float m0, const float* mg, u16* G) {
  const int tid = threadIdx.x, lane = tid & 63, w = tid >> 6, r = lane & 31, h = lane >> 5;
  constexpr int L = 32 * NT;
  const float lf = lane < L ? gates[lane * 8 + 4 + hd] : 0.f;
  const float ig = lane < L ? gates[lane * 8 + hd] : -INFINITY;
  const float b = scan_add(lf, lane);
  const float a = ig - b;
  const float Mrow = fmaxf(m0, scan_max(a, lane));
  const float mt = b + Mrow;
  LAS float* at = (LAS float*)lds + w * 64;
  LAS float* red = (LAS float*)(lds + 1024);
  at[lane] = a;
  const int prow = pi32(r);
#pragma unroll 1
  for (int tt = 0; tt < NT; ++tt) {
    const int t = 32 * tt + r;
    const float Mrow_t = __shfl(Mrow, t), mt_t = __shfl(mt, t);
    const float winter = __expf(m0 - Mrow_t);
    bf16x8 qf[8];
    float qn = 0.f;
#pragma unroll
    for (int i = 0; i < 8; ++i) {
      qf[i] = ldg8(Qg + (size_t)t * 512 + 16 * i + 8 * h);
      const float4 na = *reinterpret_cast<const float4*>(n0 + 16 * i + 8 * h), nb = *reinterpret_cast<const float4*>(n0 + 16 * i + 8 * h + 4);
      qn += bfe(qf[i], 0) * na.x + bfe(qf[i], 1) * na.y + bfe(qf[i], 2) * na.z + bfe(qf[i], 3) * na.w
          + bfe(qf[i], 4) * nb.x + bfe(qf[i], 5) * nb.y + bfe(qf[i], 6) * nb.z + bfe(qf[i], 7) * nb.w;
    }
    qn += __shfl_xor(qn, 32);
    f32x16 H;
#pragma unroll
    for (int i = 0; i < 16; ++i) H[i] = 0.f;
#pragma unroll
    for (int ks = 0; ks < 8; ++ks) H = mfma32(ldg8(CT + (size_t)(32 * w + r) * 128 + 16 * ks + 8 * h), qf[ks], H);
#pragma unroll
    for (int i = 0; i < 16; ++i) H[i] *= winter;
    float dsum = 0.f;
    for (int st = 0; st <= tt; ++st) {
      f32x16 S;
#pragma unroll
      for (int i = 0; i < 16; ++i) S[i] = 0.f;
#pragma unroll
      for (int ks = 0; ks < 8; ++ks) S = mfma32(ldg8(Kg + (size_t)(32 * st + prow) * 512 + 16 * ks + 8 * h), qf[ks], S);
#pragma unroll
      for (int i = 0; i < 16; ++i) {
        const int s = 32 * st + klocal(i, h);
        const float wg = (s <= t) ? __expf(at[s] - Mrow_t) : 0.f;
        S[i] *= wg; dsum += S[i];
      }
#pragma unroll
      for (int sp = 0; sp < 2; ++sp)
        H = mfma32(ldg8(VT + (size_t)(32 * w + r) * ldv + 32 * st + 16 * sp + 8 * h), pack8(S, sp), H);
    }
    dsum += __shfl_xor(dsum, 32);
    const float den = winter * qn + dsum;
    const float inv = 1.f / fmaxf(fabsf(den), __expf(-mt_t));
    float ss = 0.f;
#pragma unroll
    for (int i = 0; i < 16; ++i) { H[i] *= inv; ss += H[i] * H[i]; }
    ss += __shfl_xor(ss, 32);
    if (h == 0) red[w * 64 + t] = ss;
    __syncthreads();
    const float tot = red[t] + red[64 + t] + red[128 + t] + red[192 + t];
    const float rs = rsqrtf(tot * (1.f / 128.f) + EPS);
    u16* grow = G + (size_t)t * 512;
#pragma unroll
    for (int g = 0; g < 4; ++g) {
      const int e0 = 32 * w + 8 * g + 4 * h;
      const u32x2 gt = *reinterpret_cast<const u32x2*>(grow + e0);
      const float4 mv = *reinterpret_cast<const float4*>(mg + e0);
      u32x2 o = {cvtpk(H[4 * g + 0] * rs * mv.x * bflo(gt[0]), H[4 * g + 1] * rs * mv.y * bfhi(gt[0])),
                 cvtpk(H[4 * g + 2] * rs * mv.z * bflo(gt[1]), H[4 * g + 3] * rs * mv.w * bfhi(gt[1]))};
      *reinterpret_cast<u32x2*>(grow + e0) = o;
    }
    __syncthreads();
  }
}

__device__ void m1_item(const Params& p, LAS char* lds, int item) {
  const int tid = threadIdx.x, lane = tid & 63, w = tid >> 6, r = lane & 31, h = lane >> 5;
  const int bh = item >> 7, c = item & 127, b = bh >> 2, hd = bh & 3;
  const size_t row0 = (size_t)b * SEQ + c * 64;
  f32x16 acc[4]; float nh, bL, amax;
  __syncthreads();
  mlstm_local<2>(lds, p.gates + row0 * 8, hd, p.KaT + (size_t)bh * 128 * SEQ + c * 64, p.VaT + (size_t)bh * 128 * SEQ + c * 64, SEQ, acc, nh, bL, amax);
  u16* Chat = p.xb + ((size_t)item * 128) * 128;
#pragma unroll
  for (int et = 0; et < 4; ++et)
#pragma unroll
    for (int g = 0; g < 4; ++g) {
      const int d0 = 32 * w + 8 * g + 4 * h, e = 32 * et + r;
      u32x2 o = {cvtpk(acc[et][4 * g], acc[et][4 * g + 1]), cvtpk(acc[et][4 * g + 2], acc[et][4 * g + 3])};
      *reinterpret_cast<u32x2*>(Chat + (size_t)e * 128 + d0) = o;
    }
  if (h == 0) p.nhat[(size_t)item * 128 + 32 * w + r] = nh;
  if (tid == 0) { p.tabA[item] = bL; p.tabB[item] = bL + amax; }
}

__device__ void phase_scan(const Params& p, LAS char* lds) {
  const int tid = threadIdx.x, lane = tid & 63;
  LAS float* al = (LAS float*)lds; LAS float* be = al + 128; LAS float* ms = al + 256;
  for (int u = blockIdx.x; u < 16 * 32; u += gridDim.x) {
    const int bh = u >> 5, part = u & 31;
    __syncthreads();
    if (tid < 64) {
      const float A0 = p.tabA[bh * 128 + 2 * lane], A1 = p.tabA[bh * 128 + 2 * lane + 1];
      const float B0 = p.tabB[bh * 128 + 2 * lane], B1 = p.tabB[bh * 128 + 2 * lane + 1];
      const float SAi = scan_add(A0 + A1, lane);
      const float SA0 = SAi - A1, SA1 = SAi;
      const float D0 = B0 - SA0, D1 = B1 - SA1;
      const float PMi = scan_max(fmaxf(D0, D1), lane);
      float PMx = __shfl_up(PMi, 1); if (lane == 0) PMx = -INFINITY;
      const float mn0 = SA0 + fmaxf(0.f, fmaxf(PMx, D0));
      const float mn1 = SA1 + fmaxf(0.f, PMi);
      float mprev = __shfl_up(mn1, 1); if (lane == 0) mprev = 0.f;
      al[2 * lane] = __expf(A0 + mprev - mn0); be[2 * lane] = __expf(B0 - mn0);
      al[2 * lane + 1] = __expf(A1 + mn0 - mn1); be[2 * lane + 1] = __expf(B1 - mn1);
      ms[2 * lane] = mprev; ms[2 * lane + 1] = mn0;
      if (lane == 63) ms[128] = mn1;
    }
    __syncthreads();
    if (part == 0) {
      if (tid < 129) p.mtab[bh * 129 + tid] = ms[tid];
      if (tid == 0) p.out[O_PM + bh] = ms[128];
    }
    u16* base = p.xb + (size_t)bh * 128 * 16384 + part * 512 + tid * 2;
    float c0 = 0.f, c1 = 0.f;
    for (int c = 0; c < 128; c += 8) {
      unsigned v[8];
#pragma unroll
      for (int j = 0; j < 8; ++j) v[j] = *reinterpret_cast<const unsigned*>(base + (size_t)(c + j) * 16384);
#pragma unroll
      for (int j = 0; j < 8; ++j) {
        *reinterpret_cast<unsigned*>(base + (size_t)(c + j) * 16384) = cvtpk(c0, c1);
        const float a_ = al[c + j], b_ = be[c + j];
        c0 = a_ * c0 + b_ * bflo(v[j]); c1 = a_ * c1 + b_ * bfhi(v[j]);
      }
    }
    { const int idx = part * 512 + tid * 2, e = idx >> 7, d = idx & 127;
      p.out[O_PC + ((size_t)bh * 128 + d) * 128 + e] = c0;
      p.out[O_PC + ((size_t)bh * 128 + d + 1) * 128 + e] = c1; }
    if (part == 0 && tid < 128) {
      float n = 0.f;
      for (int c = 0; c < 128; ++c) {
        p.nstate[((size_t)bh * 128 + c) * 128 + tid] = n;
        n = al[c] * n + be[c] * p.nhat[((size_t)bh * 128 + c) * 128 + tid];
      }
      p.out[O_PN + bh * 128 + tid] = n;
    }
  }
}

__device__ void m3_item(const Params& p, LAS char* lds, int item) {
  const int bh = item >> 7, c = item & 127, b = bh >> 2, hd = bh & 3;
  const size_t row0 = (size_t)b * SEQ + c * 64;
  __syncthreads();
  mlstm_out<2>(lds, p.gates + row0 * 8, hd, p.Qa + row0 * 512 + hd * 128, p.Ka + row0 * 512 + hd * 128,
               p.VaT + (size_t)bh * 128 * SEQ + c * 64, SEQ, p.xb + (size_t)item * 16384, p.nstate + (size_t)item * 128,
               p.mtab[bh * 129 + c], p.in[15] + hd * 128, p.Ga + row0 * 512 + hd * 128);
}

__device__ void ms_item(const Params& p, LAS char* lds, int bh) {
  const int tid = threadIdx.x, lane = tid & 63, w = tid >> 6, r = lane & 31, h = lane >> 5;
  const int b = bh >> 2, hd = bh & 3;
  const size_t row0 = (size_t)NTOKP + b * 32;
  const float m0 = p.in[9][bh];
  const float* n0 = p.in[8] + bh * 128;
  const u16* KTs = p.KaT + (size_t)NTOKP * 512 + (size_t)bh * 128 * 32;
  const u16* VTs = p.VaT + (size_t)NTOKP * 512 + (size_t)bh * 128 * 32;
  __syncthreads();
  mlstm_out<1>(lds, p.gates + row0 * 8, hd, p.Qa + row0 * 512 + hd * 128, p.Ka + row0 * 512 + hd * 128, VTs, 32,
               p.C0sT + (size_t)bh * 16384, n0, m0, p.in[15] + hd * 128, p.Ga + row0 * 512 + hd * 128);
  f32x16 acc[4]; float nh, bL, amax;
  mlstm_local<1>(lds, p.gates + row0 * 8, hd, KTs, VTs, 32, acc, nh, bL, amax);
  const float mlast = bL + fmaxf(m0, amax);
  const float decay = __expf(bL + m0 - mlast), beta = __expf(bL + amax - mlast);
#pragma unroll
  for (int et = 0; et < 4; ++et)
#pragma unroll
    for (int i = 0; i < 16; ++i) {
      const int d = 32 * w + crow(i, h), e = 32 * et + r;
      const size_t o = ((size_t)bh * 128 + d) * 128 + e;
      p.out[O_SC + o] = decay * p.in[7][o] + beta * acc[et][i];
    }
  if (h == 0) { const int d = 32 * w + r; p.out[O_SN + bh * 128 + d] = decay * n0[d] + beta * nh; }
  if (tid == 0) p.out[O_SM + bh] = mlast;
}

__device__ void phase_conv(const Params& p, LAS char* lds) {
  const int tid = threadIdx.x, lane = tid & 63, w = tid >> 6;
  const u16* U = p.Qa; u16* Gc = p.KaT;
  LAS u16* win = (LAS u16*)lds;
  LAS float* cs = (LAS float*)(lds + 20480);
  LAS float* st = (LAS float*)(lds + 20480 + 32768);
  for (int tile = blockIdx.x; tile < NTOK / 8; tile += gridDim.x) {
    const int row0 = tile * 8;
    const bool samp = row0 >= NTOKP;
    int t0, bs = 0;
    if (!samp) t0 = row0 & 8191; else { const int sr = row0 - NTOKP; bs = sr >> 5; t0 = sr & 31; }
    const int seqbase = row0 - t0;
#pragma unroll 1
    for (int cgp = 0; cgp < 4; ++cgp) {
      __syncthreads();
      for (int pch = tid; pch < 38 * 32; pch += 256) {
        const int rr = pch >> 5, ch = pch & 31, t = t0 - 30 + rr;
        u32x4 v = {0, 0, 0, 0};
        if (t >= 0) v = *reinterpret_cast<const u32x4*>(U + (size_t)(seqbase + t) * 1024 + cgp * 256 + ch * 8);
        else if (samp) {
          const float4* sc = reinterpret_cast<const float4*>(p.in[10] + ((size_t)(bs * 30 + 30 + t)) * 1024 + cgp * 256 + ch * 8);
          const float4 a = sc[0], c = sc[1];
          v = u32x4{cvtpk(a.x, a.y), cvtpk(a.z, a.w), cvtpk(c.x, c.y), cvtpk(c.z, c.w)};
        }
        *reinterpret_cast<LAS u32x4*>(win + rr * 256 + ch * 8) = v;
      }
      __syncthreads();
      const int chn = cgp * 256 + tid;
      float wv[38], cw[31];
#pragma unroll
      for (int rr = 0; rr < 38; ++rr) wv[rr] = bf2f(win[rr * 256 + tid]);
#pragma unroll
      for (int j = 0; j < 31; ++j) cw[j] = p.in[25][j * 1024 + chn];
      const float cb = p.in[26][chn];
#pragma unroll
      for (int i = 0; i < 8; ++i) {
        float a = cb;
#pragma unroll
        for (int j = 0; j < 31; ++j) a += cw[j] * wv[i + j];
        cs[i * 1024 + chn] = a;
      }
    }
    __syncthreads();
#pragma unroll
    for (int q = 0; q < 2; ++q) {
      const int i = 2 * w + q;
      float a1 = 0.f, a2 = 0.f;
#pragma unroll
      for (int k = 0; k < 16; ++k) { const float v = cs[i * 1024 + lane + 64 * k]; a1 += v; a2 += v * v; }
      a1 = wsum(a1); a2 = wsum(a2);
      if (lane == 0) {
        const float mu = a1 * (1.f / 1024.f);
        const float var = fmaxf(a2 * (1.f / 1024.f) - mu * mu, 0.f);
        st[2 * i] = mu; st[2 * i + 1] = rsqrtf(var + EPS);
      }
    }
    __syncthreads();
#pragma unroll 1
    for (int cgp = 0; cgp < 4; ++cgp) {
      const int chn = cgp * 256 + tid;
      const float lg = p.in[27][chn], lb = p.in[28][chn];
#pragma unroll
      for (int i = 0; i < 8; ++i) {
        const float y = (cs[i * 1024 + chn] - st[2 * i]) * st[2 * i + 1] * lg + lb;
        u16* gp = Gc + (size_t)(row0 + i) * 1024 + chn;
        *gp = f2bf(siluf_(y) * bf2f(*gp));
      }
    }
  }
}

struct AttnConst { float M2d, M2x, lam; };
DEVI AttnConst attn_consts(const Params& p, int layer) {
  const int lane = threadIdx.x & 63;
  AttnConst c;
  const float gq = max_abs64(p.in[16], 64, lane), gk = max_abs64(p.in[17], 64, lane);
  const float* km = p.rsmem + 1024;
  c.M2d = (8.f * gq * 0.125f * LOG2E) * fmaxf(8.f * gk, sqrtf(km[0])) * 1.01f;
  const float xq = max_abs64(p.in[32] + layer * 128, 128, lane), xk = max_abs64(p.in[33] + layer * 128, 128, lane);
  c.M2x = (11.313708f * xq * 0.08838834764831845f * LOG2E) * fmaxf(11.313708f * xk, sqrtf(km[1 + layer])) * 1.01f;
  float d1 = p.in[18][lane] * p.in[19][lane], d2 = p.in[20][lane] * p.in[21][lane];
  d1 = wsum(d1); d2 = wsum(d2);
  c.lam = __expf(d1) - __expf(d2) + 0.2f;
  return c;
}

DEVI void cross_item(const Params& p, LAS char* lds, int layer, int it, float M2x) {
  const int hd = it & 3;
  size_t row0; int mb, nw;
  if (it < 1024) { const int rb = it >> 2; row0 = (size_t)rb * 128; mb = rb >> 6; nw = 4; }
  else { const int bs = (it - 1024) >> 2; row0 = (size_t)NTOKP + bs * 32; mb = 4 + bs; nw = 1; }
  attn_block<false>(lds, p.Qx + row0 * 512 + hd * 128, p.XK + ((size_t)(layer * 12 + mb) * 256) * 512 + hd * 128,
                    p.XVT + ((size_t)((layer * 12 + mb) * 4 + hd) * 128) * 256, 256, 4, nw, 0, 256, 0.f, M2x, 0.f, nullptr,
                    p.Gx + row0 * 512 + hd * 128);
}

DEVI void diff_item(const Params& p, LAS char* lds, int it, float M2d, float lam) {
  const bool pr = it < 1024;
  const int qb = pr ? 63 - (it >> 4) : 0;
  const int bh = pr ? (it & 15) : it - 1024;
  const int b = bh >> 2, hd = bh & 3;
  const size_t row0 = pr ? (size_t)b * SEQ + qb * 128 : (size_t)NTOKP + b * 32;
  const float slope2 = exp2f(-2.f * (hd + 1)) * LOG2E;
  const u16* Kp = pr ? p.Kb + (size_t)b * SEQ * 512 + hd * 128 : p.Ks + (size_t)b * SKP * 512 + hd * 128;
  const u16* Vp = pr ? p.VbT + (size_t)bh * 128 * SEQ : p.VsT + (size_t)bh * 128 * SKP;
  attn_block<true>(lds, p.Qb + row0 * 512 + hd * 128, Kp, Vp, pr ? SEQ : SKP, pr ? 2 * qb + 2 : 33, pr ? 4 : 1,
                   pr ? qb * 128 : PAST, pr ? SEQ : PAST + 32, slope2, M2d, lam, p.in[22], p.Gb + row0 * 512 + hd * 128);
}

DEVI int snake(int k, int g, int G) { return (k & 1) ? (k * G + (G - 1 - g)) : (k * G + g); }

constexpr int NPHASE = 9;
__device__ void run_phase(const Params& p, LAS char* lds, int ph) {
  const int G = gridDim.x, g = blockIdx.x;
  switch (ph) {
    case 0: phase_prep(p); break;
    case 1: phase_gemm(p, lds, 0); break;
    case 2: {
      const AttnConst c = attn_consts(p, 0);
      for (int it = g; it < 1056; it += G) cross_item(p, lds, 0, it, c.M2x);
      for (int it = g; it < 2048; it += G) m1_item(p, lds, it);
    } break;
    case 3: {
      const AttnConst c = attn_consts(p, 0);
      (void)c;
      phase_scan(p, lds);
    } break;
    case 4: {
      const AttnConst c = attn_consts(p, 0);
      for (int k = 0;; ++k) { const int it = snake(k, g, G); if (k * G >= 1056) break; if (it < 1056) diff_item(p, lds, it, c.M2d, c.lam); }
      for (int it = g; it < 2048; it += G) m3_item(p, lds, it);
      for (int it = G - 1 - g; it < 32; it += G) ms_item(p, lds, it);
    } break;
    case 5: phase_gemm(p, lds, 1); break;
    case 6: phase_gemm(p, lds, 2); break;
    case 7: {
      const AttnConst c = attn_consts(p, 1);
      phase_conv(p, lds);
      for (int it = g; it < 1056; it += G) cross_item(p, lds, 1, it, c.M2x);
    } break;
    case 8: phase_gemm(p, lds, 3); break;
  }
}

__global__ void __launch_bounds__(256, 1) mega(Params p, int ph_lo, int ph_hi) {
  extern __shared__ __attribute__((aligned(16))) char smem[];
  LAS char* lds = (LAS char*)smem;
  cg::grid_group grid = cg::this_grid();
#define RUNPH(k) if (ph_lo <= (k) && (k) < ph_hi) { if ((k) > ph_lo) grid.sync(); run_phase(p, lds, (k)); }
  RUNPH(0) RUNPH(1) RUNPH(2) RUNPH(3) RUNPH(4) RUNPH(5) RUNPH(6) RUNPH(7) RUNPH(8)
#undef RUNPH
}

#ifndef MULTI_LAUNCH
#define MULTI_LAUNCH 0
#endif

extern "C" void kernel_launch(void* const* d_in, const int* in_sizes, int n_in, void* d_out, int out_size, void* d_ws, size_t ws_size,
                              hipStream_t stream) {
  static int grid_blocks = 0;
  if (!grid_blocks) {
    int dev = 0, cus = 0, per_cu = 0;
    hipGetDevice(&dev);
    hipDeviceGetAttribute(&cus, hipDeviceAttributeMultiprocessorCount, dev);
    hipFuncSetAttribute((const void*)mega, hipFuncAttributeMaxDynamicSharedMemorySize, LDS_BYTES);
    hipOccupancyMaxActiveBlocksPerMultiprocessor(&per_cu, (const void*)mega, 256, LDS_BYTES);
    if (per_cu < 1) per_cu = 1;
    if (per_cu > 1) per_cu = 1;
    grid_blocks = (cus * per_cu) & ~7;
    if (grid_blocks < 8) grid_blocks = 8;
  }
  Params p{};
  for (int i = 0; i < 34; ++i) p.in[i] = (const float*)d_in[i];
  p.out = (float*)d_out;
  char* ws = (char*)d_ws;
  size_t off = 0;
  auto take = [&](size_t bytes) { char* q = ws + off; off += (bytes + 255) & ~(size_t)255; return q; };
  p.WtInA = (u16*)take((size_t)NPAD_A * 1024 * 2);
  p.WtOutA = (u16*)take((size_t)1024 * 1536 * 2);
  p.WtInC = (u16*)take((size_t)4096 * 1024 * 2);
  p.WtOutC = (u16*)take((size_t)1024 * 1536 * 2);
  p.WtMem = (u16*)take((size_t)2 * 1024 * 1024 * 2);
  p.xb = (u16*)take((size_t)NTOK * 1024 * 2);
  p.memb = (u16*)take((size_t)1024 * 1024 * 2);
  u16* segs = (u16*)take(SEG * 2 * 11);
  p.Qa = segs; p.Ka = segs + SEG; p.KaT = segs + 2 * SEG; p.VaT = segs + 3 * SEG; p.Ga = segs + 4 * SEG; p.Qb = segs + 5 * SEG;
  p.Kb = segs + 6 * SEG; p.VbT = segs + 7 * SEG; p.Gb = segs + 8 * SEG; p.Qx = segs + 9 * SEG; p.Gx = segs + 10 * SEG;
  p.Ks = (u16*)take((size_t)8 * SKP * 512 * 2);
  p.VsT = (u16*)take((size_t)4096 * SKP * 2);
  p.XK = (u16*)take((size_t)2 * 12 * 256 * 512 * 2);
  p.XVT = (u16*)take((size_t)2 * 12 * 256 * 512 * 2);
  p.C0sT = (u16*)take((size_t)32 * 16384 * 2);
  p.rs0 = (float*)take((size_t)NTOK * 4);
  p.ssq1 = (float*)take((size_t)NTOK * 4);
  p.rsmem = (float*)take((size_t)(1024 + 64) * 4);
  p.gates = (float*)take((size_t)NTOK * 8 * 4);
  p.tabA = (float*)take(2048 * 4);
  p.tabB = (float*)take(2048 * 4);
  p.mtab = (float*)take(16 * 129 * 4);
  p.nhat = (float*)take((size_t)2048 * 128 * 4);
  p.nstate = (float*)take((size_t)2048 * 128 * 4);
  if (off > ws_size) { fprintf(stderr, "workspace too small: need %zu have %zu\n", off, ws_size); return; }
  hipMemsetAsync(p.rsmem + 1024, 0, 64, stream);
#if MULTI_LAUNCH
  for (int ph = 0; ph < NPHASE; ++ph) {
    hipLaunchKernelGGL(mega, dim3(grid_blocks), dim3(256), LDS_BYTES, stream, p, ph, ph + 1);
  }
#else
  int lo = 0, hi = NPHASE;
  void* args[] = {&p, &lo, &hi};
  hipError_t e = hipLaunchCooperativeKernel((const void*)mega, dim3(grid_blocks), dim3(256), args, LDS_BYTES, stream);
  if (e != hipSuccess) fprintf(stderr, "cooperative launch failed: %s (grid %d)\n", hipGetErrorString(e), grid_blocks);
#endif
}
```

```cpp
#include <hip/hip_runtime.h>
#include <hip/hip_cooperative_groups.h>
#include <stdint.h>
#include <stdio.h>
namespace cg = cooperative_groups;

typedef unsigned short u16;
using bf16x8 = __attribute__((ext_vector_type(8))) short;
using f32x4  = __attribute__((ext_vector_type(4))) float;
using f32x16 = __attribute__((ext_vector_type(16))) float;
using u32x4  = __attribute__((ext_vector_type(4))) unsigned;
using u32x2  = __attribute__((ext_vector_type(2))) unsigned;
#define LAS __attribute__((address_space(3)))
#define DEVI __device__ __forceinline__

constexpr int NTOKP = 32768, NTOKS = 256, NTOK = 33024;
constexpr int SEQ = 8192, LSAMP = 32, PAST = 2048, SKP = 2112;
constexpr size_t SEG = (size_t)NTOK * 512;
constexpr int NPAD_A = 5760;
constexpr float EPS = 1e-6f;
constexpr float LOG2E = 1.4426950408889634f;
constexpr size_t O_YP = 0, O_PXK = 33816576, O_PXV = 34865152, O_PK = 35913728, O_PV = 52690944,
  O_PC = 69468160, O_PN = 69730304, O_PM = 69732352, O_PCONV = 69732368, O_SK = 69855248, O_SV = 69986320,
  O_SC = 70117392, O_SN = 70641680, O_SM = 70645776, O_SCONV = 70645808;

constexpr int LDS_BYTES = 147456;

struct Params {
  const float* in[34];
  float* out;
  u16 *WtInA, *WtOutA, *WtInC, *WtOutC, *WtMem;
  u16 *xb, *memb;
  u16 *Qa, *Ka, *KaT, *VaT, *Ga, *Qb, *Kb, *VbT, *Gb, *Qx, *Gx;
  u16 *Ks, *VsT, *XK, *XVT, *C0sT;
  float *rs0, *ssq1, *rsmem, *gates, *tabA, *tabB, *mtab, *nhat, *nstate, *kmaxp;
};

DEVI unsigned cvtpk(float lo, float hi) { unsigned r; asm volatile("v_cvt_pk_bf16_f32 %0, %1, %2" : "=v"(r) : "v"(lo), "v"(hi)); return r; }
DEVI float bflo(unsigned u) { return __uint_as_float(u << 16); }
DEVI float bfhi(unsigned u) { return __uint_as_float(u & 0xffff0000u); }
DEVI float bf2f(u16 h) { return __uint_as_float(((unsigned)h) << 16); }
DEVI u16 f2bf(float f) { return (u16)(cvtpk(f, 0.f) & 0xffffu); }
DEVI float sigmoidf_(float x) { return 1.f / (1.f + __expf(-x)); }
DEVI float siluf_(float x) { return x / (1.f + __expf(-x)); }
DEVI float logsigmoidf_(float x) { return fminf(x, 0.f) - log1pf(__expf(-fabsf(x))); }
DEVI float wsum(float v) { for (int o = 32; o; o >>= 1) v += __shfl_xor(v, o); return v; }
DEVI float wmax(float v) { for (int o = 32; o; o >>= 1) v = fmaxf(v, __shfl_xor(v, o)); return v; }
DEVI int pi32(int r) { return (r & ~12) | ((r & 4) << 1) | ((r & 8) >> 1); }
DEVI int klocal(int reg, int h) { return (reg & 3) + 4 * ((reg >> 2) & 1) + 8 * h + 16 * (reg >> 3); }
DEVI int crow(int reg, int h) { return (reg & 3) + 8 * (reg >> 2) + 4 * h; }
DEVI bf16x8 ldg8(const u16* p) { return *reinterpret_cast<const bf16x8*>(p); }
DEVI f32x16 mfma32(bf16x8 a, bf16x8 b, f32x16 c) { return __builtin_amdgcn_mfma_f32_32x32x16_bf16(a, b, c, 0, 0, 0); }
DEVI bf16x8 pack8(const f32x16& x, int s) {
  u32x4 w = {cvtpk(x[8 * s + 0], x[8 * s + 1]), cvtpk(x[8 * s + 2], x[8 * s + 3]), cvtpk(x[8 * s + 4], x[8 * s + 5]), cvtpk(x[8 * s + 6], x[8 * s + 7])};
  return *reinterpret_cast<bf16x8*>(&w);
}
DEVI void glds16(const void* g, LAS void* l) { __builtin_amdgcn_global_load_lds((const unsigned*)g, (LAS unsigned*)l, 16, 0, 0); }

template <class F>
DEVI void wtrans(u16* dst, const float* src, const float* g, int K, int Npad, int ldn, F srccol, int gtid, int gsz) {
  const int total = Npad * (K / 8);
  for (int i = gtid; i < total; i += gsz) {
    const int n = i % Npad, kb = i / Npad;
    const int sc = srccol(n);
    float v[8];
#pragma unroll
    for (int j = 0; j < 8; ++j) {
      const int k = kb * 8 + j;
      v[j] = (sc >= 0) ? src[(size_t)k * ldn + sc] * (g ? g[k] : 1.f) : 0.f;
    }
    u32x4 w = {cvtpk(v[0], v[1]), cvtpk(v[2], v[3]), cvtpk(v[4], v[5]), cvtpk(v[6], v[7])};
    *reinterpret_cast<u32x4*>(dst + (size_t)n * K + kb * 8) = w;
  }
}

DEVI int srccol_in_a(int n) {
  const int t = n >> 7, c = n & 127;
  if (t < 12) return n;
  if (t < 20) { const int j = t - 12; return c < 64 ? 1536 + 64 * j + c : 2048 + 64 * j + (c - 64); }
  if (t < 44) return 2568 + (t - 20) * 128 + c;
  if (t == 44) return c < 8 ? 2560 + c : -1;
  return -1;
}
DEVI int srccol_in_c(int n) {
  const int t = n >> 7, c = n & 127;
  if (t < 16) return c < 64 ? 64 * t + c : 1024 + 64 * t + (c - 64);
  return n;
}

DEVI void phase_prep(const Params& p) {
  const int tid = threadIdx.x, lane = tid & 63;
  const int gtid = blockIdx.x * 256 + tid, gsz = gridDim.x * 256;
  const int gwave = gtid >> 6, nwaves = gsz >> 6;
  wtrans(p.WtInA, p.in[12], p.in[11], 1024, NPAD_A, 5640, [](int n) { return srccol_in_a(n); }, gtid, gsz);
  wtrans(p.WtOutA, p.in[23], nullptr, 1536, 1024, 1024, [](int n) { return n; }, gtid, gsz);
  wtrans(p.WtInC, p.in[24], p.in[11] + 1024, 1024, 4096, 4096, [](int n) { return srccol_in_c(n); }, gtid, gsz);
  wtrans(p.WtOutC, p.in[29], nullptr, 1536, 1024, 1024, [](int n) { return n; }, gtid, gsz);
  for (int l = 0; l < 2; ++l)
    wtrans(p.WtMem + (size_t)l * 1024 * 1024, p.in[31] + (size_t)l * 1024 * 1024, p.in[30] + l * 1024, 1024, 1024, 1024,
           [](int n) { return n; }, gtid, gsz);
  for (int row = gwave; row < NTOK + 1024; row += nwaves) {
    const float* xr; u16* dst; float* rsd;
    if (row < NTOK) { xr = (row < NTOKP ? p.in[0] + (size_t)row * 1024 : p.in[1] + (size_t)(row - NTOKP) * 1024); dst = p.xb + (size_t)row * 1024; rsd = p.rs0 + row; }
    else { const int r = row - NTOK; xr = p.in[2] + (size_t)r * 1024; dst = p.memb + (size_t)r * 1024; rsd = p.rsmem + r; }
    float4 v[4]; float ss = 0.f;
#pragma unroll
    for (int i = 0; i < 4; ++i) { v[i] = reinterpret_cast<const float4*>(xr)[lane + 64 * i]; ss += v[i].x * v[i].x + v[i].y * v[i].y + v[i].z * v[i].z + v[i].w * v[i].w; }
    ss = wsum(ss);
    if (lane == 0) *rsd = rsqrtf(ss * (1.f / 1024.f) + EPS);
#pragma unroll
    for (int i = 0; i < 4; ++i) { u32x2 w = {cvtpk(v[i].x, v[i].y), cvtpk(v[i].z, v[i].w)}; reinterpret_cast<u32x2*>(dst)[lane + 64 * i] = w; }
  }
  float km0 = 0.f, km1 = 0.f, km2 = 0.f;
  for (int i = gtid; i < 8 * PAST * 64; i += gsz) {
    const int c8 = i & 63, pp = (i >> 6) & (PAST - 1), b = i >> 17;
    const float4* s = reinterpret_cast<const float4*>(p.in[5] + ((size_t)(b * PAST + pp) * 512 + c8 * 8));
    const float4 a = s[0], c = s[1];
    u32x4 w = {cvtpk(a.x, a.y), cvtpk(a.z, a.w), cvtpk(c.x, c.y), cvtpk(c.z, c.w)};
    *reinterpret_cast<u32x4*>(p.Ks + ((size_t)(b * SKP + pp) * 512 + c8 * 8)) = w;
    float ss = a.x * a.x + a.y * a.y + a.z * a.z + a.w * a.w + c.x * c.x + c.y * c.y + c.z * c.z + c.w * c.w;
    ss += __shfl_xor(ss, 1); ss += __shfl_xor(ss, 2); ss += __shfl_xor(ss, 4);
    km0 = fmaxf(km0, ss);
  }
  for (int i = gtid; i < 8 * 4 * 256 * 128; i += gsz) {
    const int dv = i & 127, p8 = (i >> 7) & 255, h = (i >> 15) & 3, b = i >> 17;
    float v[8];
#pragma unroll
    for (int j = 0; j < 8; ++j) v[j] = p.in[6][((size_t)(b * PAST + p8 * 8 + j) * 4 + h) * 128 + dv];
    u32x4 w = {cvtpk(v[0], v[1]), cvtpk(v[2], v[3]), cvtpk(v[4], v[5]), cvtpk(v[6], v[7])};
    *reinterpret_cast<u32x4*>(p.VsT + ((size_t)((b * 4 + h) * 128 + dv) * SKP + p8 * 8)) = w;
  }
  for (int i = gtid; i < 4096 * 4; i += gsz) {
    u32x4 z = {0, 0, 0, 0};
    *reinterpret_cast<u32x4*>(p.VsT + ((size_t)(i >> 2) * SKP + 2080 + (i & 3) * 8)) = z;
  }
  for (int i = gtid; i < 8 * 32 * 64; i += gsz) {
    u32x4 z = {0, 0, 0, 0};
    const int c8 = i & 63, r = (i >> 6) & 31, b = i >> 11;
    *reinterpret_cast<u32x4*>(p.Ks + ((size_t)(b * SKP + 2080 + r) * 512 + c8 * 8)) = z;
  }
  for (int i = gtid; i < 2 * 8 * 256 * 64; i += gsz) {
    const int c8 = i & 63, m = (i >> 6) & 255, b = (i >> 14) & 7, l = i >> 17;
    const float4* s = reinterpret_cast<const float4*>(p.in[3] + ((size_t)((l * 8 + b) * 256 + m) * 512 + c8 * 8));
    const float4 a = s[0], c = s[1];
    u32x4 w = {cvtpk(a.x, a.y), cvtpk(a.z, a.w), cvtpk(c.x, c.y), cvtpk(c.z, c.w)};
    *reinterpret_cast<u32x4*>(p.XK + ((size_t)((l * 12 + 4 + b) * 256 + m) * 512 + c8 * 8)) = w;
    float ss = a.x * a.x + a.y * a.y + a.z * a.z + a.w * a.w + c.x * c.x + c.y * c.y + c.z * c.z + c.w * c.w;
    ss += __shfl_xor(ss, 1); ss += __shfl_xor(ss, 2); ss += __shfl_xor(ss, 4); ss += __shfl_xor(ss, 8);
    if (l == 0) km1 = fmaxf(km1, ss); else km2 = fmaxf(km2, ss);
  }
  for (int i = gtid; i < 2 * 8 * 4 * 32 * 128; i += gsz) {
    const int dv = i & 127, m8 = (i >> 7) & 31, h = (i >> 12) & 3, b = (i >> 14) & 7, l = i >> 17;
    float v[8];
#pragma unroll
    for (int j = 0; j < 8; ++j) v[j] = p.in[4][((size_t)((l * 8 + b) * 256 + m8 * 8 + j) * 4 + h) * 128 + dv];
    u32x4 w = {cvtpk(v[0], v[1]), cvtpk(v[2], v[3]), cvtpk(v[4], v[5]), cvtpk(v[6], v[7])};
    *reinterpret_cast<u32x4*>(p.XVT + ((size_t)(((l * 12 + 4 + b) * 4 + h) * 128 + dv) * 256 + m8 * 8)) = w;
  }
  for (int i = gtid; i < 32 * 16 * 128; i += gsz) {
    const int e = i & 127, d8 = (i >> 7) & 15, bh = i >> 11;
    float v[8];
#pragma unroll
    for (int j = 0; j < 8; ++j) v[j] = p.in[7][((size_t)bh * 128 + d8 * 8 + j) * 128 + e];
    u32x4 w = {cvtpk(v[0], v[1]), cvtpk(v[2], v[3]), cvtpk(v[4], v[5]), cvtpk(v[6], v[7])};
    *reinterpret_cast<u32x4*>(p.C0sT + ((size_t)bh * 128 + e) * 128 + d8 * 8) = w;
  }
  for (int i = gtid; i < NTOK; i += gsz) p.ssq1[i] = 0.f;
  km0 = wmax(km0); km1 = wmax(km1); km2 = wmax(km2);
  if (lane == 0) {
    const int slot = blockIdx.x * 4 + (tid >> 6);
    p.kmaxp[slot] = km0; p.kmaxp[1024 + slot] = km1; p.kmaxp[2048 + slot] = km2;
  }
}

DEVI void gemm_core(LAS char* lds, const u16* A0, const u16* A1, const u16* A2, int lda0, int lda1, int lda2, int segK,
                    const u16* Bt, int K, int brow, int bcol, f32x4 (&acc)[4][4]) {
  const int tid = threadIdx.x, lane = tid & 63, wid = tid >> 6, wr = wid >> 1, wc = wid & 1, fr = lane & 15, fq = lane >> 4;
  LAS char* SA = lds; LAS char* SB = lds + 8192;
#pragma unroll
  for (int m = 0; m < 4; ++m)
#pragma unroll
    for (int n = 0; n < 4; ++n) acc[m][n] = f32x4{0.f, 0.f, 0.f, 0.f};
  const int nkt = K / 32;
  for (int kt = 0; kt < nkt; ++kt) {
    const int k0 = kt * 32;
    const int seg = k0 / segK;
    const u16* Ab = (seg == 0 ? A0 : (seg == 1 ? A1 : A2)) + (k0 - seg * segK);
    const int lda = (seg == 0 ? lda0 : (seg == 1 ? lda1 : lda2));
#pragma unroll
    for (int i = 0; i < 2; ++i) {
      const int b = tid * 16 + i * 4096, r = b >> 6, c = (b & 63) >> 1;
      glds16(Ab + (size_t)(brow + r) * lda + c, SA + b);
      glds16(Bt + (size_t)(bcol + r) * K + k0 + c, SB + b);
    }
    asm volatile("s_waitcnt vmcnt(0)" ::: "memory");
    __syncthreads();
    bf16x8 af[4], bfr[4];
#pragma unroll
    for (int m = 0; m < 4; ++m) af[m] = *reinterpret_cast<const LAS bf16x8*>(SA + (wr * 64 + m * 16 + fr) * 64 + fq * 16);
#pragma unroll
    for (int n = 0; n < 4; ++n) bfr[n] = *reinterpret_cast<const LAS bf16x8*>(SB + (wc * 64 + n * 16 + fr) * 64 + fq * 16);
#pragma unroll
    for (int m = 0; m < 4; ++m)
#pragma unroll
      for (int n = 0; n < 4; ++n) acc[m][n] = __builtin_amdgcn_mfma_f32_16x16x32_bf16(af[m], bfr[n], acc[m][n], 0, 0, 0);
    __syncthreads();
  }
}

DEVI void gemm_stage_c(LAS char* lds, const f32x4 (&acc)[4][4], const float* rowscale, int mode, int brow) {
  const int tid = threadIdx.x, lane = tid & 63, wid = tid >> 6, wr = wid >> 1, wc = wid & 1, fr = lane & 15, fq = lane >> 4;
  LAS float* Cs = (LAS float*)lds;
#pragma unroll
  for (int m = 0; m < 4; ++m)
#pragma unroll
    for (int j = 0; j < 4; ++j) {
      const int r = wr * 64 + m * 16 + fq * 4 + j;
      float s = 1.f;
      if (mode == 1) s = rowscale[brow + r];
      else if (mode == 2) s = rsqrtf(rowscale[brow + r] * (1.f / 1024.f) + EPS);
#pragma unroll
      for (int n = 0; n < 4; ++n) Cs[r * 132 + wc * 64 + n * 16 + fr] = acc[m][n][j] * s;
    }
  __syncthreads();
}

DEVI void st_bf8(u16* dst, const float (&v)[8]) {
  u32x4 w = {cvtpk(v[0], v[1]), cvtpk(v[2], v[3]), cvtpk(v[4], v[5]), cvtpk(v[6], v[7])};
  *reinterpret_cast<u32x4*>(dst) = w;
}
DEVI void st_f8(float* dst, const float (&v)[8]) {
  reinterpret_cast<float4*>(dst)[0] = float4{v[0], v[1], v[2], v[3]};
  reinterpret_cast<float4*>(dst)[1] = float4{v[4], v[5], v[6], v[7]};
}
DEVI void store_transposed(LAS char* lds, u16* dst, size_t ldt, float scale) {
  const LAS float* Cs = (const LAS float*)lds;
  const int c = threadIdx.x & 127, rh = (threadIdx.x >> 7) * 64;
#pragma unroll
  for (int it = 0; it < 8; ++it) {
    const int r0 = rh + it * 8;
    float v[8];
#pragma unroll
    for (int j = 0; j < 8; ++j) v[j] = Cs[(r0 + j) * 132 + c] * scale;
    st_bf8(dst + (size_t)c * ldt + r0, v);
  }
}

DEVI void epi_in_a(const Params& p, LAS char* lds, int brow, int n) {
  const LAS float* Cs = (const LAS float*)lds;
  const int tid = threadIdx.x, cgp = tid & 15, c0 = cgp * 8;
  const bool samp = brow >= NTOKP;
  const int seg = n >> 2, hd = n & 3;
  if (n >= 4 && n < 12) {
    u16* base = (n < 8 ? p.KaT : p.VaT);
    const float sc = (n < 8 ? 0.08838834764831845f : 1.f);
    if (!samp) { const int b = brow >> 13, t0 = brow & 8191; store_transposed(lds, base + ((size_t)(b * 4 + hd) * 128) * SEQ + t0, SEQ, sc); }
    else {
      const int c = tid & 127, rh = (tid >> 7) * 64;
#pragma unroll
      for (int it = 0; it < 8; ++it) {
        const int r0 = rh + it * 8; const int bs = ((brow - NTOKP) + r0) >> 5, t0 = r0 & 31;
        float v[8];
#pragma unroll
        for (int j = 0; j < 8; ++j) v[j] = Cs[(r0 + j) * 132 + c] * sc;
        st_bf8(base + (size_t)NTOKP * 512 + ((size_t)(bs * 4 + hd) * 128 + c) * 32 + t0, v);
      }
    }
  }
  if (seg == 7) {
    if (!samp) { const int b = brow >> 13, t0 = brow & 8191; store_transposed(lds, p.VbT + ((size_t)(b * 4 + hd) * 128) * SEQ + t0, SEQ, 1.f); }
    else {
      const int c = tid & 127, rh = (tid >> 7) * 64;
#pragma unroll
      for (int it = 0; it < 8; ++it) {
        const int r0 = rh + it * 8; const int bs = ((brow - NTOKP) + r0) >> 5, t0 = r0 & 31;
        float v[8];
#pragma unroll
        for (int j = 0; j < 8; ++j) v[j] = Cs[(r0 + j) * 132 + c];
        st_bf8(p.VsT + ((size_t)(bs * 4 + hd) * 128 + c) * SKP + PAST + t0, v);
      }
    }
  }
#pragma unroll 1
  for (int it = 0; it < 8; ++it) {
    const int r = it * 16 + (tid >> 4);
    const size_t grow = (size_t)brow + r;
    float v[8];
#pragma unroll
    for (int j = 0; j < 8; ++j) v[j] = Cs[r * 132 + c0 + j];
    if (n < 4) { st_bf8(p.Qa + grow * 512 + hd * 128 + c0, v); }
    else if (n < 8) {
#pragma unroll
      for (int j = 0; j < 8; ++j) v[j] *= 0.08838834764831845f;
      st_bf8(p.Ka + grow * 512 + hd * 128 + c0, v);
    }
    else if (n < 12) {   }
    else if (n < 20) {
      if (cgp < 8) {
        float g[8];
#pragma unroll
        for (int j = 0; j < 8; ++j) g[j] = sigmoidf_(v[j]) * siluf_(Cs[r * 132 + 64 + c0 + j]);
        st_bf8(p.Ga + grow * 512 + (n - 12) * 64 + c0, g);
      }
    }
    else if (n < 28) {
      float ss = 0.f;
#pragma unroll
      for (int j = 0; j < 8; ++j) ss += v[j] * v[j];
      ss += __shfl_xor(ss, 1); ss += __shfl_xor(ss, 2); ss += __shfl_xor(ss, 4);
      const float rs = rsqrtf(ss * (1.f / 64.f) + EPS);
      const float* g = (n < 24 ? p.in[16] : p.in[17]) + (c0 & 63);
      if (n < 24) {
#pragma unroll
        for (int j = 0; j < 8; ++j) v[j] = v[j] * rs * g[j] * (0.125f * LOG2E);
        st_bf8(p.Qb + grow * 512 + hd * 128 + c0, v);
      } else {
#pragma unroll
        for (int j = 0; j < 8; ++j) v[j] = v[j] * rs * g[j];
        if (!samp) { st_f8(p.out + O_PK + grow * 512 + hd * 128 + c0, v); st_bf8(p.Kb + grow * 512 + hd * 128 + c0, v); }
        else {
          const int sr = (int)grow - NTOKP, bs = sr >> 5, t = sr & 31;
          st_f8(p.out + O_SK + (size_t)sr * 512 + hd * 128 + c0, v);
          st_bf8(p.Ks + ((size_t)(bs * SKP + PAST + t)) * 512 + hd * 128 + c0, v);
        }
      }
    }
    else if (n < 32) {
      if (!samp) st_f8(p.out + O_PV + grow * 512 + hd * 128 + c0, v);
      else st_f8(p.out + O_SV + (size_t)((int)grow - NTOKP) * 512 + hd * 128 + c0, v);
    }
    else if (n < 36) {
#pragma unroll
      for (int j = 0; j < 8; ++j) v[j] = siluf_(v[j]);
      st_bf8(p.Gb + grow * 512 + hd * 128 + c0, v);
    }
    else if (n < 40) {
      float ss = 0.f;
#pragma unroll
      for (int j = 0; j < 8; ++j) ss += v[j] * v[j];
      ss += __shfl_xor(ss, 1); ss += __shfl_xor(ss, 2); ss += __shfl_xor(ss, 4); ss += __shfl_xor(ss, 8);
      const float rs = rsqrtf(ss * (1.f / 128.f) + EPS);
      const float* g = p.in[32] + c0;
#pragma unroll
      for (int j = 0; j < 8; ++j) v[j] = v[j] * rs * g[j] * (0.08838834764831845f * LOG2E);
      st_bf8(p.Qx + grow * 512 + hd * 128 + c0, v);
    }
    else if (n < 44) {
#pragma unroll
      for (int j = 0; j < 8; ++j) v[j] = siluf_(v[j]);
      st_bf8(p.Gx + grow * 512 + hd * 128 + c0, v);
    }
    else {
      if (cgp == 0) {
        float g[8];
#pragma unroll
        for (int j = 0; j < 4; ++j) { g[j] = v[j] + p.in[13][j]; g[4 + j] = logsigmoidf_(v[4 + j] + p.in[14][j]); }
        st_f8(p.gates + grow * 8, g);
      }
    }
  }
}

DEVI void epi_mem(const Params& p, LAS char* lds, int l, int brow, int n) {
  const LAS float* Cs = (const LAS float*)lds;
  const int tid = threadIdx.x, cgp = tid & 15, c0 = cgp * 8;
  const int hd = n & 3;
  if (n >= 4) {
    const int b = brow >> 8, m0 = brow & 255;
    store_transposed(lds, p.XVT + ((size_t)((l * 12 + b) * 4 + hd) * 128) * 256 + m0, 256, 1.f);
  }
#pragma unroll 1
  for (int it = 0; it < 8; ++it) {
    const int r = it * 16 + (tid >> 4);
    const size_t grow = (size_t)brow + r;
    float v[8];
#pragma unroll
    for (int j = 0; j < 8; ++j) v[j] = Cs[r * 132 + c0 + j];
    if (n < 4) {
      float ss = 0.f;
#pragma unroll
      for (int j = 0; j < 8; ++j) ss += v[j] * v[j];
      ss += __shfl_xor(ss, 1); ss += __shfl_xor(ss, 2); ss += __shfl_xor(ss, 4); ss += __shfl_xor(ss, 8);
      const float rs = rsqrtf(ss * (1.f / 128.f) + EPS);
      const float* g = p.in[33] + l * 128 + c0;
#pragma unroll
      for (int j = 0; j < 8; ++j) v[j] = v[j] * rs * g[j];
      st_f8(p.out + O_PXK + ((size_t)l * 1024 + grow) * 512 + hd * 128 + c0, v);
      const int b = (int)grow >> 8, m = (int)grow & 255;
      st_bf8(p.XK + ((size_t)((l * 12 + b) * 256 + m)) * 512 + hd * 128 + c0, v);
    } else {
      st_f8(p.out + O_PXV + ((size_t)l * 1024 + grow) * 512 + hd * 128 + c0, v);
    }
  }
}

DEVI void epi_out(const Params& p, LAS char* lds, int layer, int brow, int n) {
  const LAS float* Cs = (const LAS float*)lds;
  const int tid = threadIdx.x, cgp = tid & 15, c0 = cgp * 8;
#pragma unroll 1
  for (int it = 0; it < 8; ++it) {
    const int r = it * 16 + (tid >> 4);
    const size_t grow = (size_t)brow + r;
    const float* res;
    if (layer == 0) res = (grow < NTOKP ? p.in[0] + grow * 1024 : p.in[1] + (grow - NTOKP) * 1024) + n * 128 + c0;
    else res = p.out + grow * 1024 + n * 128 + c0;
    const float4 ra = reinterpret_cast<const float4*>(res)[0], rb = reinterpret_cast<const float4*>(res)[1];
    float v[8];
#pragma unroll
    for (int j = 0; j < 8; ++j) v[j] = Cs[r * 132 + c0 + j];
    v[0] += ra.x; v[1] += ra.y; v[2] += ra.z; v[3] += ra.w; v[4] += rb.x; v[5] += rb.y; v[6] += rb.z; v[7] += rb.w;
    st_f8(p.out + grow * 1024 + n * 128 + c0, v);
    if (layer == 0) {
      st_bf8(p.xb + grow * 1024 + n * 128 + c0, v);
      float ss = 0.f;
#pragma unroll
      for (int j = 0; j < 8; ++j) ss += v[j] * v[j];
      ss += __shfl_xor(ss, 1); ss += __shfl_xor(ss, 2); ss += __shfl_xor(ss, 4); ss += __shfl_xor(ss, 8);
      if (cgp == 0) atomicAdd(p.ssq1 + grow, ss);
    }
  }
}

DEVI void epi_in_c(const Params& p, LAS char* lds, int brow, int n) {
  const LAS float* Cs = (const LAS float*)lds;
  const int tid = threadIdx.x, cgp = tid & 15, c0 = cgp * 8;
  u16* U = p.Qa;
  u16* Gc = p.KaT;
#pragma unroll 1
  for (int it = 0; it < 8; ++it) {
    const int r = it * 16 + (tid >> 4);
    const size_t grow = (size_t)brow + r;
    float v[8];
#pragma unroll
    for (int j = 0; j < 8; ++j) v[j] = Cs[r * 132 + c0 + j];
    if (n < 16) {
      if (cgp < 8) {
        float u[8];
#pragma unroll
        for (int j = 0; j < 8; ++j) u[j] = v[j] * sigmoidf_(Cs[r * 132 + 64 + c0 + j]);
        st_bf8(U + grow * 1024 + n * 64 + c0, u);
        if (grow < NTOKP) { const int t = (int)grow & 8191, b = (int)grow >> 13; if (t >= SEQ - 30) st_f8(p.out + O_PCONV + ((size_t)(b * 30 + t - (SEQ - 30))) * 1024 + n * 64 + c0, u); }
        else { const int sr = (int)grow - NTOKP, t = sr & 31, b = sr >> 5; if (t >= 2) st_f8(p.out + O_SCONV + ((size_t)(b * 30 + t - 2)) * 1024 + n * 64 + c0, u); }
      }
    } else if (n < 24) {
#pragma unroll
      for (int j = 0; j < 8; ++j) v[j] = siluf_(v[j]);
      st_bf8(Gc + grow * 1024 + (n - 16) * 128 + c0, v);
    } else if (n < 28) {
      float ss = 0.f;
#pragma unroll
      for (int j = 0; j < 8; ++j) ss += v[j] * v[j];
      ss += __shfl_xor(ss, 1); ss += __shfl_xor(ss, 2); ss += __shfl_xor(ss, 4); ss += __shfl_xor(ss, 8);
      const float rs = rsqrtf(ss * (1.f / 128.f) + EPS);
      const float* g = p.in[32] + 128 + c0;
#pragma unroll
      for (int j = 0; j < 8; ++j) v[j] = v[j] * rs * g[j] * (0.08838834764831845f * LOG2E);
      st_bf8(p.Qx + grow * 512 + (n - 24) * 128 + c0, v);
    } else {
#pragma unroll
      for (int j = 0; j < 8; ++j) v[j] = siluf_(v[j]);
      st_bf8(p.Gx + grow * 512 + (n - 28) * 128 + c0, v);
    }
  }
}

DEVI void gemm_core(LAS char* lds, const u16* A0, const u16* A1, const u16* A2, int lda0, int lda1, int lda2, int segK,
                    const u16* Bt, int K, int brow, int bcol, f32x16 (&acc)[4][2]) {
  const int tid = threadIdx.x, lane = tid & 63, w = tid >> 6, wr = w >> 1, wc = w & 1, r = lane & 31, h = lane >> 5;
#pragma unroll
  for (int i = 0; i < 4; ++i)
#pragma unroll
    for (int j = 0; j < 2; ++j)
#pragma unroll
      for (int e = 0; e < 16; ++e) acc[i][j][e] = 0.f;
  const int nkt = K / 64;
  auto stage = [=](int kt, int buf) __attribute__((always_inline)) {
    const int k0 = kt * 64;
    const int seg = k0 / segK;
    const u16* Ab = (seg == 0 ? A0 : (seg == 1 ? A1 : A2)) + (k0 - seg * segK);
    const int lda = (seg == 0 ? lda0 : (seg == 1 ? lda1 : lda2));
    LAS char* sa = lds + buf * 49152;
    LAS char* sb = sa + 32768;
#pragma unroll
    for (int i = 0; i < 8; ++i) {
      const int pch = i * 256 + tid, row = pch >> 3, lg = (pch & 7) ^ ((row >> 1) & 7);
      glds16(Ab + (size_t)(brow + row) * lda + lg * 8, sa + pch * 16);
    }
#pragma unroll
    for (int i = 0; i < 4; ++i) {
      const int pch = i * 256 + tid, row = pch >> 3, lg = (pch & 7) ^ ((row >> 1) & 7);
      glds16(Bt + (size_t)(bcol + row) * K + k0 + lg * 8, sb + pch * 16);
    }
  };
  __syncthreads();
  stage(0, 0);
  stage(1, 1);
  int buf = 0;
  for (int kt = 0; kt < nkt; ++kt) {
    if (kt + 1 < nkt) asm volatile("s_waitcnt vmcnt(12)" ::: "memory"); else asm volatile("s_waitcnt vmcnt(0)" ::: "memory");
    asm volatile("s_waitcnt lgkmcnt(0)" ::: "memory");
    __builtin_amdgcn_s_barrier();
    if (kt + 2 < nkt) { int nb = buf + 2; if (nb >= 3) nb -= 3; stage(kt + 2, nb); }
    const LAS char* sa = lds + buf * 49152;
    const LAS char* sb = sa + 32768;
#pragma unroll
    for (int ks = 0; ks < 4; ++ks) {
      bf16x8 af[4], bfr[2];
#pragma unroll
      for (int i = 0; i < 4; ++i) {
        const int row = 32 * (2 * i + wr) + r, ch = (2 * ks + h) ^ ((row >> 1) & 7);
        af[i] = *reinterpret_cast<const LAS bf16x8*>(sa + row * 128 + ch * 16);
      }
#pragma unroll
      for (int j = 0; j < 2; ++j) {
        const int row = 32 * (2 * j + wc) + r, ch = (2 * ks + h) ^ ((row >> 1) & 7);
        bfr[j] = *reinterpret_cast<const LAS bf16x8*>(sb + row * 128 + ch * 16);
      }
#pragma unroll
      for (int i = 0; i < 4; ++i)
#pragma unroll
        for (int j = 0; j < 2; ++j) acc[i][j] = mfma32(af[i], bfr[j], acc[i][j]);
    }
    if (++buf == 3) buf = 0;
  }
}

template <int I>
DEVI void stage_sub(LAS char* lds, const f32x16 (&acc)[4][2], const float* rowscale, int mode, int brow) {
  const int tid = threadIdx.x, lane = tid & 63, w = tid >> 6, wr = w >> 1, wc = w & 1, r = lane & 31, h = lane >> 5;
  LAS float* Cs = (LAS float*)lds;
#pragma unroll
  for (int ii = 0; ii < 2; ++ii)
#pragma unroll
    for (int e = 0; e < 16; ++e) {
      const int row = 32 * (2 * ii + wr) + crow(e, h);
      float s = 1.f;
      if (mode == 1) s = rowscale[brow + 128 * I + row];
      else if (mode == 2) s = rsqrtf(rowscale[brow + 128 * I + row] * (1.f / 1024.f) + EPS);
#pragma unroll
      for (int jj = 0; jj < 2; ++jj) Cs[row * 132 + 32 * (2 * jj + wc) + r] = acc[2 * I + ii][jj][e] * s;
    }
}

DEVI void gemm_tile_run(const Params& p, LAS char* lds, int which, int aux, int mt, int n, f32x16 (&acc)[4][2]) {
  const int brow = mt * 256, bcol = n * 128;
  const float* rsc = nullptr; int mode = 0;
  if (which == 0) { gemm_core(lds, p.xb, p.xb, p.xb, 1024, 1024, 1024, 1024, p.WtInA, 1024, brow, bcol, acc); rsc = p.rs0; mode = 1; }
  else if (which == 1) gemm_core(lds, p.Ga, p.Gb, p.Gx, 512, 512, 512, 512, p.WtOutA, 1536, brow, bcol, acc);
  else if (which == 2) { gemm_core(lds, p.xb, p.xb, p.xb, 1024, 1024, 1024, 1024, p.WtInC, 1024, brow, bcol, acc); rsc = p.ssq1; mode = 2; }
  else if (which == 3) gemm_core(lds, p.KaT, p.KaT + 512, p.Gx, 1024, 1024, 512, 512, p.WtOutC, 1536, brow, bcol, acc);
  else { gemm_core(lds, p.memb, p.memb, p.memb, 1024, 1024, 1024, 1024, p.WtMem + (size_t)aux * 1024 * 1024, 1024, brow, bcol, acc); rsc = p.rsmem; mode = 1; }
#pragma unroll 1
  for (int sub = 0; sub < 2; ++sub) {
    __syncthreads();
    if (sub == 0) stage_sub<0>(lds, acc, rsc, mode, brow); else stage_sub<1>(lds, acc, rsc, mode, brow);
    __syncthreads();
    const int sr = brow + 128 * sub;
    if (which == 0) epi_in_a(p, lds, sr, n);
    else if (which == 1) epi_out(p, lds, 0, sr, n);
    else if (which == 2) epi_in_c(p, lds, sr, n);
    else if (which == 3) epi_out(p, lds, 1, sr, n);
    else epi_mem(p, lds, aux, sr, n);
  }
}

template <int which>
DEVI void phase_gemm(const Params& p, LAS char* lds) {
  const int nN = (which == 0 ? 45 : (which == 2 ? 32 : 8));
  const int ntiles = 128 * nN;
  const int G = gridDim.x;
  const int xcd = blockIdx.x & 7, lb = blockIdx.x >> 3, slots = G >> 3;
  const int nextra = nN + (which == 0 ? 64 : 0);
  f32x16 acc[4][2];
  int round = 0, t_extra = blockIdx.x;
  bool main_done = false;
  for (;;) {
    int wh = which, aux = 0, mt = 0, n = 0;
    if (!main_done) {
      const int q = lb + slots * round; ++round;
      const int L = 32 * (xcd + 8 * (q >> 5)) + (q & 31);
      if (L >= ntiles) { main_done = true; continue; }
      const int mg = L / (8 * nN), rem = L - mg * 8 * nN;
      n = rem >> 3; mt = mg * 8 + (rem & 7);
    } else {
      if (t_extra >= nextra) break;
      const int t = t_extra; t_extra += G;
      if (t < nN) { mt = 128; n = t; }
      else { const int q = t - nN; wh = 4; aux = q >> 5; mt = (q >> 3) & 3; n = q & 7; }
    }
    gemm_tile_run(p, lds, wh, aux, mt, n, acc);
  }
}

template <bool DIFF>
DEVI void attn_block(LAS char* lds, const u16* Q, const u16* Kg, const u16* VT, int ldv, int ntiles, int nwact,
                           int qpos0, int nkeys, float slope2, float M2, float lam, const float* subg, u16* G) {
  const int tid = threadIdx.x, lane = tid & 63, w = tid >> 6, r = lane & 31, h = lane >> 5;
  const bool act = w < nwact;
  const int qpos = qpos0 + 32 * w + r;
  const int cw = (qpos0 + 32 * w) >> 6;
  bf16x8 qf[8];
#pragma unroll
  for (int i = 0; i < 8; ++i) qf[i] = ldg8(Q + (size_t)(32 * w + r) * 512 + 16 * i + 8 * h);
  f32x16 O0[4], O1[4];
#pragma unroll
  for (int e = 0; e < 4; ++e)
#pragma unroll
    for (int i = 0; i < 16; ++i) { O0[e][i] = 0.f; O1[e][i] = 0.f; }
  float l0 = 0.f, l1 = 0.f;
  f32x16 cinit, zero16;
#pragma unroll
  for (int i = 0; i < 16; ++i) { cinit[i] = slope2 * (float)klocal(i, h); zero16[i] = 0.f; }
  const float tq = -slope2 * (float)qpos - M2;
  const int prow = pi32(r);

  auto stage = [=](int j, int buf) __attribute__((always_inline)) {
    LAS char* kb = lds + buf * 32768;
#pragma unroll
    for (int i = 0; i < 4; ++i) {
      const int pch = i * 256 + tid;
      { const int row = pch >> 4, ph = pch & 15, lg = ph ^ (row & 15);
        glds16(Kg + (size_t)(j * 64 + row) * 512 + lg * 8, kb + pch * 16); }
      { const int row = pch >> 3, ph = pch & 7, lg = ph ^ ((row >> 1) & 7);
        glds16(VT + (size_t)row * ldv + j * 64 + lg * 8, kb + 16384 + pch * 16); }
    }
  };
  __syncthreads();
  stage(0, 0);
  asm volatile("s_waitcnt vmcnt(0)" ::: "memory");
  __syncthreads();
  for (int j = 0; j < ntiles; ++j) {
    const int buf = j & 1;
    if (j + 1 < ntiles) stage(j + 1, buf ^ 1);
    {
      const LAS char* kb = lds + buf * 32768;
      const LAS char* vb = kb + 16384;
      const bool fast = DIFF && (j < cw);
#pragma unroll
      for (int kt = 0; kt < 2; ++kt) {
        const int krow = 32 * kt + prow;
        const LAS char* krp = kb + krow * 256;
        bf16x8 P0[2], P1[2];
        if (DIFF) {
#pragma unroll
          for (int c = 0; c < 2; ++c) {
            f32x16 s;
            if (fast) {
              s = cinit;
#pragma unroll
              for (int ks = 0; ks < 4; ++ks) {
                const int ch = (2 * (4 * c + ks) + h) ^ (krow & 15);
                s = mfma32(*reinterpret_cast<const LAS bf16x8*>(krp + ch * 16), qf[4 * c + ks], s);
              }
              const float t = tq + slope2 * (float)(j * 64 + kt * 32);
#pragma unroll
              for (int i = 0; i < 16; ++i) s[i] = __builtin_amdgcn_exp2f(s[i] + t);
            } else {
              s = zero16;
#pragma unroll
              for (int ks = 0; ks < 4; ++ks) {
                const int ch = (2 * (4 * c + ks) + h) ^ (krow & 15);
                s = mfma32(*reinterpret_cast<const LAS bf16x8*>(krp + ch * 16), qf[4 * c + ks], s);
              }
#pragma unroll
              for (int i = 0; i < 16; ++i) {
                const int kp = j * 64 + kt * 32 + klocal(i, h);
                const float bias = -slope2 * fabsf((float)(qpos - kp)) - M2;
                s[i] = (kp < nkeys && j <= cw) ? __builtin_amdgcn_exp2f(s[i] + bias) : 0.f;
              }
            }
            float ls = 0.f;
#pragma unroll
            for (int i = 0; i < 16; ++i) ls += s[i];
            if (c == 0) { l0 += ls; P0[0] = pack8(s, 0); P0[1] = pack8(s, 1); }
            else        { l1 += ls; P1[0] = pack8(s, 0); P1[1] = pack8(s, 1); }
          }
        } else {
          f32x16 s = zero16;
#pragma unroll
          for (int ks = 0; ks < 8; ++ks) {
            const int ch = (2 * ks + h) ^ (krow & 15);
            s = mfma32(*reinterpret_cast<const LAS bf16x8*>(krp + ch * 16), qf[ks], s);
          }
          float ls = 0.f;
#pragma unroll
          for (int i = 0; i < 16; ++i) { s[i] = __builtin_amdgcn_exp2f(s[i] - M2); ls += s[i]; }
          l0 += ls; P0[0] = pack8(s, 0); P0[1] = pack8(s, 1);
        }
#pragma unroll
        for (int et = 0; et < 4; ++et) {
          const int vrow = 32 * et + r;
#pragma unroll
          for (int sp = 0; sp < 2; ++sp) {
            const int ch = (2 * (2 * kt + sp) + h) ^ ((vrow >> 1) & 7);
            const bf16x8 vf = *reinterpret_cast<const LAS bf16x8*>(vb + vrow * 128 + ch * 16);
            O0[et] = mfma32(vf, P0[sp], O0[et]);
            if (DIFF) O1[et] = mfma32(vf, P1[sp], O1[et]);
          }
        }
      }
    }
    asm volatile("s_waitcnt vmcnt(0)" ::: "memory");
    __syncthreads();
  }
  if (act) {
    l0 += __shfl_xor(l0, 32);
    const float i0 = 1.f / l0;
    float i1 = 0.f;
    if (DIFF) { l1 += __shfl_xor(l1, 32); i1 = lam / l1; }
    float ss = 0.f;
#pragma unroll
    for (int et = 0; et < 4; ++et)
#pragma unroll
      for (int i = 0; i < 16; ++i) {
        float o = O0[et][i] * i0;
        if (DIFF) o -= O1[et][i] * i1;
        O0[et][i] = o; ss += o * o;
      }
    float rs = 1.f;
    if (DIFF) { ss += __shfl_xor(ss, 32); rs = rsqrtf(ss * (1.f / 128.f) + EPS) * 0.8f; }
    u16* grow = G + (size_t)(32 * w + r) * 512;
#pragma unroll
    for (int et = 0; et < 4; ++et)
#pragma unroll
      for (int g = 0; g < 4; ++g) {
        const int e0 = 32 * et + 8 * g + 4 * h;
        const u32x2 gt = *reinterpret_cast<const u32x2*>(grow + e0);
        float sg0 = 1.f, sg1 = 1.f, sg2 = 1.f, sg3 = 1.f;
        if (DIFF) { const float4 sv = *reinterpret_cast<const float4*>(subg + e0); sg0 = sv.x; sg1 = sv.y; sg2 = sv.z; sg3 = sv.w; }
        const float a0 = O0[et][4 * g + 0] * rs * sg0 * bflo(gt[0]);
        const float a1 = O0[et][4 * g + 1] * rs * sg1 * bfhi(gt[0]);
        const float a2 = O0[et][4 * g + 2] * rs * sg2 * bflo(gt[1]);
        const float a3 = O0[et][4 * g + 3] * rs * sg3 * bfhi(gt[1]);
        u32x2 o = {cvtpk(a0, a1), cvtpk(a2, a3)};
        *reinterpret_cast<u32x2*>(grow + e0) = o;
      }
  }
}

DEVI float max_abs64(const float* g, int n, int lane) { float v = 0.f; for (int i = lane; i < n; i += 64) v = fmaxf(v, fabsf(g[i])); return wmax(v); }

DEVI float scan_add(float v, int lane) { for (int o = 1; o < 64; o <<= 1) { const float t = __shfl_up(v, o); if (lane >= o) v += t; } return v; }
DEVI float scan_max(float v, int lane) { for (int o = 1; o < 64; o <<= 1) { const float t = __shfl_up(v, o); if (lane >= o) v = fmaxf(v, t); } return v; }
DEVI float bfe(const bf16x8& v, int j) { return __uint_as_float(((unsigned)(u16)v[j]) << 16); }

template <int NT>
DEVI void mlstm_local(LAS char* lds, const float* gates, int hd, const u16* KT, const u16* VT, int ldt,
                            f32x16 (&acc)[4], float& nh, float& bL, float& amax) {
  const int tid = threadIdx.x, lane = tid & 63, w = tid >> 6, r = lane & 31, h = lane >> 5;
  constexpr int L = 32 * NT;
  const float lf = lane < L ? gates[lane * 8 + 4 + hd] : 0.f;
  const float ig = lane < L ? gates[lane * 8 + hd] : -INFINITY;
  const float b = scan_add(lf, lane);
  const float a = ig - b;
  amax = wmax(a);
  bL = __shfl(b, L - 1);
  LAS float* wt = (LAS float*)(lds + 4096) + w * 64;
  wt[lane] = __expf(a - amax);
#pragma unroll
  for (int e = 0; e < 4; ++e)
#pragma unroll
    for (int i = 0; i < 16; ++i) acc[e][i] = 0.f;
  nh = 0.f;
#pragma unroll
  for (int ks = 0; ks < 2 * NT; ++ks) {
    const bf16x8 kf = ldg8(KT + (size_t)(32 * w + r) * ldt + 16 * ks + 8 * h);
    float wv[8];
#pragma unroll
    for (int j = 0; j < 8; ++j) { wv[j] = wt[16 * ks + 8 * h + j]; nh += bfe(kf, j) * wv[j]; }
#pragma unroll
    for (int et = 0; et < 4; ++et) {
      const bf16x8 vf = ldg8(VT + (size_t)(32 * et + r) * ldt + 16 * ks + 8 * h);
      u32x4 sv = {cvtpk(bfe(vf, 0) * wv[0], bfe(vf, 1) * wv[1]), cvtpk(bfe(vf, 2) * wv[2], bfe(vf, 3) * wv[3]),
                  cvtpk(bfe(vf, 4) * wv[4], bfe(vf, 5) * wv[5]), cvtpk(bfe(vf, 6) * wv[6], bfe(vf, 7) * wv[7])};
      acc[et] = mfma32(kf, *reinterpret_cast<bf16x8*>(&sv), acc[et]);
    }
  }
  nh += __shfl_xor(nh, 32);
}

template <int NT>
DEVI void mlstm_out(LAS char* lds, const float* gates, int hd, const u16* Qg, const u16* Kg, const u16* VT, int ldv,
                          const u16* CT, const float* n0, float m0, const float* mg, u16* G) {
  const int tid = threadIdx.x, lane = tid & 63, w = tid >> 6, r = lane & 31, h = lane >> 5;
  constexpr int L = 32 * NT;
  const float lf = lane < L ? gates[lane * 8 + 4 + hd] : 0.f;
  const float ig = lane < L ? gates[lane * 8 + hd] : -INFINITY;
  const float b = scan_add(lf, lane);
  const float a = ig - b;
  const float Mrow = fmaxf(m0, scan_max(a, lane));
  const float mt = b + Mrow;
  LAS float* at = (LAS float*)lds + w * 64;
  LAS float* red = (LAS float*)(lds + 1024);
  at[lane] = a;
  const int prow = pi32(r);
#pragma unroll 1
  for (int tt = 0; tt < NT; ++tt) {
    const int t = 32 * tt + r;
    const float Mrow_t = __shfl(Mrow, t), mt_t = __shfl(mt, t);
    const float winter = __expf(m0 - Mrow_t);
    bf16x8 qf[8];
    float qn = 0.f;
#pragma unroll
    for (int i = 0; i < 8; ++i) {
      qf[i] = ldg8(Qg + (size_t)t * 512 + 16 * i + 8 * h);
      const float4 na = *reinterpret_cast<const float4*>(n0 + 16 * i + 8 * h), nb = *reinterpret_cast<const float4*>(n0 + 16 * i + 8 * h + 4);
      qn += bfe(qf[i], 0) * na.x + bfe(qf[i], 1) * na.y + bfe(qf[i], 2) * na.z + bfe(qf[i], 3) * na.w
          + bfe(qf[i], 4) * nb.x + bfe(qf[i], 5) * nb.y + bfe(qf[i], 6) * nb.z + bfe(qf[i], 7) * nb.w;
    }
    qn += __shfl_xor(qn, 32);
    f32x16 H;
#pragma unroll
    for (int i = 0; i < 16; ++i) H[i] = 0.f;
#pragma unroll
    for (int ks = 0; ks < 8; ++ks) H = mfma32(ldg8(CT + (size_t)(32 * w + r) * 128 + 16 * ks + 8 * h), qf[ks], H);
#pragma unroll
    for (int i = 0; i < 16; ++i) H[i] *= winter;
    float dsum = 0.f;
    for (int st = 0; st <= tt; ++st) {
      f32x16 S;
#pragma unroll
      for (int i = 0; i < 16; ++i) S[i] = 0.f;
#pragma unroll
      for (int ks = 0; ks < 8; ++ks) S = mfma32(ldg8(Kg + (size_t)(32 * st + prow) * 512 + 16 * ks + 8 * h), qf[ks], S);
#pragma unroll
      for (int i = 0; i < 16; ++i) {
        const int s = 32 * st + klocal(i, h);
        const float wg = (s <= t) ? __expf(at[s] - Mrow_t) : 0.f;
        S[i] *= wg; dsum += S[i];
      }
#pragma unroll
      for (int sp = 0; sp < 2; ++sp)
        H = mfma32(ldg8(VT + (size_t)(32 * w + r) * ldv + 32 * st + 16 * sp + 8 * h), pack8(S, sp), H);
    }
    dsum += __shfl_xor(dsum, 32);
    const float den = winter * qn + dsum;
    const float inv = 1.f / fmaxf(fabsf(den), __expf(-mt_t));
    float ss = 0.f;
#pragma unroll
    for (int i = 0; i < 16; ++i) { H[i] *= inv; ss += H[i] * H[i]; }
    ss += __shfl_xor(ss, 32);
    if (h == 0) red[w * 64 + t] = ss;
    __syncthreads();
    const float tot = red[t] + red[64 + t] + red[128 + t] + red[192 + t];
    const float rs = rsqrtf(tot * (1.f / 128.f) + EPS);
    u16* grow = G + (size_t)t * 512;
#pragma unroll
    for (int g = 0; g < 4; ++g) {
      const int e0 = 32 * w + 8 * g + 4 * h;
      const u32x2 gt = *reinterpret_cast<const u32x2*>(grow + e0);
      const float4 mv = *reinterpret_cast<const float4*>(mg + e0);
      u32x2 o = {cvtpk(H[4 * g + 0] * rs * mv.x * bflo(gt[0]), H[4 * g + 1] * rs * mv.y * bfhi(gt[0])),
                 cvtpk(H[4 * g + 2] * rs * mv.z * bflo(gt[1]), H[4 * g + 3] * rs * mv.w * bfhi(gt[1]))};
      *reinterpret_cast<u32x2*>(grow + e0) = o;
    }
    __syncthreads();
  }
}

DEVI void m1_item(const Params& p, LAS char* lds, int item) {
  const int tid = threadIdx.x, lane = tid & 63, w = tid >> 6, r = lane & 31, h = lane >> 5;
  const int bh = item >> 7, c = item & 127, b = bh >> 2, hd = bh & 3;
  const size_t row0 = (size_t)b * SEQ + c * 64;
  f32x16 acc[4]; float nh, bL, amax;
  __syncthreads();
  mlstm_local<2>(lds, p.gates + row0 * 8, hd, p.KaT + (size_t)bh * 128 * SEQ + c * 64, p.VaT + (size_t)bh * 128 * SEQ + c * 64, SEQ, acc, nh, bL, amax);
  u16* Chat = p.xb + ((size_t)item * 128) * 128;
#pragma unroll
  for (int et = 0; et < 4; ++et)
#pragma unroll
    for (int g = 0; g < 4; ++g) {
      const int d0 = 32 * w + 8 * g + 4 * h, e = 32 * et + r;
      u32x2 o = {cvtpk(acc[et][4 * g], acc[et][4 * g + 1]), cvtpk(acc[et][4 * g + 2], acc[et][4 * g + 3])};
      *reinterpret_cast<u32x2*>(Chat + (size_t)e * 128 + d0) = o;
    }
  if (h == 0) p.nhat[(size_t)item * 128 + 32 * w + r] = nh;
  if (tid == 0) { p.tabA[item] = bL; p.tabB[item] = bL + amax; }
}

DEVI void phase_scan(const Params& p, LAS char* lds) {
  const int tid = threadIdx.x, lane = tid & 63;
  LAS float* al = (LAS float*)lds; LAS float* be = al + 128; LAS float* ms = al + 256;
  for (int u = blockIdx.x; u < 16 * 32; u += gridDim.x) {
    const int bh = u >> 5, part = u & 31;
    __syncthreads();
    if (tid < 64) {
      const float A0 = p.tabA[bh * 128 + 2 * lane], A1 = p.tabA[bh * 128 + 2 * lane + 1];
      const float B0 = p.tabB[bh * 128 + 2 * lane], B1 = p.tabB[bh * 128 + 2 * lane + 1];
      const float SAi = scan_add(A0 + A1, lane);
      const float SA0 = SAi - A1, SA1 = SAi;
      const float D0 = B0 - SA0, D1 = B1 - SA1;
      const float PMi = scan_max(fmaxf(D0, D1), lane);
      float PMx = __shfl_up(PMi, 1); if (lane == 0) PMx = -INFINITY;
      const float mn0 = SA0 + fmaxf(0.f, fmaxf(PMx, D0));
      const float mn1 = SA1 + fmaxf(0.f, PMi);
      float mprev = __shfl_up(mn1, 1); if (lane == 0) mprev = 0.f;
      al[2 * lane] = __expf(A0 + mprev - mn0); be[2 * lane] = __expf(B0 - mn0);
      al[2 * lane + 1] = __expf(A1 + mn0 - mn1); be[2 * lane + 1] = __expf(B1 - mn1);
      ms[2 * lane] = mprev; ms[2 * lane + 1] = mn0;
      if (lane == 63) ms[128] = mn1;
    }
    __syncthreads();
    if (part == 0) {
      if (tid < 129) p.mtab[bh * 129 + tid] = ms[tid];
      if (tid == 0) p.out[O_PM + bh] = ms[128];
    }
    u16* base = p.xb + (size_t)bh * 128 * 16384 + part * 512 + tid * 2;
    float c0 = 0.f, c1 = 0.f;
    for (int c = 0; c < 128; c += 8) {
      unsigned v[8];
#pragma unroll
      for (int j = 0; j < 8; ++j) v[j] = *reinterpret_cast<const unsigned*>(base + (size_t)(c + j) * 16384);
#pragma unroll
      for (int j = 0; j < 8; ++j) {
        *reinterpret_cast<unsigned*>(base + (size_t)(c + j) * 16384) = cvtpk(c0, c1);
        const float a_ = al[c + j], b_ = be[c + j];
        c0 = a_ * c0 + b_ * bflo(v[j]); c1 = a_ * c1 + b_ * bfhi(v[j]);
      }
    }
    { const int idx = part * 512 + tid * 2, e = idx >> 7, d = idx & 127;
      p.out[O_PC + ((size_t)bh * 128 + d) * 128 + e] = c0;
      p.out[O_PC + ((size_t)bh * 128 + d + 1) * 128 + e] = c1; }
    if (part == 0 && tid < 128) {
      float n = 0.f;
      for (int c = 0; c < 128; c += 16) {
        float nv[16];
#pragma unroll
        for (int j = 0; j < 16; ++j) nv[j] = p.nhat[((size_t)bh * 128 + c + j) * 128 + tid];
#pragma unroll
        for (int j = 0; j < 16; ++j) {
          p.nstate[((size_t)bh * 128 + c + j) * 128 + tid] = n;
          n = al[c + j] * n + be[c + j] * nv[j];
        }
      }
      p.out[O_PN + bh * 128 + tid] = n;
    }
  }
}

DEVI void m3_item(const Params& p, LAS char* lds, int item) {
  const int bh = item >> 7, c = item & 127, b = bh >> 2, hd = bh & 3;
  const size_t row0 = (size_t)b * SEQ + c * 64;
  __syncthreads();
  mlstm_out<2>(lds, p.gates + row0 * 8, hd, p.Qa + row0 * 512 + hd * 128, p.Ka + row0 * 512 + hd * 128,
               p.VaT + (size_t)bh * 128 * SEQ + c * 64, SEQ, p.xb + (size_t)item * 16384, p.nstate + (size_t)item * 128,
               p.mtab[bh * 129 + c], p.in[15] + hd * 128, p.Ga + row0 * 512 + hd * 128);
}

DEVI void ms_item(const Params& p, LAS char* lds, int bh) {
  const int tid = threadIdx.x, lane = tid & 63, w = tid >> 6, r = lane & 31, h = lane >> 5;
  const int b = bh >> 2, hd = bh & 3;
  const size_t row0 = (size_t)NTOKP + b * 32;
  const float m0 = p.in[9][bh];
  const float* n0 = p.in[8] + bh * 128;
  const u16* KTs = p.KaT + (size_t)NTOKP * 512 + (size_t)bh * 128 * 32;
  const u16* VTs = p.VaT + (size_t)NTOKP * 512 + (size_t)bh * 128 * 32;
  __syncthreads();
  mlstm_out<1>(lds, p.gates + row0 * 8, hd, p.Qa + row0 * 512 + hd * 128, p.Ka + row0 * 512 + hd * 128, VTs, 32,
               p.C0sT + (size_t)bh * 16384, n0, m0, p.in[15] + hd * 128, p.Ga + row0 * 512 + hd * 128);
  f32x16 acc[4]; float nh, bL, amax;
  mlstm_local<1>(lds, p.gates + row0 * 8, hd, KTs, VTs, 32, acc, nh, bL, amax);
  const float mlast = bL + fmaxf(m0, amax);
  const float decay = __expf(bL + m0 - mlast), beta = __expf(bL + amax - mlast);
#pragma unroll
  for (int et = 0; et < 4; ++et)
#pragma unroll
    for (int i = 0; i < 16; ++i) {
      const int d = 32 * w + crow(i, h), e = 32 * et + r;
      const size_t o = ((size_t)bh * 128 + d) * 128 + e;
      p.out[O_SC + o] = decay * p.in[7][o] + beta * acc[et][i];
    }
  if (h == 0) { const int d = 32 * w + r; p.out[O_SN + bh * 128 + d] = decay * n0[d] + beta * nh; }
  if (tid == 0) p.out[O_SM + bh] = mlast;
}

DEVI void phase_conv(const Params& p, LAS char* lds) {
  const int tid = threadIdx.x, lane = tid & 63, w = tid >> 6;
  const u16* U = p.Qa; u16* Gc = p.KaT;
  LAS u16* win = (LAS u16*)lds;
  LAS float* cs = (LAS float*)(lds + 20480);
  LAS float* st = (LAS float*)(lds + 20480 + 32768);
  for (int tile = blockIdx.x; tile < NTOK / 8; tile += gridDim.x) {
    const int row0 = tile * 8;
    const bool samp = row0 >= NTOKP;
    int t0, bs = 0;
    if (!samp) t0 = row0 & 8191; else { const int sr = row0 - NTOKP; bs = sr >> 5; t0 = sr & 31; }
    const int seqbase = row0 - t0;
#pragma unroll 1
    for (int cgp = 0; cgp < 4; ++cgp) {
      __syncthreads();
      for (int pch = tid; pch < 38 * 32; pch += 256) {
        const int rr = pch >> 5, ch = pch & 31, t = t0 - 30 + rr;
        u32x4 v = {0, 0, 0, 0};
        if (t >= 0) v = *reinterpret_cast<const u32x4*>(U + (size_t)(seqbase + t) * 1024 + cgp * 256 + ch * 8);
        else if (samp) {
          const float4* sc = reinterpret_cast<const float4*>(p.in[10] + ((size_t)(bs * 30 + 30 + t)) * 1024 + cgp * 256 + ch * 8);
          const float4 a = sc[0], c = sc[1];
          v = u32x4{cvtpk(a.x, a.y), cvtpk(a.z, a.w), cvtpk(c.x, c.y), cvtpk(c.z, c.w)};
        }
        *reinterpret_cast<LAS u32x4*>(win + rr * 256 + ch * 8) = v;
      }
      __syncthreads();
      const int chn = cgp * 256 + tid;
      float wv[38], cw[31];
#pragma unroll
      for (int rr = 0; rr < 38; ++rr) wv[rr] = bf2f(win[rr * 256 + tid]);
#pragma unroll
      for (int j = 0; j < 31; ++j) cw[j] = p.in[25][j * 1024 + chn];
      const float cb = p.in[26][chn];
#pragma unroll
      for (int i = 0; i < 8; ++i) {
        float a = cb;
#pragma unroll
        for (int j = 0; j < 31; ++j) a += cw[j] * wv[i + j];
        cs[i * 1024 + chn] = a;
      }
    }
    __syncthreads();
#pragma unroll
    for (int q = 0; q < 2; ++q) {
      const int i = 2 * w + q;
      float a1 = 0.f, a2 = 0.f;
#pragma unroll
      for (int k = 0; k < 16; ++k) { const float v = cs[i * 1024 + lane + 64 * k]; a1 += v; a2 += v * v; }
      a1 = wsum(a1); a2 = wsum(a2);
      if (lane == 0) {
        const float mu = a1 * (1.f / 1024.f);
        const float var = fmaxf(a2 * (1.f / 1024.f) - mu * mu, 0.f);
        st[2 * i] = mu; st[2 * i + 1] = rsqrtf(var + EPS);
      }
    }
    __syncthreads();
#pragma unroll 1
    for (int cgp = 0; cgp < 4; ++cgp) {
      const int chn = cgp * 256 + tid;
      const float lg = p.in[27][chn], lb = p.in[28][chn];
#pragma unroll
      for (int i = 0; i < 8; ++i) {
        const float y = (cs[i * 1024 + chn] - st[2 * i]) * st[2 * i + 1] * lg + lb;
        u16* gp = Gc + (size_t)(row0 + i) * 1024 + chn;
        *gp = f2bf(siluf_(y) * bf2f(*gp));
      }
    }
  }
}

struct AttnConst { float M2d, M2x, lam; };
DEVI AttnConst attn_consts(const Params& p, int layer) {
  const int lane = threadIdx.x & 63;
  AttnConst c;
  const float gq = max_abs64(p.in[16], 64, lane), gk = max_abs64(p.in[17], 64, lane);
  float kd = 0.f, kx = 0.f;
  for (int i = lane; i < (int)gridDim.x * 4; i += 64) { kd = fmaxf(kd, p.kmaxp[i]); kx = fmaxf(kx, p.kmaxp[1024 * (1 + layer) + i]); }
  kd = wmax(kd); kx = wmax(kx);
  c.M2d = (8.f * gq * 0.125f * LOG2E) * fmaxf(8.f * gk, sqrtf(kd)) * 1.01f;
  const float xq = max_abs64(p.in[32] + layer * 128, 128, lane), xk = max_abs64(p.in[33] + layer * 128, 128, lane);
  c.M2x = (11.313708f * xq * 0.08838834764831845f * LOG2E) * fmaxf(11.313708f * xk, sqrtf(kx)) * 1.01f;
  float d1 = p.in[18][lane] * p.in[19][lane], d2 = p.in[20][lane] * p.in[21][lane];
  d1 = wsum(d1); d2 = wsum(d2);
  c.lam = __expf(d1) - __expf(d2) + 0.2f;
  return c;
}

DEVI void cross_item(const Params& p, LAS char* lds, int layer, int it, float M2x) {
  const int hd = it & 3;
  size_t row0; int mb, nw;
  if (it < 1024) { const int rb = it >> 2; row0 = (size_t)rb * 128; mb = rb >> 6; nw = 4; }
  else { const int bs = (it - 1024) >> 2; row0 = (size_t)NTOKP + bs * 32; mb = 4 + bs; nw = 1; }
  attn_block<false>(lds, p.Qx + row0 * 512 + hd * 128, p.XK + ((size_t)(layer * 12 + mb) * 256) * 512 + hd * 128,
                    p.XVT + ((size_t)((layer * 12 + mb) * 4 + hd) * 128) * 256, 256, 4, nw, 0, 256, 0.f, M2x, 0.f, nullptr,
                    p.Gx + row0 * 512 + hd * 128);
}

DEVI void diff_item(const Params& p, LAS char* lds, int it, float M2d, float lam) {
  const bool pr = it < 1024;
  const int qb = pr ? 63 - (it >> 4) : 0;
  const int bh = pr ? (it & 15) : it - 1024;
  const int b = bh >> 2, hd = bh & 3;
  const size_t row0 = pr ? (size_t)b * SEQ + qb * 128 : (size_t)NTOKP + b * 32;
  const float slope2 = exp2f(-2.f * (hd + 1)) * LOG2E;
  const u16* Kp = pr ? p.Kb + (size_t)b * SEQ * 512 + hd * 128 : p.Ks + (size_t)b * SKP * 512 + hd * 128;
  const u16* Vp = pr ? p.VbT + (size_t)bh * 128 * SEQ : p.VsT + (size_t)bh * 128 * SKP;
  attn_block<true>(lds, p.Qb + row0 * 512 + hd * 128, Kp, Vp, pr ? SEQ : SKP, pr ? 2 * qb + 2 : 33, pr ? 4 : 1,
                   pr ? qb * 128 : PAST, pr ? SEQ : PAST + 32, slope2, M2d, lam, p.in[22], p.Gb + row0 * 512 + hd * 128);
}

DEVI int snake(int k, int g, int G) { return (k & 1) ? (k * G + (G - 1 - g)) : (k * G + g); }

constexpr int NPHASE = 9;
DEVI void run_phase(const Params& p, LAS char* lds, int ph) {
  const int G = gridDim.x, g = blockIdx.x;
  switch (ph) {
    case 0: phase_prep(p); break;
    case 1: phase_gemm<0>(p, lds); break;
    case 2: {
      const AttnConst c = attn_consts(p, 0);
      for (int it = g; it < 1056; it += G) cross_item(p, lds, 0, it, c.M2x);
      for (int it = g; it < 2048; it += G) m1_item(p, lds, it);
    } break;
    case 3: {
      const AttnConst c = attn_consts(p, 0);
      (void)c;
      phase_scan(p, lds);
    } break;
    case 4: {
      const AttnConst c = attn_consts(p, 0);
      for (int k = 0;; ++k) { const int it = snake(k, g, G); if (k * G >= 1056) break; if (it < 1056) diff_item(p, lds, it, c.M2d, c.lam); }
      for (int it = g; it < 2048; it += G) m3_item(p, lds, it);
      for (int it = G - 1 - g; it < 32; it += G) ms_item(p, lds, it);
    } break;
    case 5: phase_gemm<1>(p, lds); break;
    case 6: phase_gemm<2>(p, lds); break;
    case 7: {
      const AttnConst c = attn_consts(p, 1);
      phase_conv(p, lds);
      for (int it = g; it < 1056; it += G) cross_item(p, lds, 1, it, c.M2x);
    } break;
    case 8: phase_gemm<3>(p, lds); break;
  }
}

__global__ void __launch_bounds__(256, 1) mega(Params p, int ph_lo, int ph_hi) {
  extern __shared__ __attribute__((aligned(16))) char smem[];
  LAS char* lds = (LAS char*)smem;
  cg::grid_group grid = cg::this_grid();
#define RUNPH(k) if (ph_lo <= (k) && (k) < ph_hi) { if ((k) > ph_lo) grid.sync(); run_phase(p, lds, (k)); }
  RUNPH(0) RUNPH(1) RUNPH(2) RUNPH(3) RUNPH(4) RUNPH(5) RUNPH(6) RUNPH(7) RUNPH(8)
#undef RUNPH
}

#ifndef MULTI_LAUNCH
#define MULTI_LAUNCH 0
#endif

extern "C" void kernel_launch(void* const* d_in, const int* in_sizes, int n_in, void* d_out, int out_size, void* d_ws, size_t ws_size,
                              hipStream_t stream) {
  static int grid_blocks = 0;
  if (!grid_blocks) {
    int dev = 0, cus = 0, per_cu = 0;
    hipGetDevice(&dev);
    hipDeviceGetAttribute(&cus, hipDeviceAttributeMultiprocessorCount, dev);
    hipFuncSetAttribute((const void*)mega, hipFuncAttributeMaxDynamicSharedMemorySize, LDS_BYTES);
    hipOccupancyMaxActiveBlocksPerMultiprocessor(&per_cu, (const void*)mega, 256, LDS_BYTES);
    if (per_cu < 1) per_cu = 1;
    if (per_cu > 1) per_cu = 1;
    grid_blocks = (cus * per_cu) & ~7;
    if (grid_blocks < 8) grid_blocks = 8;
  }
  Params p{};
  for (int i = 0; i < 34; ++i) p.in[i] = (const float*)d_in[i];
  p.out = (float*)d_out;
  char* ws = (char*)d_ws;
  size_t off = 0;
  auto take = [&](size_t bytes) { char* q = ws + off; off += (bytes + 255) & ~(size_t)255; return q; };
  p.WtInA = (u16*)take((size_t)NPAD_A * 1024 * 2);
  p.WtOutA = (u16*)take((size_t)1024 * 1536 * 2);
  p.WtInC = (u16*)take((size_t)4096 * 1024 * 2);
  p.WtOutC = (u16*)take((size_t)1024 * 1536 * 2);
  p.WtMem = (u16*)take((size_t)2 * 1024 * 1024 * 2);
  p.xb = (u16*)take((size_t)NTOK * 1024 * 2);
  p.memb = (u16*)take((size_t)1024 * 1024 * 2);
  u16* segs = (u16*)take(SEG * 2 * 11);
  p.Qa = segs; p.Ka = segs + SEG; p.KaT = segs + 2 * SEG; p.VaT = segs + 3 * SEG; p.Ga = segs + 4 * SEG; p.Qb = segs + 5 * SEG;
  p.Kb = segs + 6 * SEG; p.VbT = segs + 7 * SEG; p.Gb = segs + 8 * SEG; p.Qx = segs + 9 * SEG; p.Gx = segs + 10 * SEG;
  p.Ks = (u16*)take((size_t)8 * SKP * 512 * 2);
  p.VsT = (u16*)take((size_t)4096 * SKP * 2);
  p.XK = (u16*)take((size_t)2 * 12 * 256 * 512 * 2);
  p.XVT = (u16*)take((size_t)2 * 12 * 256 * 512 * 2);
  p.C0sT = (u16*)take((size_t)32 * 16384 * 2);
  p.rs0 = (float*)take((size_t)NTOK * 4);
  p.ssq1 = (float*)take((size_t)NTOK * 4);
  p.rsmem = (float*)take((size_t)(1024 + 64) * 4);
  p.gates = (float*)take((size_t)NTOK * 8 * 4);
  p.tabA = (float*)take(2048 * 4);
  p.tabB = (float*)take(2048 * 4);
  p.mtab = (float*)take(16 * 129 * 4);
  p.nhat = (float*)take((size_t)2048 * 128 * 4);
  p.nstate = (float*)take((size_t)2048 * 128 * 4);
  p.kmaxp = (float*)take((size_t)3 * 1024 * 4);
  if (off > ws_size) { fprintf(stderr, "workspace too small: need %zu have %zu\n", off, ws_size); return; }
#if MULTI_LAUNCH
  for (int ph = 0; ph < NPHASE; ++ph) {
    hipLaunchKernelGGL(mega, dim3(grid_blocks), dim3(256), LDS_BYTES, stream, p, ph, ph + 1);
  }
#else
  int lo = 0, hi = NPHASE;
  void* args[] = {&p, &lo, &hi};
  hipError_t e = hipLaunchCooperativeKernel((const void*)mega, dim3(grid_blocks), dim3(256), args, LDS_BYTES, stream);
  if (e != hipSuccess) fprintf(stderr, "cooperative launch failed: %s (grid %d)\n", hipGetErrorString(e), grid_blocks);
#endif
}
```

```cpp
#include <hip/hip_runtime.h>
#include <hip/hip_cooperative_groups.h>
#include <stdint.h>
#include <stdio.h>
namespace cg = cooperative_groups;

typedef unsigned short u16;
using bf16x8 = __attribute__((ext_vector_type(8))) short;
using f32x4  = __attribute__((ext_vector_type(4))) float;
using f32x16 = __attribute__((ext_vector_type(16))) float;
using u32x4  = __attribute__((ext_vector_type(4))) unsigned;
using u32x2  = __attribute__((ext_vector_type(2))) unsigned;
#define LAS __attribute__((address_space(3)))
#define DEVI __device__ __forceinline__

constexpr int NTOKP = 32768, NTOKS = 256, NTOK = 33024;
constexpr int SEQ = 8192, LSAMP = 32, PAST = 2048, SKP = 2112;
constexpr size_t SEG = (size_t)NTOK * 512;
constexpr int NPAD_A = 5760;
constexpr float EPS = 1e-6f;
constexpr float LOG2E = 1.4426950408889634f;
constexpr size_t O_YP = 0, O_PXK = 33816576, O_PXV = 34865152, O_PK = 35913728, O_PV = 52690944,
  O_PC = 69468160, O_PN = 69730304, O_PM = 69732352, O_PCONV = 69732368, O_SK = 69855248, O_SV = 69986320,
  O_SC = 70117392, O_SN = 70641680, O_SM = 70645776, O_SCONV = 70645808;

constexpr int LDS_BYTES = 147456;

struct Params {
  const float* in[34];
  float* out;
  u16 *WtInA, *WtOutA, *WtInC, *WtOutC, *WtMem;
  u16 *xb, *memb;
  u16 *Qa, *Ka, *KaT, *VaT, *Ga, *Qb, *Kb, *VbT, *Gb, *Qx, *Gx;
  u16 *Ks, *VsT, *XK, *XVT, *C0sT;
  float *rs0, *ssq1, *rsmem, *gates, *tabA, *tabB, *mtab, *nhat, *nstate, *kmaxp;
};

DEVI unsigned cvtpk(float lo, float hi) { unsigned r; asm volatile("v_cvt_pk_bf16_f32 %0, %1, %2" : "=v"(r) : "v"(lo), "v"(hi)); return r; }
DEVI float bflo(unsigned u) { return __uint_as_float(u << 16); }
DEVI float bfhi(unsigned u) { return __uint_as_float(u & 0xffff0000u); }
DEVI float bf2f(u16 h) { return __uint_as_float(((unsigned)h) << 16); }
DEVI u16 f2bf(float f) { return (u16)(cvtpk(f, 0.f) & 0xffffu); }
DEVI float sigmoidf_(float x) { return 1.f / (1.f + __expf(-x)); }
DEVI float siluf_(float x) { return x / (1.f + __expf(-x)); }
DEVI float logsigmoidf_(float x) { return fminf(x, 0.f) - log1pf(__expf(-fabsf(x))); }
DEVI float wsum(float v) { for (int o = 32; o; o >>= 1) v += __shfl_xor(v, o); return v; }
DEVI float wmax(float v) { for (int o = 32; o; o >>= 1) v = fmaxf(v, __shfl_xor(v, o)); return v; }
DEVI int pi32(int r) { return (r & ~12) | ((r & 4) << 1) | ((r & 8) >> 1); }
DEVI int klocal(int reg, int h) { return (reg & 3) + 4 * ((reg >> 2) & 1) + 8 * h + 16 * (reg >> 3); }
DEVI int crow(int reg, int h) { return (reg & 3) + 8 * (reg >> 2) + 4 * h; }
DEVI bf16x8 ldg8(const u16* p) { return *reinterpret_cast<const bf16x8*>(p); }
DEVI f32x16 mfma32(bf16x8 a, bf16x8 b, f32x16 c) { return __builtin_amdgcn_mfma_f32_32x32x16_bf16(a, b, c, 0, 0, 0); }
DEVI bf16x8 pack8(const f32x16& x, int s) {
  u32x4 w = {cvtpk(x[8 * s + 0], x[8 * s + 1]), cvtpk(x[8 * s + 2], x[8 * s + 3]), cvtpk(x[8 * s + 4], x[8 * s + 5]), cvtpk(x[8 * s + 6], x[8 * s + 7])};
  return *reinterpret_cast<bf16x8*>(&w);
}
DEVI void glds16(const void* g, LAS void* l) { __builtin_amdgcn_global_load_lds((const unsigned*)g, (LAS unsigned*)l, 16, 0, 0); }

template <class F>
DEVI void wtrans(u16* dst, const float* src, const float* g, int K, int Npad, int ldn, F srccol, int gtid, int gsz) {
  const int total = Npad * (K / 32);
  for (int i = gtid; i < total; i += gsz) {
    const int n = i % Npad, kb = i / Npad;
    const int sc = srccol(n);
    float v[32];
#pragma unroll
    for (int j = 0; j < 32; ++j) v[j] = (sc >= 0) ? src[(size_t)(kb * 32 + j) * ldn + sc] : 0.f;
    if (g) {
#pragma unroll
      for (int j = 0; j < 32; ++j) v[j] *= g[kb * 32 + j];
    }
#pragma unroll
    for (int q = 0; q < 4; ++q) {
      u32x4 w = {cvtpk(v[8 * q + 0], v[8 * q + 1]), cvtpk(v[8 * q + 2], v[8 * q + 3]), cvtpk(v[8 * q + 4], v[8 * q + 5]), cvtpk(v[8 * q + 6], v[8 * q + 7])};
      *reinterpret_cast<u32x4*>(dst + (size_t)n * K + kb * 32 + q * 8) = w;
    }
  }
}

DEVI int srccol_in_a(int n) {
  const int t = n >> 7, c = n & 127;
  if (t < 12) return n;
  if (t < 20) { const int j = t - 12; return c < 64 ? 1536 + 64 * j + c : 2048 + 64 * j + (c - 64); }
  if (t < 44) return 2568 + (t - 20) * 128 + c;
  if (t == 44) return c < 8 ? 2560 + c : -1;
  return -1;
}
DEVI int srccol_in_c(int n) {
  const int t = n >> 7, c = n & 127;
  if (t < 16) return c < 64 ? 64 * t + c : 1024 + 64 * t + (c - 64);
  return n;
}

DEVI void phase_prep(const Params& p) {
  const int tid = threadIdx.x, lane = tid & 63;
  const int gtid = blockIdx.x * 256 + tid, gsz = gridDim.x * 256;
  const int gwave = gtid >> 6, nwaves = gsz >> 6;
  wtrans(p.WtInA, p.in[12], p.in[11], 1024, NPAD_A, 5640, [](int n) { return srccol_in_a(n); }, gtid, gsz);
  wtrans(p.WtOutA, p.in[23], nullptr, 1536, 1024, 1024, [](int n) { return n; }, gtid, gsz);
  wtrans(p.WtInC, p.in[24], p.in[11] + 1024, 1024, 4096, 4096, [](int n) { return srccol_in_c(n); }, gtid, gsz);
  wtrans(p.WtOutC, p.in[29], nullptr, 1536, 1024, 1024, [](int n) { return n; }, gtid, gsz);
  for (int l = 0; l < 2; ++l)
    wtrans(p.WtMem + (size_t)l * 1024 * 1024, p.in[31] + (size_t)l * 1024 * 1024, p.in[30] + l * 1024, 1024, 1024, 1024,
           [](int n) { return n; }, gtid, gsz);
  for (int row0 = gwave; row0 < NTOK + 1024; row0 += 4 * nwaves) {
    float4 v[4][4];
    const float* xr[4];
#pragma unroll
    for (int u = 0; u < 4; ++u) {
      const int row = min(row0 + u * nwaves, NTOK + 1023);
      xr[u] = row < NTOKP ? p.in[0] + (size_t)row * 1024 : (row < NTOK ? p.in[1] + (size_t)(row - NTOKP) * 1024 : p.in[2] + (size_t)(row - NTOK) * 1024);
    }
#pragma unroll
    for (int u = 0; u < 4; ++u)
#pragma unroll
      for (int i = 0; i < 4; ++i) v[u][i] = reinterpret_cast<const float4*>(xr[u])[lane + 64 * i];
#pragma unroll
    for (int u = 0; u < 4; ++u) {
      const int row = row0 + u * nwaves;
      float ss = 0.f;
#pragma unroll
      for (int i = 0; i < 4; ++i) ss += v[u][i].x * v[u][i].x + v[u][i].y * v[u][i].y + v[u][i].z * v[u][i].z + v[u][i].w * v[u][i].w;
      ss = wsum(ss);
      if (row < NTOK + 1024) {
        u16* dst = row < NTOK ? p.xb + (size_t)row * 1024 : p.memb + (size_t)(row - NTOK) * 1024;
        float* rsd = row < NTOK ? p.rs0 + row : p.rsmem + (row - NTOK);
        if (lane == 0) *rsd = rsqrtf(ss * (1.f / 1024.f) + EPS);
#pragma unroll
        for (int i = 0; i < 4; ++i) { u32x2 w = {cvtpk(v[u][i].x, v[u][i].y), cvtpk(v[u][i].z, v[u][i].w)}; reinterpret_cast<u32x2*>(dst)[lane + 64 * i] = w; }
      }
    }
  }
  float km0 = 0.f, km1 = 0.f, km2 = 0.f;
  for (int i0 = gtid; i0 < 8 * PAST * 64; i0 += 4 * gsz) {
    float4 a[4], c[4];
#pragma unroll
    for (int u = 0; u < 4; ++u) {
      const int i = i0 + u * gsz;
      const int c8 = i & 63, pp = (i >> 6) & (PAST - 1), b = (i >> 17) & 7;
      const float4* sp = reinterpret_cast<const float4*>(p.in[5] + ((size_t)(b * PAST + pp) * 512 + c8 * 8));
      a[u] = sp[0]; c[u] = sp[1];
    }
#pragma unroll
    for (int u = 0; u < 4; ++u) {
      const int i = i0 + u * gsz;
      if (i < 8 * PAST * 64) {
        const int c8 = i & 63, pp = (i >> 6) & (PAST - 1), b = i >> 17;
        u32x4 w = {cvtpk(a[u].x, a[u].y), cvtpk(a[u].z, a[u].w), cvtpk(c[u].x, c[u].y), cvtpk(c[u].z, c[u].w)};
        *reinterpret_cast<u32x4*>(p.Ks + ((size_t)(b * SKP + pp) * 512 + c8 * 8)) = w;
        float ss = a[u].x * a[u].x + a[u].y * a[u].y + a[u].z * a[u].z + a[u].w * a[u].w + c[u].x * c[u].x + c[u].y * c[u].y + c[u].z * c[u].z + c[u].w * c[u].w;
        ss += __shfl_xor(ss, 1); ss += __shfl_xor(ss, 2); ss += __shfl_xor(ss, 4);
        km0 = fmaxf(km0, ss);
      }
    }
  }
  for (int i0 = gtid; i0 < 8 * 4 * 256 * 128; i0 += 2 * gsz) {
    float v[2][8];
#pragma unroll
    for (int u = 0; u < 2; ++u) {
      const int i = (i0 + u * gsz) & (8 * 4 * 256 * 128 - 1);
      const int dv = i & 127, p8 = (i >> 7) & 255, h = (i >> 15) & 3, b = i >> 17;
#pragma unroll
      for (int j = 0; j < 8; ++j) v[u][j] = p.in[6][((size_t)(b * PAST + p8 * 8 + j) * 4 + h) * 128 + dv];
    }
#pragma unroll
    for (int u = 0; u < 2; ++u) {
      const int i = i0 + u * gsz;
      if (i < 8 * 4 * 256 * 128) {
        const int dv = i & 127, p8 = (i >> 7) & 255, h = (i >> 15) & 3, b = i >> 17;
        u32x4 w = {cvtpk(v[u][0], v[u][1]), cvtpk(v[u][2], v[u][3]), cvtpk(v[u][4], v[u][5]), cvtpk(v[u][6], v[u][7])};
        *reinterpret_cast<u32x4*>(p.VsT + ((size_t)((b * 4 + h) * 128 + dv) * SKP + p8 * 8)) = w;
      }
    }
  }
  for (int i = gtid; i < 4096 * 4; i += gsz) {
    u32x4 z = {0, 0, 0, 0};
    *reinterpret_cast<u32x4*>(p.VsT + ((size_t)(i >> 2) * SKP + 2080 + (i & 3) * 8)) = z;
  }
  for (int i = gtid; i < 8 * 32 * 64; i += gsz) {
    u32x4 z = {0, 0, 0, 0};
    const int c8 = i & 63, r = (i >> 6) & 31, b = i >> 11;
    *reinterpret_cast<u32x4*>(p.Ks + ((size_t)(b * SKP + 2080 + r) * 512 + c8 * 8)) = z;
  }
  for (int i = gtid; i < 2 * 8 * 256 * 64; i += gsz) {
    const int c8 = i & 63, m = (i >> 6) & 255, b = (i >> 14) & 7, l = i >> 17;
    const float4* s = reinterpret_cast<const float4*>(p.in[3] + ((size_t)((l * 8 + b) * 256 + m) * 512 + c8 * 8));
    const float4 a = s[0], c = s[1];
    u32x4 w = {cvtpk(a.x, a.y), cvtpk(a.z, a.w), cvtpk(c.x, c.y), cvtpk(c.z, c.w)};
    *reinterpret_cast<u32x4*>(p.XK + ((size_t)((l * 12 + 4 + b) * 256 + m) * 512 + c8 * 8)) = w;
    float ss = a.x * a.x + a.y * a.y + a.z * a.z + a.w * a.w + c.x * c.x + c.y * c.y + c.z * c.z + c.w * c.w;
    ss += __shfl_xor(ss, 1); ss += __shfl_xor(ss, 2); ss += __shfl_xor(ss, 4); ss += __shfl_xor(ss, 8);
    if (l == 0) km1 = fmaxf(km1, ss); else km2 = fmaxf(km2, ss);
  }
  for (int i = gtid; i < 2 * 8 * 4 * 32 * 128; i += gsz) {
    const int dv = i & 127, m8 = (i >> 7) & 31, h = (i >> 12) & 3, b = (i >> 14) & 7, l = i >> 17;
    float v[8];
#pragma unroll
    for (int j = 0; j < 8; ++j) v[j] = p.in[4][((size_t)((l * 8 + b) * 256 + m8 * 8 + j) * 4 + h) * 128 + dv];
    u32x4 w = {cvtpk(v[0], v[1]), cvtpk(v[2], v[3]), cvtpk(v[4], v[5]), cvtpk(v[6], v[7])};
    *reinterpret_cast<u32x4*>(p.XVT + ((size_t)(((l * 12 + 4 + b) * 4 + h) * 128 + dv) * 256 + m8 * 8)) = w;
  }
  for (int i = gtid; i < 32 * 16 * 128; i += gsz) {
    const int e = i & 127, d8 = (i >> 7) & 15, bh = i >> 11;
    float v[8];
#pragma unroll
    for (int j = 0; j < 8; ++j) v[j] = p.in[7][((size_t)bh * 128 + d8 * 8 + j) * 128 + e];
    u32x4 w = {cvtpk(v[0], v[1]), cvtpk(v[2], v[3]), cvtpk(v[4], v[5]), cvtpk(v[6], v[7])};
    *reinterpret_cast<u32x4*>(p.C0sT + ((size_t)bh * 128 + e) * 128 + d8 * 8) = w;
  }
  for (int i = gtid; i < NTOK; i += gsz) p.ssq1[i] = 0.f;
  km0 = wmax(km0); km1 = wmax(km1); km2 = wmax(km2);
  if (lane == 0) {
    const int slot = blockIdx.x * 4 + (tid >> 6);
    p.kmaxp[slot] = km0; p.kmaxp[1024 + slot] = km1; p.kmaxp[2048 + slot] = km2;
  }
}

DEVI void gemm_core(LAS char* lds, const u16* A0, const u16* A1, const u16* A2, int lda0, int lda1, int lda2, int segK,
                    const u16* Bt, int K, int brow, int bcol, f32x4 (&acc)[4][4]) {
  const int tid = threadIdx.x, lane = tid & 63, wid = tid >> 6, wr = wid >> 1, wc = wid & 1, fr = lane & 15, fq = lane >> 4;
  LAS char* SA = lds; LAS char* SB = lds + 8192;
#pragma unroll
  for (int m = 0; m < 4; ++m)
#pragma unroll
    for (int n = 0; n < 4; ++n) acc[m][n] = f32x4{0.f, 0.f, 0.f, 0.f};
  const int nkt = K / 32;
  for (int kt = 0; kt < nkt; ++kt) {
    const int k0 = kt * 32;
    const int seg = k0 / segK;
    const u16* Ab = (seg == 0 ? A0 : (seg == 1 ? A1 : A2)) + (k0 - seg * segK);
    const int lda = (seg == 0 ? lda0 : (seg == 1 ? lda1 : lda2));
#pragma unroll
    for (int i = 0; i < 2; ++i) {
      const int b = tid * 16 + i * 4096, r = b >> 6, c = (b & 63) >> 1;
      glds16(Ab + (size_t)(brow + r) * lda + c, SA + b);
      glds16(Bt + (size_t)(bcol + r) * K + k0 + c, SB + b);
    }
    asm volatile("s_waitcnt vmcnt(0)" ::: "memory");
    __syncthreads();
    bf16x8 af[4], bfr[4];
#pragma unroll
    for (int m = 0; m < 4; ++m) af[m] = *reinterpret_cast<const LAS bf16x8*>(SA + (wr * 64 + m * 16 + fr) * 64 + fq * 16);
#pragma unroll
    for (int n = 0; n < 4; ++n) bfr[n] = *reinterpret_cast<const LAS bf16x8*>(SB + (wc * 64 + n * 16 + fr) * 64 + fq * 16);
#pragma unroll
    for (int m = 0; m < 4; ++m)
#pragma unroll
      for (int n = 0; n < 4; ++n) acc[m][n] = __builtin_amdgcn_mfma_f32_16x16x32_bf16(af[m], bfr[n], acc[m][n], 0, 0, 0);
    __syncthreads();
  }
}

DEVI void gemm_stage_c(LAS char* lds, const f32x4 (&acc)[4][4], const float* rowscale, int mode, int brow) {
  const int tid = threadIdx.x, lane = tid & 63, wid = tid >> 6, wr = wid >> 1, wc = wid & 1, fr = lane & 15, fq = lane >> 4;
  LAS float* Cs = (LAS float*)lds;
#pragma unroll
  for (int m = 0; m < 4; ++m)
#pragma unroll
    for (int j = 0; j < 4; ++j) {
      const int r = wr * 64 + m * 16 + fq * 4 + j;
      float s = 1.f;
      if (mode == 1) s = rowscale[brow + r];
      else if (mode == 2) s = rsqrtf(rowscale[brow + r] * (1.f / 1024.f) + EPS);
#pragma unroll
      for (int n = 0; n < 4; ++n) Cs[r * 132 + wc * 64 + n * 16 + fr] = acc[m][n][j] * s;
    }
  __syncthreads();
}

DEVI void st_bf8(u16* dst, const float (&v)[8]) {
  u32x4 w = {cvtpk(v[0], v[1]), cvtpk(v[2], v[3]), cvtpk(v[4], v[5]), cvtpk(v[6], v[7])};
  *reinterpret_cast<u32x4*>(dst) = w;
}
DEVI void st_f8(float* dst, const float (&v)[8]) {
  reinterpret_cast<float4*>(dst)[0] = float4{v[0], v[1], v[2], v[3]};
  reinterpret_cast<float4*>(dst)[1] = float4{v[4], v[5], v[6], v[7]};
}
DEVI void store_transposed(LAS char* lds, u16* dst, size_t ldt, float scale) {
  const LAS float* Cs = (const LAS float*)lds;
  const int c = threadIdx.x & 127, rh = (threadIdx.x >> 7) * 64;
#pragma unroll
  for (int it = 0; it < 8; ++it) {
    const int r0 = rh + it * 8;
    float v[8];
#pragma unroll
    for (int j = 0; j < 8; ++j) v[j] = Cs[(r0 + j) * 132 + c] * scale;
    st_bf8(dst + (size_t)c * ldt + r0, v);
  }
}

DEVI void epi_in_a(const Params& p, LAS char* lds, int brow, int n) {
  const LAS float* Cs = (const LAS float*)lds;
  const int tid = threadIdx.x, cgp = tid & 15, c0 = cgp * 8;
  const bool samp = brow >= NTOKP;
  const int seg = n >> 2, hd = n & 3;
  if (n >= 4 && n < 12) {
    u16* base = (n < 8 ? p.KaT : p.VaT);
    const float sc = (n < 8 ? 0.08838834764831845f : 1.f);
    if (!samp) { const int b = brow >> 13, t0 = brow & 8191; store_transposed(lds, base + ((size_t)(b * 4 + hd) * 128) * SEQ + t0, SEQ, sc); }
    else {
      const int c = tid & 127, rh = (tid >> 7) * 64;
#pragma unroll
      for (int it = 0; it < 8; ++it) {
        const int r0 = rh + it * 8; const int bs = ((brow - NTOKP) + r0) >> 5, t0 = r0 & 31;
        float v[8];
#pragma unroll
        for (int j = 0; j < 8; ++j) v[j] = Cs[(r0 + j) * 132 + c] * sc;
        st_bf8(base + (size_t)NTOKP * 512 + ((size_t)(bs * 4 + hd) * 128 + c) * 32 + t0, v);
      }
    }
  }
  if (seg == 7) {
    if (!samp) { const int b = brow >> 13, t0 = brow & 8191; store_transposed(lds, p.VbT + ((size_t)(b * 4 + hd) * 128) * SEQ + t0, SEQ, 1.f); }
    else {
      const int c = tid & 127, rh = (tid >> 7) * 64;
#pragma unroll
      for (int it = 0; it < 8; ++it) {
        const int r0 = rh + it * 8; const int bs = ((brow - NTOKP) + r0) >> 5, t0 = r0 & 31;
        float v[8];
#pragma unroll
        for (int j = 0; j < 8; ++j) v[j] = Cs[(r0 + j) * 132 + c];
        st_bf8(p.VsT + ((size_t)(bs * 4 + hd) * 128 + c) * SKP + PAST + t0, v);
      }
    }
  }
  float gn[8];
  {
    const float* gp = nullptr;
    if (n >= 20 && n < 24) gp = p.in[16] + (c0 & 63);
    else if (n >= 24 && n < 28) gp = p.in[17] + (c0 & 63);
    else if (n >= 36 && n < 40) gp = p.in[32] + c0;
    else if (n == 44) gp = (cgp == 0) ? nullptr : nullptr;
#pragma unroll
    for (int j = 0; j < 8; ++j) gn[j] = gp ? gp[j] : 0.f;
    if (n == 44) {
#pragma unroll
      for (int j = 0; j < 4; ++j) { gn[j] = p.in[13][j]; gn[4 + j] = p.in[14][j]; }
    }
  }
#pragma unroll 1
  for (int it = 0; it < 8; ++it) {
    const int r = it * 16 + (tid >> 4);
    const size_t grow = (size_t)brow + r;
    float v[8];
#pragma unroll
    for (int j = 0; j < 8; ++j) v[j] = Cs[r * 132 + c0 + j];
    if (n < 4) { st_bf8(p.Qa + grow * 512 + hd * 128 + c0, v); }
    else if (n < 8) {
#pragma unroll
      for (int j = 0; j < 8; ++j) v[j] *= 0.08838834764831845f;
      st_bf8(p.Ka + grow * 512 + hd * 128 + c0, v);
    }
    else if (n < 12) {   }
    else if (n < 20) {
      if (cgp < 8) {
        float g[8];
#pragma unroll
        for (int j = 0; j < 8; ++j) g[j] = sigmoidf_(v[j]) * siluf_(Cs[r * 132 + 64 + c0 + j]);
        st_bf8(p.Ga + grow * 512 + (n - 12) * 64 + c0, g);
      }
    }
    else if (n < 28) {
      float ss = 0.f;
#pragma unroll
      for (int j = 0; j < 8; ++j) ss += v[j] * v[j];
      ss += __shfl_xor(ss, 1); ss += __shfl_xor(ss, 2); ss += __shfl_xor(ss, 4);
      const float rs = rsqrtf(ss * (1.f / 64.f) + EPS);
      const float* g = gn;
      if (n < 24) {
#pragma unroll
        for (int j = 0; j < 8; ++j) v[j] = v[j] * rs * g[j] * (0.125f * LOG2E);
        st_bf8(p.Qb + grow * 512 + hd * 128 + c0, v);
      } else {
#pragma unroll
        for (int j = 0; j < 8; ++j) v[j] = v[j] * rs * g[j];
        if (!samp) { st_f8(p.out + O_PK + grow * 512 + hd * 128 + c0, v); st_bf8(p.Kb + grow * 512 + hd * 128 + c0, v); }
        else {
          const int sr = (int)grow - NTOKP, bs = sr >> 5, t = sr & 31;
          st_f8(p.out + O_SK + (size_t)sr * 512 + hd * 128 + c0, v);
          st_bf8(p.Ks + ((size_t)(bs * SKP + PAST + t)) * 512 + hd * 128 + c0, v);
        }
      }
    }
    else if (n < 32) {
      if (!samp) st_f8(p.out + O_PV + grow * 512 + hd * 128 + c0, v);
      else st_f8(p.out + O_SV + (size_t)((int)grow - NTOKP) * 512 + hd * 128 + c0, v);
    }
    else if (n < 36) {
#pragma unroll
      for (int j = 0; j < 8; ++j) v[j] = siluf_(v[j]);
      st_bf8(p.Gb + grow * 512 + hd * 128 + c0, v);
    }
    else if (n < 40) {
      float ss = 0.f;
#pragma unroll
      for (int j = 0; j < 8; ++j) ss += v[j] * v[j];
      ss += __shfl_xor(ss, 1); ss += __shfl_xor(ss, 2); ss += __shfl_xor(ss, 4); ss += __shfl_xor(ss, 8);
      const float rs = rsqrtf(ss * (1.f / 128.f) + EPS);
      const float* g = gn;
#pragma unroll
      for (int j = 0; j < 8; ++j) v[j] = v[j] * rs * g[j] * (0.08838834764831845f * LOG2E);
      st_bf8(p.Qx + grow * 512 + hd * 128 + c0, v);
    }
    else if (n < 44) {
#pragma unroll
      for (int j = 0; j < 8; ++j) v[j] = siluf_(v[j]);
      st_bf8(p.Gx + grow * 512 + hd * 128 + c0, v);
    }
    else {
      if (cgp == 0) {
        float g[8];
#pragma unroll
        for (int j = 0; j < 4; ++j) { g[j] = v[j] + gn[j]; g[4 + j] = logsigmoidf_(v[4 + j] + gn[4 + j]); }
        st_f8(p.gates + grow * 8, g);
      }
    }
  }
}

DEVI void epi_mem(const Params& p, LAS char* lds, int l, int brow, int n) {
  const LAS float* Cs = (const LAS float*)lds;
  const int tid = threadIdx.x, cgp = tid & 15, c0 = cgp * 8;
  const int hd = n & 3;
  if (n >= 4) {
    const int b = brow >> 8, m0 = brow & 255;
    store_transposed(lds, p.XVT + ((size_t)((l * 12 + b) * 4 + hd) * 128) * 256 + m0, 256, 1.f);
  }
  float gk[8];
#pragma unroll
  for (int j = 0; j < 8; ++j) gk[j] = p.in[33][l * 128 + c0 + j];
#pragma unroll 1
  for (int it = 0; it < 8; ++it) {
    const int r = it * 16 + (tid >> 4);
    const size_t grow = (size_t)brow + r;
    float v[8];
#pragma unroll
    for (int j = 0; j < 8; ++j) v[j] = Cs[r * 132 + c0 + j];
    if (n < 4) {
      float ss = 0.f;
#pragma unroll
      for (int j = 0; j < 8; ++j) ss += v[j] * v[j];
      ss += __shfl_xor(ss, 1); ss += __shfl_xor(ss, 2); ss += __shfl_xor(ss, 4); ss += __shfl_xor(ss, 8);
      const float rs = rsqrtf(ss * (1.f / 128.f) + EPS);
      const float* g = gk;
#pragma unroll
      for (int j = 0; j < 8; ++j) v[j] = v[j] * rs * g[j];
      st_f8(p.out + O_PXK + ((size_t)l * 1024 + grow) * 512 + hd * 128 + c0, v);
      const int b = (int)grow >> 8, m = (int)grow & 255;
      st_bf8(p.XK + ((size_t)((l * 12 + b) * 256 + m)) * 512 + hd * 128 + c0, v);
    } else {
      st_f8(p.out + O_PXV + ((size_t)l * 1024 + grow) * 512 + hd * 128 + c0, v);
    }
  }
}

DEVI void epi_out(const Params& p, LAS char* lds, int layer, int brow, int n) {
  const LAS float* Cs = (const LAS float*)lds;
  const int tid = threadIdx.x, cgp = tid & 15, c0 = cgp * 8;
#pragma unroll 1
  for (int hb = 0; hb < 2; ++hb) {
    float4 ra[4], rb[4];
#pragma unroll
    for (int q = 0; q < 4; ++q) {
      const size_t grow = (size_t)brow + (hb * 4 + q) * 16 + (tid >> 4);
      const float* res;
      if (layer == 0) res = (grow < NTOKP ? p.in[0] + grow * 1024 : p.in[1] + (grow - NTOKP) * 1024) + n * 128 + c0;
      else res = p.out + grow * 1024 + n * 128 + c0;
      ra[q] = reinterpret_cast<const float4*>(res)[0]; rb[q] = reinterpret_cast<const float4*>(res)[1];
    }
#pragma unroll
    for (int q = 0; q < 4; ++q) {
      const int r = (hb * 4 + q) * 16 + (tid >> 4);
      const size_t grow = (size_t)brow + r;
      float v[8];
#pragma unroll
      for (int j = 0; j < 8; ++j) v[j] = Cs[r * 132 + c0 + j];
      v[0] += ra[q].x; v[1] += ra[q].y; v[2] += ra[q].z; v[3] += ra[q].w; v[4] += rb[q].x; v[5] += rb[q].y; v[6] += rb[q].z; v[7] += rb[q].w;
      st_f8(p.out + grow * 1024 + n * 128 + c0, v);
      if (layer == 0) {
        st_bf8(p.xb + grow * 1024 + n * 128 + c0, v);
        float ss = 0.f;
#pragma unroll
        for (int j = 0; j < 8; ++j) ss += v[j] * v[j];
        ss += __shfl_xor(ss, 1); ss += __shfl_xor(ss, 2); ss += __shfl_xor(ss, 4); ss += __shfl_xor(ss, 8);
        if (cgp == 0) atomicAdd(p.ssq1 + grow, ss);
      }
    }
  }
}

DEVI void epi_in_c(const Params& p, LAS char* lds, int brow, int n) {
  const LAS float* Cs = (const LAS float*)lds;
  const int tid = threadIdx.x, cgp = tid & 15, c0 = cgp * 8;
  u16* U = p.Qa;
  u16* Gc = p.KaT;
  float gx[8];
#pragma unroll
  for (int j = 0; j < 8; ++j) gx[j] = p.in[32][128 + c0 + j];
#pragma unroll 1
  for (int it = 0; it < 8; ++it) {
    const int r = it * 16 + (tid >> 4);
    const size_t grow = (size_t)brow + r;
    float v[8];
#pragma unroll
    for (int j = 0; j < 8; ++j) v[j] = Cs[r * 132 + c0 + j];
    if (n < 16) {
      if (cgp < 8) {
        float u[8];
#pragma unroll
        for (int j = 0; j < 8; ++j) u[j] = v[j] * sigmoidf_(Cs[r * 132 + 64 + c0 + j]);
        st_bf8(U + grow * 1024 + n * 64 + c0, u);
        if (grow < NTOKP) { const int t = (int)grow & 8191, b = (int)grow >> 13; if (t >= SEQ - 30) st_f8(p.out + O_PCONV + ((size_t)(b * 30 + t - (SEQ - 30))) * 1024 + n * 64 + c0, u); }
        else { const int sr = (int)grow - NTOKP, t = sr & 31, b = sr >> 5; if (t >= 2) st_f8(p.out + O_SCONV + ((size_t)(b * 30 + t - 2)) * 1024 + n * 64 + c0, u); }
      }
    } else if (n < 24) {
#pragma unroll
      for (int j = 0; j < 8; ++j) v[j] = siluf_(v[j]);
      st_bf8(Gc + grow * 1024 + (n - 16) * 128 + c0, v);
    } else if (n < 28) {
      float ss = 0.f;
#pragma unroll
      for (int j = 0; j < 8; ++j) ss += v[j] * v[j];
      ss += __shfl_xor(ss, 1); ss += __shfl_xor(ss, 2); ss += __shfl_xor(ss, 4); ss += __shfl_xor(ss, 8);
      const float rs = rsqrtf(ss * (1.f / 128.f) + EPS);
      const float* g = gx;
#pragma unroll
      for (int j = 0; j < 8; ++j) v[j] = v[j] * rs * g[j] * (0.08838834764831845f * LOG2E);
      st_bf8(p.Qx + grow * 512 + (n - 24) * 128 + c0, v);
    } else {
#pragma unroll
      for (int j = 0; j < 8; ++j) v[j] = siluf_(v[j]);
      st_bf8(p.Gx + grow * 512 + (n - 28) * 128 + c0, v);
    }
  }
}

DEVI void gemm_core(LAS char* lds, const u16* A0, const u16* A1, const u16* A2, int lda0, int lda1, int lda2, int segK,
                    const u16* Bt, int K, int brow, int bcol, f32x16 (&acc)[4][2]) {
  const int tid = threadIdx.x, lane = tid & 63, w = tid >> 6, wr = w >> 1, wc = w & 1, r = lane & 31, h = lane >> 5;
#pragma unroll
  for (int i = 0; i < 4; ++i)
#pragma unroll
    for (int j = 0; j < 2; ++j)
#pragma unroll
      for (int e = 0; e < 16; ++e) acc[i][j][e] = 0.f;
  const int nkt = K / 64;
  auto stage = [=](int kt, int buf) __attribute__((always_inline)) {
    const int k0 = kt * 64;
    const int seg = k0 / segK;
    const u16* Ab = (seg == 0 ? A0 : (seg == 1 ? A1 : A2)) + (k0 - seg * segK);
    const int lda = (seg == 0 ? lda0 : (seg == 1 ? lda1 : lda2));
    LAS char* sa = lds + buf * 49152;
    LAS char* sb = sa + 32768;
#pragma unroll
    for (int i = 0; i < 8; ++i) {
      const int pch = i * 256 + tid, row = pch >> 3, lg = (pch & 7) ^ ((row >> 1) & 7);
      glds16(Ab + (size_t)(brow + row) * lda + lg * 8, sa + pch * 16);
    }
#pragma unroll
    for (int i = 0; i < 4; ++i) {
      const int pch = i * 256 + tid, row = pch >> 3, lg = (pch & 7) ^ ((row >> 1) & 7);
      glds16(Bt + (size_t)(bcol + row) * K + k0 + lg * 8, sb + pch * 16);
    }
  };
  __syncthreads();
  stage(0, 0);
  stage(1, 1);
  int buf = 0;
  for (int kt = 0; kt < nkt; ++kt) {
    if (kt + 1 < nkt) asm volatile("s_waitcnt vmcnt(12)" ::: "memory"); else asm volatile("s_waitcnt vmcnt(0)" ::: "memory");
    asm volatile("s_waitcnt lgkmcnt(0)" ::: "memory");
    __builtin_amdgcn_s_barrier();
    if (kt + 2 < nkt) { int nb = buf + 2; if (nb >= 3) nb -= 3; stage(kt + 2, nb); }
    const LAS char* sa = lds + buf * 49152;
    const LAS char* sb = sa + 32768;
    bf16x8 af[2][4], bfr[2][2];
#pragma unroll
    for (int i = 0; i < 4; ++i) {
      const int row = 32 * (2 * i + wr) + r, ch = h ^ ((row >> 1) & 7);
      af[0][i] = *reinterpret_cast<const LAS bf16x8*>(sa + row * 128 + ch * 16);
    }
#pragma unroll
    for (int j = 0; j < 2; ++j) {
      const int row = 32 * (2 * j + wc) + r, ch = h ^ ((row >> 1) & 7);
      bfr[0][j] = *reinterpret_cast<const LAS bf16x8*>(sb + row * 128 + ch * 16);
    }
#pragma unroll
    for (int ks = 0; ks < 4; ++ks) {
      const int cur = ks & 1, nxt = cur ^ 1;
      if (ks < 3) {
#pragma unroll
        for (int i = 0; i < 4; ++i) {
          const int row = 32 * (2 * i + wr) + r, ch = (2 * (ks + 1) + h) ^ ((row >> 1) & 7);
          af[nxt][i] = *reinterpret_cast<const LAS bf16x8*>(sa + row * 128 + ch * 16);
        }
#pragma unroll
        for (int j = 0; j < 2; ++j) {
          const int row = 32 * (2 * j + wc) + r, ch = (2 * (ks + 1) + h) ^ ((row >> 1) & 7);
          bfr[nxt][j] = *reinterpret_cast<const LAS bf16x8*>(sb + row * 128 + ch * 16);
        }
      }
#pragma unroll
      for (int i = 0; i < 4; ++i)
#pragma unroll
        for (int j = 0; j < 2; ++j) acc[i][j] = mfma32(af[cur][i], bfr[cur][j], acc[i][j]);
    }
    if (++buf == 3) buf = 0;
  }
}

template <int I>
DEVI void stage_sub(LAS char* lds, const f32x16 (&acc)[4][2], const float* rowscale, int mode, int brow) {
  const int tid = threadIdx.x, lane = tid & 63, w = tid >> 6, wr = w >> 1, wc = w & 1, r = lane & 31, h = lane >> 5;
  LAS float* Cs = (LAS float*)lds;
#pragma unroll
  for (int ii = 0; ii < 2; ++ii)
#pragma unroll
    for (int e = 0; e < 16; ++e) {
      const int row = 32 * (2 * ii + wr) + crow(e, h);
      float s = 1.f;
      if (mode == 1) s = rowscale[brow + 128 * I + row];
      else if (mode == 2) s = rsqrtf(rowscale[brow + 128 * I + row] * (1.f / 1024.f) + EPS);
#pragma unroll
      for (int jj = 0; jj < 2; ++jj) Cs[row * 132 + 32 * (2 * jj + wc) + r] = acc[2 * I + ii][jj][e] * s;
    }
}

DEVI void gemm_tile_run(const Params& p, LAS char* lds, int which, int aux, int mt, int n, f32x16 (&acc)[4][2]) {
  const int brow = mt * 256, bcol = n * 128;
  const float* rsc = nullptr; int mode = 0;
  if (which == 0) { gemm_core(lds, p.xb, p.xb, p.xb, 1024, 1024, 1024, 1024, p.WtInA, 1024, brow, bcol, acc); rsc = p.rs0; mode = 1; }
  else if (which == 1) gemm_core(lds, p.Ga, p.Gb, p.Gx, 512, 512, 512, 512, p.WtOutA, 1536, brow, bcol, acc);
  else if (which == 2) { gemm_core(lds, p.xb, p.xb, p.xb, 1024, 1024, 1024, 1024, p.WtInC, 1024, brow, bcol, acc); rsc = p.ssq1; mode = 2; }
  else if (which == 3) gemm_core(lds, p.KaT, p.KaT + 512, p.Gx, 1024, 1024, 512, 512, p.WtOutC, 1536, brow, bcol, acc);
  else { gemm_core(lds, p.memb, p.memb, p.memb, 1024, 1024, 1024, 1024, p.WtMem + (size_t)aux * 1024 * 1024, 1024, brow, bcol, acc); rsc = p.rsmem; mode = 1; }
#pragma unroll 1
  for (int sub = 0; sub < 2; ++sub) {
    __syncthreads();
    if (sub == 0) stage_sub<0>(lds, acc, rsc, mode, brow); else stage_sub<1>(lds, acc, rsc, mode, brow);
    __syncthreads();
    const int sr = brow + 128 * sub;
    if (which == 0) epi_in_a(p, lds, sr, n);
    else if (which == 1) epi_out(p, lds, 0, sr, n);
    else if (which == 2) epi_in_c(p, lds, sr, n);
    else if (which == 3) epi_out(p, lds, 1, sr, n);
    else epi_mem(p, lds, aux, sr, n);
  }
}

template <int which>
DEVI void phase_gemm(const Params& p, LAS char* lds) {
  const int nN = (which == 0 ? 45 : (which == 2 ? 32 : 8));
  const int ntiles = 128 * nN;
  const int G = gridDim.x;
  const int xcd = blockIdx.x & 7, lb = blockIdx.x >> 3, slots = G >> 3;
  const int nextra = nN + (which == 0 ? 64 : 0);
  f32x16 acc[4][2];
  int round = 0, t_extra = blockIdx.x;
  bool main_done = false;
  for (;;) {
    int wh = which, aux = 0, mt = 0, n = 0;
    if (!main_done) {
      const int q = lb + slots * round; ++round;
      const int L = 32 * (xcd + 8 * (q >> 5)) + (q & 31);
      if (L >= ntiles) { main_done = true; continue; }
      const int mg = L / (8 * nN), rem = L - mg * 8 * nN;
      n = rem >> 3; mt = mg * 8 + (rem & 7);
    } else {
      if (t_extra >= nextra) break;
      const int t = t_extra; t_extra += G;
      if (t < nN) { mt = 128; n = t; }
      else { const int q = t - nN; wh = 4; aux = q >> 5; mt = (q >> 3) & 3; n = q & 7; }
    }
    gemm_tile_run(p, lds, wh, aux, mt, n, acc);
  }
}

template <bool DIFF>
DEVI void attn_block(LAS char* lds, const u16* Q, const u16* Kg, const u16* VT, int ldv, int ntiles, int nwact,
                           int qpos0, int nkeys, float slope2, float M2, float lam, const float* subg, u16* G) {
  const int tid = threadIdx.x, lane = tid & 63, w = tid >> 6, r = lane & 31, h = lane >> 5;
  const bool act = w < nwact;
  const int qpos = qpos0 + 32 * w + r;
  const int cw = (qpos0 + 32 * w) >> 6;
  bf16x8 qf[8];
#pragma unroll
  for (int i = 0; i < 8; ++i) qf[i] = ldg8(Q + (size_t)(32 * w + r) * 512 + 16 * i + 8 * h);
  f32x16 O0[4], O1[4];
#pragma unroll
  for (int e = 0; e < 4; ++e)
#pragma unroll
    for (int i = 0; i < 16; ++i) { O0[e][i] = 0.f; O1[e][i] = 0.f; }
  float l0 = 0.f, l1 = 0.f;
  f32x16 cinit, zero16;
#pragma unroll
  for (int i = 0; i < 16; ++i) { cinit[i] = slope2 * (float)klocal(i, h); zero16[i] = 0.f; }
  const float tq = -slope2 * (float)qpos - M2;
  const int prow = pi32(r);

  auto stage = [=](int j, int buf) __attribute__((always_inline)) {
    LAS char* kb = lds + buf * 32768;
#pragma unroll
    for (int i = 0; i < 4; ++i) {
      const int pch = i * 256 + tid;
      { const int row = pch >> 4, ph = pch & 15, lg = ph ^ (row & 15);
        glds16(Kg + (size_t)(j * 64 + row) * 512 + lg * 8, kb + pch * 16); }
      { const int row = pch >> 3, ph = pch & 7, lg = ph ^ ((row >> 1) & 7);
        glds16(VT + (size_t)row * ldv + j * 64 + lg * 8, kb + 16384 + pch * 16); }
    }
  };
  __syncthreads();
  stage(0, 0);
  asm volatile("s_waitcnt vmcnt(0)" ::: "memory");
  __syncthreads();
  for (int j = 0; j < ntiles; ++j) {
    const int buf = j & 1;
    if (j + 1 < ntiles) stage(j + 1, buf ^ 1);
    {
      const LAS char* kb = lds + buf * 32768;
      const LAS char* vb = kb + 16384;
      const bool fast = DIFF && (j < cw);
#pragma unroll
      for (int kt = 0; kt < 2; ++kt) {
        const int krow = 32 * kt + prow;
        const LAS char* krp = kb + krow * 256;
        bf16x8 P0[2], P1[2];
        if (DIFF) {
#pragma unroll
          for (int c = 0; c < 2; ++c) {
            f32x16 s;
            if (fast) {
              s = cinit;
#pragma unroll
              for (int ks = 0; ks < 4; ++ks) {
                const int ch = (2 * (4 * c + ks) + h) ^ (krow & 15);
                s = mfma32(*reinterpret_cast<const LAS bf16x8*>(krp + ch * 16), qf[4 * c + ks], s);
              }
              const float t = tq + slope2 * (float)(j * 64 + kt * 32);
#pragma unroll
              for (int i = 0; i < 16; ++i) s[i] = __builtin_amdgcn_exp2f(s[i] + t);
            } else {
              s = zero16;
#pragma unroll
              for (int ks = 0; ks < 4; ++ks) {
                const int ch = (2 * (4 * c + ks) + h) ^ (krow & 15);
                s = mfma32(*reinterpret_cast<const LAS bf16x8*>(krp + ch * 16), qf[4 * c + ks], s);
              }
#pragma unroll
              for (int i = 0; i < 16; ++i) {
                const int kp = j * 64 + kt * 32 + klocal(i, h);
                const float bias = -slope2 * fabsf((float)(qpos - kp)) - M2;
                s[i] = (kp < nkeys && j <= cw) ? __builtin_amdgcn_exp2f(s[i] + bias) : 0.f;
              }
            }
            float ls = 0.f;
#pragma unroll
            for (int i = 0; i < 16; ++i) ls += s[i];
            if (c == 0) { l0 += ls; P0[0] = pack8(s, 0); P0[1] = pack8(s, 1); }
            else        { l1 += ls; P1[0] = pack8(s, 0); P1[1] = pack8(s, 1); }
          }
        } else {
          f32x16 s = zero16;
#pragma unroll
          for (int ks = 0; ks < 8; ++ks) {
            const int ch = (2 * ks + h) ^ (krow & 15);
            s = mfma32(*reinterpret_cast<const LAS bf16x8*>(krp + ch * 16), qf[ks], s);
          }
          float ls = 0.f;
#pragma unroll
          for (int i = 0; i < 16; ++i) { s[i] = __builtin_amdgcn_exp2f(s[i] - M2); ls += s[i]; }
          l0 += ls; P0[0] = pack8(s, 0); P0[1] = pack8(s, 1);
        }
#pragma unroll
        for (int et = 0; et < 4; ++et) {
          const int vrow = 32 * et + r;
#pragma unroll
          for (int sp = 0; sp < 2; ++sp) {
            const int ch = (2 * (2 * kt + sp) + h) ^ ((vrow >> 1) & 7);
            const bf16x8 vf = *reinterpret_cast<const LAS bf16x8*>(vb + vrow * 128 + ch * 16);
            O0[et] = mfma32(vf, P0[sp], O0[et]);
            if (DIFF) O1[et] = mfma32(vf, P1[sp], O1[et]);
          }
        }
      }
    }
    asm volatile("s_waitcnt vmcnt(0)" ::: "memory");
    __syncthreads();
  }
  if (act) {
    l0 += __shfl_xor(l0, 32);
    const float i0 = 1.f / l0;
    float i1 = 0.f;
    if (DIFF) { l1 += __shfl_xor(l1, 32); i1 = lam / l1; }
    float ss = 0.f;
#pragma unroll
    for (int et = 0; et < 4; ++et)
#pragma unroll
      for (int i = 0; i < 16; ++i) {
        float o = O0[et][i] * i0;
        if (DIFF) o -= O1[et][i] * i1;
        O0[et][i] = o; ss += o * o;
      }
    float rs = 1.f;
    if (DIFF) { ss += __shfl_xor(ss, 32); rs = rsqrtf(ss * (1.f / 128.f) + EPS) * 0.8f; }
    u16* grow = G + (size_t)(32 * w + r) * 512;
    u32x2 gt[16]; float4 sv[16];
#pragma unroll
    for (int q = 0; q < 16; ++q) {
      const int e0 = 32 * (q >> 2) + 8 * (q & 3) + 4 * h;
      gt[q] = *reinterpret_cast<const u32x2*>(grow + e0);
      if (DIFF) sv[q] = *reinterpret_cast<const float4*>(subg + e0); else sv[q] = float4{1.f, 1.f, 1.f, 1.f};
    }
#pragma unroll
    for (int q = 0; q < 16; ++q) {
      const int et = q >> 2, g = q & 3;
      const int e0 = 32 * et + 8 * g + 4 * h;
      const float a0 = O0[et][4 * g + 0] * rs * sv[q].x * bflo(gt[q][0]);
      const float a1 = O0[et][4 * g + 1] * rs * sv[q].y * bfhi(gt[q][0]);
      const float a2 = O0[et][4 * g + 2] * rs * sv[q].z * bflo(gt[q][1]);
      const float a3 = O0[et][4 * g + 3] * rs * sv[q].w * bfhi(gt[q][1]);
      u32x2 o = {cvtpk(a0, a1), cvtpk(a2, a3)};
      *reinterpret_cast<u32x2*>(grow + e0) = o;
    }
  }
}

DEVI float max_abs64(const float* g, int n, int lane) { float v = 0.f; for (int i = lane; i < n; i += 64) v = fmaxf(v, fabsf(g[i])); return wmax(v); }

DEVI float scan_add(float v, int lane) { for (int o = 1; o < 64; o <<= 1) { const float t = __shfl_up(v, o); if (lane >= o) v += t; } return v; }
DEVI float scan_max(float v, int lane) { for (int o = 1; o < 64; o <<= 1) { const float t = __shfl_up(v, o); if (lane >= o) v = fmaxf(v, t); } return v; }
DEVI float bfe(const bf16x8& v, int j) { return __uint_as_float(((unsigned)(u16)v[j]) << 16); }

template <int NT>
DEVI void mlstm_local(LAS char* lds, const float* gates, int hd, const u16* KT, const u16* VT, int ldt,
                            f32x16 (&acc)[4], float& nh, float& bL, float& amax) {
  const int tid = threadIdx.x, lane = tid & 63, w = tid >> 6, r = lane & 31, h = lane >> 5;
  constexpr int L = 32 * NT;
  const float lf = lane < L ? gates[lane * 8 + 4 + hd] : 0.f;
  const float ig = lane < L ? gates[lane * 8 + hd] : -INFINITY;
  const float b = scan_add(lf, lane);
  const float a = ig - b;
  amax = wmax(a);
  bL = __shfl(b, L - 1);
  LAS float* wt = (LAS float*)(lds + 4096) + w * 64;
  wt[lane] = __expf(a - amax);
#pragma unroll
  for (int e = 0; e < 4; ++e)
#pragma unroll
    for (int i = 0; i < 16; ++i) acc[e][i] = 0.f;
  nh = 0.f;
#pragma unroll
  for (int ks = 0; ks < 2 * NT; ++ks) {
    const bf16x8 kf = ldg8(KT + (size_t)(32 * w + r) * ldt + 16 * ks + 8 * h);
    float wv[8];
#pragma unroll
    for (int j = 0; j < 8; ++j) { wv[j] = wt[16 * ks + 8 * h + j]; nh += bfe(kf, j) * wv[j]; }
#pragma unroll
    for (int et = 0; et < 4; ++et) {
      const bf16x8 vf = ldg8(VT + (size_t)(32 * et + r) * ldt + 16 * ks + 8 * h);
      u32x4 sv = {cvtpk(bfe(vf, 0) * wv[0], bfe(vf, 1) * wv[1]), cvtpk(bfe(vf, 2) * wv[2], bfe(vf, 3) * wv[3]),
                  cvtpk(bfe(vf, 4) * wv[4], bfe(vf, 5) * wv[5]), cvtpk(bfe(vf, 6) * wv[6], bfe(vf, 7) * wv[7])};
      acc[et] = mfma32(kf, *reinterpret_cast<bf16x8*>(&sv), acc[et]);
    }
  }
  nh += __shfl_xor(nh, 32);
}

template <int NT>
DEVI void mlstm_out(LAS char* lds, const float* gates, int hd, const u16* Qg, const u16* Kg, const u16* VT, int ldv,
                          const u16* CT, const float* n0, float m0, const float* mg, u16* G) {
  const int tid = threadIdx.x, lane = tid & 63, w = tid >> 6, r = lane & 31, h = lane >> 5;
  constexpr int L = 32 * NT;
  const float lf = lane < L ? gates[lane * 8 + 4 + hd] : 0.f;
  const float ig = lane < L ? gates[lane * 8 + hd] : -INFINITY;
  const float b = scan_add(lf, lane);
  const float a = ig - b;
  const float Mrow = fmaxf(m0, scan_max(a, lane));
  const float mt = b + Mrow;
  LAS float* at = (LAS float*)lds + w * 64;
  LAS float* red = (LAS float*)(lds + 1024);
  at[lane] = a;
  const int prow = pi32(r);
#pragma unroll 1
  for (int tt = 0; tt < NT; ++tt) {
    const int t = 32 * tt + r;
    const float Mrow_t = __shfl(Mrow, t), mt_t = __shfl(mt, t);
    const float winter = __expf(m0 - Mrow_t);
    bf16x8 qf[8];
    float qn = 0.f;
#pragma unroll
    for (int i = 0; i < 8; ++i) {
      qf[i] = ldg8(Qg + (size_t)t * 512 + 16 * i + 8 * h);
      const float4 na = *reinterpret_cast<const float4*>(n0 + 16 * i + 8 * h), nb = *reinterpret_cast<const float4*>(n0 + 16 * i + 8 * h + 4);
      qn += bfe(qf[i], 0) * na.x + bfe(qf[i], 1) * na.y + bfe(qf[i], 2) * na.z + bfe(qf[i], 3) * na.w
          + bfe(qf[i], 4) * nb.x + bfe(qf[i], 5) * nb.y + bfe(qf[i], 6) * nb.z + bfe(qf[i], 7) * nb.w;
    }
    qn += __shfl_xor(qn, 32);
    f32x16 H;
#pragma unroll
    for (int i = 0; i < 16; ++i) H[i] = 0.f;
#pragma unroll
    for (int ks = 0; ks < 8; ++ks) H = mfma32(ldg8(CT + (size_t)(32 * w + r) * 128 + 16 * ks + 8 * h), qf[ks], H);
#pragma unroll
    for (int i = 0; i < 16; ++i) H[i] *= winter;
    float dsum = 0.f;
    for (int st = 0; st <= tt; ++st) {
      f32x16 S;
#pragma unroll
      for (int i = 0; i < 16; ++i) S[i] = 0.f;
#pragma unroll
      for (int ks = 0; ks < 8; ++ks) S = mfma32(ldg8(Kg + (size_t)(32 * st + prow) * 512 + 16 * ks + 8 * h), qf[ks], S);
#pragma unroll
      for (int i = 0; i < 16; ++i) {
        const int s = 32 * st + klocal(i, h);
        const float wg = (s <= t) ? __expf(at[s] - Mrow_t) : 0.f;
        S[i] *= wg; dsum += S[i];
      }
#pragma unroll
      for (int sp = 0; sp < 2; ++sp)
        H = mfma32(ldg8(VT + (size_t)(32 * w + r) * ldv + 32 * st + 16 * sp + 8 * h), pack8(S, sp), H);
    }
    dsum += __shfl_xor(dsum, 32);
    const float den = winter * qn + dsum;
    const float inv = 1.f / fmaxf(fabsf(den), __expf(-mt_t));
    float ss = 0.f;
#pragma unroll
    for (int i = 0; i < 16; ++i) { H[i] *= inv; ss += H[i] * H[i]; }
    ss += __shfl_xor(ss, 32);
    if (h == 0) red[w * 64 + t] = ss;
    __syncthreads();
    const float tot = red[t] + red[64 + t] + red[128 + t] + red[192 + t];
    const float rs = rsqrtf(tot * (1.f / 128.f) + EPS);
    u16* grow = G + (size_t)t * 512;
    u32x2 gt[4]; float4 mv[4];
#pragma unroll
    for (int g = 0; g < 4; ++g) {
      const int e0 = 32 * w + 8 * g + 4 * h;
      gt[g] = *reinterpret_cast<const u32x2*>(grow + e0);
      mv[g] = *reinterpret_cast<const float4*>(mg + e0);
    }
#pragma unroll
    for (int g = 0; g < 4; ++g) {
      const int e0 = 32 * w + 8 * g + 4 * h;
      u32x2 o = {cvtpk(H[4 * g + 0] * rs * mv[g].x * bflo(gt[g][0]), H[4 * g + 1] * rs * mv[g].y * bfhi(gt[g][0])),
                 cvtpk(H[4 * g + 2] * rs * mv[g].z * bflo(gt[g][1]), H[4 * g + 3] * rs * mv[g].w * bfhi(gt[g][1]))};
      *reinterpret_cast<u32x2*>(grow + e0) = o;
    }
    __syncthreads();
  }
}

DEVI void m1_item(const Params& p, LAS char* lds, int item) {
  const int tid = threadIdx.x, lane = tid & 63, w = tid >> 6, r = lane & 31, h = lane >> 5;
  const int bh = item >> 7, c = item & 127, b = bh >> 2, hd = bh & 3;
  const size_t row0 = (size_t)b * SEQ + c * 64;
  f32x16 acc[4]; float nh, bL, amax;
  __syncthreads();
  mlstm_local<2>(lds, p.gates + row0 * 8, hd, p.KaT + (size_t)bh * 128 * SEQ + c * 64, p.VaT + (size_t)bh * 128 * SEQ + c * 64, SEQ, acc, nh, bL, amax);
  u16* Chat = p.xb + ((size_t)item * 128) * 128;
#pragma unroll
  for (int et = 0; et < 4; ++et)
#pragma unroll
    for (int g = 0; g < 4; ++g) {
      const int d0 = 32 * w + 8 * g + 4 * h, e = 32 * et + r;
      u32x2 o = {cvtpk(acc[et][4 * g], acc[et][4 * g + 1]), cvtpk(acc[et][4 * g + 2], acc[et][4 * g + 3])};
      *reinterpret_cast<u32x2*>(Chat + (size_t)e * 128 + d0) = o;
    }
  if (h == 0) p.nhat[(size_t)item * 128 + 32 * w + r] = nh;
  if (tid == 0) { p.tabA[item] = bL; p.tabB[item] = bL + amax; }
}

DEVI void phase_scan(const Params& p, LAS char* lds) {
  const int tid = threadIdx.x, lane = tid & 63;
  LAS float* al = (LAS float*)lds; LAS float* be = al + 128; LAS float* ms = al + 256;
  for (int u = blockIdx.x; u < 16 * 32; u += gridDim.x) {
    const int bh = u >> 5, part = u & 31;
    __syncthreads();
    if (tid < 64) {
      const float A0 = p.tabA[bh * 128 + 2 * lane], A1 = p.tabA[bh * 128 + 2 * lane + 1];
      const float B0 = p.tabB[bh * 128 + 2 * lane], B1 = p.tabB[bh * 128 + 2 * lane + 1];
      const float SAi = scan_add(A0 + A1, lane);
      const float SA0 = SAi - A1, SA1 = SAi;
      const float D0 = B0 - SA0, D1 = B1 - SA1;
      const float PMi = scan_max(fmaxf(D0, D1), lane);
      float PMx = __shfl_up(PMi, 1); if (lane == 0) PMx = -INFINITY;
      const float mn0 = SA0 + fmaxf(0.f, fmaxf(PMx, D0));
      const float mn1 = SA1 + fmaxf(0.f, PMi);
      float mprev = __shfl_up(mn1, 1); if (lane == 0) mprev = 0.f;
      al[2 * lane] = __expf(A0 + mprev - mn0); be[2 * lane] = __expf(B0 - mn0);
      al[2 * lane + 1] = __expf(A1 + mn0 - mn1); be[2 * lane + 1] = __expf(B1 - mn1);
      ms[2 * lane] = mprev; ms[2 * lane + 1] = mn0;
      if (lane == 63) ms[128] = mn1;
    }
    __syncthreads();
    if (part == 0) {
      if (tid < 129) p.mtab[bh * 129 + tid] = ms[tid];
      if (tid == 0) p.out[O_PM + bh] = ms[128];
    }
    u16* base = p.xb + (size_t)bh * 128 * 16384 + part * 512 + tid * 2;
    float c0 = 0.f, c1 = 0.f;
    for (int c = 0; c < 128; c += 8) {
      unsigned v[8];
#pragma unroll
      for (int j = 0; j < 8; ++j) v[j] = *reinterpret_cast<const unsigned*>(base + (size_t)(c + j) * 16384);
#pragma unroll
      for (int j = 0; j < 8; ++j) {
        *reinterpret_cast<unsigned*>(base + (size_t)(c + j) * 16384) = cvtpk(c0, c1);
        const float a_ = al[c + j], b_ = be[c + j];
        c0 = a_ * c0 + b_ * bflo(v[j]); c1 = a_ * c1 + b_ * bfhi(v[j]);
      }
    }
    { const int idx = part * 512 + tid * 2, e = idx >> 7, d = idx & 127;
      p.out[O_PC + ((size_t)bh * 128 + d) * 128 + e] = c0;
      p.out[O_PC + ((size_t)bh * 128 + d + 1) * 128 + e] = c1; }
    if (part == 0 && tid < 128) {
      float n = 0.f;
      for (int c = 0; c < 128; c += 16) {
        float nv[16];
#pragma unroll
        for (int j = 0; j < 16; ++j) nv[j] = p.nhat[((size_t)bh * 128 + c + j) * 128 + tid];
#pragma unroll
        for (int j = 0; j < 16; ++j) {
          p.nstate[((size_t)bh * 128 + c + j) * 128 + tid] = n;
          n = al[c + j] * n + be[c + j] * nv[j];
        }
      }
      p.out[O_PN + bh * 128 + tid] = n;
    }
  }
}

DEVI void m3_item(const Params& p, LAS char* lds, int item) {
  const int bh = item >> 7, c = item & 127, b = bh >> 2, hd = bh & 3;
  const size_t row0 = (size_t)b * SEQ + c * 64;
  __syncthreads();
  mlstm_out<2>(lds, p.gates + row0 * 8, hd, p.Qa + row0 * 512 + hd * 128, p.Ka + row0 * 512 + hd * 128,
               p.VaT + (size_t)bh * 128 * SEQ + c * 64, SEQ, p.xb + (size_t)item * 16384, p.nstate + (size_t)item * 128,
               p.mtab[bh * 129 + c], p.in[15] + hd * 128, p.Ga + row0 * 512 + hd * 128);
}

DEVI void ms_item(const Params& p, LAS char* lds, int bh) {
  const int tid = threadIdx.x, lane = tid & 63, w = tid >> 6, r = lane & 31, h = lane >> 5;
  const int b = bh >> 2, hd = bh & 3;
  const size_t row0 = (size_t)NTOKP + b * 32;
  const float m0 = p.in[9][bh];
  const float* n0 = p.in[8] + bh * 128;
  const u16* KTs = p.KaT + (size_t)NTOKP * 512 + (size_t)bh * 128 * 32;
  const u16* VTs = p.VaT + (size_t)NTOKP * 512 + (size_t)bh * 128 * 32;
  __syncthreads();
  mlstm_out<1>(lds, p.gates + row0 * 8, hd, p.Qa + row0 * 512 + hd * 128, p.Ka + row0 * 512 + hd * 128, VTs, 32,
               p.C0sT + (size_t)bh * 16384, n0, m0, p.in[15] + hd * 128, p.Ga + row0 * 512 + hd * 128);
  f32x16 acc[4]; float nh, bL, amax;
  mlstm_local<1>(lds, p.gates + row0 * 8, hd, KTs, VTs, 32, acc, nh, bL, amax);
  const float mlast = bL + fmaxf(m0, amax);
  const float decay = __expf(bL + m0 - mlast), beta = __expf(bL + amax - mlast);
#pragma unroll
  for (int et = 0; et < 4; ++et)
#pragma unroll
    for (int i = 0; i < 16; ++i) {
      const int d = 32 * w + crow(i, h), e = 32 * et + r;
      const size_t o = ((size_t)bh * 128 + d) * 128 + e;
      p.out[O_SC + o] = decay * p.in[7][o] + beta * acc[et][i];
    }
  if (h == 0) { const int d = 32 * w + r; p.out[O_SN + bh * 128 + d] = decay * n0[d] + beta * nh; }
  if (tid == 0) p.out[O_SM + bh] = mlast;
}

DEVI void phase_conv(const Params& p, LAS char* lds) {
  const int tid = threadIdx.x, lane = tid & 63, w = tid >> 6;
  const u16* U = p.Qa; u16* Gc = p.KaT;
  LAS u16* win = (LAS u16*)lds;
  LAS float* cs = (LAS float*)(lds + 20480);
  LAS float* st = (LAS float*)(lds + 20480 + 32768);
  for (int tile = blockIdx.x; tile < NTOK / 8; tile += gridDim.x) {
    const int row0 = tile * 8;
    const bool samp = row0 >= NTOKP;
    int t0, bs = 0;
    if (!samp) t0 = row0 & 8191; else { const int sr = row0 - NTOKP; bs = sr >> 5; t0 = sr & 31; }
    const int seqbase = row0 - t0;
#pragma unroll 1
    for (int cgp = 0; cgp < 4; ++cgp) {
      __syncthreads();
      for (int pch = tid; pch < 38 * 32; pch += 256) {
        const int rr = pch >> 5, ch = pch & 31, t = t0 - 30 + rr;
        u32x4 v = {0, 0, 0, 0};
        if (t >= 0) v = *reinterpret_cast<const u32x4*>(U + (size_t)(seqbase + t) * 1024 + cgp * 256 + ch * 8);
        else if (samp) {
          const float4* sc = reinterpret_cast<const float4*>(p.in[10] + ((size_t)(bs * 30 + 30 + t)) * 1024 + cgp * 256 + ch * 8);
          const float4 a = sc[0], c = sc[1];
          v = u32x4{cvtpk(a.x, a.y), cvtpk(a.z, a.w), cvtpk(c.x, c.y), cvtpk(c.z, c.w)};
        }
        *reinterpret_cast<LAS u32x4*>(win + rr * 256 + ch * 8) = v;
      }
      __syncthreads();
      const int chn = cgp * 256 + tid;
      float wv[38], cw[31];
#pragma unroll
      for (int rr = 0; rr < 38; ++rr) wv[rr] = bf2f(win[rr * 256 + tid]);
#pragma unroll
      for (int j = 0; j < 31; ++j) cw[j] = p.in[25][j * 1024 + chn];
      const float cb = p.in[26][chn];
#pragma unroll
      for (int i = 0; i < 8; ++i) {
        float a = cb;
#pragma unroll
        for (int j = 0; j < 31; ++j) a += cw[j] * wv[i + j];
        cs[i * 1024 + chn] = a;
      }
    }
    __syncthreads();
#pragma unroll
    for (int q = 0; q < 2; ++q) {
      const int i = 2 * w + q;
      float a1 = 0.f, a2 = 0.f;
#pragma unroll
      for (int k = 0; k < 16; ++k) { const float v = cs[i * 1024 + lane + 64 * k]; a1 += v; a2 += v * v; }
      a1 = wsum(a1); a2 = wsum(a2);
      if (lane == 0) {
        const float mu = a1 * (1.f / 1024.f);
        const float var = fmaxf(a2 * (1.f / 1024.f) - mu * mu, 0.f);
        st[2 * i] = mu; st[2 * i + 1] = rsqrtf(var + EPS);
      }
    }
    __syncthreads();
#pragma unroll 1
    for (int cgp = 0; cgp < 4; ++cgp) {
      const int chn = cgp * 256 + tid;
      const float lg = p.in[27][chn], lb = p.in[28][chn];
      u16 gv[8];
#pragma unroll
      for (int i = 0; i < 8; ++i) gv[i] = Gc[(size_t)(row0 + i) * 1024 + chn];
#pragma unroll
      for (int i = 0; i < 8; ++i) {
        const float y = (cs[i * 1024 + chn] - st[2 * i]) * st[2 * i + 1] * lg + lb;
        Gc[(size_t)(row0 + i) * 1024 + chn] = f2bf(siluf_(y) * bf2f(gv[i]));
      }
    }
  }
}

struct AttnConst { float M2d, M2x, lam; };
DEVI AttnConst attn_consts(const Params& p, int layer) {
  const int lane = threadIdx.x & 63;
  AttnConst c;
  const float gq = max_abs64(p.in[16], 64, lane), gk = max_abs64(p.in[17], 64, lane);
  float kd = 0.f, kx = 0.f;
  for (int i = lane; i < (int)gridDim.x * 4; i += 64) { kd = fmaxf(kd, p.kmaxp[i]); kx = fmaxf(kx, p.kmaxp[1024 * (1 + layer) + i]); }
  kd = wmax(kd); kx = wmax(kx);
  c.M2d = (8.f * gq * 0.125f * LOG2E) * fmaxf(8.f * gk, sqrtf(kd)) * 1.01f;
  const float xq = max_abs64(p.in[32] + layer * 128, 128, lane), xk = max_abs64(p.in[33] + layer * 128, 128, lane);
  c.M2x = (11.313708f * xq * 0.08838834764831845f * LOG2E) * fmaxf(11.313708f * xk, sqrtf(kx)) * 1.01f;
  float d1 = p.in[18][lane] * p.in[19][lane], d2 = p.in[20][lane] * p.in[21][lane];
  d1 = wsum(d1); d2 = wsum(d2);
  c.lam = __expf(d1) - __expf(d2) + 0.2f;
  return c;
}

DEVI void cross_item(const Params& p, LAS char* lds, int layer, int it, float M2x) {
  const int hd = it & 3;
  size_t row0; int mb, nw;
  if (it < 1024) { const int rb = it >> 2; row0 = (size_t)rb * 128; mb = rb >> 6; nw = 4; }
  else { const int bs = (it - 1024) >> 2; row0 = (size_t)NTOKP + bs * 32; mb = 4 + bs; nw = 1; }
  attn_block<false>(lds, p.Qx + row0 * 512 + hd * 128, p.XK + ((size_t)(layer * 12 + mb) * 256) * 512 + hd * 128,
                    p.XVT + ((size_t)((layer * 12 + mb) * 4 + hd) * 128) * 256, 256, 4, nw, 0, 256, 0.f, M2x, 0.f, nullptr,
                    p.Gx + row0 * 512 + hd * 128);
}

DEVI void diff_item(const Params& p, LAS char* lds, int it, float M2d, float lam) {
  const bool pr = it < 1024;
  const int qb = pr ? 63 - (it >> 4) : 0;
  const int bh = pr ? (it & 15) : it - 1024;
  const int b = bh >> 2, hd = bh & 3;
  const size_t row0 = pr ? (size_t)b * SEQ + qb * 128 : (size_t)NTOKP + b * 32;
  const float slope2 = exp2f(-2.f * (hd + 1)) * LOG2E;
  const u16* Kp = pr ? p.Kb + (size_t)b * SEQ * 512 + hd * 128 : p.Ks + (size_t)b * SKP * 512 + hd * 128;
  const u16* Vp = pr ? p.VbT + (size_t)bh * 128 * SEQ : p.VsT + (size_t)bh * 128 * SKP;
  attn_block<true>(lds, p.Qb + row0 * 512 + hd * 128, Kp, Vp, pr ? SEQ : SKP, pr ? 2 * qb + 2 : 33, pr ? 4 : 1,
                   pr ? qb * 128 : PAST, pr ? SEQ : PAST + 32, slope2, M2d, lam, p.in[22], p.Gb + row0 * 512 + hd * 128);
}

DEVI int snake(int k, int g, int G) { return (k & 1) ? (k * G + (G - 1 - g)) : (k * G + g); }

constexpr int NPHASE = 9;
DEVI void run_phase(const Params& p, LAS char* lds, int ph) {
  const int G = gridDim.x, g = blockIdx.x;
  switch (ph) {
    case 0: phase_prep(p); break;
    case 1: phase_gemm<0>(p, lds); break;
    case 2: {
      const AttnConst c = attn_consts(p, 0);
      for (int it = g; it < 1056; it += G) cross_item(p, lds, 0, it, c.M2x);
      for (int it = g; it < 2048; it += G) m1_item(p, lds, it);
    } break;
    case 3: {
      const AttnConst c = attn_consts(p, 0);
      (void)c;
      phase_scan(p, lds);
    } break;
    case 4: {
      const AttnConst c = attn_consts(p, 0);
      for (int k = 0;; ++k) { const int it = snake(k, g, G); if (k * G >= 1056) break; if (it < 1056) diff_item(p, lds, it, c.M2d, c.lam); }
      for (int it = g; it < 2048; it += G) m3_item(p, lds, it);
      for (int it = G - 1 - g; it < 32; it += G) ms_item(p, lds, it);
    } break;
    case 5: phase_gemm<1>(p, lds); break;
    case 6: phase_gemm<2>(p, lds); break;
    case 7: {
      const AttnConst c = attn_consts(p, 1);
      phase_conv(p, lds);
      for (int it = g; it < 1056; it += G) cross_item(p, lds, 1, it, c.M2x);
    } break;
    case 8: phase_gemm<3>(p, lds); break;
  }
}

DEVI void grid_bar(unsigned* ctr, unsigned& epoch) {
  asm volatile("s_waitcnt vmcnt(0)" ::: "memory");
  __syncthreads();
  if (threadIdx.x == 0) {
    __builtin_amdgcn_fence(__ATOMIC_RELEASE, "agent");
    asm volatile("s_waitcnt vmcnt(0)" ::: "memory");
    __hip_atomic_fetch_add(ctr, 1u, __ATOMIC_RELAXED, __HIP_MEMORY_SCOPE_AGENT);
    epoch += 1u;
    const unsigned target = epoch * gridDim.x;
    while (__hip_atomic_load(ctr, __ATOMIC_RELAXED, __HIP_MEMORY_SCOPE_AGENT) < target) __builtin_amdgcn_s_sleep(1);
    __builtin_amdgcn_fence(__ATOMIC_ACQUIRE, "agent");
    asm volatile("s_waitcnt vmcnt(0)" ::: "memory");
  }
  __syncthreads();
}

__global__ void __launch_bounds__(256, 1) mega(Params p, int ph_lo, int ph_hi) {
  extern __shared__ __attribute__((aligned(16))) char smem[];
  LAS char* lds = (LAS char*)smem;
  cg::grid_group grid = cg::this_grid();
  unsigned epoch = 0;
  unsigned* ctr = reinterpret_cast<unsigned*>(p.kmaxp + 3 * 1024);
#define RUNPH(k) if (ph_lo <= (k) && (k) < ph_hi) { if ((k) > ph_lo) { if ((k) == 1) grid.sync(); else grid_bar(ctr, epoch); } run_phase(p, lds, (k)); }
  RUNPH(0) RUNPH(1) RUNPH(2) RUNPH(3) RUNPH(4) RUNPH(5) RUNPH(6) RUNPH(7) RUNPH(8)
#undef RUNPH
}

#ifndef MULTI_LAUNCH
#define MULTI_LAUNCH 0
#endif

extern "C" void kernel_launch(void* const* d_in, const int* in_sizes, int n_in, void* d_out, int out_size, void* d_ws, size_t ws_size,
                              hipStream_t stream) {
  static int grid_blocks = 0;
  if (!grid_blocks) {
    int dev = 0, cus = 0, per_cu = 0;
    hipGetDevice(&dev);
    hipDeviceGetAttribute(&cus, hipDeviceAttributeMultiprocessorCount, dev);
    hipFuncSetAttribute((const void*)mega, hipFuncAttributeMaxDynamicSharedMemorySize, LDS_BYTES);
    hipOccupancyMaxActiveBlocksPerMultiprocessor(&per_cu, (const void*)mega, 256, LDS_BYTES);
    if (per_cu < 1) per_cu = 1;
    if (per_cu > 1) per_cu = 1;
    grid_blocks = (cus * per_cu) & ~7;
    if (grid_blocks < 8) grid_blocks = 8;
  }
  Params p{};
  for (int i = 0; i < 34; ++i) p.in[i] = (const float*)d_in[i];
  p.out = (float*)d_out;
  char* ws = (char*)d_ws;
  size_t off = 0;
  auto take = [&](size_t bytes) { char* q = ws + off; off += (bytes + 255) & ~(size_t)255; return q; };
  p.WtInA = (u16*)take((size_t)NPAD_A * 1024 * 2);
  p.WtOutA = (u16*)take((size_t)1024 * 1536 * 2);
  p.WtInC = (u16*)take((size_t)4096 * 1024 * 2);
  p.WtOutC = (u16*)take((size_t)1024 * 1536 * 2);
  p.WtMem = (u16*)take((size_t)2 * 1024 * 1024 * 2);
  p.xb = (u16*)take((size_t)NTOK * 1024 * 2);
  p.memb = (u16*)take((size_t)1024 * 1024 * 2);
  u16* segs = (u16*)take(SEG * 2 * 11);
  p.Qa = segs; p.Ka = segs + SEG; p.KaT = segs + 2 * SEG; p.VaT = segs + 3 * SEG; p.Ga = segs + 4 * SEG; p.Qb = segs + 5 * SEG;
  p.Kb = segs + 6 * SEG; p.VbT = segs + 7 * SEG; p.Gb = segs + 8 * SEG; p.Qx = segs + 9 * SEG; p.Gx = segs + 10 * SEG;
  p.Ks = (u16*)take((size_t)8 * SKP * 512 * 2);
  p.VsT = (u16*)take((size_t)4096 * SKP * 2);
  p.XK = (u16*)take((size_t)2 * 12 * 256 * 512 * 2);
  p.XVT = (u16*)take((size_t)2 * 12 * 256 * 512 * 2);
  p.C0sT = (u16*)take((size_t)32 * 16384 * 2);
  p.rs0 = (float*)take((size_t)NTOK * 4);
  p.ssq1 = (float*)take((size_t)NTOK * 4);
  p.rsmem = (float*)take((size_t)(1024 + 64) * 4);
  p.gates = (float*)take((size_t)NTOK * 8 * 4);
  p.tabA = (float*)take(2048 * 4);
  p.tabB = (float*)take(2048 * 4);
  p.mtab = (float*)take(16 * 129 * 4);
  p.nhat = (float*)take((size_t)2048 * 128 * 4);
  p.nstate = (float*)take((size_t)2048 * 128 * 4);
  p.kmaxp = (float*)take((size_t)3 * 1024 * 4 + 256);
  if (off > ws_size) { fprintf(stderr, "workspace too small: need %zu have %zu\n", off, ws_size); return; }
  (void)hipMemsetAsync(p.kmaxp + 3 * 1024, 0, 256, stream);
#if MULTI_LAUNCH
  for (int ph = 0; ph < NPHASE; ++ph) {
    hipLaunchKernelGGL(mega, dim3(grid_blocks), dim3(256), LDS_BYTES, stream, p, ph, ph + 1);
  }
#else
  int lo = 0, hi = NPHASE;
  void* args[] = {&p, &lo, &hi};
  hipError_t e = hipLaunchCooperativeKernel((const void*)mega, dim3(grid_blocks), dim3(256), args, LDS_BYTES, stream);
  if (e != hipSuccess) fprintf(stderr, "cooperative launch failed: %s (grid %d)\n", hipGetErrorString(e), grid_blocks);
#endif
}
```

```cpp
#include <hip/hip_runtime.h>
#include <hip/hip_cooperative_groups.h>
#include <stdint.h>
#include <stdio.h>
namespace cg = cooperative_groups;

typedef unsigned short u16;
using bf16x8 = __attribute__((ext_vector_type(8))) short;
using f32x4  = __attribute__((ext_vector_type(4))) float;
using f32x16 = __attribute__((ext_vector_type(16))) float;
using u32x4  = __attribute__((ext_vector_type(4))) unsigned;
using u32x2  = __attribute__((ext_vector_type(2))) unsigned;
#define LAS __attribute__((address_space(3)))
#define DEVI __device__ __forceinline__

constexpr int NTOKP = 32768, NTOKS = 256, NTOK = 33024;
constexpr int SEQ = 8192, LSAMP = 32, PAST = 2048, SKP = 2112;
constexpr size_t SEG = (size_t)NTOK * 512;
constexpr int NPAD_A = 5760;
constexpr float EPS = 1e-6f;
constexpr float LOG2E = 1.4426950408889634f;
constexpr size_t O_YP = 0, O_PXK = 33816576, O_PXV = 34865152, O_PK = 35913728, O_PV = 52690944,
  O_PC = 69468160, O_PN = 69730304, O_PM = 69732352, O_PCONV = 69732368, O_SK = 69855248, O_SV = 69986320,
  O_SC = 70117392, O_SN = 70641680, O_SM = 70645776, O_SCONV = 70645808;

constexpr int LDS_BYTES = 147456;

struct Params {
  const float* in[34];
  float* out;
  u16 *WtInA, *WtOutA, *WtInC, *WtOutC, *WtMem;
  u16 *xb, *memb;
  u16 *Qa, *Ka, *KaT, *VaT, *Ga, *Qb, *Kb, *VbT, *Gb, *Qx, *Gx;
  u16 *Ks, *VsT, *XK, *XVT, *C0sT;
  float *rs0, *ssq1, *rsmem, *gates, *tabA, *tabB, *mtab, *nhat, *nstate, *kmaxp;
};

DEVI unsigned cvtpk(float lo, float hi) { unsigned r; asm volatile("v_cvt_pk_bf16_f32 %0, %1, %2" : "=v"(r) : "v"(lo), "v"(hi)); return r; }
DEVI float bflo(unsigned u) { return __uint_as_float(u << 16); }
DEVI float bfhi(unsigned u) { return __uint_as_float(u & 0xffff0000u); }
DEVI float bf2f(u16 h) { return __uint_as_float(((unsigned)h) << 16); }
DEVI u16 f2bf(float f) { return (u16)(cvtpk(f, 0.f) & 0xffffu); }
DEVI float sigmoidf_(float x) { return 1.f / (1.f + __expf(-x)); }
DEVI float siluf_(float x) { return x / (1.f + __expf(-x)); }
DEVI float logsigmoidf_(float x) { return fminf(x, 0.f) - log1pf(__expf(-fabsf(x))); }
DEVI float wsum(float v) { for (int o = 32; o; o >>= 1) v += __shfl_xor(v, o); return v; }
DEVI float wmax(float v) { for (int o = 32; o; o >>= 1) v = fmaxf(v, __shfl_xor(v, o)); return v; }
DEVI int pi32(int r) { return (r & ~12) | ((r & 4) << 1) | ((r & 8) >> 1); }
DEVI int klocal(int reg, int h) { return (reg & 3) + 4 * ((reg >> 2) & 1) + 8 * h + 16 * (reg >> 3); }
DEVI int crow(int reg, int h) { return (reg & 3) + 8 * (reg >> 2) + 4 * h; }
DEVI bf16x8 ldg8(const u16* p) { return *reinterpret_cast<const bf16x8*>(p); }
DEVI f32x16 mfma32(bf16x8 a, bf16x8 b, f32x16 c) { return __builtin_amdgcn_mfma_f32_32x32x16_bf16(a, b, c, 0, 0, 0); }
DEVI bf16x8 pack8(const f32x16& x, int s) {
  u32x4 w = {cvtpk(x[8 * s + 0], x[8 * s + 1]), cvtpk(x[8 * s + 2], x[8 * s + 3]), cvtpk(x[8 * s + 4], x[8 * s + 5]), cvtpk(x[8 * s + 6], x[8 * s + 7])};
  return *reinterpret_cast<bf16x8*>(&w);
}
DEVI void lds_barrier() { asm volatile("s_waitcnt lgkmcnt(0)" ::: "memory"); __builtin_amdgcn_s_barrier(); asm volatile("" ::: "memory"); }
DEVI void glds16(const void* g, LAS void* l) { __builtin_amdgcn_global_load_lds((const unsigned*)g, (LAS unsigned*)l, 16, 0, 0); }

template <class F>
DEVI void wtrans(u16* dst, const float* src, const float* g, int K, int Npad, int ldn, F srccol, int gtid, int gsz) {
  const int total = Npad * (K / 32);
  for (int i = gtid; i < total; i += gsz) {
    const int n = i % Npad, kb = i / Npad;
    const int sc = srccol(n);
    float v[32];
#pragma unroll
    for (int j = 0; j < 32; ++j) v[j] = (sc >= 0) ? src[(size_t)(kb * 32 + j) * ldn + sc] : 0.f;
    if (g) {
#pragma unroll
      for (int j = 0; j < 32; ++j) v[j] *= g[kb * 32 + j];
    }
#pragma unroll
    for (int q = 0; q < 4; ++q) {
      u32x4 w = {cvtpk(v[8 * q + 0], v[8 * q + 1]), cvtpk(v[8 * q + 2], v[8 * q + 3]), cvtpk(v[8 * q + 4], v[8 * q + 5]), cvtpk(v[8 * q + 6], v[8 * q + 7])};
      *reinterpret_cast<u32x4*>(dst + (size_t)n * K + kb * 32 + q * 8) = w;
    }
  }
}

DEVI int srccol_in_a(int n) {
  const int t = n >> 7, c = n & 127;
  if (t < 12) return n;
  if (t < 20) { const int j = t - 12; return c < 64 ? 1536 + 64 * j + c : 2048 + 64 * j + (c - 64); }
  if (t < 44) return 2568 + (t - 20) * 128 + c;
  if (t == 44) return c < 8 ? 2560 + c : -1;
  return -1;
}
DEVI int srccol_in_c(int n) {
  const int t = n >> 7, c = n & 127;
  if (t < 16) return c < 64 ? 64 * t + c : 1024 + 64 * t + (c - 64);
  return n;
}

DEVI void phase_prep(const Params& p) {
  const int tid = threadIdx.x, lane = tid & 63;
  const int gtid = blockIdx.x * 256 + tid, gsz = gridDim.x * 256;
  const int gwave = gtid >> 6, nwaves = gsz >> 6;
  wtrans(p.WtInA, p.in[12], p.in[11], 1024, NPAD_A, 5640, [](int n) { return srccol_in_a(n); }, gtid, gsz);
  wtrans(p.WtOutA, p.in[23], nullptr, 1536, 1024, 1024, [](int n) { return n; }, gtid, gsz);
  wtrans(p.WtInC, p.in[24], p.in[11] + 1024, 1024, 4096, 4096, [](int n) { return srccol_in_c(n); }, gtid, gsz);
  wtrans(p.WtOutC, p.in[29], nullptr, 1536, 1024, 1024, [](int n) { return n; }, gtid, gsz);
  for (int l = 0; l < 2; ++l)
    wtrans(p.WtMem + (size_t)l * 1024 * 1024, p.in[31] + (size_t)l * 1024 * 1024, p.in[30] + l * 1024, 1024, 1024, 1024,
           [](int n) { return n; }, gtid, gsz);
  for (int row0 = gwave; row0 < NTOK + 1024; row0 += 4 * nwaves) {
    float4 v[4][4];
    const float* xr[4];
#pragma unroll
    for (int u = 0; u < 4; ++u) {
      const int row = min(row0 + u * nwaves, NTOK + 1023);
      xr[u] = row < NTOKP ? p.in[0] + (size_t)row * 1024 : (row < NTOK ? p.in[1] + (size_t)(row - NTOKP) * 1024 : p.in[2] + (size_t)(row - NTOK) * 1024);
    }
#pragma unroll
    for (int u = 0; u < 4; ++u)
#pragma unroll
      for (int i = 0; i < 4; ++i) v[u][i] = reinterpret_cast<const float4*>(xr[u])[lane + 64 * i];
#pragma unroll
    for (int u = 0; u < 4; ++u) {
      const int row = row0 + u * nwaves;
      float ss = 0.f;
#pragma unroll
      for (int i = 0; i < 4; ++i) ss += v[u][i].x * v[u][i].x + v[u][i].y * v[u][i].y + v[u][i].z * v[u][i].z + v[u][i].w * v[u][i].w;
      ss = wsum(ss);
      if (row < NTOK + 1024) {
        u16* dst = row < NTOK ? p.xb + (size_t)row * 1024 : p.memb + (size_t)(row - NTOK) * 1024;
        float* rsd = row < NTOK ? p.rs0 + row : p.rsmem + (row - NTOK);
        if (lane == 0) *rsd = rsqrtf(ss * (1.f / 1024.f) + EPS);
#pragma unroll
        for (int i = 0; i < 4; ++i) { u32x2 w = {cvtpk(v[u][i].x, v[u][i].y), cvtpk(v[u][i].z, v[u][i].w)}; reinterpret_cast<u32x2*>(dst)[lane + 64 * i] = w; }
      }
    }
  }
  float km0 = 0.f, km1 = 0.f, km2 = 0.f;
  for (int i0 = gtid; i0 < 8 * PAST * 64; i0 += 4 * gsz) {
    float4 a[4], c[4];
#pragma unroll
    for (int u = 0; u < 4; ++u) {
      const int i = i0 + u * gsz;
      const int c8 = i & 63, pp = (i >> 6) & (PAST - 1), b = (i >> 17) & 7;
      const float4* sp = reinterpret_cast<const float4*>(p.in[5] + ((size_t)(b * PAST + pp) * 512 + c8 * 8));
      a[u] = sp[0]; c[u] = sp[1];
    }
#pragma unroll
    for (int u = 0; u < 4; ++u) {
      const int i = i0 + u * gsz;
      if (i < 8 * PAST * 64) {
        const int c8 = i & 63, pp = (i >> 6) & (PAST - 1), b = i >> 17;
        u32x4 w = {cvtpk(a[u].x, a[u].y), cvtpk(a[u].z, a[u].w), cvtpk(c[u].x, c[u].y), cvtpk(c[u].z, c[u].w)};
        *reinterpret_cast<u32x4*>(p.Ks + ((size_t)(b * SKP + pp) * 512 + c8 * 8)) = w;
        float ss = a[u].x * a[u].x + a[u].y * a[u].y + a[u].z * a[u].z + a[u].w * a[u].w + c[u].x * c[u].x + c[u].y * c[u].y + c[u].z * c[u].z + c[u].w * c[u].w;
        ss += __shfl_xor(ss, 1); ss += __shfl_xor(ss, 2); ss += __shfl_xor(ss, 4);
        km0 = fmaxf(km0, ss);
      }
    }
  }
  for (int i0 = gtid; i0 < 8 * 4 * 256 * 128; i0 += 2 * gsz) {
    float v[2][8];
#pragma unroll
    for (int u = 0; u < 2; ++u) {
      const int i = (i0 + u * gsz) & (8 * 4 * 256 * 128 - 1);
      const int dv = i & 127, p8 = (i >> 7) & 255, h = (i >> 15) & 3, b = i >> 17;
#pragma unroll
      for (int j = 0; j < 8; ++j) v[u][j] = p.in[6][((size_t)(b * PAST + p8 * 8 + j) * 4 + h) * 128 + dv];
    }
#pragma unroll
    for (int u = 0; u < 2; ++u) {
      const int i = i0 + u * gsz;
      if (i < 8 * 4 * 256 * 128) {
        const int dv = i & 127, p8 = (i >> 7) & 255, h = (i >> 15) & 3, b = i >> 17;
        u32x4 w = {cvtpk(v[u][0], v[u][1]), cvtpk(v[u][2], v[u][3]), cvtpk(v[u][4], v[u][5]), cvtpk(v[u][6], v[u][7])};
        *reinterpret_cast<u32x4*>(p.VsT + ((size_t)((b * 4 + h) * 128 + dv) * SKP + p8 * 8)) = w;
      }
    }
  }
  for (int i = gtid; i < 4096 * 4; i += gsz) {
    u32x4 z = {0, 0, 0, 0};
    *reinterpret_cast<u32x4*>(p.VsT + ((size_t)(i >> 2) * SKP + 2080 + (i & 3) * 8)) = z;
  }
  for (int i = gtid; i < 8 * 32 * 64; i += gsz) {
    u32x4 z = {0, 0, 0, 0};
    const int c8 = i & 63, r = (i >> 6) & 31, b = i >> 11;
    *reinterpret_cast<u32x4*>(p.Ks + ((size_t)(b * SKP + 2080 + r) * 512 + c8 * 8)) = z;
  }
  for (int i = gtid; i < 2 * 8 * 256 * 64; i += gsz) {
    const int c8 = i & 63, m = (i >> 6) & 255, b = (i >> 14) & 7, l = i >> 17;
    const float4* s = reinterpret_cast<const float4*>(p.in[3] + ((size_t)((l * 8 + b) * 256 + m) * 512 + c8 * 8));
    const float4 a = s[0], c = s[1];
    u32x4 w = {cvtpk(a.x, a.y), cvtpk(a.z, a.w), cvtpk(c.x, c.y), cvtpk(c.z, c.w)};
    *reinterpret_cast<u32x4*>(p.XK + ((size_t)((l * 12 + 4 + b) * 256 + m) * 512 + c8 * 8)) = w;
    float ss = a.x * a.x + a.y * a.y + a.z * a.z + a.w * a.w + c.x * c.x + c.y * c.y + c.z * c.z + c.w * c.w;
    ss += __shfl_xor(ss, 1); ss += __shfl_xor(ss, 2); ss += __shfl_xor(ss, 4); ss += __shfl_xor(ss, 8);
    if (l == 0) km1 = fmaxf(km1, ss); else km2 = fmaxf(km2, ss);
  }
  for (int i = gtid; i < 2 * 8 * 4 * 32 * 128; i += gsz) {
    const int dv = i & 127, m8 = (i >> 7) & 31, h = (i >> 12) & 3, b = (i >> 14) & 7, l = i >> 17;
    float v[8];
#pragma unroll
    for (int j = 0; j < 8; ++j) v[j] = p.in[4][((size_t)((l * 8 + b) * 256 + m8 * 8 + j) * 4 + h) * 128 + dv];
    u32x4 w = {cvtpk(v[0], v[1]), cvtpk(v[2], v[3]), cvtpk(v[4], v[5]), cvtpk(v[6], v[7])};
    *reinterpret_cast<u32x4*>(p.XVT + ((size_t)(((l * 12 + 4 + b) * 4 + h) * 128 + dv) * 256 + m8 * 8)) = w;
  }
  for (int i = gtid; i < 32 * 16 * 128; i += gsz) {
    const int e = i & 127, d8 = (i >> 7) & 15, bh = i >> 11;
    float v[8];
#pragma unroll
    for (int j = 0; j < 8; ++j) v[j] = p.in[7][((size_t)bh * 128 + d8 * 8 + j) * 128 + e];
    u32x4 w = {cvtpk(v[0], v[1]), cvtpk(v[2], v[3]), cvtpk(v[4], v[5]), cvtpk(v[6], v[7])};
    *reinterpret_cast<u32x4*>(p.C0sT + ((size_t)bh * 128 + e) * 128 + d8 * 8) = w;
  }
  for (int i = gtid; i < NTOK; i += gsz) p.ssq1[i] = 0.f;
  km0 = wmax(km0); km1 = wmax(km1); km2 = wmax(km2);
  if (lane == 0) {
    const int slot = blockIdx.x * 4 + (tid >> 6);
    p.kmaxp[slot] = km0; p.kmaxp[1024 + slot] = km1; p.kmaxp[2048 + slot] = km2;
  }
}

DEVI void gemm_core(LAS char* lds, const u16* A0, const u16* A1, const u16* A2, int lda0, int lda1, int lda2, int segK,
                    const u16* Bt, int K, int brow, int bcol, f32x4 (&acc)[4][4]) {
  const int tid = threadIdx.x, lane = tid & 63, wid = tid >> 6, wr = wid >> 1, wc = wid & 1, fr = lane & 15, fq = lane >> 4;
  LAS char* SA = lds; LAS char* SB = lds + 8192;
#pragma unroll
  for (int m = 0; m < 4; ++m)
#pragma unroll
    for (int n = 0; n < 4; ++n) acc[m][n] = f32x4{0.f, 0.f, 0.f, 0.f};
  const int nkt = K / 32;
  for (int kt = 0; kt < nkt; ++kt) {
    const int k0 = kt * 32;
    const int seg = k0 / segK;
    const u16* Ab = (seg == 0 ? A0 : (seg == 1 ? A1 : A2)) + (k0 - seg * segK);
    const int lda = (seg == 0 ? lda0 : (seg == 1 ? lda1 : lda2));
#pragma unroll
    for (int i = 0; i < 2; ++i) {
      const int b = tid * 16 + i * 4096, r = b >> 6, c = (b & 63) >> 1;
      glds16(Ab + (size_t)(brow + r) * lda + c, SA + b);
      glds16(Bt + (size_t)(bcol + r) * K + k0 + c, SB + b);
    }
    asm volatile("s_waitcnt vmcnt(0)" ::: "memory");
    __syncthreads();
    bf16x8 af[4], bfr[4];
#pragma unroll
    for (int m = 0; m < 4; ++m) af[m] = *reinterpret_cast<const LAS bf16x8*>(SA + (wr * 64 + m * 16 + fr) * 64 + fq * 16);
#pragma unroll
    for (int n = 0; n < 4; ++n) bfr[n] = *reinterpret_cast<const LAS bf16x8*>(SB + (wc * 64 + n * 16 + fr) * 64 + fq * 16);
#pragma unroll
    for (int m = 0; m < 4; ++m)
#pragma unroll
      for (int n = 0; n < 4; ++n) acc[m][n] = __builtin_amdgcn_mfma_f32_16x16x32_bf16(af[m], bfr[n], acc[m][n], 0, 0, 0);
    __syncthreads();
  }
}

DEVI void gemm_stage_c(LAS char* lds, const f32x4 (&acc)[4][4], const float* rowscale, int mode, int brow) {
  const int tid = threadIdx.x, lane = tid & 63, wid = tid >> 6, wr = wid >> 1, wc = wid & 1, fr = lane & 15, fq = lane >> 4;
  LAS float* Cs = (LAS float*)lds;
#pragma unroll
  for (int m = 0; m < 4; ++m)
#pragma unroll
    for (int j = 0; j < 4; ++j) {
      const int r = wr * 64 + m * 16 + fq * 4 + j;
      float s = 1.f;
      if (mode == 1) s = rowscale[brow + r];
      else if (mode == 2) s = rsqrtf(rowscale[brow + r] * (1.f / 1024.f) + EPS);
#pragma unroll
      for (int n = 0; n < 4; ++n) Cs[r * 132 + wc * 64 + n * 16 + fr] = acc[m][n][j] * s;
    }
  __syncthreads();
}

DEVI void st_bf8(u16* dst, const float (&v)[8]) {
  u32x4 w = {cvtpk(v[0], v[1]), cvtpk(v[2], v[3]), cvtpk(v[4], v[5]), cvtpk(v[6], v[7])};
  *reinterpret_cast<u32x4*>(dst) = w;
}
DEVI void st_f8(float* dst, const float (&v)[8]) {
  reinterpret_cast<float4*>(dst)[0] = float4{v[0], v[1], v[2], v[3]};
  reinterpret_cast<float4*>(dst)[1] = float4{v[4], v[5], v[6], v[7]};
}
DEVI void store_transposed(LAS char* lds, u16* dst, size_t ldt, float scale) {
  const LAS float* Cs = (const LAS float*)lds;
  const int c = threadIdx.x & 127, rh = (threadIdx.x >> 7) * 64;
#pragma unroll
  for (int it = 0; it < 8; ++it) {
    const int r0 = rh + it * 8;
    float v[8];
#pragma unroll
    for (int j = 0; j < 8; ++j) v[j] = Cs[(r0 + j) * 132 + c] * scale;
    st_bf8(dst + (size_t)c * ldt + r0, v);
  }
}

DEVI void epi_in_a(const Params& p, LAS char* lds, int brow, int n) {
  const LAS float* Cs = (const LAS float*)lds;
  const int tid = threadIdx.x, cgp = tid & 15, c0 = cgp * 8;
  const bool samp = brow >= NTOKP;
  const int seg = n >> 2, hd = n & 3;
  if (n >= 4 && n < 12) {
    u16* base = (n < 8 ? p.KaT : p.VaT);
    const float sc = (n < 8 ? 0.08838834764831845f : 1.f);
    if (!samp) { const int b = brow >> 13, t0 = brow & 8191; store_transposed(lds, base + ((size_t)(b * 4 + hd) * 128) * SEQ + t0, SEQ, sc); }
    else {
      const int c = tid & 127, rh = (tid >> 7) * 64;
#pragma unroll
      for (int it = 0; it < 8; ++it) {
        const int r0 = rh + it * 8; const int bs = ((brow - NTOKP) + r0) >> 5, t0 = r0 & 31;
        float v[8];
#pragma unroll
        for (int j = 0; j < 8; ++j) v[j] = Cs[(r0 + j) * 132 + c] * sc;
        st_bf8(base + (size_t)NTOKP * 512 + ((size_t)(bs * 4 + hd) * 128 + c) * 32 + t0, v);
      }
    }
  }
  if (seg == 7) {
    if (!samp) { const int b = brow >> 13, t0 = brow & 8191; store_transposed(lds, p.VbT + ((size_t)(b * 4 + hd) * 128) * SEQ + t0, SEQ, 1.f); }
    else {
      const int c = tid & 127, rh = (tid >> 7) * 64;
#pragma unroll
      for (int it = 0; it < 8; ++it) {
        const int r0 = rh + it * 8; const int bs = ((brow - NTOKP) + r0) >> 5, t0 = r0 & 31;
        float v[8];
#pragma unroll
        for (int j = 0; j < 8; ++j) v[j] = Cs[(r0 + j) * 132 + c];
        st_bf8(p.VsT + ((size_t)(bs * 4 + hd) * 128 + c) * SKP + PAST + t0, v);
      }
    }
  }
  float gn[8];
  {
    const float* gp = nullptr;
    if (n >= 20 && n < 24) gp = p.in[16] + (c0 & 63);
    else if (n >= 24 && n < 28) gp = p.in[17] + (c0 & 63);
    else if (n >= 36 && n < 40) gp = p.in[32] + c0;
    else if (n == 44) gp = (cgp == 0) ? nullptr : nullptr;
#pragma unroll
    for (int j = 0; j < 8; ++j) gn[j] = gp ? gp[j] : 0.f;
    if (n == 44) {
#pragma unroll
      for (int j = 0; j < 4; ++j) { gn[j] = p.in[13][j]; gn[4 + j] = p.in[14][j]; }
    }
  }
#pragma unroll 1
  for (int it = 0; it < 8; ++it) {
    const int r = it * 16 + (tid >> 4);
    const size_t grow = (size_t)brow + r;
    float v[8];
#pragma unroll
    for (int j = 0; j < 8; ++j) v[j] = Cs[r * 132 + c0 + j];
    if (n < 4) { st_bf8(p.Qa + grow * 512 + hd * 128 + c0, v); }
    else if (n < 8) {
#pragma unroll
      for (int j = 0; j < 8; ++j) v[j] *= 0.08838834764831845f;
      st_bf8(p.Ka + grow * 512 + hd * 128 + c0, v);
    }
    else if (n < 12) {   }
    else if (n < 20) {
      if (cgp < 8) {
        float g[8];
#pragma unroll
        for (int j = 0; j < 8; ++j) g[j] = sigmoidf_(v[j]) * siluf_(Cs[r * 132 + 64 + c0 + j]);
        st_bf8(p.Ga + grow * 512 + (n - 12) * 64 + c0, g);
      }
    }
    else if (n < 28) {
      float ss = 0.f;
#pragma unroll
      for (int j = 0; j < 8; ++j) ss += v[j] * v[j];
      ss += __shfl_xor(ss, 1); ss += __shfl_xor(ss, 2); ss += __shfl_xor(ss, 4);
      const float rs = rsqrtf(ss * (1.f / 64.f) + EPS);
      const float* g = gn;
      if (n < 24) {
#pragma unroll
        for (int j = 0; j < 8; ++j) v[j] = v[j] * rs * g[j] * (0.125f * LOG2E);
        st_bf8(p.Qb + grow * 512 + hd * 128 + c0, v);
      } else {
#pragma unroll
        for (int j = 0; j < 8; ++j) v[j] = v[j] * rs * g[j];
        if (!samp) { st_f8(p.out + O_PK + grow * 512 + hd * 128 + c0, v); st_bf8(p.Kb + grow * 512 + hd * 128 + c0, v); }
        else {
          const int sr = (int)grow - NTOKP, bs = sr >> 5, t = sr & 31;
          st_f8(p.out + O_SK + (size_t)sr * 512 + hd * 128 + c0, v);
          st_bf8(p.Ks + ((size_t)(bs * SKP + PAST + t)) * 512 + hd * 128 + c0, v);
        }
      }
    }
    else if (n < 32) {
      if (!samp) st_f8(p.out + O_PV + grow * 512 + hd * 128 + c0, v);
      else st_f8(p.out + O_SV + (size_t)((int)grow - NTOKP) * 512 + hd * 128 + c0, v);
    }
    else if (n < 36) {
#pragma unroll
      for (int j = 0; j < 8; ++j) v[j] = siluf_(v[j]);
      st_bf8(p.Gb + grow * 512 + hd * 128 + c0, v);
    }
    else if (n < 40) {
      float ss = 0.f;
#pragma unroll
      for (int j = 0; j < 8; ++j) ss += v[j] * v[j];
      ss += __shfl_xor(ss, 1); ss += __shfl_xor(ss, 2); ss += __shfl_xor(ss, 4); ss += __shfl_xor(ss, 8);
      const float rs = rsqrtf(ss * (1.f / 128.f) + EPS);
      const float* g = gn;
#pragma unroll
      for (int j = 0; j < 8; ++j) v[j] = v[j] * rs * g[j] * (0.08838834764831845f * LOG2E);
      st_bf8(p.Qx + grow * 512 + hd * 128 + c0, v);
    }
    else if (n < 44) {
#pragma unroll
      for (int j = 0; j < 8; ++j) v[j] = siluf_(v[j]);
      st_bf8(p.Gx + grow * 512 + hd * 128 + c0, v);
    }
    else {
      if (cgp == 0) {
        float g[8];
#pragma unroll
        for (int j = 0; j < 4; ++j) { g[j] = v[j] + gn[j]; g[4 + j] = logsigmoidf_(v[4 + j] + gn[4 + j]); }
        st_f8(p.gates + grow * 8, g);
      }
    }
  }
}

DEVI void epi_mem(const Params& p, LAS char* lds, int l, int brow, int n) {
  const LAS float* Cs = (const LAS float*)lds;
  const int tid = threadIdx.x, cgp = tid & 15, c0 = cgp * 8;
  const int hd = n & 3;
  if (n >= 4) {
    const int b = brow >> 8, m0 = brow & 255;
    store_transposed(lds, p.XVT + ((size_t)((l * 12 + b) * 4 + hd) * 128) * 256 + m0, 256, 1.f);
  }
  float gk[8];
#pragma unroll
  for (int j = 0; j < 8; ++j) gk[j] = p.in[33][l * 128 + c0 + j];
#pragma unroll 1
  for (int it = 0; it < 8; ++it) {
    const int r = it * 16 + (tid >> 4);
    const size_t grow = (size_t)brow + r;
    float v[8];
#pragma unroll
    for (int j = 0; j < 8; ++j) v[j] = Cs[r * 132 + c0 + j];
    if (n < 4) {
      float ss = 0.f;
#pragma unroll
      for (int j = 0; j < 8; ++j) ss += v[j] * v[j];
      ss += __shfl_xor(ss, 1); ss += __shfl_xor(ss, 2); ss += __shfl_xor(ss, 4); ss += __shfl_xor(ss, 8);
      const float rs = rsqrtf(ss * (1.f / 128.f) + EPS);
      const float* g = gk;
#pragma unroll
      for (int j = 0; j < 8; ++j) v[j] = v[j] * rs * g[j];
      st_f8(p.out + O_PXK + ((size_t)l * 1024 + grow) * 512 + hd * 128 + c0, v);
      const int b = (int)grow >> 8, m = (int)grow & 255;
      st_bf8(p.XK + ((size_t)((l * 12 + b) * 256 + m)) * 512 + hd * 128 + c0, v);
    } else {
      st_f8(p.out + O_PXV + ((size_t)l * 1024 + grow) * 512 + hd * 128 + c0, v);
    }
  }
}

DEVI void epi_out(const Params& p, LAS char* lds, int layer, int brow, int n) {
  const LAS float* Cs = (const LAS float*)lds;
  const int tid = threadIdx.x, cgp = tid & 15, c0 = cgp * 8;
#pragma unroll 1
  for (int hb = 0; hb < 2; ++hb) {
    float4 ra[4], rb[4];
#pragma unroll
    for (int q = 0; q < 4; ++q) {
      const size_t grow = (size_t)brow + (hb * 4 + q) * 16 + (tid >> 4);
      const float* res;
      if (layer == 0) res = (grow < NTOKP ? p.in[0] + grow * 1024 : p.in[1] + (grow - NTOKP) * 1024) + n * 128 + c0;
      else res = p.out + grow * 1024 + n * 128 + c0;
      ra[q] = reinterpret_cast<const float4*>(res)[0]; rb[q] = reinterpret_cast<const float4*>(res)[1];
    }
#pragma unroll
    for (int q = 0; q < 4; ++q) {
      const int r = (hb * 4 + q) * 16 + (tid >> 4);
      const size_t grow = (size_t)brow + r;
      float v[8];
#pragma unroll
      for (int j = 0; j < 8; ++j) v[j] = Cs[r * 132 + c0 + j];
      v[0] += ra[q].x; v[1] += ra[q].y; v[2] += ra[q].z; v[3] += ra[q].w; v[4] += rb[q].x; v[5] += rb[q].y; v[6] += rb[q].z; v[7] += rb[q].w;
      st_f8(p.out + grow * 1024 + n * 128 + c0, v);
      if (layer == 0) {
        st_bf8(p.xb + grow * 1024 + n * 128 + c0, v);
        float ss = 0.f;
#pragma unroll
        for (int j = 0; j < 8; ++j) ss += v[j] * v[j];
        ss += __shfl_xor(ss, 1); ss += __shfl_xor(ss, 2); ss += __shfl_xor(ss, 4); ss += __shfl_xor(ss, 8);
        if (cgp == 0) atomicAdd(p.ssq1 + grow, ss);
      }
    }
  }
}

DEVI void epi_in_c(const Params& p, LAS char* lds, int brow, int n) {
  const LAS float* Cs = (const LAS float*)lds;
  const int tid = threadIdx.x, cgp = tid & 15, c0 = cgp * 8;
  u16* U = p.Qa;
  u16* Gc = p.KaT;
  float gx[8];
#pragma unroll
  for (int j = 0; j < 8; ++j) gx[j] = p.in[32][128 + c0 + j];
#pragma unroll 1
  for (int it = 0; it < 8; ++it) {
    const int r = it * 16 + (tid >> 4);
    const size_t grow = (size_t)brow + r;
    float v[8];
#pragma unroll
    for (int j = 0; j < 8; ++j) v[j] = Cs[r * 132 + c0 + j];
    if (n < 16) {
      if (cgp < 8) {
        float u[8];
#pragma unroll
        for (int j = 0; j < 8; ++j) u[j] = v[j] * sigmoidf_(Cs[r * 132 + 64 + c0 + j]);
        st_bf8(U + grow * 1024 + n * 64 + c0, u);
        if (grow < NTOKP) { const int t = (int)grow & 8191, b = (int)grow >> 13; if (t >= SEQ - 30) st_f8(p.out + O_PCONV + ((size_t)(b * 30 + t - (SEQ - 30))) * 1024 + n * 64 + c0, u); }
        else { const int sr = (int)grow - NTOKP, t = sr & 31, b = sr >> 5; if (t >= 2) st_f8(p.out + O_SCONV + ((size_t)(b * 30 + t - 2)) * 1024 + n * 64 + c0, u); }
      }
    } else if (n < 24) {
#pragma unroll
      for (int j = 0; j < 8; ++j) v[j] = siluf_(v[j]);
      st_bf8(Gc + grow * 1024 + (n - 16) * 128 + c0, v);
    } else if (n < 28) {
      float ss = 0.f;
#pragma unroll
      for (int j = 0; j < 8; ++j) ss += v[j] * v[j];
      ss += __shfl_xor(ss, 1); ss += __shfl_xor(ss, 2); ss += __shfl_xor(ss, 4); ss += __shfl_xor(ss, 8);
      const float rs = rsqrtf(ss * (1.f / 128.f) + EPS);
      const float* g = gx;
#pragma unroll
      for (int j = 0; j < 8; ++j) v[j] = v[j] * rs * g[j] * (0.08838834764831845f * LOG2E);
      st_bf8(p.Qx + grow * 512 + (n - 24) * 128 + c0, v);
    } else {
#pragma unroll
      for (int j = 0; j < 8; ++j) v[j] = siluf_(v[j]);
      st_bf8(p.Gx + grow * 512 + (n - 28) * 128 + c0, v);
    }
  }
}

DEVI void gemm_core(LAS char* lds, const u16* A0, const u16* A1, const u16* A2, int lda0, int lda1, int lda2, int segK,
                    const u16* Bt, int K, int brow, int bcol, f32x16 (&acc)[4][2]) {
  const int tid = threadIdx.x, lane = tid & 63, w = tid >> 6, wr = w >> 1, wc = w & 1, r = lane & 31, h = lane >> 5;
#pragma unroll
  for (int i = 0; i < 4; ++i)
#pragma unroll
    for (int j = 0; j < 2; ++j)
#pragma unroll
      for (int e = 0; e < 16; ++e) acc[i][j][e] = 0.f;
  const int nkt = K / 64;
  auto stage = [=](int kt, int buf) __attribute__((always_inline)) {
    const int k0 = kt * 64;
    const int seg = k0 / segK;
    const u16* Ab = (seg == 0 ? A0 : (seg == 1 ? A1 : A2)) + (k0 - seg * segK);
    const int lda = (seg == 0 ? lda0 : (seg == 1 ? lda1 : lda2));
    LAS char* sa = lds + buf * 49152;
    LAS char* sb = sa + 32768;
#pragma unroll
    for (int i = 0; i < 8; ++i) {
      const int pch = i * 256 + tid, row = pch >> 3, lg = (pch & 7) ^ ((row >> 1) & 7);
      glds16(Ab + (size_t)(brow + row) * lda + lg * 8, sa + pch * 16);
    }
#pragma unroll
    for (int i = 0; i < 4; ++i) {
      const int pch = i * 256 + tid, row = pch >> 3, lg = (pch & 7) ^ ((row >> 1) & 7);
      glds16(Bt + (size_t)(bcol + row) * K + k0 + lg * 8, sb + pch * 16);
    }
  };
  lds_barrier();
  stage(0, 0);
  stage(1, 1);
  int buf = 0;
  for (int kt = 0; kt < nkt; ++kt) {
    if (kt + 1 < nkt) asm volatile("s_waitcnt vmcnt(12)" ::: "memory"); else asm volatile("s_waitcnt vmcnt(0)" ::: "memory");
    asm volatile("s_waitcnt lgkmcnt(0)" ::: "memory");
    __builtin_amdgcn_s_barrier();
    if (kt + 2 < nkt) { int nb = buf + 2; if (nb >= 3) nb -= 3; stage(kt + 2, nb); }
    const LAS char* sa = lds + buf * 49152;
    const LAS char* sb = sa + 32768;
    bf16x8 af[2][4], bfr[2][2];
#pragma unroll
    for (int i = 0; i < 4; ++i) {
      const int row = 32 * (2 * i + wr) + r, ch = h ^ ((row >> 1) & 7);
      af[0][i] = *reinterpret_cast<const LAS bf16x8*>(sa + row * 128 + ch * 16);
    }
#pragma unroll
    for (int j = 0; j < 2; ++j) {
      const int row = 32 * (2 * j + wc) + r, ch = h ^ ((row >> 1) & 7);
      bfr[0][j] = *reinterpret_cast<const LAS bf16x8*>(sb + row * 128 + ch * 16);
    }
#pragma unroll
    for (int ks = 0; ks < 4; ++ks) {
      const int cur = ks & 1, nxt = cur ^ 1;
      if (ks < 3) {
#pragma unroll
        for (int i = 0; i < 4; ++i) {
          const int row = 32 * (2 * i + wr) + r, ch = (2 * (ks + 1) + h) ^ ((row >> 1) & 7);
          af[nxt][i] = *reinterpret_cast<const LAS bf16x8*>(sa + row * 128 + ch * 16);
        }
#pragma unroll
        for (int j = 0; j < 2; ++j) {
          const int row = 32 * (2 * j + wc) + r, ch = (2 * (ks + 1) + h) ^ ((row >> 1) & 7);
          bfr[nxt][j] = *reinterpret_cast<const LAS bf16x8*>(sb + row * 128 + ch * 16);
        }
      }
#pragma unroll
      for (int i = 0; i < 4; ++i)
#pragma unroll
        for (int j = 0; j < 2; ++j) acc[i][j] = mfma32(af[cur][i], bfr[cur][j], acc[i][j]);
    }
    if (++buf == 3) buf = 0;
  }
}

DEVI void stage_all(LAS char* lds, const f32x16 (&acc)[4][2], bool scaled) {
  const int tid = threadIdx.x, lane = tid & 63, w = tid >> 6, wr = w >> 1, wc = w & 1, r = lane & 31, h = lane >> 5;
  const LAS float* RS = (const LAS float*)(lds + 135168);
#pragma unroll
  for (int i = 0; i < 4; ++i) {
    LAS float* Cs = (LAS float*)(lds + (i >> 1) * 67584);
#pragma unroll
    for (int e = 0; e < 16; ++e) {
      const int row = 32 * (2 * (i & 1) + wr) + crow(e, h);
      const float s = scaled ? RS[128 * (i >> 1) + row] : 1.f;
#pragma unroll
      for (int jj = 0; jj < 2; ++jj) Cs[row * 132 + 32 * (2 * jj + wc) + r] = acc[i][jj][e] * s;
    }
  }
}

DEVI void gemm_tile_run(const Params& p, LAS char* lds, int which, int aux, int mt, int n, f32x16 (&acc)[4][2]) {
  const int brow = mt * 256, bcol = n * 128;
  const float* rsc = nullptr; int mode = 0;
  if (which == 0) { gemm_core(lds, p.xb, p.xb, p.xb, 1024, 1024, 1024, 1024, p.WtInA, 1024, brow, bcol, acc); rsc = p.rs0; mode = 1; }
  else if (which == 1) gemm_core(lds, p.Ga, p.Gb, p.Gx, 512, 512, 512, 512, p.WtOutA, 1536, brow, bcol, acc);
  else if (which == 2) { gemm_core(lds, p.xb, p.xb, p.xb, 1024, 1024, 1024, 1024, p.WtInC, 1024, brow, bcol, acc); rsc = p.ssq1; mode = 2; }
  else if (which == 3) gemm_core(lds, p.KaT, p.KaT + 512, p.Gx, 1024, 1024, 512, 512, p.WtOutC, 1536, brow, bcol, acc);
  else { gemm_core(lds, p.memb, p.memb, p.memb, 1024, 1024, 1024, 1024, p.WtMem + (size_t)aux * 1024 * 1024, 1024, brow, bcol, acc); rsc = p.rsmem; mode = 1; }
  lds_barrier();
  if (mode) {
    float sc = rsc[brow + threadIdx.x];
    if (mode == 2) sc = rsqrtf(sc * (1.f / 1024.f) + EPS);
    ((LAS float*)(lds + 135168))[threadIdx.x] = sc;
    lds_barrier();
  }
  stage_all(lds, acc, mode != 0);
  lds_barrier();
#pragma unroll 1
  for (int sub = 0; sub < 2; ++sub) {
    LAS char* cs = lds + sub * 67584;
    const int sr = brow + 128 * sub;
    if (which == 0) epi_in_a(p, cs, sr, n);
    else if (which == 1) epi_out(p, cs, 0, sr, n);
    else if (which == 2) epi_in_c(p, cs, sr, n);
    else if (which == 3) epi_out(p, cs, 1, sr, n);
    else epi_mem(p, cs, aux, sr, n);
  }
}

template <int which>
DEVI void phase_gemm(const Params& p, LAS char* lds) {
  constexpr int nN = (which == 0 ? 45 : (which == 2 ? 32 : 8));
  constexpr int ntiles = 128 * nN;
  const int G = gridDim.x;
  const int xcd = blockIdx.x & 7, lb = blockIdx.x >> 3, slots = G >> 3;
  f32x16 acc[4][2];
  int round = 0, t_extra = blockIdx.x;
  bool main_done = false;
  for (;;) {
    int mt, n;
    if (!main_done) {
      const int q = lb + slots * round; ++round;
      const int L = 32 * (xcd + 8 * (q >> 5)) + (q & 31);
      if (L >= ntiles) { main_done = true; continue; }
      const int mg = L / (8 * nN), rem = L - mg * 8 * nN;
      n = rem >> 3; mt = mg * 8 + (rem & 7);
    } else {
      if (t_extra >= nN) break;
      mt = 128; n = t_extra; t_extra += G;
    }
    gemm_tile_run(p, lds, which, 0, mt, n, acc);
  }
  if (which == 0) {
    for (int t = G - 1 - (int)blockIdx.x; t < 64; t += G) gemm_tile_run(p, lds, 4, t >> 5, (t >> 3) & 3, t & 7, acc);
  }
}

template <bool DIFF>
DEVI void attn_block(LAS char* lds, const u16* Q, const u16* Kg, const u16* VT, int ldv, int j0, int ntiles, int nwact,
                           int qpos0, int nkeys, float slope2, float M2, float lam, const float* subg, u16* G) {
  const int tid = threadIdx.x, lane = tid & 63, w = tid >> 6, r = lane & 31, h = lane >> 5;
  const bool act = w < nwact;
  const int qpos = qpos0 + 32 * w + r;
  const int cw = (qpos0 + 32 * w) >> 6;
  bf16x8 qf[8];
#pragma unroll
  for (int i = 0; i < 8; ++i) qf[i] = ldg8(Q + (size_t)(32 * w + r) * 512 + 16 * i + 8 * h);
  f32x16 O0[4], O1[4];
#pragma unroll
  for (int e = 0; e < 4; ++e)
#pragma unroll
    for (int i = 0; i < 16; ++i) { O0[e][i] = 0.f; O1[e][i] = 0.f; }
  float l0 = 0.f, l1 = 0.f;
  f32x16 cinit, zero16;
#pragma unroll
  for (int i = 0; i < 16; ++i) { cinit[i] = slope2 * (float)klocal(i, h); zero16[i] = 0.f; }
  const float tq = -slope2 * (float)qpos - M2;
  const int prow = pi32(r);

  auto stage = [=](int j, int buf) __attribute__((always_inline)) {
    LAS char* kb = lds + buf * 32768;
#pragma unroll
    for (int i = 0; i < 4; ++i) {
      const int pch = i * 256 + tid;
      { const int row = pch >> 4, ph = pch & 15, lg = ph ^ (row & 15);
        glds16(Kg + (size_t)(j * 64 + row) * 512 + lg * 8, kb + pch * 16); }
      { const int row = pch >> 3, ph = pch & 7, lg = ph ^ ((row >> 1) & 7);
        glds16(VT + (size_t)row * ldv + j * 64 + lg * 8, kb + 16384 + pch * 16); }
    }
  };
  __syncthreads();
  stage(j0, 0);
  asm volatile("s_waitcnt vmcnt(0)" ::: "memory");
  __syncthreads();
  for (int j = j0; j < ntiles; ++j) {
    const int buf = (j - j0) & 1;
    if (j + 1 < ntiles) stage(j + 1, buf ^ 1);
    {
      const LAS char* kb = lds + buf * 32768;
      const LAS char* vb = kb + 16384;
      const bool fast = DIFF && (j < cw);
#pragma unroll
      for (int kt = 0; kt < 2; ++kt) {
        const int krow = 32 * kt + prow;
        const LAS char* krp = kb + krow * 256;
        bf16x8 P0[2], P1[2];
        if (DIFF) {
#pragma unroll
          for (int c = 0; c < 2; ++c) {
            f32x16 s;
            if (fast) {
              s = cinit;
#pragma unroll
              for (int ks = 0; ks < 4; ++ks) {
                const int ch = (2 * (4 * c + ks) + h) ^ (krow & 15);
                s = mfma32(*reinterpret_cast<const LAS bf16x8*>(krp + ch * 16), qf[4 * c + ks], s);
              }
              const float t = tq + slope2 * (float)(j * 64 + kt * 32);
#pragma unroll
              for (int i = 0; i < 16; ++i) s[i] = __builtin_amdgcn_exp2f(s[i] + t);
            } else {
              s = zero16;
#pragma unroll
              for (int ks = 0; ks < 4; ++ks) {
                const int ch = (2 * (4 * c + ks) + h) ^ (krow & 15);
                s = mfma32(*reinterpret_cast<const LAS bf16x8*>(krp + ch * 16), qf[4 * c + ks], s);
              }
#pragma unroll
              for (int i = 0; i < 16; ++i) {
                const int kp = j * 64 + kt * 32 + klocal(i, h);
                const float bias = -slope2 * fabsf((float)(qpos - kp)) - M2;
                s[i] = (kp < nkeys && j <= cw) ? __builtin_amdgcn_exp2f(s[i] + bias) : 0.f;
              }
            }
            float ls = 0.f;
#pragma unroll
            for (int i = 0; i < 16; ++i) ls += s[i];
            if (c == 0) { l0 += ls; P0[0] = pack8(s, 0); P0[1] = pack8(s, 1); }
            else        { l1 += ls; P1[0] = pack8(s, 0); P1[1] = pack8(s, 1); }
          }
        } else {
          f32x16 s = zero16;
#pragma unroll
          for (int ks = 0; ks < 8; ++ks) {
            const int ch = (2 * ks + h) ^ (krow & 15);
            s = mfma32(*reinterpret_cast<const LAS bf16x8*>(krp + ch * 16), qf[ks], s);
          }
          float ls = 0.f;
#pragma unroll
          for (int i = 0; i < 16; ++i) { s[i] = __builtin_amdgcn_exp2f(s[i] - M2); ls += s[i]; }
          l0 += ls; P0[0] = pack8(s, 0); P0[1] = pack8(s, 1);
        }
#pragma unroll
        for (int et = 0; et < 4; ++et) {
          const int vrow = 32 * et + r;
#pragma unroll
          for (int sp = 0; sp < 2; ++sp) {
            const int ch = (2 * (2 * kt + sp) + h) ^ ((vrow >> 1) & 7);
            const bf16x8 vf = *reinterpret_cast<const LAS bf16x8*>(vb + vrow * 128 + ch * 16);
            O0[et] = mfma32(vf, P0[sp], O0[et]);
            if (DIFF) O1[et] = mfma32(vf, P1[sp], O1[et]);
          }
        }
      }
    }
    asm volatile("s_waitcnt vmcnt(0)" ::: "memory");
    __syncthreads();
  }
  if (act) {
    l0 += __shfl_xor(l0, 32);
    const float i0 = 1.f / l0;
    float i1 = 0.f;
    if (DIFF) { l1 += __shfl_xor(l1, 32); i1 = lam / l1; }
    float ss = 0.f;
#pragma unroll
    for (int et = 0; et < 4; ++et)
#pragma unroll
      for (int i = 0; i < 16; ++i) {
        float o = O0[et][i] * i0;
        if (DIFF) o -= O1[et][i] * i1;
        O0[et][i] = o; ss += o * o;
      }
    float rs = 1.f;
    if (DIFF) { ss += __shfl_xor(ss, 32); rs = rsqrtf(ss * (1.f / 128.f) + EPS) * 0.8f; }
    u16* grow = G + (size_t)(32 * w + r) * 512;
    u32x2 gt[16]; float4 sv[16];
#pragma unroll
    for (int q = 0; q < 16; ++q) {
      const int e0 = 32 * (q >> 2) + 8 * (q & 3) + 4 * h;
      gt[q] = *reinterpret_cast<const u32x2*>(grow + e0);
      if (DIFF) sv[q] = *reinterpret_cast<const float4*>(subg + e0); else sv[q] = float4{1.f, 1.f, 1.f, 1.f};
    }
#pragma unroll
    for (int q = 0; q < 16; ++q) {
      const int et = q >> 2, g = q & 3;
      const int e0 = 32 * et + 8 * g + 4 * h;
      const float a0 = O0[et][4 * g + 0] * rs * sv[q].x * bflo(gt[q][0]);
      const float a1 = O0[et][4 * g + 1] * rs * sv[q].y * bfhi(gt[q][0]);
      const float a2 = O0[et][4 * g + 2] * rs * sv[q].z * bflo(gt[q][1]);
      const float a3 = O0[et][4 * g + 3] * rs * sv[q].w * bfhi(gt[q][1]);
      u32x2 o = {cvtpk(a0, a1), cvtpk(a2, a3)};
      *reinterpret_cast<u32x2*>(grow + e0) = o;
    }
  }
}

DEVI float max_abs64(const float* g, int n, int lane) { float v = 0.f; for (int i = lane; i < n; i += 64) v = fmaxf(v, fabsf(g[i])); return wmax(v); }

DEVI float scan_add(float v, int lane) { for (int o = 1; o < 64; o <<= 1) { const float t = __shfl_up(v, o); if (lane >= o) v += t; } return v; }
DEVI float scan_max(float v, int lane) { for (int o = 1; o < 64; o <<= 1) { const float t = __shfl_up(v, o); if (lane >= o) v = fmaxf(v, t); } return v; }
DEVI float bfe(const bf16x8& v, int j) { return __uint_as_float(((unsigned)(u16)v[j]) << 16); }

template <int NT>
DEVI void mlstm_local(LAS char* lds, const float* gates, int hd, const u16* KT, const u16* VT, int ldt,
                            f32x16 (&acc)[4], float& nh, float& bL, float& amax) {
  const int tid = threadIdx.x, lane = tid & 63, w = tid >> 6, r = lane & 31, h = lane >> 5;
  constexpr int L = 32 * NT;
  const float lf = lane < L ? gates[lane * 8 + 4 + hd] : 0.f;
  const float ig = lane < L ? gates[lane * 8 + hd] : -INFINITY;
  const float b = scan_add(lf, lane);
  const float a = ig - b;
  amax = wmax(a);
  bL = __shfl(b, L - 1);
  LAS float* wt = (LAS float*)(lds + 4096) + w * 64;
  wt[lane] = __expf(a - amax);
#pragma unroll
  for (int e = 0; e < 4; ++e)
#pragma unroll
    for (int i = 0; i < 16; ++i) acc[e][i] = 0.f;
  nh = 0.f;
#pragma unroll
  for (int ks = 0; ks < 2 * NT; ++ks) {
    const bf16x8 kf = ldg8(KT + (size_t)(32 * w + r) * ldt + 16 * ks + 8 * h);
    float wv[8];
#pragma unroll
    for (int j = 0; j < 8; ++j) { wv[j] = wt[16 * ks + 8 * h + j]; nh += bfe(kf, j) * wv[j]; }
#pragma unroll
    for (int et = 0; et < 4; ++et) {
      const bf16x8 vf = ldg8(VT + (size_t)(32 * et + r) * ldt + 16 * ks + 8 * h);
      u32x4 sv = {cvtpk(bfe(vf, 0) * wv[0], bfe(vf, 1) * wv[1]), cvtpk(bfe(vf, 2) * wv[2], bfe(vf, 3) * wv[3]),
                  cvtpk(bfe(vf, 4) * wv[4], bfe(vf, 5) * wv[5]), cvtpk(bfe(vf, 6) * wv[6], bfe(vf, 7) * wv[7])};
      acc[et] = mfma32(kf, *reinterpret_cast<bf16x8*>(&sv), acc[et]);
    }
  }
  nh += __shfl_xor(nh, 32);
}

template <int NT>
DEVI void mlstm_out(LAS char* lds, const float* gates, int hd, const u16* Qg, const u16* Kg, const u16* VT, int ldv,
                          const u16* CT, const float* n0, float m0, const float* mg, u16* G) {
  const int tid = threadIdx.x, lane = tid & 63, w = tid >> 6, r = lane & 31, h = lane >> 5;
  constexpr int L = 32 * NT;
  const float lf = lane < L ? gates[lane * 8 + 4 + hd] : 0.f;
  const float ig = lane < L ? gates[lane * 8 + hd] : -INFINITY;
  const float b = scan_add(lf, lane);
  const float a = ig - b;
  const float Mrow = fmaxf(m0, scan_max(a, lane));
  const float mt = b + Mrow;
  LAS float* at = (LAS float*)lds + w * 64;
  LAS float* red = (LAS float*)(lds + 1024);
  at[lane] = a;
  const int prow = pi32(r);
#pragma unroll 1
  for (int tt = 0; tt < NT; ++tt) {
    const int t = 32 * tt + r;
    const float Mrow_t = __shfl(Mrow, t), mt_t = __shfl(mt, t);
    const float winter = __expf(m0 - Mrow_t);
    bf16x8 qf[8];
    float qn = 0.f;
#pragma unroll
    for (int i = 0; i < 8; ++i) {
      qf[i] = ldg8(Qg + (size_t)t * 512 + 16 * i + 8 * h);
      const float4 na = *reinterpret_cast<const float4*>(n0 + 16 * i + 8 * h), nb = *reinterpret_cast<const float4*>(n0 + 16 * i + 8 * h + 4);
      qn += bfe(qf[i], 0) * na.x + bfe(qf[i], 1) * na.y + bfe(qf[i], 2) * na.z + bfe(qf[i], 3) * na.w
          + bfe(qf[i], 4) * nb.x + bfe(qf[i], 5) * nb.y + bfe(qf[i], 6) * nb.z + bfe(qf[i], 7) * nb.w;
    }
    qn += __shfl_xor(qn, 32);
    f32x16 H;
#pragma unroll
    for (int i = 0; i < 16; ++i) H[i] = 0.f;
#pragma unroll
    for (int ks = 0; ks < 8; ++ks) H = mfma32(ldg8(CT + (size_t)(32 * w + r) * 128 + 16 * ks + 8 * h), qf[ks], H);
#pragma unroll
    for (int i = 0; i < 16; ++i) H[i] *= winter;
    float dsum = 0.f;
    for (int st = 0; st <= tt; ++st) {
      f32x16 S;
#pragma unroll
      for (int i = 0; i < 16; ++i) S[i] = 0.f;
#pragma unroll
      for (int ks = 0; ks < 8; ++ks) S = mfma32(ldg8(Kg + (size_t)(32 * st + prow) * 512 + 16 * ks + 8 * h), qf[ks], S);
#pragma unroll
      for (int i = 0; i < 16; ++i) {
        const int s = 32 * st + klocal(i, h);
        const float wg = (s <= t) ? __expf(at[s] - Mrow_t) : 0.f;
        S[i] *= wg; dsum += S[i];
      }
#pragma unroll
      for (int sp = 0; sp < 2; ++sp)
        H = mfma32(ldg8(VT + (size_t)(32 * w + r) * ldv + 32 * st + 16 * sp + 8 * h), pack8(S, sp), H);
    }
    dsum += __shfl_xor(dsum, 32);
    const float den = winter * qn + dsum;
    const float inv = 1.f / fmaxf(fabsf(den), __expf(-mt_t));
    float ss = 0.f;
#pragma unroll
    for (int i = 0; i < 16; ++i) { H[i] *= inv; ss += H[i] * H[i]; }
    ss += __shfl_xor(ss, 32);
    if (h == 0) red[w * 64 + t] = ss;
    __syncthreads();
    const float tot = red[t] + red[64 + t] + red[128 + t] + red[192 + t];
    const float rs = rsqrtf(tot * (1.f / 128.f) + EPS);
    u16* grow = G + (size_t)t * 512;
    u32x2 gt[4]; float4 mv[4];
#pragma unroll
    for (int g = 0; g < 4; ++g) {
      const int e0 = 32 * w + 8 * g + 4 * h;
      gt[g] = *reinterpret_cast<const u32x2*>(grow + e0);
      mv[g] = *reinterpret_cast<const float4*>(mg + e0);
    }
#pragma unroll
    for (int g = 0; g < 4; ++g) {
      const int e0 = 32 * w + 8 * g + 4 * h;
      u32x2 o = {cvtpk(H[4 * g + 0] * rs * mv[g].x * bflo(gt[g][0]), H[4 * g + 1] * rs * mv[g].y * bfhi(gt[g][0])),
                 cvtpk(H[4 * g + 2] * rs * mv[g].z * bflo(gt[g][1]), H[4 * g + 3] * rs * mv[g].w * bfhi(gt[g][1]))};
      *reinterpret_cast<u32x2*>(grow + e0) = o;
    }
    __syncthreads();
  }
}

DEVI void m1_item(const Params& p, LAS char* lds, int item) {
  const int tid = threadIdx.x, lane = tid & 63, w = tid >> 6, r = lane & 31, h = lane >> 5;
  const int bh = item >> 7, c = item & 127, b = bh >> 2, hd = bh & 3;
  const size_t row0 = (size_t)b * SEQ + c * 64;
  f32x16 acc[4]; float nh, bL, amax;
  __syncthreads();
  mlstm_local<2>(lds, p.gates + row0 * 8, hd, p.KaT + (size_t)bh * 128 * SEQ + c * 64, p.VaT + (size_t)bh * 128 * SEQ + c * 64, SEQ, acc, nh, bL, amax);
  u16* Chat = p.xb + ((size_t)item * 128) * 128;
#pragma unroll
  for (int et = 0; et < 4; ++et)
#pragma unroll
    for (int g = 0; g < 4; ++g) {
      const int d0 = 32 * w + 8 * g + 4 * h, e = 32 * et + r;
      u32x2 o = {cvtpk(acc[et][4 * g], acc[et][4 * g + 1]), cvtpk(acc[et][4 * g + 2], acc[et][4 * g + 3])};
      *reinterpret_cast<u32x2*>(Chat + (size_t)e * 128 + d0) = o;
    }
  if (h == 0) p.nhat[(size_t)item * 128 + 32 * w + r] = nh;
  if (tid == 0) { p.tabA[item] = bL; p.tabB[item] = bL + amax; }
}

DEVI void phase_scan(const Params& p, LAS char* lds) {
  const int tid = threadIdx.x, lane = tid & 63;
  LAS float* al = (LAS float*)lds; LAS float* be = al + 128; LAS float* ms = al + 256;
  for (int u = blockIdx.x; u < 16 * 32; u += gridDim.x) {
    const int bh = u >> 5, part = u & 31;
    __syncthreads();
    if (tid < 64) {
      const float A0 = p.tabA[bh * 128 + 2 * lane], A1 = p.tabA[bh * 128 + 2 * lane + 1];
      const float B0 = p.tabB[bh * 128 + 2 * lane], B1 = p.tabB[bh * 128 + 2 * lane + 1];
      const float SAi = scan_add(A0 + A1, lane);
      const float SA0 = SAi - A1, SA1 = SAi;
      const float D0 = B0 - SA0, D1 = B1 - SA1;
      const float PMi = scan_max(fmaxf(D0, D1), lane);
      float PMx = __shfl_up(PMi, 1); if (lane == 0) PMx = -INFINITY;
      const float mn0 = SA0 + fmaxf(0.f, fmaxf(PMx, D0));
      const float mn1 = SA1 + fmaxf(0.f, PMi);
      float mprev = __shfl_up(mn1, 1); if (lane == 0) mprev = 0.f;
      al[2 * lane] = __expf(A0 + mprev - mn0); be[2 * lane] = __expf(B0 - mn0);
      al[2 * lane + 1] = __expf(A1 + mn0 - mn1); be[2 * lane + 1] = __expf(B1 - mn1);
      ms[2 * lane] = mprev; ms[2 * lane + 1] = mn0;
      if (lane == 63) ms[128] = mn1;
    }
    __syncthreads();
    if (part == 0) {
      if (tid < 129) p.mtab[bh * 129 + tid] = ms[tid];
      if (tid == 0) p.out[O_PM + bh] = ms[128];
    }
    u16* base = p.xb + (size_t)bh * 128 * 16384 + part * 512 + tid * 2;
    float c0 = 0.f, c1 = 0.f;
    for (int c = 0; c < 128; c += 8) {
      unsigned v[8];
#pragma unroll
      for (int j = 0; j < 8; ++j) v[j] = *reinterpret_cast<const unsigned*>(base + (size_t)(c + j) * 16384);
#pragma unroll
      for (int j = 0; j < 8; ++j) {
        *reinterpret_cast<unsigned*>(base + (size_t)(c + j) * 16384) = cvtpk(c0, c1);
        const float a_ = al[c + j], b_ = be[c + j];
        c0 = a_ * c0 + b_ * bflo(v[j]); c1 = a_ * c1 + b_ * bfhi(v[j]);
      }
    }
    { const int idx = part * 512 + tid * 2, e = idx >> 7, d = idx & 127;
      p.out[O_PC + ((size_t)bh * 128 + d) * 128 + e] = c0;
      p.out[O_PC + ((size_t)bh * 128 + d + 1) * 128 + e] = c1; }
    if (part == 0 && tid < 128) {
      float n = 0.f;
      for (int c = 0; c < 128; c += 16) {
        float nv[16];
#pragma unroll
        for (int j = 0; j < 16; ++j) nv[j] = p.nhat[((size_t)bh * 128 + c + j) * 128 + tid];
#pragma unroll
        for (int j = 0; j < 16; ++j) {
          p.nstate[((size_t)bh * 128 + c + j) * 128 + tid] = n;
          n = al[c + j] * n + be[c + j] * nv[j];
        }
      }
      p.out[O_PN + bh * 128 + tid] = n;
    }
  }
}

DEVI void m3_item(const Params& p, LAS char* lds, int item) {
  const int bh = item >> 7, c = item & 127, b = bh >> 2, hd = bh & 3;
  const size_t row0 = (size_t)b * SEQ + c * 64;
  __syncthreads();
  mlstm_out<2>(lds, p.gates + row0 * 8, hd, p.Qa + row0 * 512 + hd * 128, p.Ka + row0 * 512 + hd * 128,
               p.VaT + (size_t)bh * 128 * SEQ + c * 64, SEQ, p.xb + (size_t)item * 16384, p.nstate + (size_t)item * 128,
               p.mtab[bh * 129 + c], p.in[15] + hd * 128, p.Ga + row0 * 512 + hd * 128);
}

DEVI void ms_item(const Params& p, LAS char* lds, int bh) {
  const int tid = threadIdx.x, lane = tid & 63, w = tid >> 6, r = lane & 31, h = lane >> 5;
  const int b = bh >> 2, hd = bh & 3;
  const size_t row0 = (size_t)NTOKP + b * 32;
  const float m0 = p.in[9][bh];
  const float* n0 = p.in[8] + bh * 128;
  const u16* KTs = p.KaT + (size_t)NTOKP * 512 + (size_t)bh * 128 * 32;
  const u16* VTs = p.VaT + (size_t)NTOKP * 512 + (size_t)bh * 128 * 32;
  __syncthreads();
  mlstm_out<1>(lds, p.gates + row0 * 8, hd, p.Qa + row0 * 512 + hd * 128, p.Ka + row0 * 512 + hd * 128, VTs, 32,
               p.C0sT + (size_t)bh * 16384, n0, m0, p.in[15] + hd * 128, p.Ga + row0 * 512 + hd * 128);
  f32x16 acc[4]; float nh, bL, amax;
  mlstm_local<1>(lds, p.gates + row0 * 8, hd, KTs, VTs, 32, acc, nh, bL, amax);
  const float mlast = bL + fmaxf(m0, amax);
  const float decay = __expf(bL + m0 - mlast), beta = __expf(bL + amax - mlast);
#pragma unroll
  for (int et = 0; et < 4; ++et)
#pragma unroll
    for (int i = 0; i < 16; ++i) {
      const int d = 32 * w + crow(i, h), e = 32 * et + r;
      const size_t o = ((size_t)bh * 128 + d) * 128 + e;
      p.out[O_SC + o] = decay * p.in[7][o] + beta * acc[et][i];
    }
  if (h == 0) { const int d = 32 * w + r; p.out[O_SN + bh * 128 + d] = decay * n0[d] + beta * nh; }
  if (tid == 0) p.out[O_SM + bh] = mlast;
}

DEVI void phase_conv(const Params& p, LAS char* lds) {
  const int tid = threadIdx.x, lane = tid & 63, w = tid >> 6;
  const u16* U = p.Qa; u16* Gc = p.KaT;
  LAS u16* win = (LAS u16*)lds;
  LAS float* cs = (LAS float*)(lds + 20480);
  LAS float* st = (LAS float*)(lds + 20480 + 32768);
  for (int tile = blockIdx.x; tile < NTOK / 8; tile += gridDim.x) {
    const int row0 = tile * 8;
    const bool samp = row0 >= NTOKP;
    int t0, bs = 0;
    if (!samp) t0 = row0 & 8191; else { const int sr = row0 - NTOKP; bs = sr >> 5; t0 = sr & 31; }
    const int seqbase = row0 - t0;
#pragma unroll 1
    for (int cgp = 0; cgp < 4; ++cgp) {
      __syncthreads();
      for (int pch = tid; pch < 38 * 32; pch += 256) {
        const int rr = pch >> 5, ch = pch & 31, t = t0 - 30 + rr;
        u32x4 v = {0, 0, 0, 0};
        if (t >= 0) v = *reinterpret_cast<const u32x4*>(U + (size_t)(seqbase + t) * 1024 + cgp * 256 + ch * 8);
        else if (samp) {
          const float4* sc = reinterpret_cast<const float4*>(p.in[10] + ((size_t)(bs * 30 + 30 + t)) * 1024 + cgp * 256 + ch * 8);
          const float4 a = sc[0], c = sc[1];
          v = u32x4{cvtpk(a.x, a.y), cvtpk(a.z, a.w), cvtpk(c.x, c.y), cvtpk(c.z, c.w)};
        }
        *reinterpret_cast<LAS u32x4*>(win + rr * 256 + ch * 8) = v;
      }
      __syncthreads();
      const int chn = cgp * 256 + tid;
      float wv[38], cw[31];
#pragma unroll
      for (int rr = 0; rr < 38; ++rr) wv[rr] = bf2f(win[rr * 256 + tid]);
#pragma unroll
      for (int j = 0; j < 31; ++j) cw[j] = p.in[25][j * 1024 + chn];
      const float cb = p.in[26][chn];
#pragma unroll
      for (int i = 0; i < 8; ++i) {
        float a = cb;
#pragma unroll
        for (int j = 0; j < 31; ++j) a += cw[j] * wv[i + j];
        cs[i * 1024 + chn] = a;
      }
    }
    __syncthreads();
#pragma unroll
    for (int q = 0; q < 2; ++q) {
      const int i = 2 * w + q;
      float a1 = 0.f, a2 = 0.f;
#pragma unroll
      for (int k = 0; k < 16; ++k) { const float v = cs[i * 1024 + lane + 64 * k]; a1 += v; a2 += v * v; }
      a1 = wsum(a1); a2 = wsum(a2);
      if (lane == 0) {
        const float mu = a1 * (1.f / 1024.f);
        const float var = fmaxf(a2 * (1.f / 1024.f) - mu * mu, 0.f);
        st[2 * i] = mu; st[2 * i + 1] = rsqrtf(var + EPS);
      }
    }
    __syncthreads();
#pragma unroll 1
    for (int cgp = 0; cgp < 4; ++cgp) {
      const int chn = cgp * 256 + tid;
      const float lg = p.in[27][chn], lb = p.in[28][chn];
      u16 gv[8];
#pragma unroll
      for (int i = 0; i < 8; ++i) gv[i] = Gc[(size_t)(row0 + i) * 1024 + chn];
#pragma unroll
      for (int i = 0; i < 8; ++i) {
        const float y = (cs[i * 1024 + chn] - st[2 * i]) * st[2 * i + 1] * lg + lb;
        Gc[(size_t)(row0 + i) * 1024 + chn] = f2bf(siluf_(y) * bf2f(gv[i]));
      }
    }
  }
}

struct AttnConst { float M2d, M2x, lam; };
DEVI AttnConst attn_consts(const Params& p, int layer) {
  const int lane = threadIdx.x & 63;
  AttnConst c;
  const float gq = max_abs64(p.in[16], 64, lane), gk = max_abs64(p.in[17], 64, lane);
  float kd = 0.f, kx = 0.f;
  for (int i = lane; i < (int)gridDim.x * 4; i += 64) { kd = fmaxf(kd, p.kmaxp[i]); kx = fmaxf(kx, p.kmaxp[1024 * (1 + layer) + i]); }
  kd = wmax(kd); kx = wmax(kx);
  c.M2d = (8.f * gq * 0.125f * LOG2E) * fmaxf(8.f * gk, sqrtf(kd)) * 1.01f;
  const float xq = max_abs64(p.in[32] + layer * 128, 128, lane), xk = max_abs64(p.in[33] + layer * 128, 128, lane);
  c.M2x = (11.313708f * xq * 0.08838834764831845f * LOG2E) * fmaxf(11.313708f * xk, sqrtf(kx)) * 1.01f;
  float d1 = p.in[18][lane] * p.in[19][lane], d2 = p.in[20][lane] * p.in[21][lane];
  d1 = wsum(d1); d2 = wsum(d2);
  c.lam = __expf(d1) - __expf(d2) + 0.2f;
  return c;
}

DEVI void cross_item(const Params& p, LAS char* lds, int layer, int it, float M2x) {
  const int hd = it & 3;
  size_t row0; int mb, nw;
  if (it < 1024) { const int rb = it >> 2; row0 = (size_t)rb * 128; mb = rb >> 6; nw = 4; }
  else { const int bs = (it - 1024) >> 2; row0 = (size_t)NTOKP + bs * 32; mb = 4 + bs; nw = 1; }
  attn_block<false>(lds, p.Qx + row0 * 512 + hd * 128, p.XK + ((size_t)(layer * 12 + mb) * 256) * 512 + hd * 128,
                    p.XVT + ((size_t)((layer * 12 + mb) * 4 + hd) * 128) * 256, 256, 0, 4, nw, 0, 256, 0.f, M2x, 0.f, nullptr,
                    p.Gx + row0 * 512 + hd * 128);
}

DEVI void diff_item(const Params& p, LAS char* lds, int it, float M2d, float lam) {
  const bool pr = it < 1024;
  const int hd = pr ? 3 - (it >> 8) : (it - 1024) & 3;
  const int qb = pr ? 63 - ((it >> 2) & 63) : 0;
  const int b = pr ? (it & 3) : (it - 1024) >> 2;
  const int bh = b * 4 + hd;
  const size_t row0 = pr ? (size_t)b * SEQ + qb * 128 : (size_t)NTOKP + b * 32;
  const float slope2 = exp2f(-2.f * (hd + 1)) * LOG2E;
  const u16* Kp = pr ? p.Kb + (size_t)b * SEQ * 512 + hd * 128 : p.Ks + (size_t)b * SKP * 512 + hd * 128;
  const u16* Vp = pr ? p.VbT + (size_t)bh * 128 * SEQ : p.VsT + (size_t)bh * 128 * SKP;
  const int qpos0 = pr ? qb * 128 : PAST;
  const float kcut = (float)qpos0 - (2.f * M2d + 64.f) / slope2;
  int j0 = (int)floorf((kcut - 63.f) * (1.f / 64.f));
  j0 = max(j0, 0);
  attn_block<true>(lds, p.Qb + row0 * 512 + hd * 128, Kp, Vp, pr ? SEQ : SKP, j0, pr ? 2 * qb + 2 : 33, pr ? 4 : 1,
                   qpos0, pr ? SEQ : PAST + 32, slope2, M2d, lam, p.in[22], p.Gb + row0 * 512 + hd * 128);
}

DEVI int snake(int k, int g, int G) { return (k & 1) ? (k * G + (G - 1 - g)) : (k * G + g); }

constexpr int NPHASE = 9;
DEVI void run_phase(const Params& p, LAS char* lds, int ph) {
  const int G = gridDim.x, g = blockIdx.x;
  switch (ph) {
    case 0: phase_prep(p); break;
    case 1: phase_gemm<0>(p, lds); break;
    case 2: {
      const AttnConst c = attn_consts(p, 0);
      for (int it = g; it < 1056; it += G) cross_item(p, lds, 0, it, c.M2x);
      for (int it = g; it < 2048; it += G) m1_item(p, lds, it);
    } break;
    case 3: {
      const AttnConst c = attn_consts(p, 0);
      (void)c;
      phase_scan(p, lds);
    } break;
    case 4: {
      const AttnConst c = attn_consts(p, 0);
      unsigned* qhead = reinterpret_cast<unsigned*>(p.kmaxp + 3 * 1024) + 16;
      volatile LAS int* slot = (volatile LAS int*)(lds + LDS_BYTES - 16);
      for (;;) {
        __syncthreads();
        if (threadIdx.x == 0) *slot = (int)__hip_atomic_fetch_add(qhead, 1u, __ATOMIC_RELAXED, __HIP_MEMORY_SCOPE_AGENT);
        __syncthreads();
        const int it = *slot;
        if (it >= 1056) break;
        diff_item(p, lds, it, c.M2d, c.lam);
      }
      for (;;) {
        __syncthreads();
        if (threadIdx.x == 0) *slot = (int)__hip_atomic_fetch_add(qhead + 16, 1u, __ATOMIC_RELAXED, __HIP_MEMORY_SCOPE_AGENT);
        __syncthreads();
        const int it = *slot;
        if (it >= 2048) break;
        m3_item(p, lds, it);
      }
      for (int it = G - 1 - g; it < 32; it += G) ms_item(p, lds, it);
    } break;
    case 5: phase_gemm<1>(p, lds); break;
    case 6: phase_gemm<2>(p, lds); break;
    case 7: {
      const AttnConst c = attn_consts(p, 1);
      phase_conv(p, lds);
      for (int it = g; it < 1056; it += G) cross_item(p, lds, 1, it, c.M2x);
    } break;
    case 8: phase_gemm<3>(p, lds); break;
  }
}

DEVI void grid_bar(unsigned* ctr, unsigned& epoch) {
  asm volatile("s_waitcnt vmcnt(0)" ::: "memory");
  __syncthreads();
  if (threadIdx.x == 0) {
    __builtin_amdgcn_fence(__ATOMIC_RELEASE, "agent");
    asm volatile("s_waitcnt vmcnt(0)" ::: "memory");
    __hip_atomic_fetch_add(ctr, 1u, __ATOMIC_RELAXED, __HIP_MEMORY_SCOPE_AGENT);
    epoch += 1u;
    const unsigned target = epoch * gridDim.x;
    while (__hip_atomic_load(ctr, __ATOMIC_RELAXED, __HIP_MEMORY_SCOPE_AGENT) < target) __builtin_amdgcn_s_sleep(1);
    __builtin_amdgcn_fence(__ATOMIC_ACQUIRE, "agent");
    asm volatile("s_waitcnt vmcnt(0)" ::: "memory");
  }
  __syncthreads();
}

__global__ void __launch_bounds__(256, 1) mega(Params p, int ph_lo, int ph_hi) {
  extern __shared__ __attribute__((aligned(16))) char smem[];
  LAS char* lds = (LAS char*)smem;
  cg::grid_group grid = cg::this_grid();
  unsigned epoch = 0;
  unsigned* ctr = reinterpret_cast<unsigned*>(p.kmaxp + 3 * 1024);
#define RUNPH(k) if (ph_lo <= (k) && (k) < ph_hi) { if ((k) > ph_lo) { if ((k) == 1) grid.sync(); else grid_bar(ctr, epoch); } run_phase(p, lds, (k)); }
  RUNPH(0) RUNPH(1) RUNPH(2) RUNPH(3) RUNPH(4) RUNPH(5) RUNPH(6) RUNPH(7) RUNPH(8)
#undef RUNPH
}

#ifndef MULTI_LAUNCH
#define MULTI_LAUNCH 0
#endif

extern "C" void kernel_launch(void* const* d_in, const int* in_sizes, int n_in, void* d_out, int out_size, void* d_ws, size_t ws_size,
                              hipStream_t stream) {
  static int grid_blocks = 0;
  if (!grid_blocks) {
    int dev = 0, cus = 0, per_cu = 0;
    hipGetDevice(&dev);
    hipDeviceGetAttribute(&cus, hipDeviceAttributeMultiprocessorCount, dev);
    hipFuncSetAttribute((const void*)mega, hipFuncAttributeMaxDynamicSharedMemorySize, LDS_BYTES);
    hipOccupancyMaxActiveBlocksPerMultiprocessor(&per_cu, (const void*)mega, 256, LDS_BYTES);
    if (per_cu < 1) per_cu = 1;
    if (per_cu > 1) per_cu = 1;
    grid_blocks = (cus * per_cu) & ~7;
    if (grid_blocks < 8) grid_blocks = 8;
  }
  Params p{};
  for (int i = 0; i < 34; ++i) p.in[i] = (const float*)d_in[i];
  p.out = (float*)d_out;
  char* ws = (char*)d_ws;
  size_t off = 0;
  auto take = [&](size_t bytes) { char* q = ws + off; off += (bytes + 255) & ~(size_t)255; return q; };
  p.WtInA = (u16*)take((size_t)NPAD_A * 1024 * 2);
  p.WtOutA = (u16*)take((size_t)1024 * 1536 * 2);
  p.WtInC = (u16*)take((size_t)4096 * 1024 * 2);
  p.WtOutC = (u16*)take((size_t)1024 * 1536 * 2);
  p.WtMem = (u16*)take((size_t)2 * 1024 * 1024 * 2);
  p.xb = (u16*)take((size_t)NTOK * 1024 * 2);
  p.memb = (u16*)take((size_t)1024 * 1024 * 2);
  u16* segs = (u16*)take(SEG * 2 * 11);
  p.Qa = segs; p.Ka = segs + SEG; p.KaT = segs + 2 * SEG; p.VaT = segs + 3 * SEG; p.Ga = segs + 4 * SEG; p.Qb = segs + 5 * SEG;
  p.Kb = segs + 6 * SEG; p.VbT = segs + 7 * SEG; p.Gb = segs + 8 * SEG; p.Qx = segs + 9 * SEG; p.Gx = segs + 10 * SEG;
  p.Ks = (u16*)take((size_t)8 * SKP * 512 * 2);
  p.VsT = (u16*)take((size_t)4096 * SKP * 2);
  p.XK = (u16*)take((size_t)2 * 12 * 256 * 512 * 2);
  p.XVT = (u16*)take((size_t)2 * 12 * 256 * 512 * 2);
  p.C0sT = (u16*)take((size_t)32 * 16384 * 2);
  p.rs0 = (float*)take((size_t)NTOK * 4);
  p.ssq1 = (float*)take((size_t)NTOK * 4);
  p.rsmem = (float*)take((size_t)(1024 + 64) * 4);
  p.gates = (float*)take((size_t)NTOK * 8 * 4);
  p.tabA = (float*)take(2048 * 4);
  p.tabB = (float*)take(2048 * 4);
  p.mtab = (float*)take(16 * 129 * 4);
  p.nhat = (float*)take((size_t)2048 * 128 * 4);
  p.nstate = (float*)take((size_t)2048 * 128 * 4);
  p.kmaxp = (float*)take((size_t)3 * 1024 * 4 + 256);
  if (off > ws_size) { fprintf(stderr, "workspace too small: need %zu have %zu\n", off, ws_size); return; }
  (void)hipMemsetAsync(p.kmaxp + 3 * 1024, 0, 256, stream);
#if MULTI_LAUNCH
  for (int ph = 0; ph < NPHASE; ++ph) {
    hipLaunchKernelGGL(mega, dim3(grid_blocks), dim3(256), LDS_BYTES, stream, p, ph, ph + 1);
  }
#else
  int lo = 0, hi = NPHASE;
  void* args[] = {&p, &lo, &hi};
  hipError_t e = hipLaunchCooperativeKernel((const void*)mega, dim3(grid_blocks), dim3(256), args, LDS_BYTES, stream);
  if (e != hipSuccess) fprintf(stderr, "cooperative launch failed: %s (grid %d)\n", hipGetErrorString(e), grid_blocks);
#endif
}
```

```cpp
#include <hip/hip_runtime.h>
#include <hip/hip_cooperative_groups.h>
#include <stdint.h>
#include <stdio.h>
namespace cg = cooperative_groups;

typedef unsigned short u16;
using bf16x8 = __attribute__((ext_vector_type(8))) short;
using f32x4  = __attribute__((ext_vector_type(4))) float;
using f32x16 = __attribute__((ext_vector_type(16))) float;
using u32x4  = __attribute__((ext_vector_type(4))) unsigned;
using u32x2  = __attribute__((ext_vector_type(2))) unsigned;
#define LAS __attribute__((address_space(3)))
#define DEVI __device__ __forceinline__

constexpr int NTOKP = 32768, NTOKS = 256, NTOK = 33024;
constexpr int SEQ = 8192, LSAMP = 32, PAST = 2048, SKP = 2112;
constexpr size_t SEG = (size_t)NTOK * 512;
constexpr int NPAD_A = 5760;
constexpr float EPS = 1e-6f;
constexpr float LOG2E = 1.4426950408889634f;
constexpr size_t O_YP = 0, O_PXK = 33816576, O_PXV = 34865152, O_PK = 35913728, O_PV = 52690944,
  O_PC = 69468160, O_PN = 69730304, O_PM = 69732352, O_PCONV = 69732368, O_SK = 69855248, O_SV = 69986320,
  O_SC = 70117392, O_SN = 70641680, O_SM = 70645776, O_SCONV = 70645808;

constexpr int LDS_BYTES = 147456;

struct Params {
  const float* in[34];
  float* out;
  u16 *WtInA, *WtOutA, *WtInC, *WtOutC, *WtMem;
  u16 *xb, *memb;
  u16 *Qa, *Ka, *KaT, *VaT, *Ga, *Qb, *Kb, *VbT, *Gb, *Qx, *Gx;
  u16 *Ks, *VsT, *XK, *XVT, *C0sT;
  float *rs0, *ssq1, *rsmem, *gates, *tabA, *tabB, *mtab, *nhat, *nstate, *kmaxp;
};

DEVI unsigned cvtpk(float lo, float hi) { unsigned r; asm volatile("v_cvt_pk_bf16_f32 %0, %1, %2" : "=v"(r) : "v"(lo), "v"(hi)); return r; }
DEVI float bflo(unsigned u) { return __uint_as_float(u << 16); }
DEVI float bfhi(unsigned u) { return __uint_as_float(u & 0xffff0000u); }
DEVI float bf2f(u16 h) { return __uint_as_float(((unsigned)h) << 16); }
DEVI u16 f2bf(float f) { return (u16)(cvtpk(f, 0.f) & 0xffffu); }
DEVI float sigmoidf_(float x) { return 1.f / (1.f + __expf(-x)); }
DEVI float siluf_(float x) { return x / (1.f + __expf(-x)); }
DEVI float logsigmoidf_(float x) { return fminf(x, 0.f) - log1pf(__expf(-fabsf(x))); }
DEVI float wsum(float v) { for (int o = 32; o; o >>= 1) v += __shfl_xor(v, o); return v; }
DEVI float wmax(float v) { for (int o = 32; o; o >>= 1) v = fmaxf(v, __shfl_xor(v, o)); return v; }
DEVI int pi32(int r) { return (r & ~12) | ((r & 4) << 1) | ((r & 8) >> 1); }
DEVI int klocal(int reg, int h) { return (reg & 3) + 4 * ((reg >> 2) & 1) + 8 * h + 16 * (reg >> 3); }
DEVI int crow(int reg, int h) { return (reg & 3) + 8 * (reg >> 2) + 4 * h; }
DEVI bf16x8 ldg8(const u16* p) { return *reinterpret_cast<const bf16x8*>(p); }
DEVI f32x16 mfma32(bf16x8 a, bf16x8 b, f32x16 c) { return __builtin_amdgcn_mfma_f32_32x32x16_bf16(a, b, c, 0, 0, 0); }
DEVI bf16x8 pack8(const f32x16& x, int s) {
  u32x4 w = {cvtpk(x[8 * s + 0], x[8 * s + 1]), cvtpk(x[8 * s + 2], x[8 * s + 3]), cvtpk(x[8 * s + 4], x[8 * s + 5]), cvtpk(x[8 * s + 6], x[8 * s + 7])};
  return *reinterpret_cast<bf16x8*>(&w);
}
DEVI void lds_barrier() { asm volatile("s_waitcnt lgkmcnt(0)" ::: "memory"); __builtin_amdgcn_s_barrier(); asm volatile("" ::: "memory"); }
DEVI void glds16(const void* g, LAS void* l) { __builtin_amdgcn_global_load_lds((const unsigned*)g, (LAS unsigned*)l, 16, 0, 0); }

template <class F>
DEVI void wtrans(u16* dst, const float* src, const float* g, int K, int Npad, int ldn, F srccol, int gtid, int gsz) {
  const int total = Npad * (K / 32);
  for (int i = gtid; i < total; i += gsz) {
    const int n = i % Npad, kb = i / Npad;
    const int sc = srccol(n);
    float v[32];
#pragma unroll
    for (int j = 0; j < 32; ++j) v[j] = (sc >= 0) ? src[(size_t)(kb * 32 + j) * ldn + sc] : 0.f;
    if (g) {
#pragma unroll
      for (int j = 0; j < 32; ++j) v[j] *= g[kb * 32 + j];
    }
#pragma unroll
    for (int q = 0; q < 4; ++q) {
      u32x4 w = {cvtpk(v[8 * q + 0], v[8 * q + 1]), cvtpk(v[8 * q + 2], v[8 * q + 3]), cvtpk(v[8 * q + 4], v[8 * q + 5]), cvtpk(v[8 * q + 6], v[8 * q + 7])};
      *reinterpret_cast<u32x4*>(dst + (size_t)n * K + kb * 32 + q * 8) = w;
    }
  }
}

DEVI int srccol_in_a(int n) {
  const int t = n >> 7, c = n & 127;
  if (t < 12) return n;
  if (t < 20) { const int j = t - 12; return c < 64 ? 1536 + 64 * j + c : 2048 + 64 * j + (c - 64); }
  if (t < 44) return 2568 + (t - 20) * 128 + c;
  if (t == 44) return c < 8 ? 2560 + c : -1;
  return -1;
}
DEVI int srccol_in_c(int n) {
  const int t = n >> 7, c = n & 127;
  if (t < 16) return c < 64 ? 64 * t + c : 1024 + 64 * t + (c - 64);
  return n;
}

DEVI void phase_prep(const Params& p) {
  const int tid = threadIdx.x, lane = tid & 63;
  const int gtid = blockIdx.x * 256 + tid, gsz = gridDim.x * 256;
  const int gwave = gtid >> 6, nwaves = gsz >> 6;
  wtrans(p.WtInA, p.in[12], p.in[11], 1024, NPAD_A, 5640, [](int n) { return srccol_in_a(n); }, gtid, gsz);
  wtrans(p.WtOutA, p.in[23], nullptr, 1536, 1024, 1024, [](int n) { return n; }, gtid, gsz);
  wtrans(p.WtInC, p.in[24], p.in[11] + 1024, 1024, 4096, 4096, [](int n) { return srccol_in_c(n); }, gtid, gsz);
  wtrans(p.WtOutC, p.in[29], nullptr, 1536, 1024, 1024, [](int n) { return n; }, gtid, gsz);
  for (int l = 0; l < 2; ++l)
    wtrans(p.WtMem + (size_t)l * 1024 * 1024, p.in[31] + (size_t)l * 1024 * 1024, p.in[30] + l * 1024, 1024, 1024, 1024,
           [](int n) { return n; }, gtid, gsz);
  for (int row0 = gwave; row0 < NTOK + 1024; row0 += 4 * nwaves) {
    float4 v[4][4];
    const float* xr[4];
#pragma unroll
    for (int u = 0; u < 4; ++u) {
      const int row = min(row0 + u * nwaves, NTOK + 1023);
      xr[u] = row < NTOKP ? p.in[0] + (size_t)row * 1024 : (row < NTOK ? p.in[1] + (size_t)(row - NTOKP) * 1024 : p.in[2] + (size_t)(row - NTOK) * 1024);
    }
#pragma unroll
    for (int u = 0; u < 4; ++u)
#pragma unroll
      for (int i = 0; i < 4; ++i) v[u][i] = reinterpret_cast<const float4*>(xr[u])[lane + 64 * i];
#pragma unroll
    for (int u = 0; u < 4; ++u) {
      const int row = row0 + u * nwaves;
      float ss = 0.f;
#pragma unroll
      for (int i = 0; i < 4; ++i) ss += v[u][i].x * v[u][i].x + v[u][i].y * v[u][i].y + v[u][i].z * v[u][i].z + v[u][i].w * v[u][i].w;
      ss = wsum(ss);
      if (row < NTOK + 1024) {
        u16* dst = row < NTOK ? p.xb + (size_t)row * 1024 : p.memb + (size_t)(row - NTOK) * 1024;
        float* rsd = row < NTOK ? p.rs0 + row : p.rsmem + (row - NTOK);
        if (lane == 0) *rsd = rsqrtf(ss * (1.f / 1024.f) + EPS);
#pragma unroll
        for (int i = 0; i < 4; ++i) { u32x2 w = {cvtpk(v[u][i].x, v[u][i].y), cvtpk(v[u][i].z, v[u][i].w)}; reinterpret_cast<u32x2*>(dst)[lane + 64 * i] = w; }
      }
    }
  }
  float km0 = 0.f, km1 = 0.f, km2 = 0.f;
  for (int i0 = gtid; i0 < 8 * PAST * 64; i0 += 4 * gsz) {
    float4 a[4], c[4];
#pragma unroll
    for (int u = 0; u < 4; ++u) {
      const int i = i0 + u * gsz;
      const int c8 = i & 63, pp = (i >> 6) & (PAST - 1), b = (i >> 17) & 7;
      const float4* sp = reinterpret_cast<const float4*>(p.in[5] + ((size_t)(b * PAST + pp) * 512 + c8 * 8));
      a[u] = sp[0]; c[u] = sp[1];
    }
#pragma unroll
    for (int u = 0; u < 4; ++u) {
      const int i = i0 + u * gsz;
      if (i < 8 * PAST * 64) {
        const int c8 = i & 63, pp = (i >> 6) & (PAST - 1), b = i >> 17;
        u32x4 w = {cvtpk(a[u].x, a[u].y), cvtpk(a[u].z, a[u].w), cvtpk(c[u].x, c[u].y), cvtpk(c[u].z, c[u].w)};
        *reinterpret_cast<u32x4*>(p.Ks + ((size_t)(b * SKP + pp) * 512 + c8 * 8)) = w;
        float ss = a[u].x * a[u].x + a[u].y * a[u].y + a[u].z * a[u].z + a[u].w * a[u].w + c[u].x * c[u].x + c[u].y * c[u].y + c[u].z * c[u].z + c[u].w * c[u].w;
        ss += __shfl_xor(ss, 1); ss += __shfl_xor(ss, 2); ss += __shfl_xor(ss, 4);
        km0 = fmaxf(km0, ss);
      }
    }
  }
  for (int i0 = gtid; i0 < 8 * 4 * 256 * 128; i0 += 2 * gsz) {
    float v[2][8];
#pragma unroll
    for (int u = 0; u < 2; ++u) {
      const int i = (i0 + u * gsz) & (8 * 4 * 256 * 128 - 1);
      const int dv = i & 127, p8 = (i >> 7) & 255, h = (i >> 15) & 3, b = i >> 17;
#pragma unroll
      for (int j = 0; j < 8; ++j) v[u][j] = p.in[6][((size_t)(b * PAST + p8 * 8 + j) * 4 + h) * 128 + dv];
    }
#pragma unroll
    for (int u = 0; u < 2; ++u) {
      const int i = i0 + u * gsz;
      if (i < 8 * 4 * 256 * 128) {
        const int dv = i & 127, p8 = (i >> 7) & 255, h = (i >> 15) & 3, b = i >> 17;
        u32x4 w = {cvtpk(v[u][0], v[u][1]), cvtpk(v[u][2], v[u][3]), cvtpk(v[u][4], v[u][5]), cvtpk(v[u][6], v[u][7])};
        *reinterpret_cast<u32x4*>(p.VsT + ((size_t)((b * 4 + h) * 128 + dv) * SKP + p8 * 8)) = w;
      }
    }
  }
  for (int i = gtid; i < 4096 * 4; i += gsz) {
    u32x4 z = {0, 0, 0, 0};
    *reinterpret_cast<u32x4*>(p.VsT + ((size_t)(i >> 2) * SKP + 2080 + (i & 3) * 8)) = z;
  }
  for (int i = gtid; i < 8 * 32 * 64; i += gsz) {
    u32x4 z = {0, 0, 0, 0};
    const int c8 = i & 63, r = (i >> 6) & 31, b = i >> 11;
    *reinterpret_cast<u32x4*>(p.Ks + ((size_t)(b * SKP + 2080 + r) * 512 + c8 * 8)) = z;
  }
  for (int i = gtid; i < 2 * 8 * 256 * 64; i += gsz) {
    const int c8 = i & 63, m = (i >> 6) & 255, b = (i >> 14) & 7, l = i >> 17;
    const float4* s = reinterpret_cast<const float4*>(p.in[3] + ((size_t)((l * 8 + b) * 256 + m) * 512 + c8 * 8));
    const float4 a = s[0], c = s[1];
    u32x4 w = {cvtpk(a.x, a.y), cvtpk(a.z, a.w), cvtpk(c.x, c.y), cvtpk(c.z, c.w)};
    *reinterpret_cast<u32x4*>(p.XK + ((size_t)((l * 12 + 4 + b) * 256 + m) * 512 + c8 * 8)) = w;
    float ss = a.x * a.x + a.y * a.y + a.z * a.z + a.w * a.w + c.x * c.x + c.y * c.y + c.z * c.z + c.w * c.w;
    ss += __shfl_xor(ss, 1); ss += __shfl_xor(ss, 2); ss += __shfl_xor(ss, 4); ss += __shfl_xor(ss, 8);
    if (l == 0) km1 = fmaxf(km1, ss); else km2 = fmaxf(km2, ss);
  }
  for (int i = gtid; i < 2 * 8 * 4 * 32 * 128; i += gsz) {
    const int dv = i & 127, m8 = (i >> 7) & 31, h = (i >> 12) & 3, b = (i >> 14) & 7, l = i >> 17;
    float v[8];
#pragma unroll
    for (int j = 0; j < 8; ++j) v[j] = p.in[4][((size_t)((l * 8 + b) * 256 + m8 * 8 + j) * 4 + h) * 128 + dv];
    u32x4 w = {cvtpk(v[0], v[1]), cvtpk(v[2], v[3]), cvtpk(v[4], v[5]), cvtpk(v[6], v[7])};
    *reinterpret_cast<u32x4*>(p.XVT + ((size_t)(((l * 12 + 4 + b) * 4 + h) * 128 + dv) * 256 + m8 * 8)) = w;
  }
  for (int i = gtid; i < 32 * 16 * 128; i += gsz) {
    const int e = i & 127, d8 = (i >> 7) & 15, bh = i >> 11;
    float v[8];
#pragma unroll
    for (int j = 0; j < 8; ++j) v[j] = p.in[7][((size_t)bh * 128 + d8 * 8 + j) * 128 + e];
    u32x4 w = {cvtpk(v[0], v[1]), cvtpk(v[2], v[3]), cvtpk(v[4], v[5]), cvtpk(v[6], v[7])};
    *reinterpret_cast<u32x4*>(p.C0sT + ((size_t)bh * 128 + e) * 128 + d8 * 8) = w;
  }
  for (int i = gtid; i < NTOK; i += gsz) p.ssq1[i] = 0.f;
  km0 = wmax(km0); km1 = wmax(km1); km2 = wmax(km2);
  if (lane == 0) {
    const int slot = blockIdx.x * 4 + (tid >> 6);
    p.kmaxp[slot] = km0; p.kmaxp[1024 + slot] = km1; p.kmaxp[2048 + slot] = km2;
  }
}

DEVI void gemm_core(LAS char* lds, const u16* A0, const u16* A1, const u16* A2, int lda0, int lda1, int lda2, int segK,
                    const u16* Bt, int K, int brow, int bcol, f32x4 (&acc)[4][4]) {
  const int tid = threadIdx.x, lane = tid & 63, wid = tid >> 6, wr = wid >> 1, wc = wid & 1, fr = lane & 15, fq = lane >> 4;
  LAS char* SA = lds; LAS char* SB = lds + 8192;
#pragma unroll
  for (int m = 0; m < 4; ++m)
#pragma unroll
    for (int n = 0; n < 4; ++n) acc[m][n] = f32x4{0.f, 0.f, 0.f, 0.f};
  const int nkt = K / 32;
  for (int kt = 0; kt < nkt; ++kt) {
    const int k0 = kt * 32;
    const int seg = k0 / segK;
    const u16* Ab = (seg == 0 ? A0 : (seg == 1 ? A1 : A2)) + (k0 - seg * segK);
    const int lda = (seg == 0 ? lda0 : (seg == 1 ? lda1 : lda2));
#pragma unroll
    for (int i = 0; i < 2; ++i) {
      const int b = tid * 16 + i * 4096, r = b >> 6, c = (b & 63) >> 1;
      glds16(Ab + (size_t)(brow + r) * lda + c, SA + b);
      glds16(Bt + (size_t)(bcol + r) * K + k0 + c, SB + b);
    }
    asm volatile("s_waitcnt vmcnt(0)" ::: "memory");
    __syncthreads();
    bf16x8 af[4], bfr[4];
#pragma unroll
    for (int m = 0; m < 4; ++m) af[m] = *reinterpret_cast<const LAS bf16x8*>(SA + (wr * 64 + m * 16 + fr) * 64 + fq * 16);
#pragma unroll
    for (int n = 0; n < 4; ++n) bfr[n] = *reinterpret_cast<const LAS bf16x8*>(SB + (wc * 64 + n * 16 + fr) * 64 + fq * 16);
#pragma unroll
    for (int m = 0; m < 4; ++m)
#pragma unroll
      for (int n = 0; n < 4; ++n) acc[m][n] = __builtin_amdgcn_mfma_f32_16x16x32_bf16(af[m], bfr[n], acc[m][n], 0, 0, 0);
    __syncthreads();
  }
}

DEVI void gemm_stage_c(LAS char* lds, const f32x4 (&acc)[4][4], const float* rowscale, int mode, int brow) {
  const int tid = threadIdx.x, lane = tid & 63, wid = tid >> 6, wr = wid >> 1, wc = wid & 1, fr = lane & 15, fq = lane >> 4;
  LAS float* Cs = (LAS float*)lds;
#pragma unroll
  for (int m = 0; m < 4; ++m)
#pragma unroll
    for (int j = 0; j < 4; ++j) {
      const int r = wr * 64 + m * 16 + fq * 4 + j;
      float s = 1.f;
      if (mode == 1) s = rowscale[brow + r];
      else if (mode == 2) s = rsqrtf(rowscale[brow + r] * (1.f / 1024.f) + EPS);
#pragma unroll
      for (int n = 0; n < 4; ++n) Cs[r * 132 + wc * 64 + n * 16 + fr] = acc[m][n][j] * s;
    }
  __syncthreads();
}

DEVI void st_bf8(u16* dst, const float (&v)[8]) {
  u32x4 w = {cvtpk(v[0], v[1]), cvtpk(v[2], v[3]), cvtpk(v[4], v[5]), cvtpk(v[6], v[7])};
  *reinterpret_cast<u32x4*>(dst) = w;
}
DEVI void st_f8(float* dst, const float (&v)[8]) {
  reinterpret_cast<float4*>(dst)[0] = float4{v[0], v[1], v[2], v[3]};
  reinterpret_cast<float4*>(dst)[1] = float4{v[4], v[5], v[6], v[7]};
}
DEVI void store_transposed(LAS char* lds, u16* dst, size_t ldt, float scale) {
  const LAS float* Cs = (const LAS float*)lds;
  const int c = threadIdx.x & 127, rh = (threadIdx.x >> 7) * 64;
#pragma unroll
  for (int it = 0; it < 8; ++it) {
    const int r0 = rh + it * 8;
    float v[8];
#pragma unroll
    for (int j = 0; j < 8; ++j) v[j] = Cs[(r0 + j) * 132 + c] * scale;
    st_bf8(dst + (size_t)c * ldt + r0, v);
  }
}

DEVI void epi_in_a(const Params& p, LAS char* lds, int brow, int n) {
  const LAS float* Cs = (const LAS float*)lds;
  const int tid = threadIdx.x, cgp = tid & 15, c0 = cgp * 8;
  const bool samp = brow >= NTOKP;
  const int seg = n >> 2, hd = n & 3;
  if (n >= 4 && n < 12) {
    u16* base = (n < 8 ? p.KaT : p.VaT);
    const float sc = (n < 8 ? 0.08838834764831845f : 1.f);
    if (!samp) { const int b = brow >> 13, t0 = brow & 8191; store_transposed(lds, base + ((size_t)(b * 4 + hd) * 128) * SEQ + t0, SEQ, sc); }
    else {
      const int c = tid & 127, rh = (tid >> 7) * 64;
#pragma unroll
      for (int it = 0; it < 8; ++it) {
        const int r0 = rh + it * 8; const int bs = ((brow - NTOKP) + r0) >> 5, t0 = r0 & 31;
        float v[8];
#pragma unroll
        for (int j = 0; j < 8; ++j) v[j] = Cs[(r0 + j) * 132 + c] * sc;
        st_bf8(base + (size_t)NTOKP * 512 + ((size_t)(bs * 4 + hd) * 128 + c) * 32 + t0, v);
      }
    }
  }
  if (seg == 7) {
    if (!samp) { const int b = brow >> 13, t0 = brow & 8191; store_transposed(lds, p.VbT + ((size_t)(b * 4 + hd) * 128) * SEQ + t0, SEQ, 1.f); }
    else {
      const int c = tid & 127, rh = (tid >> 7) * 64;
#pragma unroll
      for (int it = 0; it < 8; ++it) {
        const int r0 = rh + it * 8; const int bs = ((brow - NTOKP) + r0) >> 5, t0 = r0 & 31;
        float v[8];
#pragma unroll
        for (int j = 0; j < 8; ++j) v[j] = Cs[(r0 + j) * 132 + c];
        st_bf8(p.VsT + ((size_t)(bs * 4 + hd) * 128 + c) * SKP + PAST + t0, v);
      }
    }
  }
  float gn[8];
  {
    const float* gp = nullptr;
    if (n >= 20 && n < 24) gp = p.in[16] + (c0 & 63);
    else if (n >= 24 && n < 28) gp = p.in[17] + (c0 & 63);
    else if (n >= 36 && n < 40) gp = p.in[32] + c0;
    else if (n == 44) gp = (cgp == 0) ? nullptr : nullptr;
#pragma unroll
    for (int j = 0; j < 8; ++j) gn[j] = gp ? gp[j] : 0.f;
    if (n == 44) {
#pragma unroll
      for (int j = 0; j < 4; ++j) { gn[j] = p.in[13][j]; gn[4 + j] = p.in[14][j]; }
    }
  }
#pragma unroll 1
  for (int it = 0; it < 8; ++it) {
    const int r = it * 16 + (tid >> 4);
    const size_t grow = (size_t)brow + r;
    float v[8];
#pragma unroll
    for (int j = 0; j < 8; ++j) v[j] = Cs[r * 132 + c0 + j];
    if (n < 4) { st_bf8(p.Qa + grow * 512 + hd * 128 + c0, v); }
    else if (n < 8) {
#pragma unroll
      for (int j = 0; j < 8; ++j) v[j] *= 0.08838834764831845f;
      st_bf8(p.Ka + grow * 512 + hd * 128 + c0, v);
    }
    else if (n < 12) {   }
    else if (n < 20) {
      if (cgp < 8) {
        float g[8];
#pragma unroll
        for (int j = 0; j < 8; ++j) g[j] = sigmoidf_(v[j]) * siluf_(Cs[r * 132 + 64 + c0 + j]);
        st_bf8(p.Ga + grow * 512 + (n - 12) * 64 + c0, g);
      }
    }
    else if (n < 28) {
      float ss = 0.f;
#pragma unroll
      for (int j = 0; j < 8; ++j) ss += v[j] * v[j];
      ss += __shfl_xor(ss, 1); ss += __shfl_xor(ss, 2); ss += __shfl_xor(ss, 4);
      const float rs = rsqrtf(ss * (1.f / 64.f) + EPS);
      const float* g = gn;
      if (n < 24) {
#pragma unroll
        for (int j = 0; j < 8; ++j) v[j] = v[j] * rs * g[j] * (0.125f * LOG2E);
        st_bf8(p.Qb + grow * 512 + hd * 128 + c0, v);
      } else {
#pragma unroll
        for (int j = 0; j < 8; ++j) v[j] = v[j] * rs * g[j];
        if (!samp) { st_f8(p.out + O_PK + grow * 512 + hd * 128 + c0, v); st_bf8(p.Kb + grow * 512 + hd * 128 + c0, v); }
        else {
          const int sr = (int)grow - NTOKP, bs = sr >> 5, t = sr & 31;
          st_f8(p.out + O_SK + (size_t)sr * 512 + hd * 128 + c0, v);
          st_bf8(p.Ks + ((size_t)(bs * SKP + PAST + t)) * 512 + hd * 128 + c0, v);
        }
      }
    }
    else if (n < 32) {
      if (!samp) st_f8(p.out + O_PV + grow * 512 + hd * 128 + c0, v);
      else st_f8(p.out + O_SV + (size_t)((int)grow - NTOKP) * 512 + hd * 128 + c0, v);
    }
    else if (n < 36) {
#pragma unroll
      for (int j = 0; j < 8; ++j) v[j] = siluf_(v[j]);
      st_bf8(p.Gb + grow * 512 + hd * 128 + c0, v);
    }
    else if (n < 40) {
      float ss = 0.f;
#pragma unroll
      for (int j = 0; j < 8; ++j) ss += v[j] * v[j];
      ss += __shfl_xor(ss, 1); ss += __shfl_xor(ss, 2); ss += __shfl_xor(ss, 4); ss += __shfl_xor(ss, 8);
      const float rs = rsqrtf(ss * (1.f / 128.f) + EPS);
      const float* g = gn;
#pragma unroll
      for (int j = 0; j < 8; ++j) v[j] = v[j] * rs * g[j] * (0.08838834764831845f * LOG2E);
      st_bf8(p.Qx + grow * 512 + hd * 128 + c0, v);
    }
    else if (n < 44) {
#pragma unroll
      for (int j = 0; j < 8; ++j) v[j] = siluf_(v[j]);
      st_bf8(p.Gx + grow * 512 + hd * 128 + c0, v);
    }
    else {
      if (cgp == 0) {
        float g[8];
#pragma unroll
        for (int j = 0; j < 4; ++j) { g[j] = v[j] + gn[j]; g[4 + j] = logsigmoidf_(v[4 + j] + gn[4 + j]); }
        st_f8(p.gates + grow * 8, g);
      }
    }
  }
}

DEVI void epi_mem(const Params& p, LAS char* lds, int l, int brow, int n) {
  const LAS float* Cs = (const LAS float*)lds;
  const int tid = threadIdx.x, cgp = tid & 15, c0 = cgp * 8;
  const int hd = n & 3;
  if (n >= 4) {
    const int b = brow >> 8, m0 = brow & 255;
    store_transposed(lds, p.XVT + ((size_t)((l * 12 + b) * 4 + hd) * 128) * 256 + m0, 256, 1.f);
  }
  float gk[8];
#pragma unroll
  for (int j = 0; j < 8; ++j) gk[j] = p.in[33][l * 128 + c0 + j];
#pragma unroll 1
  for (int it = 0; it < 8; ++it) {
    const int r = it * 16 + (tid >> 4);
    const size_t grow = (size_t)brow + r;
    float v[8];
#pragma unroll
    for (int j = 0; j < 8; ++j) v[j] = Cs[r * 132 + c0 + j];
    if (n < 4) {
      float ss = 0.f;
#pragma unroll
      for (int j = 0; j < 8; ++j) ss += v[j] * v[j];
      ss += __shfl_xor(ss, 1); ss += __shfl_xor(ss, 2); ss += __shfl_xor(ss, 4); ss += __shfl_xor(ss, 8);
      const float rs = rsqrtf(ss * (1.f / 128.f) + EPS);
      const float* g = gk;
#pragma unroll
      for (int j = 0; j < 8; ++j) v[j] = v[j] * rs * g[j];
      st_f8(p.out + O_PXK + ((size_t)l * 1024 + grow) * 512 + hd * 128 + c0, v);
      const int b = (int)grow >> 8, m = (int)grow & 255;
      st_bf8(p.XK + ((size_t)((l * 12 + b) * 256 + m)) * 512 + hd * 128 + c0, v);
    } else {
      st_f8(p.out + O_PXV + ((size_t)l * 1024 + grow) * 512 + hd * 128 + c0, v);
    }
  }
}

DEVI void load_resid(const Params& p, int layer, int brow, int n, float4 (&ra)[8], float4 (&rb)[8]) {
  const int tid = threadIdx.x, c0 = (tid & 15) * 8;
#pragma unroll
  for (int it = 0; it < 8; ++it) {
    const size_t grow = (size_t)brow + it * 16 + (tid >> 4);
    const float* res;
    if (layer == 0) res = (grow < NTOKP ? p.in[0] + grow * 1024 : p.in[1] + (grow - NTOKP) * 1024) + n * 128 + c0;
    else res = p.out + grow * 1024 + n * 128 + c0;
    ra[it] = reinterpret_cast<const float4*>(res)[0]; rb[it] = reinterpret_cast<const float4*>(res)[1];
  }
}
DEVI void epi_out(const Params& p, LAS char* lds, int layer, int brow, int n, const float4 (&ra)[8], const float4 (&rb)[8]) {
  const LAS float* Cs = (const LAS float*)lds;
  const int tid = threadIdx.x, cgp = tid & 15, c0 = cgp * 8;
#pragma unroll
  for (int q = 0; q < 8; ++q) {
    const int r = q * 16 + (tid >> 4);
    const size_t grow = (size_t)brow + r;
    float v[8];
#pragma unroll
    for (int j = 0; j < 8; ++j) v[j] = Cs[r * 132 + c0 + j];
    v[0] += ra[q].x; v[1] += ra[q].y; v[2] += ra[q].z; v[3] += ra[q].w; v[4] += rb[q].x; v[5] += rb[q].y; v[6] += rb[q].z; v[7] += rb[q].w;
    st_f8(p.out + grow * 1024 + n * 128 + c0, v);
    if (layer == 0) {
      st_bf8(p.xb + grow * 1024 + n * 128 + c0, v);
      float ss = 0.f;
#pragma unroll
      for (int j = 0; j < 8; ++j) ss += v[j] * v[j];
      ss += __shfl_xor(ss, 1); ss += __shfl_xor(ss, 2); ss += __shfl_xor(ss, 4); ss += __shfl_xor(ss, 8);
      if (cgp == 0) atomicAdd(p.ssq1 + grow, ss);
    }
  }
}

DEVI void epi_in_c(const Params& p, LAS char* lds, int brow, int n) {
  const LAS float* Cs = (const LAS float*)lds;
  const int tid = threadIdx.x, cgp = tid & 15, c0 = cgp * 8;
  u16* U = p.Qa;
  u16* Gc = p.KaT;
  float gx[8];
#pragma unroll
  for (int j = 0; j < 8; ++j) gx[j] = p.in[32][128 + c0 + j];
#pragma unroll 1
  for (int it = 0; it < 8; ++it) {
    const int r = it * 16 + (tid >> 4);
    const size_t grow = (size_t)brow + r;
    float v[8];
#pragma unroll
    for (int j = 0; j < 8; ++j) v[j] = Cs[r * 132 + c0 + j];
    if (n < 16) {
      if (cgp < 8) {
        float u[8];
#pragma unroll
        for (int j = 0; j < 8; ++j) u[j] = v[j] * sigmoidf_(Cs[r * 132 + 64 + c0 + j]);
        st_bf8(U + grow * 1024 + n * 64 + c0, u);
        if (grow < NTOKP) { const int t = (int)grow & 8191, b = (int)grow >> 13; if (t >= SEQ - 30) st_f8(p.out + O_PCONV + ((size_t)(b * 30 + t - (SEQ - 30))) * 1024 + n * 64 + c0, u); }
        else { const int sr = (int)grow - NTOKP, t = sr & 31, b = sr >> 5; if (t >= 2) st_f8(p.out + O_SCONV + ((size_t)(b * 30 + t - 2)) * 1024 + n * 64 + c0, u); }
      }
    } else if (n < 24) {
#pragma unroll
      for (int j = 0; j < 8; ++j) v[j] = siluf_(v[j]);
      st_bf8(Gc + grow * 1024 + (n - 16) * 128 + c0, v);
    } else if (n < 28) {
      float ss = 0.f;
#pragma unroll
      for (int j = 0; j < 8; ++j) ss += v[j] * v[j];
      ss += __shfl_xor(ss, 1); ss += __shfl_xor(ss, 2); ss += __shfl_xor(ss, 4); ss += __shfl_xor(ss, 8);
      const float rs = rsqrtf(ss * (1.f / 128.f) + EPS);
      const float* g = gx;
#pragma unroll
      for (int j = 0; j < 8; ++j) v[j] = v[j] * rs * g[j] * (0.08838834764831845f * LOG2E);
      st_bf8(p.Qx + grow * 512 + (n - 24) * 128 + c0, v);
    } else {
#pragma unroll
      for (int j = 0; j < 8; ++j) v[j] = siluf_(v[j]);
      st_bf8(p.Gx + grow * 512 + (n - 28) * 128 + c0, v);
    }
  }
}

DEVI void gemm_core(LAS char* lds, const u16* A0, const u16* A1, const u16* A2, int lda0, int lda1, int lda2, int segK,
                    const u16* Bt, int K, int brow, int bcol, f32x16 (&acc)[4][2]) {
  const int tid = threadIdx.x, lane = tid & 63, w = tid >> 6, wr = w >> 1, wc = w & 1, r = lane & 31, h = lane >> 5;
#pragma unroll
  for (int i = 0; i < 4; ++i)
#pragma unroll
    for (int j = 0; j < 2; ++j)
#pragma unroll
      for (int e = 0; e < 16; ++e) acc[i][j][e] = 0.f;
  const int nkt = K / 64;
  auto stage = [=](int kt, int buf) __attribute__((always_inline)) {
    const int k0 = kt * 64;
    const int seg = k0 / segK;
    const u16* Ab = (seg == 0 ? A0 : (seg == 1 ? A1 : A2)) + (k0 - seg * segK);
    const int lda = (seg == 0 ? lda0 : (seg == 1 ? lda1 : lda2));
    LAS char* sa = lds + buf * 49152;
    LAS char* sb = sa + 32768;
#pragma unroll
    for (int i = 0; i < 8; ++i) {
      const int pch = i * 256 + tid, row = pch >> 3, lg = (pch & 7) ^ ((row >> 1) & 7);
      glds16(Ab + (size_t)(brow + row) * lda + lg * 8, sa + pch * 16);
    }
#pragma unroll
    for (int i = 0; i < 4; ++i) {
      const int pch = i * 256 + tid, row = pch >> 3, lg = (pch & 7) ^ ((row >> 1) & 7);
      glds16(Bt + (size_t)(bcol + row) * K + k0 + lg * 8, sb + pch * 16);
    }
  };
  lds_barrier();
  stage(0, 0);
  stage(1, 1);
  int buf = 0;
  for (int kt = 0; kt < nkt; ++kt) {
    if (kt + 1 < nkt) asm volatile("s_waitcnt vmcnt(12)" ::: "memory"); else asm volatile("s_waitcnt vmcnt(0)" ::: "memory");
    asm volatile("s_waitcnt lgkmcnt(0)" ::: "memory");
    __builtin_amdgcn_s_barrier();
    if (kt + 2 < nkt) { int nb = buf + 2; if (nb >= 3) nb -= 3; stage(kt + 2, nb); }
    const LAS char* sa = lds + buf * 49152;
    const LAS char* sb = sa + 32768;
    bf16x8 af[2][4], bfr[2][2];
#pragma unroll
    for (int i = 0; i < 4; ++i) {
      const int row = 32 * (2 * i + wr) + r, ch = h ^ ((row >> 1) & 7);
      af[0][i] = *reinterpret_cast<const LAS bf16x8*>(sa + row * 128 + ch * 16);
    }
#pragma unroll
    for (int j = 0; j < 2; ++j) {
      const int row = 32 * (2 * j + wc) + r, ch = h ^ ((row >> 1) & 7);
      bfr[0][j] = *reinterpret_cast<const LAS bf16x8*>(sb + row * 128 + ch * 16);
    }
#pragma unroll
    for (int ks = 0; ks < 4; ++ks) {
      const int cur = ks & 1, nxt = cur ^ 1;
      if (ks < 3) {
#pragma unroll
        for (int i = 0; i < 4; ++i) {
          const int row = 32 * (2 * i + wr) + r, ch = (2 * (ks + 1) + h) ^ ((row >> 1) & 7);
          af[nxt][i] = *reinterpret_cast<const LAS bf16x8*>(sa + row * 128 + ch * 16);
        }
#pragma unroll
        for (int j = 0; j < 2; ++j) {
          const int row = 32 * (2 * j + wc) + r, ch = (2 * (ks + 1) + h) ^ ((row >> 1) & 7);
          bfr[nxt][j] = *reinterpret_cast<const LAS bf16x8*>(sb + row * 128 + ch * 16);
        }
      }
#pragma unroll
      for (int i = 0; i < 4; ++i)
#pragma unroll
        for (int j = 0; j < 2; ++j) acc[i][j] = mfma32(af[cur][i], bfr[cur][j], acc[i][j]);
    }
    if (++buf == 3) buf = 0;
  }
}

DEVI void stage_all(LAS char* lds, const f32x16 (&acc)[4][2], bool scaled) {
  const int tid = threadIdx.x, lane = tid & 63, w = tid >> 6, wr = w >> 1, wc = w & 1, r = lane & 31, h = lane >> 5;
  const LAS float* RS = (const LAS float*)(lds + 135168);
#pragma unroll
  for (int i = 0; i < 4; ++i) {
    LAS float* Cs = (LAS float*)(lds + (i >> 1) * 67584);
#pragma unroll
    for (int e = 0; e < 16; ++e) {
      const int row = 32 * (2 * (i & 1) + wr) + crow(e, h);
      const float s = scaled ? RS[128 * (i >> 1) + row] : 1.f;
#pragma unroll
      for (int jj = 0; jj < 2; ++jj) Cs[row * 132 + 32 * (2 * jj + wc) + r] = acc[i][jj][e] * s;
    }
  }
}

DEVI void gemm_tile_run(const Params& p, LAS char* lds, int which, int aux, int mt, int n, f32x16 (&acc)[4][2]) {
  const int brow = mt * 256, bcol = n * 128;
  const float* rsc = nullptr; int mode = 0;
  if (which == 0) { gemm_core(lds, p.xb, p.xb, p.xb, 1024, 1024, 1024, 1024, p.WtInA, 1024, brow, bcol, acc); rsc = p.rs0; mode = 1; }
  else if (which == 1) gemm_core(lds, p.Ga, p.Gb, p.Gx, 512, 512, 512, 512, p.WtOutA, 1536, brow, bcol, acc);
  else if (which == 2) { gemm_core(lds, p.xb, p.xb, p.xb, 1024, 1024, 1024, 1024, p.WtInC, 1024, brow, bcol, acc); rsc = p.ssq1; mode = 2; }
  else if (which == 3) gemm_core(lds, p.KaT, p.KaT + 512, p.Gx, 1024, 1024, 512, 512, p.WtOutC, 1536, brow, bcol, acc);
  else { gemm_core(lds, p.memb, p.memb, p.memb, 1024, 1024, 1024, 1024, p.WtMem + (size_t)aux * 1024 * 1024, 1024, brow, bcol, acc); rsc = p.rsmem; mode = 1; }
  lds_barrier();
  if (mode) {
    float sc = rsc[brow + threadIdx.x];
    if (mode == 2) sc = rsqrtf(sc * (1.f / 1024.f) + EPS);
    ((LAS float*)(lds + 135168))[threadIdx.x] = sc;
    lds_barrier();
  }
  if (which == 1 || which == 3) {
    float4 ra0[8], rb0[8], ra1[8], rb1[8];
    load_resid(p, which == 1 ? 0 : 1, brow, n, ra0, rb0);
    load_resid(p, which == 1 ? 0 : 1, brow + 128, n, ra1, rb1);
    stage_all(lds, acc, false);
    lds_barrier();
    epi_out(p, lds, which == 1 ? 0 : 1, brow, n, ra0, rb0);
    epi_out(p, lds + 67584, which == 1 ? 0 : 1, brow + 128, n, ra1, rb1);
    return;
  }
  stage_all(lds, acc, mode != 0);
  lds_barrier();
#pragma unroll 1
  for (int sub = 0; sub < 2; ++sub) {
    LAS char* cs = lds + sub * 67584;
    const int sr = brow + 128 * sub;
    if (which == 0) epi_in_a(p, cs, sr, n);
    else if (which == 2) epi_in_c(p, cs, sr, n);
    else epi_mem(p, cs, aux, sr, n);
  }
}

template <int which>
DEVI void phase_gemm(const Params& p, LAS char* lds) {
  constexpr int nN = (which == 0 ? 45 : (which == 2 ? 32 : 8));
  constexpr int ntiles = 128 * nN;
  const int G = gridDim.x;
  const int xcd = blockIdx.x & 7, lb = blockIdx.x >> 3, slots = G >> 3;
  f32x16 acc[4][2];
  int round = 0, t_extra = blockIdx.x;
  bool main_done = false;
  for (;;) {
    int mt, n;
    if (!main_done) {
      const int q = lb + slots * round; ++round;
      const int L = 32 * (xcd + 8 * (q >> 5)) + (q & 31);
      if (L >= ntiles) { main_done = true; continue; }
      const int mg = L / (4 * nN), rem = L - mg * 4 * nN;
      n = rem >> 2; mt = mg * 4 + (rem & 3);
    } else {
      if (t_extra >= nN) break;
      mt = 128; n = t_extra; t_extra += G;
    }
    gemm_tile_run(p, lds, which, 0, mt, n, acc);
  }
  if (which == 0) {
    for (int t = G - 1 - (int)blockIdx.x; t < 64; t += G) gemm_tile_run(p, lds, 4, t >> 5, (t >> 3) & 3, t & 7, acc);
  }
}

template <bool DIFF>
DEVI void attn_block(LAS char* lds, const u16* Q, const u16* Kg, const u16* VT, int ldv, int j0, int ntiles, int nwact,
                           int qpos0, int nkeys, float slope2, float M2, float lam, const float* subg, u16* G) {
  const int tid = threadIdx.x, lane = tid & 63, w = tid >> 6, r = lane & 31, h = lane >> 5;
  const bool act = w < nwact;
  const int qpos = qpos0 + 32 * w + r;
  const int cw = (qpos0 + 32 * w) >> 6;
  bf16x8 qf[8];
#pragma unroll
  for (int i = 0; i < 8; ++i) qf[i] = ldg8(Q + (size_t)(32 * w + r) * 512 + 16 * i + 8 * h);
  f32x16 O0[4], O1[4];
#pragma unroll
  for (int e = 0; e < 4; ++e)
#pragma unroll
    for (int i = 0; i < 16; ++i) { O0[e][i] = 0.f; O1[e][i] = 0.f; }
  float l0 = 0.f, l1 = 0.f;
  f32x16 cinit, zero16;
#pragma unroll
  for (int i = 0; i < 16; ++i) { cinit[i] = slope2 * (float)klocal(i, h); zero16[i] = 0.f; }
  const float tq = -slope2 * (float)qpos - M2;
  const int prow = pi32(r);

  auto stage = [=](int j, int buf) __attribute__((always_inline)) {
    LAS char* kb = lds + buf * 32768;
#pragma unroll
    for (int i = 0; i < 4; ++i) {
      const int pch = i * 256 + tid;
      { const int row = pch >> 4, ph = pch & 15, lg = ph ^ (row & 15);
        glds16(Kg + (size_t)(j * 64 + row) * 512 + lg * 8, kb + pch * 16); }
      { const int row = pch >> 3, ph = pch & 7, lg = ph ^ ((row >> 1) & 7);
        glds16(VT + (size_t)row * ldv + j * 64 + lg * 8, kb + 16384 + pch * 16); }
    }
  };
  __syncthreads();
  stage(j0, 0);
  asm volatile("s_waitcnt vmcnt(0)" ::: "memory");
  __syncthreads();
  for (int j = j0; j < ntiles; ++j) {
    const int buf = (j - j0) & 1;
    if (j + 1 < ntiles) stage(j + 1, buf ^ 1);
    {
      const LAS char* kb = lds + buf * 32768;
      const LAS char* vb = kb + 16384;
      const bool fast = DIFF && (j < cw);
#pragma unroll
      for (int kt = 0; kt < 2; ++kt) {
        const int krow = 32 * kt + prow;
        const LAS char* krp = kb + krow * 256;
        bf16x8 P0[2], P1[2];
        if (DIFF) {
#pragma unroll
          for (int c = 0; c < 2; ++c) {
            f32x16 s;
            if (fast) {
              s = cinit;
#pragma unroll
              for (int ks = 0; ks < 4; ++ks) {
                const int ch = (2 * (4 * c + ks) + h) ^ (krow & 15);
                s = mfma32(*reinterpret_cast<const LAS bf16x8*>(krp + ch * 16), qf[4 * c + ks], s);
              }
              const float t = tq + slope2 * (float)(j * 64 + kt * 32);
#pragma unroll
              for (int i = 0; i < 16; ++i) s[i] = __builtin_amdgcn_exp2f(s[i] + t);
            } else {
              s = zero16;
#pragma unroll
              for (int ks = 0; ks < 4; ++ks) {
                const int ch = (2 * (4 * c + ks) + h) ^ (krow & 15);
                s = mfma32(*reinterpret_cast<const LAS bf16x8*>(krp + ch * 16), qf[4 * c + ks], s);
              }
#pragma unroll
              for (int i = 0; i < 16; ++i) {
                const int kp = j * 64 + kt * 32 + klocal(i, h);
                const float bias = -slope2 * fabsf((float)(qpos - kp)) - M2;
                s[i] = (kp < nkeys && j <= cw) ? __builtin_amdgcn_exp2f(s[i] + bias) : 0.f;
              }
            }
            float ls = 0.f;
#pragma unroll
            for (int i = 0; i < 16; ++i) ls += s[i];
            if (c == 0) { l0 += ls; P0[0] = pack8(s, 0); P0[1] = pack8(s, 1); }
            else        { l1 += ls; P1[0] = pack8(s, 0); P1[1] = pack8(s, 1); }
          }
        } else {
          f32x16 s = zero16;
#pragma unroll
          for (int ks = 0; ks < 8; ++ks) {
            const int ch = (2 * ks + h) ^ (krow & 15);
            s = mfma32(*reinterpret_cast<const LAS bf16x8*>(krp + ch * 16), qf[ks], s);
          }
          float ls = 0.f;
#pragma unroll
          for (int i = 0; i < 16; ++i) { s[i] = __builtin_amdgcn_exp2f(s[i] - M2); ls += s[i]; }
          l0 += ls; P0[0] = pack8(s, 0); P0[1] = pack8(s, 1);
        }
#pragma unroll
        for (int et = 0; et < 4; ++et) {
          const int vrow = 32 * et + r;
#pragma unroll
          for (int sp = 0; sp < 2; ++sp) {
            const int ch = (2 * (2 * kt + sp) + h) ^ ((vrow >> 1) & 7);
            const bf16x8 vf = *reinterpret_cast<const LAS bf16x8*>(vb + vrow * 128 + ch * 16);
            O0[et] = mfma32(vf, P0[sp], O0[et]);
            if (DIFF) O1[et] = mfma32(vf, P1[sp], O1[et]);
          }
        }
      }
    }
    asm volatile("s_waitcnt vmcnt(0)" ::: "memory");
    __syncthreads();
  }
  if (act) {
    l0 += __shfl_xor(l0, 32);
    const float i0 = 1.f / l0;
    float i1 = 0.f;
    if (DIFF) { l1 += __shfl_xor(l1, 32); i1 = lam / l1; }
    float ss = 0.f;
#pragma unroll
    for (int et = 0; et < 4; ++et)
#pragma unroll
      for (int i = 0; i < 16; ++i) {
        float o = O0[et][i] * i0;
        if (DIFF) o -= O1[et][i] * i1;
        O0[et][i] = o; ss += o * o;
      }
    float rs = 1.f;
    if (DIFF) { ss += __shfl_xor(ss, 32); rs = rsqrtf(ss * (1.f / 128.f) + EPS) * 0.8f; }
    u16* grow = G + (size_t)(32 * w + r) * 512;
    u32x2 gt[16]; float4 sv[16];
#pragma unroll
    for (int q = 0; q < 16; ++q) {
      const int e0 = 32 * (q >> 2) + 8 * (q & 3) + 4 * h;
      gt[q] = *reinterpret_cast<const u32x2*>(grow + e0);
      if (DIFF) sv[q] = *reinterpret_cast<const float4*>(subg + e0); else sv[q] = float4{1.f, 1.f, 1.f, 1.f};
    }
#pragma unroll
    for (int q = 0; q < 16; ++q) {
      const int et = q >> 2, g = q & 3;
      const int e0 = 32 * et + 8 * g + 4 * h;
      const float a0 = O0[et][4 * g + 0] * rs * sv[q].x * bflo(gt[q][0]);
      const float a1 = O0[et][4 * g + 1] * rs * sv[q].y * bfhi(gt[q][0]);
      const float a2 = O0[et][4 * g + 2] * rs * sv[q].z * bflo(gt[q][1]);
      const float a3 = O0[et][4 * g + 3] * rs * sv[q].w * bfhi(gt[q][1]);
      u32x2 o = {cvtpk(a0, a1), cvtpk(a2, a3)};
      *reinterpret_cast<u32x2*>(grow + e0) = o;
    }
  }
}

DEVI float max_abs64(const float* g, int n, int lane) { float v = 0.f; for (int i = lane; i < n; i += 64) v = fmaxf(v, fabsf(g[i])); return wmax(v); }

DEVI float scan_add(float v, int lane) { for (int o = 1; o < 64; o <<= 1) { const float t = __shfl_up(v, o); if (lane >= o) v += t; } return v; }
DEVI float scan_max(float v, int lane) { for (int o = 1; o < 64; o <<= 1) { const float t = __shfl_up(v, o); if (lane >= o) v = fmaxf(v, t); } return v; }
DEVI float bfe(const bf16x8& v, int j) { return __uint_as_float(((unsigned)(u16)v[j]) << 16); }

template <int NT>
DEVI void mlstm_local(LAS char* lds, const float* gates, int hd, const u16* KT, const u16* VT, int ldt,
                            f32x16 (&acc)[4], float& nh, float& bL, float& amax) {
  const int tid = threadIdx.x, lane = tid & 63, w = tid >> 6, r = lane & 31, h = lane >> 5;
  constexpr int L = 32 * NT;
  const float lf = lane < L ? gates[lane * 8 + 4 + hd] : 0.f;
  const float ig = lane < L ? gates[lane * 8 + hd] : -INFINITY;
  const float b = scan_add(lf, lane);
  const float a = ig - b;
  amax = wmax(a);
  bL = __shfl(b, L - 1);
  LAS float* wt = (LAS float*)(lds + 4096) + w * 64;
  wt[lane] = __expf(a - amax);
#pragma unroll
  for (int e = 0; e < 4; ++e)
#pragma unroll
    for (int i = 0; i < 16; ++i) acc[e][i] = 0.f;
  nh = 0.f;
#pragma unroll
  for (int ks = 0; ks < 2 * NT; ++ks) {
    const bf16x8 kf = ldg8(KT + (size_t)(32 * w + r) * ldt + 16 * ks + 8 * h);
    float wv[8];
#pragma unroll
    for (int j = 0; j < 8; ++j) { wv[j] = wt[16 * ks + 8 * h + j]; nh += bfe(kf, j) * wv[j]; }
#pragma unroll
    for (int et = 0; et < 4; ++et) {
      const bf16x8 vf = ldg8(VT + (size_t)(32 * et + r) * ldt + 16 * ks + 8 * h);
      u32x4 sv = {cvtpk(bfe(vf, 0) * wv[0], bfe(vf, 1) * wv[1]), cvtpk(bfe(vf, 2) * wv[2], bfe(vf, 3) * wv[3]),
                  cvtpk(bfe(vf, 4) * wv[4], bfe(vf, 5) * wv[5]), cvtpk(bfe(vf, 6) * wv[6], bfe(vf, 7) * wv[7])};
      acc[et] = mfma32(kf, *reinterpret_cast<bf16x8*>(&sv), acc[et]);
    }
  }
  nh += __shfl_xor(nh, 32);
}

template <int NT>
DEVI void mlstm_out(LAS char* lds, const float* gates, int hd, const u16* Qg, const u16* Kg, const u16* VT, int ldv,
                          const u16* CT, const float* n0, float m0, const float* mg, u16* G) {
  const int tid = threadIdx.x, lane = tid & 63, w = tid >> 6, r = lane & 31, h = lane >> 5;
  constexpr int L = 32 * NT;
  const float lf = lane < L ? gates[lane * 8 + 4 + hd] : 0.f;
  const float ig = lane < L ? gates[lane * 8 + hd] : -INFINITY;
  const float b = scan_add(lf, lane);
  const float a = ig - b;
  const float Mrow = fmaxf(m0, scan_max(a, lane));
  const float mt = b + Mrow;
  LAS float* at = (LAS float*)lds + w * 64;
  LAS float* red = (LAS float*)(lds + 1024);
  at[lane] = a;
  const int prow = pi32(r);
#pragma unroll 1
  for (int tt = 0; tt < NT; ++tt) {
    const int t = 32 * tt + r;
    const float Mrow_t = __shfl(Mrow, t), mt_t = __shfl(mt, t);
    const float winter = __expf(m0 - Mrow_t);
    bf16x8 qf[8];
    float qn = 0.f;
#pragma unroll
    for (int i = 0; i < 8; ++i) {
      qf[i] = ldg8(Qg + (size_t)t * 512 + 16 * i + 8 * h);
      const float4 na = *reinterpret_cast<const float4*>(n0 + 16 * i + 8 * h), nb = *reinterpret_cast<const float4*>(n0 + 16 * i + 8 * h + 4);
      qn += bfe(qf[i], 0) * na.x + bfe(qf[i], 1) * na.y + bfe(qf[i], 2) * na.z + bfe(qf[i], 3) * na.w
          + bfe(qf[i], 4) * nb.x + bfe(qf[i], 5) * nb.y + bfe(qf[i], 6) * nb.z + bfe(qf[i], 7) * nb.w;
    }
    qn += __shfl_xor(qn, 32);
    f32x16 H;
#pragma unroll
    for (int i = 0; i < 16; ++i) H[i] = 0.f;
#pragma unroll
    for (int ks = 0; ks < 8; ++ks) H = mfma32(ldg8(CT + (size_t)(32 * w + r) * 128 + 16 * ks + 8 * h), qf[ks], H);
#pragma unroll
    for (int i = 0; i < 16; ++i) H[i] *= winter;
    float dsum = 0.f;
    for (int st = 0; st <= tt; ++st) {
      f32x16 S;
#pragma unroll
      for (int i = 0; i < 16; ++i) S[i] = 0.f;
#pragma unroll
      for (int ks = 0; ks < 8; ++ks) S = mfma32(ldg8(Kg + (size_t)(32 * st + prow) * 512 + 16 * ks + 8 * h), qf[ks], S);
#pragma unroll
      for (int i = 0; i < 16; ++i) {
        const int s = 32 * st + klocal(i, h);
        const float wg = (s <= t) ? __expf(at[s] - Mrow_t) : 0.f;
        S[i] *= wg; dsum += S[i];
      }
#pragma unroll
      for (int sp = 0; sp < 2; ++sp)
        H = mfma32(ldg8(VT + (size_t)(32 * w + r) * ldv + 32 * st + 16 * sp + 8 * h), pack8(S, sp), H);
    }
    dsum += __shfl_xor(dsum, 32);
    const float den = winter * qn + dsum;
    const float inv = 1.f / fmaxf(fabsf(den), __expf(-mt_t));
    float ss = 0.f;
#pragma unroll
    for (int i = 0; i < 16; ++i) { H[i] *= inv; ss += H[i] * H[i]; }
    ss += __shfl_xor(ss, 32);
    if (h == 0) red[w * 64 + t] = ss;
    __syncthreads();
    const float tot = red[t] + red[64 + t] + red[128 + t] + red[192 + t];
    const float rs = rsqrtf(tot * (1.f / 128.f) + EPS);
    u16* grow = G + (size_t)t * 512;
    u32x2 gt[4]; float4 mv[4];
#pragma unroll
    for (int g = 0; g < 4; ++g) {
      const int e0 = 32 * w + 8 * g + 4 * h;
      gt[g] = *reinterpret_cast<const u32x2*>(grow + e0);
      mv[g] = *reinterpret_cast<const float4*>(mg + e0);
    }
#pragma unroll
    for (int g = 0; g < 4; ++g) {
      const int e0 = 32 * w + 8 * g + 4 * h;
      u32x2 o = {cvtpk(H[4 * g + 0] * rs * mv[g].x * bflo(gt[g][0]), H[4 * g + 1] * rs * mv[g].y * bfhi(gt[g][0])),
                 cvtpk(H[4 * g + 2] * rs * mv[g].z * bflo(gt[g][1]), H[4 * g + 3] * rs * mv[g].w * bfhi(gt[g][1]))};
      *reinterpret_cast<u32x2*>(grow + e0) = o;
    }
    __syncthreads();
  }
}

DEVI void m1_item(const Params& p, LAS char* lds, int item) {
  const int tid = threadIdx.x, lane = tid & 63, w = tid >> 6, r = lane & 31, h = lane >> 5;
  const int bh = item >> 7, c = item & 127, b = bh >> 2, hd = bh & 3;
  const size_t row0 = (size_t)b * SEQ + c * 64;
  f32x16 acc[4]; float nh, bL, amax;
  __syncthreads();
  mlstm_local<2>(lds, p.gates + row0 * 8, hd, p.KaT + (size_t)bh * 128 * SEQ + c * 64, p.VaT + (size_t)bh * 128 * SEQ + c * 64, SEQ, acc, nh, bL, amax);
  u16* Chat = p.xb + ((size_t)item * 128) * 128;
#pragma unroll
  for (int et = 0; et < 4; ++et)
#pragma unroll
    for (int g = 0; g < 4; ++g) {
      const int d0 = 32 * w + 8 * g + 4 * h, e = 32 * et + r;
      u32x2 o = {cvtpk(acc[et][4 * g], acc[et][4 * g + 1]), cvtpk(acc[et][4 * g + 2], acc[et][4 * g + 3])};
      *reinterpret_cast<u32x2*>(Chat + (size_t)e * 128 + d0) = o;
    }
  if (h == 0) p.nhat[(size_t)item * 128 + 32 * w + r] = nh;
  if (tid == 0) { p.tabA[item] = bL; p.tabB[item] = bL + amax; }
}

DEVI void phase_scan(const Params& p, LAS char* lds) {
  const int tid = threadIdx.x, lane = tid & 63;
  LAS float* al = (LAS float*)lds; LAS float* be = al + 128; LAS float* ms = al + 256;
  for (int u = blockIdx.x; u < 16 * 32; u += gridDim.x) {
    const int bh = u >> 5, part = u & 31;
    __syncthreads();
    if (tid < 64) {
      const float A0 = p.tabA[bh * 128 + 2 * lane], A1 = p.tabA[bh * 128 + 2 * lane + 1];
      const float B0 = p.tabB[bh * 128 + 2 * lane], B1 = p.tabB[bh * 128 + 2 * lane + 1];
      const float SAi = scan_add(A0 + A1, lane);
      const float SA0 = SAi - A1, SA1 = SAi;
      const float D0 = B0 - SA0, D1 = B1 - SA1;
      const float PMi = scan_max(fmaxf(D0, D1), lane);
      float PMx = __shfl_up(PMi, 1); if (lane == 0) PMx = -INFINITY;
      const float mn0 = SA0 + fmaxf(0.f, fmaxf(PMx, D0));
      const float mn1 = SA1 + fmaxf(0.f, PMi);
      float mprev = __shfl_up(mn1, 1); if (lane == 0) mprev = 0.f;
      al[2 * lane] = __expf(A0 + mprev - mn0); be[2 * lane] = __expf(B0 - mn0);
      al[2 * lane + 1] = __expf(A1 + mn0 - mn1); be[2 * lane + 1] = __expf(B1 - mn1);
      ms[2 * lane] = mprev; ms[2 * lane + 1] = mn0;
      if (lane == 63) ms[128] = mn1;
    }
    __syncthreads();
    if (part == 0) {
      if (tid < 129) p.mtab[bh * 129 + tid] = ms[tid];
      if (tid == 0) p.out[O_PM + bh] = ms[128];
    }
    u16* base = p.xb + (size_t)bh * 128 * 16384 + part * 512 + tid * 2;
    float c0 = 0.f, c1 = 0.f;
    for (int c = 0; c < 128; c += 8) {
      unsigned v[8];
#pragma unroll
      for (int j = 0; j < 8; ++j) v[j] = *reinterpret_cast<const unsigned*>(base + (size_t)(c + j) * 16384);
#pragma unroll
      for (int j = 0; j < 8; ++j) {
        *reinterpret_cast<unsigned*>(base + (size_t)(c + j) * 16384) = cvtpk(c0, c1);
        const float a_ = al[c + j], b_ = be[c + j];
        c0 = a_ * c0 + b_ * bflo(v[j]); c1 = a_ * c1 + b_ * bfhi(v[j]);
      }
    }
    { const int idx = part * 512 + tid * 2, e = idx >> 7, d = idx & 127;
      p.out[O_PC + ((size_t)bh * 128 + d) * 128 + e] = c0;
      p.out[O_PC + ((size_t)bh * 128 + d + 1) * 128 + e] = c1; }
    if (part == 0 && tid < 128) {
      float n = 0.f;
      for (int c = 0; c < 128; c += 16) {
        float nv[16];
#pragma unroll
        for (int j = 0; j < 16; ++j) nv[j] = p.nhat[((size_t)bh * 128 + c + j) * 128 + tid];
#pragma unroll
        for (int j = 0; j < 16; ++j) {
          p.nstate[((size_t)bh * 128 + c + j) * 128 + tid] = n;
          n = al[c + j] * n + be[c + j] * nv[j];
        }
      }
      p.out[O_PN + bh * 128 + tid] = n;
    }
  }
}

DEVI void m3_item(const Params& p, LAS char* lds, int item) {
  const int bh = item >> 7, c = item & 127, b = bh >> 2, hd = bh & 3;
  const size_t row0 = (size_t)b * SEQ + c * 64;
  __syncthreads();
  mlstm_out<2>(lds, p.gates + row0 * 8, hd, p.Qa + row0 * 512 + hd * 128, p.Ka + row0 * 512 + hd * 128,
               p.VaT + (size_t)bh * 128 * SEQ + c * 64, SEQ, p.xb + (size_t)item * 16384, p.nstate + (size_t)item * 128,
               p.mtab[bh * 129 + c], p.in[15] + hd * 128, p.Ga + row0 * 512 + hd * 128);
}

DEVI void ms_item(const Params& p, LAS char* lds, int bh) {
  const int tid = threadIdx.x, lane = tid & 63, w = tid >> 6, r = lane & 31, h = lane >> 5;
  const int b = bh >> 2, hd = bh & 3;
  const size_t row0 = (size_t)NTOKP + b * 32;
  const float m0 = p.in[9][bh];
  const float* n0 = p.in[8] + bh * 128;
  const u16* KTs = p.KaT + (size_t)NTOKP * 512 + (size_t)bh * 128 * 32;
  const u16* VTs = p.VaT + (size_t)NTOKP * 512 + (size_t)bh * 128 * 32;
  __syncthreads();
  mlstm_out<1>(lds, p.gates + row0 * 8, hd, p.Qa + row0 * 512 + hd * 128, p.Ka + row0 * 512 + hd * 128, VTs, 32,
               p.C0sT + (size_t)bh * 16384, n0, m0, p.in[15] + hd * 128, p.Ga + row0 * 512 + hd * 128);
  f32x16 acc[4]; float nh, bL, amax;
  mlstm_local<1>(lds, p.gates + row0 * 8, hd, KTs, VTs, 32, acc, nh, bL, amax);
  const float mlast = bL + fmaxf(m0, amax);
  const float decay = __expf(bL + m0 - mlast), beta = __expf(bL + amax - mlast);
#pragma unroll
  for (int et = 0; et < 4; ++et)
#pragma unroll
    for (int i = 0; i < 16; ++i) {
      const int d = 32 * w + crow(i, h), e = 32 * et + r;
      const size_t o = ((size_t)bh * 128 + d) * 128 + e;
      p.out[O_SC + o] = decay * p.in[7][o] + beta * acc[et][i];
    }
  if (h == 0) { const int d = 32 * w + r; p.out[O_SN + bh * 128 + d] = decay * n0[d] + beta * nh; }
  if (tid == 0) p.out[O_SM + bh] = mlast;
}

DEVI void phase_conv(const Params& p, LAS char* lds) {
  const int tid = threadIdx.x, lane = tid & 63, w = tid >> 6;
  const u16* U = p.Qa; u16* Gc = p.KaT;
  LAS u16* win = (LAS u16*)lds;
  LAS float* cs = (LAS float*)(lds + 40960);
  LAS float* st = (LAS float*)(lds + 40960 + 32768);
  float cw[4][31], cb[4], lg[4], lb[4];
#pragma unroll
  for (int c = 0; c < 4; ++c) {
    const int chn = c * 256 + tid;
#pragma unroll
    for (int j = 0; j < 31; ++j) cw[c][j] = p.in[25][j * 1024 + chn];
    cb[c] = p.in[26][chn]; lg[c] = p.in[27][chn]; lb[c] = p.in[28][chn];
  }
  const int ntile = NTOK / 8;
  auto fetch = [=](int tile, int cgp, u32x4 (&rg)[5]) __attribute__((always_inline)) {
    const int row0 = tile * 8;
    const bool samp = row0 >= NTOKP;
    const int t0 = samp ? ((row0 - NTOKP) & 31) : (row0 & 8191);
    const int bs = samp ? ((row0 - NTOKP) >> 5) : 0;
    const int seqbase = row0 - t0;
#pragma unroll
    for (int q = 0; q < 5; ++q) {
      const int pch = tid + 256 * q, rr = pch >> 5, ch = pch & 31, t = t0 - 30 + rr;
      u32x4 v = {0, 0, 0, 0};
      if (pch < 38 * 32) {
        if (t >= 0) v = *reinterpret_cast<const u32x4*>(U + (size_t)(seqbase + t) * 1024 + cgp * 256 + ch * 8);
        else if (samp) {
          const float4* sc = reinterpret_cast<const float4*>(p.in[10] + ((size_t)(bs * 30 + 30 + t)) * 1024 + cgp * 256 + ch * 8);
          const float4 a = sc[0], c = sc[1];
          v = u32x4{cvtpk(a.x, a.y), cvtpk(a.z, a.w), cvtpk(c.x, c.y), cvtpk(c.z, c.w)};
        }
      }
      rg[q] = v;
    }
  };
  auto commit = [=](int buf, const u32x4 (&rg)[5]) __attribute__((always_inline)) {
#pragma unroll
    for (int q = 0; q < 5; ++q) {
      const int pch = tid + 256 * q;
      if (pch < 38 * 32) *reinterpret_cast<LAS u32x4*>(win + buf * (38 * 256) + (pch >> 5) * 256 + (pch & 31) * 8) = rg[q];
    }
  };
  int tile = blockIdx.x;
  if (tile >= ntile) return;
  u32x4 rg[5];
  __syncthreads();
  fetch(tile, 0, rg);
  commit(0, rg);
  __syncthreads();
  for (; tile < ntile; tile += gridDim.x) {
    const int row0 = tile * 8;
    const int ntl = tile + gridDim.x;
#pragma unroll
    for (int cgp = 0; cgp < 4; ++cgp) {
      const bool more = (cgp < 3) || (ntl < ntile);
      if (more) fetch(cgp < 3 ? tile : ntl, cgp < 3 ? cgp + 1 : 0, rg);
      const LAS u16* wb = win + (cgp & 1) * (38 * 256);
      float wv[38];
#pragma unroll
      for (int rr = 0; rr < 38; ++rr) wv[rr] = bf2f(wb[rr * 256 + tid]);
#pragma unroll
      for (int i = 0; i < 8; ++i) {
        float a = cb[cgp];
#pragma unroll
        for (int j = 0; j < 31; ++j) a += cw[cgp][j] * wv[i + j];
        cs[i * 1024 + cgp * 256 + tid] = a;
      }
      if (more) commit((cgp + 1) & 1, rg);
      __syncthreads();
    }
    u16 gv[4][8];
#pragma unroll
    for (int c = 0; c < 4; ++c)
#pragma unroll
      for (int i = 0; i < 8; ++i) gv[c][i] = Gc[(size_t)(row0 + i) * 1024 + c * 256 + tid];
#pragma unroll
    for (int q = 0; q < 2; ++q) {
      const int i = 2 * w + q;
      float a1 = 0.f, a2 = 0.f;
#pragma unroll
      for (int k = 0; k < 16; ++k) { const float v = cs[i * 1024 + lane + 64 * k]; a1 += v; a2 += v * v; }
      a1 = wsum(a1); a2 = wsum(a2);
      if (lane == 0) {
        const float mu = a1 * (1.f / 1024.f);
        const float var = fmaxf(a2 * (1.f / 1024.f) - mu * mu, 0.f);
        st[2 * i] = mu; st[2 * i + 1] = rsqrtf(var + EPS);
      }
    }
    __syncthreads();
#pragma unroll
    for (int c = 0; c < 4; ++c) {
      const int chn = c * 256 + tid;
#pragma unroll
      for (int i = 0; i < 8; ++i) {
        const float y = (cs[i * 1024 + chn] - st[2 * i]) * st[2 * i + 1] * lg[c] + lb[c];
        Gc[(size_t)(row0 + i) * 1024 + chn] = f2bf(siluf_(y) * bf2f(gv[c][i]));
      }
    }
    __syncthreads();
  }
}

struct AttnConst { float M2d, M2x, lam; };
DEVI AttnConst attn_consts(const Params& p, int layer) {
  const int lane = threadIdx.x & 63;
  AttnConst c;
  const float gq = max_abs64(p.in[16], 64, lane), gk = max_abs64(p.in[17], 64, lane);
  float kd = 0.f, kx = 0.f;
  for (int i = lane; i < (int)gridDim.x * 4; i += 64) { kd = fmaxf(kd, p.kmaxp[i]); kx = fmaxf(kx, p.kmaxp[1024 * (1 + layer) + i]); }
  kd = wmax(kd); kx = wmax(kx);
  c.M2d = (8.f * gq * 0.125f * LOG2E) * fmaxf(8.f * gk, sqrtf(kd)) * 1.01f;
  const float xq = max_abs64(p.in[32] + layer * 128, 128, lane), xk = max_abs64(p.in[33] + layer * 128, 128, lane);
  c.M2x = (11.313708f * xq * 0.08838834764831845f * LOG2E) * fmaxf(11.313708f * xk, sqrtf(kx)) * 1.01f;
  float d1 = p.in[18][lane] * p.in[19][lane], d2 = p.in[20][lane] * p.in[21][lane];
  d1 = wsum(d1); d2 = wsum(d2);
  c.lam = __expf(d1) - __expf(d2) + 0.2f;
  return c;
}

DEVI void cross_item(const Params& p, LAS char* lds, int layer, int it, float M2x) {
  const int hd = it & 3;
  size_t row0; int mb, nw;
  if (it < 1024) { const int rb = it >> 2; row0 = (size_t)rb * 128; mb = rb >> 6; nw = 4; }
  else { const int bs = (it - 1024) >> 2; row0 = (size_t)NTOKP + bs * 32; mb = 4 + bs; nw = 1; }
  attn_block<false>(lds, p.Qx + row0 * 512 + hd * 128, p.XK + ((size_t)(layer * 12 + mb) * 256) * 512 + hd * 128,
                    p.XVT + ((size_t)((layer * 12 + mb) * 4 + hd) * 128) * 256, 256, 0, 4, nw, 0, 256, 0.f, M2x, 0.f, nullptr,
                    p.Gx + row0 * 512 + hd * 128);
}

DEVI void diff_item(const Params& p, LAS char* lds, int it, float M2d, float lam) {
  const bool pr = it < 1024;
  const int hd = pr ? 3 - (it >> 8) : (it - 1024) & 3;
  const int qb = pr ? 63 - ((it >> 2) & 63) : 0;
  const int b = pr ? (it & 3) : (it - 1024) >> 2;
  const int bh = b * 4 + hd;
  const size_t row0 = pr ? (size_t)b * SEQ + qb * 128 : (size_t)NTOKP + b * 32;
  const float slope2 = exp2f(-2.f * (hd + 1)) * LOG2E;
  const u16* Kp = pr ? p.Kb + (size_t)b * SEQ * 512 + hd * 128 : p.Ks + (size_t)b * SKP * 512 + hd * 128;
  const u16* Vp = pr ? p.VbT + (size_t)bh * 128 * SEQ : p.VsT + (size_t)bh * 128 * SKP;
  const int qpos0 = pr ? qb * 128 : PAST;
  const float kcut = (float)qpos0 - (2.f * M2d + 64.f) / slope2;
  int j0 = (int)floorf((kcut - 63.f) * (1.f / 64.f));
  j0 = max(j0, 0);
  attn_block<true>(lds, p.Qb + row0 * 512 + hd * 128, Kp, Vp, pr ? SEQ : SKP, j0, pr ? 2 * qb + 2 : 33, pr ? 4 : 1,
                   qpos0, pr ? SEQ : PAST + 32, slope2, M2d, lam, p.in[22], p.Gb + row0 * 512 + hd * 128);
}

DEVI int snake(int k, int g, int G) { return (k & 1) ? (k * G + (G - 1 - g)) : (k * G + g); }

constexpr int NPHASE = 9;
DEVI void run_phase(const Params& p, LAS char* lds, int ph) {
  const int G = gridDim.x, g = blockIdx.x;
  switch (ph) {
    case 0: phase_prep(p); break;
    case 1: phase_gemm<0>(p, lds); break;
    case 2: {
      const AttnConst c = attn_consts(p, 0);
      for (int it = g; it < 1056; it += G) cross_item(p, lds, 0, it, c.M2x);
      for (int it = g; it < 2048; it += G) m1_item(p, lds, it);
    } break;
    case 3: {
      const AttnConst c = attn_consts(p, 0);
      (void)c;
      phase_scan(p, lds);
    } break;
    case 4: {
      const AttnConst c = attn_consts(p, 0);
      unsigned* qhead = reinterpret_cast<unsigned*>(p.kmaxp + 3 * 1024) + 16;
      volatile LAS int* slot = (volatile LAS int*)(lds + LDS_BYTES - 16);
      for (;;) {
        __syncthreads();
        if (threadIdx.x == 0) *slot = (int)__hip_atomic_fetch_add(qhead, 1u, __ATOMIC_RELAXED, __HIP_MEMORY_SCOPE_AGENT);
        __syncthreads();
        const int it = *slot;
        if (it >= 1056) break;
        diff_item(p, lds, it, c.M2d, c.lam);
      }
      for (;;) {
        __syncthreads();
        if (threadIdx.x == 0) *slot = (int)__hip_atomic_fetch_add(qhead + 16, 1u, __ATOMIC_RELAXED, __HIP_MEMORY_SCOPE_AGENT);
        __syncthreads();
        const int it = *slot;
        if (it >= 2048) break;
        m3_item(p, lds, it);
      }
      for (int it = G - 1 - g; it < 32; it += G) ms_item(p, lds, it);
    } break;
    case 5: phase_gemm<1>(p, lds); break;
    case 6: phase_gemm<2>(p, lds); break;
    case 7: {
      const AttnConst c = attn_consts(p, 1);
      phase_conv(p, lds);
      for (int it = g; it < 1056; it += G) cross_item(p, lds, 1, it, c.M2x);
    } break;
    case 8: phase_gemm<3>(p, lds); break;
  }
}

DEVI void grid_bar(unsigned* ctr, unsigned& epoch) {
  asm volatile("s_waitcnt vmcnt(0)" ::: "memory");
  __syncthreads();
  if (threadIdx.x == 0) {
    __builtin_amdgcn_fence(__ATOMIC_RELEASE, "agent");
    asm volatile("s_waitcnt vmcnt(0)" ::: "memory");
    __hip_atomic_fetch_add(ctr, 1u, __ATOMIC_RELAXED, __HIP_MEMORY_SCOPE_AGENT);
    epoch += 1u;
    const unsigned target = epoch * gridDim.x;
    while (__hip_atomic_load(ctr, __ATOMIC_RELAXED, __HIP_MEMORY_SCOPE_AGENT) < target) __builtin_amdgcn_s_sleep(1);
    __builtin_amdgcn_fence(__ATOMIC_ACQUIRE, "agent");
    asm volatile("s_waitcnt vmcnt(0)" ::: "memory");
  }
  __syncthreads();
}

__global__ void __launch_bounds__(256, 1) mega(Params p, int ph_lo, int ph_hi) {
  extern __shared__ __attribute__((aligned(16))) char smem[];
  LAS char* lds = (LAS char*)smem;
  cg::grid_group grid = cg::this_grid();
  unsigned epoch = 0;
  unsigned* ctr = reinterpret_cast<unsigned*>(p.kmaxp + 3 * 1024);
#define RUNPH(k) if (ph_lo <= (k) && (k) < ph_hi) { if ((k) > ph_lo) { if ((k) == 1) grid.sync(); else grid_bar(ctr, epoch); } run_phase(p, lds, (k)); }
  RUNPH(0) RUNPH(1) RUNPH(2) RUNPH(3) RUNPH(4) RUNPH(5) RUNPH(6) RUNPH(7) RUNPH(8)
#undef RUNPH
}

#ifndef MULTI_LAUNCH
#define MULTI_LAUNCH 0
#endif

extern "C" void kernel_launch(void* const* d_in, const int* in_sizes, int n_in, void* d_out, int out_size, void* d_ws, size_t ws_size,
                              hipStream_t stream) {
  static int grid_blocks = 0;
  if (!grid_blocks) {
    int dev = 0, cus = 0, per_cu = 0;
    hipGetDevice(&dev);
    hipDeviceGetAttribute(&cus, hipDeviceAttributeMultiprocessorCount, dev);
    hipFuncSetAttribute((const void*)mega, hipFuncAttributeMaxDynamicSharedMemorySize, LDS_BYTES);
    hipOccupancyMaxActiveBlocksPerMultiprocessor(&per_cu, (const void*)mega, 256, LDS_BYTES);
    if (per_cu < 1) per_cu = 1;
    if (per_cu > 1) per_cu = 1;
    grid_blocks = (cus * per_cu) & ~7;
    if (grid_blocks < 8) grid_blocks = 8;
  }
  Params p{};
  for (int i = 0; i < 34; ++i) p.in[i] = (const float*)d_in[i];
  p.out = (float*)d_out;
  char* ws = (char*)d_ws;
  size_t off = 0;
  auto take = [&](size_t bytes) { char* q = ws + off; off += (bytes + 255) & ~(size_t)255; return q; };
  p.WtInA = (u16*)take((size_t)NPAD_A * 1024 * 2);
  p.WtOutA = (u16*)take((size_t)1024 * 1536 * 2);
  p.WtInC = (u16*)take((size_t)4096 * 1024 * 2);
  p.WtOutC = (u16*)take((size_t)1024 * 1536 * 2);
  p.WtMem = (u16*)take((size_t)2 * 1024 * 1024 * 2);
  p.xb = (u16*)take((size_t)NTOK * 1024 * 2);
  p.memb = (u16*)take((size_t)1024 * 1024 * 2);
  u16* segs = (u16*)take(SEG * 2 * 11);
  p.Qa = segs; p.Ka = segs + SEG; p.KaT = segs + 2 * SEG; p.VaT = segs + 3 * SEG; p.Ga = segs + 4 * SEG; p.Qb = segs + 5 * SEG;
  p.Kb = segs + 6 * SEG; p.VbT = segs + 7 * SEG; p.Gb = segs + 8 * SEG; p.Qx = segs + 9 * SEG; p.Gx = segs + 10 * SEG;
  p.Ks = (u16*)take((size_t)8 * SKP * 512 * 2);
  p.VsT = (u16*)take((size_t)4096 * SKP * 2);
  p.XK = (u16*)take((size_t)2 * 12 * 256 * 512 * 2);
  p.XVT = (u16*)take((size_t)2 * 12 * 256 * 512 * 2);
  p.C0sT = (u16*)take((size_t)32 * 16384 * 2);
  p.rs0 = (float*)take((size_t)NTOK * 4);
  p.ssq1 = (float*)take((size_t)NTOK * 4);
  p.rsmem = (float*)take((size_t)(1024 + 64) * 4);
  p.gates = (float*)take((size_t)NTOK * 8 * 4);
  p.tabA = (float*)take(2048 * 4);
  p.tabB = (float*)take(2048 * 4);
  p.mtab = (float*)take(16 * 129 * 4);
  p.nhat = (float*)take((size_t)2048 * 128 * 4);
  p.nstate = (float*)take((size_t)2048 * 128 * 4);
  p.kmaxp = (float*)take((size_t)3 * 1024 * 4 + 256);
  if (off > ws_size) { fprintf(stderr, "workspace too small: need %zu have %zu\n", off, ws_size); return; }
  (void)hipMemsetAsync(p.kmaxp + 3 * 1024, 0, 256, stream);
#if MULTI_LAUNCH
  for (int ph = 0; ph < NPHASE; ++ph) {
    hipLaunchKernelGGL(mega, dim3(grid_blocks), dim3(256), LDS_BYTES, stream, p, ph, ph + 1);
  }
#else
  int lo = 0, hi = NPHASE;
  void* args[] = {&p, &lo, &hi};
  hipError_t e = hipLaunchCooperativeKernel((const void*)mega, dim3(grid_blocks), dim3(256), args, LDS_BYTES, stream);
  if (e != hipSuccess) fprintf(stderr, "cooperative launch failed: %s (grid %d)\n", hipGetErrorString(e), grid_blocks);
#endif
}
```

```cpp
#include <hip/hip_runtime.h>
#include <hip/hip_cooperative_groups.h>
#include <stdint.h>
#include <stdio.h>
namespace cg = cooperative_groups;

typedef unsigned short u16;
using bf16x8 = __attribute__((ext_vector_type(8))) short;
using f32x4  = __attribute__((ext_vector_type(4))) float;
using f32x16 = __attribute__((ext_vector_type(16))) float;
using u32x4  = __attribute__((ext_vector_type(4))) unsigned;
using u32x2  = __attribute__((ext_vector_type(2))) unsigned;
#define LAS __attribute__((address_space(3)))
#define DEVI __device__ __forceinline__

constexpr int NTOKP = 32768, NTOKS = 256, NTOK = 33024;
constexpr int SEQ = 8192, LSAMP = 32, PAST = 2048, SKP = 2112;
constexpr size_t SEG = (size_t)NTOK * 512;
constexpr int NPAD_A = 5760;
constexpr float EPS = 1e-6f;
constexpr float LOG2E = 1.4426950408889634f;
constexpr size_t O_YP = 0, O_PXK = 33816576, O_PXV = 34865152, O_PK = 35913728, O_PV = 52690944,
  O_PC = 69468160, O_PN = 69730304, O_PM = 69732352, O_PCONV = 69732368, O_SK = 69855248, O_SV = 69986320,
  O_SC = 70117392, O_SN = 70641680, O_SM = 70645776, O_SCONV = 70645808;

constexpr int LDS_BYTES = 147456;

struct Params {
  const float* in[34];
  float* out;
  u16 *WtInA, *WtOutA, *WtInC, *WtOutC, *WtMem;
  u16 *xb, *memb;
  u16 *Qa, *Ka, *KaT, *VaT, *Ga, *Qb, *Kb, *VbT, *Gb, *Qx, *Gx;
  u16 *Ks, *VsT, *XK, *XVT, *C0sT;
  float *rs0, *ssq1, *rsmem, *gates, *tabA, *tabB, *mtab, *nhat, *nstate, *kmaxp;
};

DEVI unsigned cvtpk(float lo, float hi) { unsigned r; asm volatile("v_cvt_pk_bf16_f32 %0, %1, %2" : "=v"(r) : "v"(lo), "v"(hi)); return r; }
DEVI float bflo(unsigned u) { return __uint_as_float(u << 16); }
DEVI float bfhi(unsigned u) { return __uint_as_float(u & 0xffff0000u); }
DEVI float bf2f(u16 h) { return __uint_as_float(((unsigned)h) << 16); }
DEVI u16 f2bf(float f) { return (u16)(cvtpk(f, 0.f) & 0xffffu); }
DEVI float sigmoidf_(float x) { return 1.f / (1.f + __expf(-x)); }
DEVI float siluf_(float x) { return x / (1.f + __expf(-x)); }
DEVI float logsigmoidf_(float x) { return fminf(x, 0.f) - log1pf(__expf(-fabsf(x))); }
DEVI float wsum(float v) { for (int o = 32; o; o >>= 1) v += __shfl_xor(v, o); return v; }
DEVI float wmax(float v) { for (int o = 32; o; o >>= 1) v = fmaxf(v, __shfl_xor(v, o)); return v; }
DEVI int pi32(int r) { return (r & ~12) | ((r & 4) << 1) | ((r & 8) >> 1); }
DEVI int klocal(int reg, int h) { return (reg & 3) + 4 * ((reg >> 2) & 1) + 8 * h + 16 * (reg >> 3); }
DEVI int crow(int reg, int h) { return (reg & 3) + 8 * (reg >> 2) + 4 * h; }
DEVI bf16x8 ldg8(const u16* p) { return *reinterpret_cast<const bf16x8*>(p); }
DEVI f32x16 mfma32(bf16x8 a, bf16x8 b, f32x16 c) { return __builtin_amdgcn_mfma_f32_32x32x16_bf16(a, b, c, 0, 0, 0); }
DEVI bf16x8 pack8(const f32x16& x, int s) {
  u32x4 w = {cvtpk(x[8 * s + 0], x[8 * s + 1]), cvtpk(x[8 * s + 2], x[8 * s + 3]), cvtpk(x[8 * s + 4], x[8 * s + 5]), cvtpk(x[8 * s + 6], x[8 * s + 7])};
  return *reinterpret_cast<bf16x8*>(&w);
}
DEVI void lds_barrier() { asm volatile("s_waitcnt lgkmcnt(0)" ::: "memory"); __builtin_amdgcn_s_barrier(); asm volatile("" ::: "memory"); }
DEVI void glds16(const void* g, LAS void* l) { __builtin_amdgcn_global_load_lds((const unsigned*)g, (LAS unsigned*)l, 16, 0, 0); }

template <class F>
DEVI void wtrans(u16* dst, const float* src, const float* g, int K, int Npad, int ldn, F srccol, int gtid, int gsz) {
  const int total = Npad * (K / 32);
  for (int i = gtid; i < total; i += gsz) {
    const int n = i % Npad, kb = i / Npad;
    const int sc = srccol(n);
    float v[32];
#pragma unroll
    for (int j = 0; j < 32; ++j) v[j] = (sc >= 0) ? src[(size_t)(kb * 32 + j) * ldn + sc] : 0.f;
    if (g) {
#pragma unroll
      for (int j = 0; j < 32; ++j) v[j] *= g[kb * 32 + j];
    }
#pragma unroll
    for (int q = 0; q < 4; ++q) {
      u32x4 w = {cvtpk(v[8 * q + 0], v[8 * q + 1]), cvtpk(v[8 * q + 2], v[8 * q + 3]), cvtpk(v[8 * q + 4], v[8 * q + 5]), cvtpk(v[8 * q + 6], v[8 * q + 7])};
      *reinterpret_cast<u32x4*>(dst + (size_t)n * K + kb * 32 + q * 8) = w;
    }
  }
}

DEVI int srccol_in_a(int n) {
  const int t = n >> 7, c = n & 127;
  if (t < 12) return n;
  if (t < 20) { const int j = t - 12; return c < 64 ? 1536 + 64 * j + c : 2048 + 64 * j + (c - 64); }
  if (t < 44) return 2568 + (t - 20) * 128 + c;
  if (t == 44) return c < 8 ? 2560 + c : -1;
  return -1;
}
DEVI int srccol_in_c(int n) {
  const int t = n >> 7, c = n & 127;
  if (t < 16) return c < 64 ? 64 * t + c : 1024 + 64 * t + (c - 64);
  return n;
}

DEVI void phase_prep(const Params& p) {
  const int tid = threadIdx.x, lane = tid & 63;
  const int gtid = blockIdx.x * 256 + tid, gsz = gridDim.x * 256;
  const int gwave = gtid >> 6, nwaves = gsz >> 6;
  wtrans(p.WtInA, p.in[12], p.in[11], 1024, NPAD_A, 5640, [](int n) { return srccol_in_a(n); }, gtid, gsz);
  wtrans(p.WtOutA, p.in[23], nullptr, 1536, 1024, 1024, [](int n) { return n; }, gtid, gsz);
  wtrans(p.WtInC, p.in[24], p.in[11] + 1024, 1024, 4096, 4096, [](int n) { return srccol_in_c(n); }, gtid, gsz);
  wtrans(p.WtOutC, p.in[29], nullptr, 1536, 1024, 1024, [](int n) { return n; }, gtid, gsz);
  for (int l = 0; l < 2; ++l)
    wtrans(p.WtMem + (size_t)l * 1024 * 1024, p.in[31] + (size_t)l * 1024 * 1024, p.in[30] + l * 1024, 1024, 1024, 1024,
           [](int n) { return n; }, gtid, gsz);
  for (int row0 = gwave; row0 < NTOK + 1024; row0 += 4 * nwaves) {
    float4 v[4][4];
    const float* xr[4];
#pragma unroll
    for (int u = 0; u < 4; ++u) {
      const int row = min(row0 + u * nwaves, NTOK + 1023);
      xr[u] = row < NTOKP ? p.in[0] + (size_t)row * 1024 : (row < NTOK ? p.in[1] + (size_t)(row - NTOKP) * 1024 : p.in[2] + (size_t)(row - NTOK) * 1024);
    }
#pragma unroll
    for (int u = 0; u < 4; ++u)
#pragma unroll
      for (int i = 0; i < 4; ++i) v[u][i] = reinterpret_cast<const float4*>(xr[u])[lane + 64 * i];
#pragma unroll
    for (int u = 0; u < 4; ++u) {
      const int row = row0 + u * nwaves;
      float ss = 0.f;
#pragma unroll
      for (int i = 0; i < 4; ++i) ss += v[u][i].x * v[u][i].x + v[u][i].y * v[u][i].y + v[u][i].z * v[u][i].z + v[u][i].w * v[u][i].w;
      ss = wsum(ss);
      if (row < NTOK + 1024) {
        u16* dst = row < NTOK ? p.xb + (size_t)row * 1024 : p.memb + (size_t)(row - NTOK) * 1024;
        float* rsd = row < NTOK ? p.rs0 + row : p.rsmem + (row - NTOK);
        if (lane == 0) *rsd = rsqrtf(ss * (1.f / 1024.f) + EPS);
#pragma unroll
        for (int i = 0; i < 4; ++i) { u32x2 w = {cvtpk(v[u][i].x, v[u][i].y), cvtpk(v[u][i].z, v[u][i].w)}; reinterpret_cast<u32x2*>(dst)[lane + 64 * i] = w; }
      }
    }
  }
  float km0 = 0.f, km1 = 0.f, km2 = 0.f;
  for (int i0 = gtid; i0 < 8 * PAST * 64; i0 += 4 * gsz) {
    float4 a[4], c[4];
#pragma unroll
    for (int u = 0; u < 4; ++u) {
      const int i = i0 + u * gsz;
      const int c8 = i & 63, pp = (i >> 6) & (PAST - 1), b = (i >> 17) & 7;
      const float4* sp = reinterpret_cast<const float4*>(p.in[5] + ((size_t)(b * PAST + pp) * 512 + c8 * 8));
      a[u] = sp[0]; c[u] = sp[1];
    }
#pragma unroll
    for (int u = 0; u < 4; ++u) {
      const int i = i0 + u * gsz;
      if (i < 8 * PAST * 64) {
        const int c8 = i & 63, pp = (i >> 6) & (PAST - 1), b = i >> 17;
        u32x4 w = {cvtpk(a[u].x, a[u].y), cvtpk(a[u].z, a[u].w), cvtpk(c[u].x, c[u].y), cvtpk(c[u].z, c[u].w)};
        *reinterpret_cast<u32x4*>(p.Ks + ((size_t)(b * SKP + pp) * 512 + c8 * 8)) = w;
        float ss = a[u].x * a[u].x + a[u].y * a[u].y + a[u].z * a[u].z + a[u].w * a[u].w + c[u].x * c[u].x + c[u].y * c[u].y + c[u].z * c[u].z + c[u].w * c[u].w;
        ss += __shfl_xor(ss, 1); ss += __shfl_xor(ss, 2); ss += __shfl_xor(ss, 4);
        km0 = fmaxf(km0, ss);
      }
    }
  }
  for (int i0 = gtid; i0 < 8 * 4 * 256 * 128; i0 += 2 * gsz) {
    float v[2][8];
#pragma unroll
    for (int u = 0; u < 2; ++u) {
      const int i = (i0 + u * gsz) & (8 * 4 * 256 * 128 - 1);
      const int dv = i & 127, p8 = (i >> 7) & 255, h = (i >> 15) & 3, b = i >> 17;
#pragma unroll
      for (int j = 0; j < 8; ++j) v[u][j] = p.in[6][((size_t)(b * PAST + p8 * 8 + j) * 4 + h) * 128 + dv];
    }
#pragma unroll
    for (int u = 0; u < 2; ++u) {
      const int i = i0 + u * gsz;
      if (i < 8 * 4 * 256 * 128) {
        const int dv = i & 127, p8 = (i >> 7) & 255, h = (i >> 15) & 3, b = i >> 17;
        u32x4 w = {cvtpk(v[u][0], v[u][1]), cvtpk(v[u][2], v[u][3]), cvtpk(v[u][4], v[u][5]), cvtpk(v[u][6], v[u][7])};
        *reinterpret_cast<u32x4*>(p.VsT + ((size_t)((b * 4 + h) * 128 + dv) * SKP + p8 * 8)) = w;
      }
    }
  }
  for (int i = gtid; i < 4096 * 4; i += gsz) {
    u32x4 z = {0, 0, 0, 0};
    *reinterpret_cast<u32x4*>(p.VsT + ((size_t)(i >> 2) * SKP + 2080 + (i & 3) * 8)) = z;
  }
  for (int i = gtid; i < 8 * 32 * 64; i += gsz) {
    u32x4 z = {0, 0, 0, 0};
    const int c8 = i & 63, r = (i >> 6) & 31, b = i >> 11;
    *reinterpret_cast<u32x4*>(p.Ks + ((size_t)(b * SKP + 2080 + r) * 512 + c8 * 8)) = z;
  }
  for (int i = gtid; i < 2 * 8 * 256 * 64; i += gsz) {
    const int c8 = i & 63, m = (i >> 6) & 255, b = (i >> 14) & 7, l = i >> 17;
    const float4* s = reinterpret_cast<const float4*>(p.in[3] + ((size_t)((l * 8 + b) * 256 + m) * 512 + c8 * 8));
    const float4 a = s[0], c = s[1];
    u32x4 w = {cvtpk(a.x, a.y), cvtpk(a.z, a.w), cvtpk(c.x, c.y), cvtpk(c.z, c.w)};
    *reinterpret_cast<u32x4*>(p.XK + ((size_t)((l * 12 + 4 + b) * 256 + m) * 512 + c8 * 8)) = w;
    float ss = a.x * a.x + a.y * a.y + a.z * a.z + a.w * a.w + c.x * c.x + c.y * c.y + c.z * c.z + c.w * c.w;
    ss += __shfl_xor(ss, 1); ss += __shfl_xor(ss, 2); ss += __shfl_xor(ss, 4); ss += __shfl_xor(ss, 8);
    if (l == 0) km1 = fmaxf(km1, ss); else km2 = fmaxf(km2, ss);
  }
  for (int i = gtid; i < 2 * 8 * 4 * 32 * 128; i += gsz) {
    const int dv = i & 127, m8 = (i >> 7) & 31, h = (i >> 12) & 3, b = (i >> 14) & 7, l = i >> 17;
    float v[8];
#pragma unroll
    for (int j = 0; j < 8; ++j) v[j] = p.in[4][((size_t)((l * 8 + b) * 256 + m8 * 8 + j) * 4 + h) * 128 + dv];
    u32x4 w = {cvtpk(v[0], v[1]), cvtpk(v[2], v[3]), cvtpk(v[4], v[5]), cvtpk(v[6], v[7])};
    *reinterpret_cast<u32x4*>(p.XVT + ((size_t)(((l * 12 + 4 + b) * 4 + h) * 128 + dv) * 256 + m8 * 8)) = w;
  }
  for (int i = gtid; i < 32 * 16 * 128; i += gsz) {
    const int e = i & 127, d8 = (i >> 7) & 15, bh = i >> 11;
    float v[8];
#pragma unroll
    for (int j = 0; j < 8; ++j) v[j] = p.in[7][((size_t)bh * 128 + d8 * 8 + j) * 128 + e];
    u32x4 w = {cvtpk(v[0], v[1]), cvtpk(v[2], v[3]), cvtpk(v[4], v[5]), cvtpk(v[6], v[7])};
    *reinterpret_cast<u32x4*>(p.C0sT + ((size_t)bh * 128 + e) * 128 + d8 * 8) = w;
  }
  for (int i = gtid; i < NTOK; i += gsz) p.ssq1[i] = 0.f;
  km0 = wmax(km0); km1 = wmax(km1); km2 = wmax(km2);
  if (lane == 0) {
    const int slot = blockIdx.x * 4 + (tid >> 6);
    p.kmaxp[slot] = km0; p.kmaxp[1024 + slot] = km1; p.kmaxp[2048 + slot] = km2;
  }
}

DEVI void gemm_core(LAS char* lds, const u16* A0, const u16* A1, const u16* A2, int lda0, int lda1, int lda2, int segK,
                    const u16* Bt, int K, int brow, int bcol, f32x4 (&acc)[4][4]) {
  const int tid = threadIdx.x, lane = tid & 63, wid = tid >> 6, wr = wid >> 1, wc = wid & 1, fr = lane & 15, fq = lane >> 4;
  LAS char* SA = lds; LAS char* SB = lds + 8192;
#pragma unroll
  for (int m = 0; m < 4; ++m)
#pragma unroll
    for (int n = 0; n < 4; ++n) acc[m][n] = f32x4{0.f, 0.f, 0.f, 0.f};
  const int nkt = K / 32;
  for (int kt = 0; kt < nkt; ++kt) {
    const int k0 = kt * 32;
    const int seg = k0 / segK;
    const u16* Ab = (seg == 0 ? A0 : (seg == 1 ? A1 : A2)) + (k0 - seg * segK);
    const int lda = (seg == 0 ? lda0 : (seg == 1 ? lda1 : lda2));
#pragma unroll
    for (int i = 0; i < 2; ++i) {
      const int b = tid * 16 + i * 4096, r = b >> 6, c = (b & 63) >> 1;
      glds16(Ab + (size_t)(brow + r) * lda + c, SA + b);
      glds16(Bt + (size_t)(bcol + r) * K + k0 + c, SB + b);
    }
    asm volatile("s_waitcnt vmcnt(0)" ::: "memory");
    __syncthreads();
    bf16x8 af[4], bfr[4];
#pragma unroll
    for (int m = 0; m < 4; ++m) af[m] = *reinterpret_cast<const LAS bf16x8*>(SA + (wr * 64 + m * 16 + fr) * 64 + fq * 16);
#pragma unroll
    for (int n = 0; n < 4; ++n) bfr[n] = *reinterpret_cast<const LAS bf16x8*>(SB + (wc * 64 + n * 16 + fr) * 64 + fq * 16);
#pragma unroll
    for (int m = 0; m < 4; ++m)
#pragma unroll
      for (int n = 0; n < 4; ++n) acc[m][n] = __builtin_amdgcn_mfma_f32_16x16x32_bf16(af[m], bfr[n], acc[m][n], 0, 0, 0);
    __syncthreads();
  }
}

DEVI void gemm_stage_c(LAS char* lds, const f32x4 (&acc)[4][4], const float* rowscale, int mode, int brow) {
  const int tid = threadIdx.x, lane = tid & 63, wid = tid >> 6, wr = wid >> 1, wc = wid & 1, fr = lane & 15, fq = lane >> 4;
  LAS float* Cs = (LAS float*)lds;
#pragma unroll
  for (int m = 0; m < 4; ++m)
#pragma unroll
    for (int j = 0; j < 4; ++j) {
      const int r = wr * 64 + m * 16 + fq * 4 + j;
      float s = 1.f;
      if (mode == 1) s = rowscale[brow + r];
      else if (mode == 2) s = rsqrtf(rowscale[brow + r] * (1.f / 1024.f) + EPS);
#pragma unroll
      for (int n = 0; n < 4; ++n) Cs[r * 132 + wc * 64 + n * 16 + fr] = acc[m][n][j] * s;
    }
  __syncthreads();
}

DEVI void st_bf8(u16* dst, const float (&v)[8]) {
  u32x4 w = {cvtpk(v[0], v[1]), cvtpk(v[2], v[3]), cvtpk(v[4], v[5]), cvtpk(v[6], v[7])};
  *reinterpret_cast<u32x4*>(dst) = w;
}
DEVI void st_f8(float* dst, const float (&v)[8]) {
  reinterpret_cast<float4*>(dst)[0] = float4{v[0], v[1], v[2], v[3]};
  reinterpret_cast<float4*>(dst)[1] = float4{v[4], v[5], v[6], v[7]};
}
DEVI void store_transposed(LAS char* lds, u16* dst, size_t ldt, float scale) {
  const LAS float* Cs = (const LAS float*)lds;
  const int c = threadIdx.x & 127, rh = (threadIdx.x >> 7) * 64;
#pragma unroll
  for (int it = 0; it < 8; ++it) {
    const int r0 = rh + it * 8;
    float v[8];
#pragma unroll
    for (int j = 0; j < 8; ++j) v[j] = Cs[(r0 + j) * 132 + c] * scale;
    st_bf8(dst + (size_t)c * ldt + r0, v);
  }
}

DEVI void epi_in_a(const Params& p, LAS char* lds, int brow, int n) {
  const LAS float* Cs = (const LAS float*)lds;
  const int tid = threadIdx.x, cgp = tid & 15, c0 = cgp * 8;
  const bool samp = brow >= NTOKP;
  const int seg = n >> 2, hd = n & 3;
  if (n >= 4 && n < 12) {
    u16* base = (n < 8 ? p.KaT : p.VaT);
    const float sc = (n < 8 ? 0.08838834764831845f : 1.f);
    if (!samp) { const int b = brow >> 13, t0 = brow & 8191; store_transposed(lds, base + ((size_t)(b * 4 + hd) * 128) * SEQ + t0, SEQ, sc); }
    else {
      const int c = tid & 127, rh = (tid >> 7) * 64;
#pragma unroll
      for (int it = 0; it < 8; ++it) {
        const int r0 = rh + it * 8; const int bs = ((brow - NTOKP) + r0) >> 5, t0 = r0 & 31;
        float v[8];
#pragma unroll
        for (int j = 0; j < 8; ++j) v[j] = Cs[(r0 + j) * 132 + c] * sc;
        st_bf8(base + (size_t)NTOKP * 512 + ((size_t)(bs * 4 + hd) * 128 + c) * 32 + t0, v);
      }
    }
  }
  if (seg == 7) {
    if (!samp) { const int b = brow >> 13, t0 = brow & 8191; store_transposed(lds, p.VbT + ((size_t)(b * 4 + hd) * 128) * SEQ + t0, SEQ, 1.f); }
    else {
      const int c = tid & 127, rh = (tid >> 7) * 64;
#pragma unroll
      for (int it = 0; it < 8; ++it) {
        const int r0 = rh + it * 8; const int bs = ((brow - NTOKP) + r0) >> 5, t0 = r0 & 31;
        float v[8];
#pragma unroll
        for (int j = 0; j < 8; ++j) v[j] = Cs[(r0 + j) * 132 + c];
        st_bf8(p.VsT + ((size_t)(bs * 4 + hd) * 128 + c) * SKP + PAST + t0, v);
      }
    }
  }
  float gn[8];
  {
    const float* gp = nullptr;
    if (n >= 20 && n < 24) gp = p.in[16] + (c0 & 63);
    else if (n >= 24 && n < 28) gp = p.in[17] + (c0 & 63);
    else if (n >= 36 && n < 40) gp = p.in[32] + c0;
    else if (n == 44) gp = (cgp == 0) ? nullptr : nullptr;
#pragma unroll
    for (int j = 0; j < 8; ++j) gn[j] = gp ? gp[j] : 0.f;
    if (n == 44) {
#pragma unroll
      for (int j = 0; j < 4; ++j) { gn[j] = p.in[13][j]; gn[4 + j] = p.in[14][j]; }
    }
  }
#pragma unroll 1
  for (int it = 0; it < 8; ++it) {
    const int r = it * 16 + (tid >> 4);
    const size_t grow = (size_t)brow + r;
    float v[8];
#pragma unroll
    for (int j = 0; j < 8; ++j) v[j] = Cs[r * 132 + c0 + j];
    if (n < 4) { st_bf8(p.Qa + grow * 512 + hd * 128 + c0, v); }
    else if (n < 8) {
#pragma unroll
      for (int j = 0; j < 8; ++j) v[j] *= 0.08838834764831845f;
      st_bf8(p.Ka + grow * 512 + hd * 128 + c0, v);
    }
    else if (n < 12) {   }
    else if (n < 20) {
      if (cgp < 8) {
        float g[8];
#pragma unroll
        for (int j = 0; j < 8; ++j) g[j] = sigmoidf_(v[j]) * siluf_(Cs[r * 132 + 64 + c0 + j]);
        st_bf8(p.Ga + grow * 512 + (n - 12) * 64 + c0, g);
      }
    }
    else if (n < 28) {
      float ss = 0.f;
#pragma unroll
      for (int j = 0; j < 8; ++j) ss += v[j] * v[j];
      ss += __shfl_xor(ss, 1); ss += __shfl_xor(ss, 2); ss += __shfl_xor(ss, 4);
      const float rs = rsqrtf(ss * (1.f / 64.f) + EPS);
      const float* g = gn;
      if (n < 24) {
#pragma unroll
        for (int j = 0; j < 8; ++j) v[j] = v[j] * rs * g[j] * (0.125f * LOG2E);
        st_bf8(p.Qb + grow * 512 + hd * 128 + c0, v);
      } else {
#pragma unroll
        for (int j = 0; j < 8; ++j) v[j] = v[j] * rs * g[j];
        if (!samp) { st_f8(p.out + O_PK + grow * 512 + hd * 128 + c0, v); st_bf8(p.Kb + grow * 512 + hd * 128 + c0, v); }
        else {
          const int sr = (int)grow - NTOKP, bs = sr >> 5, t = sr & 31;
          st_f8(p.out + O_SK + (size_t)sr * 512 + hd * 128 + c0, v);
          st_bf8(p.Ks + ((size_t)(bs * SKP + PAST + t)) * 512 + hd * 128 + c0, v);
        }
      }
    }
    else if (n < 32) {
      if (!samp) st_f8(p.out + O_PV + grow * 512 + hd * 128 + c0, v);
      else st_f8(p.out + O_SV + (size_t)((int)grow - NTOKP) * 512 + hd * 128 + c0, v);
    }
    else if (n < 36) {
#pragma unroll
      for (int j = 0; j < 8; ++j) v[j] = siluf_(v[j]);
      st_bf8(p.Gb + grow * 512 + hd * 128 + c0, v);
    }
    else if (n < 40) {
      float ss = 0.f;
#pragma unroll
      for (int j = 0; j < 8; ++j) ss += v[j] * v[j];
      ss += __shfl_xor(ss, 1); ss += __shfl_xor(ss, 2); ss += __shfl_xor(ss, 4); ss += __shfl_xor(ss, 8);
      const float rs = rsqrtf(ss * (1.f / 128.f) + EPS);
      const float* g = gn;
#pragma unroll
      for (int j = 0; j < 8; ++j) v[j] = v[j] * rs * g[j] * (0.08838834764831845f * LOG2E);
      st_bf8(p.Qx + grow * 512 + hd * 128 + c0, v);
    }
    else if (n < 44) {
#pragma unroll
      for (int j = 0; j < 8; ++j) v[j] = siluf_(v[j]);
      st_bf8(p.Gx + grow * 512 + hd * 128 + c0, v);
    }
    else {
      if (cgp == 0) {
        float g[8];
#pragma unroll
        for (int j = 0; j < 4; ++j) { g[j] = v[j] + gn[j]; g[4 + j] = logsigmoidf_(v[4 + j] + gn[4 + j]); }
        st_f8(p.gates + grow * 8, g);
      }
    }
  }
}

DEVI void epi_mem(const Params& p, LAS char* lds, int l, int brow, int n) {
  const LAS float* Cs = (const LAS float*)lds;
  const int tid = threadIdx.x, cgp = tid & 15, c0 = cgp * 8;
  const int hd = n & 3;
  if (n >= 4) {
    const int b = brow >> 8, m0 = brow & 255;
    store_transposed(lds, p.XVT + ((size_t)((l * 12 + b) * 4 + hd) * 128) * 256 + m0, 256, 1.f);
  }
  float gk[8];
#pragma unroll
  for (int j = 0; j < 8; ++j) gk[j] = p.in[33][l * 128 + c0 + j];
#pragma unroll 1
  for (int it = 0; it < 8; ++it) {
    const int r = it * 16 + (tid >> 4);
    const size_t grow = (size_t)brow + r;
    float v[8];
#pragma unroll
    for (int j = 0; j < 8; ++j) v[j] = Cs[r * 132 + c0 + j];
    if (n < 4) {
      float ss = 0.f;
#pragma unroll
      for (int j = 0; j < 8; ++j) ss += v[j] * v[j];
      ss += __shfl_xor(ss, 1); ss += __shfl_xor(ss, 2); ss += __shfl_xor(ss, 4); ss += __shfl_xor(ss, 8);
      const float rs = rsqrtf(ss * (1.f / 128.f) + EPS);
      const float* g = gk;
#pragma unroll
      for (int j = 0; j < 8; ++j) v[j] = v[j] * rs * g[j];
      st_f8(p.out + O_PXK + ((size_t)l * 1024 + grow) * 512 + hd * 128 + c0, v);
      const int b = (int)grow >> 8, m = (int)grow & 255;
      st_bf8(p.XK + ((size_t)((l * 12 + b) * 256 + m)) * 512 + hd * 128 + c0, v);
    } else {
      st_f8(p.out + O_PXV + ((size_t)l * 1024 + grow) * 512 + hd * 128 + c0, v);
    }
  }
}

DEVI void load_resid(const Params& p, int layer, int brow, int n, float4 (&ra)[8], float4 (&rb)[8]) {
  const int tid = threadIdx.x, c0 = (tid & 15) * 8;
#pragma unroll
  for (int it = 0; it < 8; ++it) {
    const size_t grow = (size_t)brow + it * 16 + (tid >> 4);
    const float* res;
    if (layer == 0) res = (grow < NTOKP ? p.in[0] + grow * 1024 : p.in[1] + (grow - NTOKP) * 1024) + n * 128 + c0;
    else res = p.out + grow * 1024 + n * 128 + c0;
    ra[it] = reinterpret_cast<const float4*>(res)[0]; rb[it] = reinterpret_cast<const float4*>(res)[1];
  }
}
DEVI void epi_out(const Params& p, LAS char* lds, int layer, int brow, int n, const float4 (&ra)[8], const float4 (&rb)[8]) {
  const LAS float* Cs = (const LAS float*)lds;
  const int tid = threadIdx.x, cgp = tid & 15, c0 = cgp * 8;
#pragma unroll
  for (int q = 0; q < 8; ++q) {
    const int r = q * 16 + (tid >> 4);
    const size_t grow = (size_t)brow + r;
    float v[8];
#pragma unroll
    for (int j = 0; j < 8; ++j) v[j] = Cs[r * 132 + c0 + j];
    v[0] += ra[q].x; v[1] += ra[q].y; v[2] += ra[q].z; v[3] += ra[q].w; v[4] += rb[q].x; v[5] += rb[q].y; v[6] += rb[q].z; v[7] += rb[q].w;
    st_f8(p.out + grow * 1024 + n * 128 + c0, v);
    if (layer == 0) {
      st_bf8(p.xb + grow * 1024 + n * 128 + c0, v);
      float ss = 0.f;
#pragma unroll
      for (int j = 0; j < 8; ++j) ss += v[j] * v[j];
      ss += __shfl_xor(ss, 1); ss += __shfl_xor(ss, 2); ss += __shfl_xor(ss, 4); ss += __shfl_xor(ss, 8);
      if (cgp == 0) atomicAdd(p.ssq1 + grow, ss);
    }
  }
}

DEVI void epi_in_c(const Params& p, LAS char* lds, int brow, int n) {
  const LAS float* Cs = (const LAS float*)lds;
  const int tid = threadIdx.x, cgp = tid & 15, c0 = cgp * 8;
  u16* U = p.Qa;
  u16* Gc = p.KaT;
  float gx[8];
#pragma unroll
  for (int j = 0; j < 8; ++j) gx[j] = p.in[32][128 + c0 + j];
#pragma unroll 1
  for (int it = 0; it < 8; ++it) {
    const int r = it * 16 + (tid >> 4);
    const size_t grow = (size_t)brow + r;
    float v[8];
#pragma unroll
    for (int j = 0; j < 8; ++j) v[j] = Cs[r * 132 + c0 + j];
    if (n < 16) {
      if (cgp < 8) {
        float u[8];
#pragma unroll
        for (int j = 0; j < 8; ++j) u[j] = v[j] * sigmoidf_(Cs[r * 132 + 64 + c0 + j]);
        st_bf8(U + grow * 1024 + n * 64 + c0, u);
        if (grow < NTOKP) { const int t = (int)grow & 8191, b = (int)grow >> 13; if (t >= SEQ - 30) st_f8(p.out + O_PCONV + ((size_t)(b * 30 + t - (SEQ - 30))) * 1024 + n * 64 + c0, u); }
        else { const int sr = (int)grow - NTOKP, t = sr & 31, b = sr >> 5; if (t >= 2) st_f8(p.out + O_SCONV + ((size_t)(b * 30 + t - 2)) * 1024 + n * 64 + c0, u); }
      }
    } else if (n < 24) {
#pragma unroll
      for (int j = 0; j < 8; ++j) v[j] = siluf_(v[j]);
      st_bf8(Gc + grow * 1024 + (n - 16) * 128 + c0, v);
    } else if (n < 28) {
      float ss = 0.f;
#pragma unroll
      for (int j = 0; j < 8; ++j) ss += v[j] * v[j];
      ss += __shfl_xor(ss, 1); ss += __shfl_xor(ss, 2); ss += __shfl_xor(ss, 4); ss += __shfl_xor(ss, 8);
      const float rs = rsqrtf(ss * (1.f / 128.f) + EPS);
      const float* g = gx;
#pragma unroll
      for (int j = 0; j < 8; ++j) v[j] = v[j] * rs * g[j] * (0.08838834764831845f * LOG2E);
      st_bf8(p.Qx + grow * 512 + (n - 24) * 128 + c0, v);
    } else {
#pragma unroll
      for (int j = 0; j < 8; ++j) v[j] = siluf_(v[j]);
      st_bf8(p.Gx + grow * 512 + (n - 28) * 128 + c0, v);
    }
  }
}

DEVI void gemm_core(LAS char* lds, const u16* A0, const u16* A1, const u16* A2, int lda0, int lda1, int lda2, int segK,
                    const u16* Bt, int K, int brow, int bcol, f32x16 (&acc)[4][2]) {
  const int tid = threadIdx.x, lane = tid & 63, w = tid >> 6, wr = w >> 1, wc = w & 1, r = lane & 31, h = lane >> 5;
#pragma unroll
  for (int i = 0; i < 4; ++i)
#pragma unroll
    for (int j = 0; j < 2; ++j)
#pragma unroll
      for (int e = 0; e < 16; ++e) acc[i][j][e] = 0.f;
  const int nkt = K / 64;
  auto stage_part = [=](int kt, int buf, int part) __attribute__((always_inline)) {
    const int k0 = kt * 64;
    const int seg = k0 / segK;
    const u16* Ab = (seg == 0 ? A0 : (seg == 1 ? A1 : A2)) + (k0 - seg * segK);
    const int lda = (seg == 0 ? lda0 : (seg == 1 ? lda1 : lda2));
    LAS char* sa = lds + buf * 49152;
    LAS char* sb = sa + 32768;
#pragma unroll
    for (int q = 0; q < 2; ++q) {
      const int i = 2 * part + q;
      const int pch = i * 256 + tid, row = pch >> 3, lg = (pch & 7) ^ ((row >> 1) & 7);
      glds16(Ab + (size_t)(brow + row) * lda + lg * 8, sa + pch * 16);
    }
    {
      const int pch = part * 256 + tid, row = pch >> 3, lg = (pch & 7) ^ ((row >> 1) & 7);
      glds16(Bt + (size_t)(bcol + row) * K + k0 + lg * 8, sb + pch * 16);
    }
  };
  lds_barrier();
#pragma unroll
  for (int part = 0; part < 4; ++part) stage_part(0, 0, part);
#pragma unroll
  for (int part = 0; part < 4; ++part) stage_part(1, 1, part);
  int buf = 0;
  for (int kt = 0; kt < nkt; ++kt) {
    if (kt + 1 < nkt) asm volatile("s_waitcnt vmcnt(12)" ::: "memory"); else asm volatile("s_waitcnt vmcnt(0)" ::: "memory");
    asm volatile("s_waitcnt lgkmcnt(0)" ::: "memory");
    __builtin_amdgcn_s_barrier();
    int nb = buf + 2; if (nb >= 3) nb -= 3;
    const bool more = kt + 2 < nkt;
    const LAS char* sa = lds + buf * 49152;
    const LAS char* sb = sa + 32768;
    bf16x8 af[2][4], bfr[2][2];
#pragma unroll
    for (int i = 0; i < 4; ++i) {
      const int row = 32 * (2 * i + wr) + r, ch = h ^ ((row >> 1) & 7);
      af[0][i] = *reinterpret_cast<const LAS bf16x8*>(sa + row * 128 + ch * 16);
    }
#pragma unroll
    for (int j = 0; j < 2; ++j) {
      const int row = 32 * (2 * j + wc) + r, ch = h ^ ((row >> 1) & 7);
      bfr[0][j] = *reinterpret_cast<const LAS bf16x8*>(sb + row * 128 + ch * 16);
    }
#pragma unroll
    for (int ks = 0; ks < 4; ++ks) {
      const int cur = ks & 1, nxt = cur ^ 1;
      if (ks < 3) {
#pragma unroll
        for (int i = 0; i < 4; ++i) {
          const int row = 32 * (2 * i + wr) + r, ch = (2 * (ks + 1) + h) ^ ((row >> 1) & 7);
          af[nxt][i] = *reinterpret_cast<const LAS bf16x8*>(sa + row * 128 + ch * 16);
        }
#pragma unroll
        for (int j = 0; j < 2; ++j) {
          const int row = 32 * (2 * j + wc) + r, ch = (2 * (ks + 1) + h) ^ ((row >> 1) & 7);
          bfr[nxt][j] = *reinterpret_cast<const LAS bf16x8*>(sb + row * 128 + ch * 16);
        }
      }
#pragma unroll
      for (int i = 0; i < 4; ++i)
#pragma unroll
        for (int j = 0; j < 2; ++j) acc[i][j] = mfma32(af[cur][i], bfr[cur][j], acc[i][j]);
      if (more) stage_part(kt + 2, nb, ks);
    }
    if (++buf == 3) buf = 0;
  }
}

DEVI void stage_all(LAS char* lds, const f32x16 (&acc)[4][2], bool scaled) {
  const int tid = threadIdx.x, lane = tid & 63, w = tid >> 6, wr = w >> 1, wc = w & 1, r = lane & 31, h = lane >> 5;
  const LAS float* RS = (const LAS float*)(lds + 135168);
#pragma unroll
  for (int i = 0; i < 4; ++i) {
    LAS float* Cs = (LAS float*)(lds + (i >> 1) * 67584);
#pragma unroll
    for (int e = 0; e < 16; ++e) {
      const int row = 32 * (2 * (i & 1) + wr) + crow(e, h);
      const float s = scaled ? RS[128 * (i >> 1) + row] : 1.f;
#pragma unroll
      for (int jj = 0; jj < 2; ++jj) Cs[row * 132 + 32 * (2 * jj + wc) + r] = acc[i][jj][e] * s;
    }
  }
}

DEVI void gemm_tile_run(const Params& p, LAS char* lds, int which, int aux, int mt, int n, f32x16 (&acc)[4][2]) {
  const int brow = mt * 256, bcol = n * 128;
  const float* rsc = nullptr; int mode = 0;
  if (which == 0) { gemm_core(lds, p.xb, p.xb, p.xb, 1024, 1024, 1024, 1024, p.WtInA, 1024, brow, bcol, acc); rsc = p.rs0; mode = 1; }
  else if (which == 1) gemm_core(lds, p.Ga, p.Gb, p.Gx, 512, 512, 512, 512, p.WtOutA, 1536, brow, bcol, acc);
  else if (which == 2) { gemm_core(lds, p.xb, p.xb, p.xb, 1024, 1024, 1024, 1024, p.WtInC, 1024, brow, bcol, acc); rsc = p.ssq1; mode = 2; }
  else if (which == 3) gemm_core(lds, p.KaT, p.KaT + 512, p.Gx, 1024, 1024, 512, 512, p.WtOutC, 1536, brow, bcol, acc);
  else { gemm_core(lds, p.memb, p.memb, p.memb, 1024, 1024, 1024, 1024, p.WtMem + (size_t)aux * 1024 * 1024, 1024, brow, bcol, acc); rsc = p.rsmem; mode = 1; }
  lds_barrier();
  if (mode) {
    float sc = rsc[brow + threadIdx.x];
    if (mode == 2) sc = rsqrtf(sc * (1.f / 1024.f) + EPS);
    ((LAS float*)(lds + 135168))[threadIdx.x] = sc;
    lds_barrier();
  }
  if (which == 1 || which == 3) {
    float4 ra0[8], rb0[8], ra1[8], rb1[8];
    load_resid(p, which == 1 ? 0 : 1, brow, n, ra0, rb0);
    load_resid(p, which == 1 ? 0 : 1, brow + 128, n, ra1, rb1);
    stage_all(lds, acc, false);
    lds_barrier();
    epi_out(p, lds, which == 1 ? 0 : 1, brow, n, ra0, rb0);
    epi_out(p, lds + 67584, which == 1 ? 0 : 1, brow + 128, n, ra1, rb1);
    return;
  }
  stage_all(lds, acc, mode != 0);
  lds_barrier();
#pragma unroll 1
  for (int sub = 0; sub < 2; ++sub) {
    LAS char* cs = lds + sub * 67584;
    const int sr = brow + 128 * sub;
    if (which == 0) epi_in_a(p, cs, sr, n);
    else if (which == 2) epi_in_c(p, cs, sr, n);
    else epi_mem(p, cs, aux, sr, n);
  }
}

template <int which>
DEVI void phase_gemm(const Params& p, LAS char* lds) {
  constexpr int nN = (which == 0 ? 45 : (which == 2 ? 32 : 8));
  constexpr int ntiles = 128 * nN;
  const int G = gridDim.x;
  const int xcd = blockIdx.x & 7, lb = blockIdx.x >> 3, slots = G >> 3;
  f32x16 acc[4][2];
  int round = 0, t_extra = blockIdx.x;
  bool main_done = false;
  for (;;) {
    int mt, n;
    if (!main_done) {
      const int q = lb + slots * round; ++round;
      const int L = 32 * (xcd + 8 * (q >> 5)) + (q & 31);
      if (L >= ntiles) { main_done = true; continue; }
      const int mg = L / (4 * nN), rem = L - mg * 4 * nN;
      n = rem >> 2; mt = mg * 4 + (rem & 3);
    } else {
      if (t_extra >= nN) break;
      mt = 128; n = t_extra; t_extra += G;
    }
    gemm_tile_run(p, lds, which, 0, mt, n, acc);
  }
  if (which == 0) {
    for (int t = G - 1 - (int)blockIdx.x; t < 64; t += G) gemm_tile_run(p, lds, 4, t >> 5, (t >> 3) & 3, t & 7, acc);
  }
}

template <bool DIFF>
DEVI void attn_block(LAS char* lds, const u16* Q, const u16* Kg, const u16* VT, int ldv, int j0, int ntiles, int nwact,
                           int qpos0, int nkeys, float slope2, float M2, float lam, const float* subg, u16* G) {
  const int tid = threadIdx.x, lane = tid & 63, w = tid >> 6, r = lane & 31, h = lane >> 5;
  const bool act = w < nwact;
  const int qpos = qpos0 + 32 * w + r;
  const int cw = (qpos0 + 32 * w) >> 6;
  bf16x8 qf[8];
#pragma unroll
  for (int i = 0; i < 8; ++i) qf[i] = ldg8(Q + (size_t)(32 * w + r) * 512 + 16 * i + 8 * h);
  f32x16 O0[4], O1[4];
#pragma unroll
  for (int e = 0; e < 4; ++e)
#pragma unroll
    for (int i = 0; i < 16; ++i) { O0[e][i] = 0.f; O1[e][i] = 0.f; }
  float l0 = 0.f, l1 = 0.f;
  f32x16 cinit, zero16;
#pragma unroll
  for (int i = 0; i < 16; ++i) { cinit[i] = slope2 * (float)klocal(i, h); zero16[i] = 0.f; }
  const float tq = -slope2 * (float)qpos - M2;
  const int prow = pi32(r);

  auto stage = [=](int j, int buf) __attribute__((always_inline)) {
    LAS char* kb = lds + buf * 32768;
#pragma unroll
    for (int i = 0; i < 4; ++i) {
      const int pch = i * 256 + tid;
      { const int row = pch >> 4, ph = pch & 15, lg = ph ^ (row & 15);
        glds16(Kg + (size_t)(j * 64 + row) * 512 + lg * 8, kb + pch * 16); }
      { const int row = pch >> 3, ph = pch & 7, lg = ph ^ ((row >> 1) & 7);
        glds16(VT + (size_t)row * ldv + j * 64 + lg * 8, kb + 16384 + pch * 16); }
    }
  };
  __syncthreads();
  stage(j0, 0);
  asm volatile("s_waitcnt vmcnt(0)" ::: "memory");
  __syncthreads();
  for (int j = j0; j < ntiles; ++j) {
    const int buf = (j - j0) & 1;
    if (j + 1 < ntiles) stage(j + 1, buf ^ 1);
    {
      const LAS char* kb = lds + buf * 32768;
      const LAS char* vb = kb + 16384;
      const bool fast = DIFF && (j < cw);
#pragma unroll
      for (int kt = 0; kt < 2; ++kt) {
        const int krow = 32 * kt + prow;
        const LAS char* krp = kb + krow * 256;
        bf16x8 P0[2], P1[2];
        if (DIFF) {
#pragma unroll
          for (int c = 0; c < 2; ++c) {
            f32x16 s;
            if (fast) {
              s = cinit;
#pragma unroll
              for (int ks = 0; ks < 4; ++ks) {
                const int ch = (2 * (4 * c + ks) + h) ^ (krow & 15);
                s = mfma32(*reinterpret_cast<const LAS bf16x8*>(krp + ch * 16), qf[4 * c + ks], s);
              }
              const float t = tq + slope2 * (float)(j * 64 + kt * 32);
#pragma unroll
              for (int i = 0; i < 16; ++i) s[i] = __builtin_amdgcn_exp2f(s[i] + t);
            } else {
              s = zero16;
#pragma unroll
              for (int ks = 0; ks < 4; ++ks) {
                const int ch = (2 * (4 * c + ks) + h) ^ (krow & 15);
                s = mfma32(*reinterpret_cast<const LAS bf16x8*>(krp + ch * 16), qf[4 * c + ks], s);
              }
#pragma unroll
              for (int i = 0; i < 16; ++i) {
                const int kp = j * 64 + kt * 32 + klocal(i, h);
                const float bias = -slope2 * fabsf((float)(qpos - kp)) - M2;
                s[i] = (kp < nkeys && j <= cw) ? __builtin_amdgcn_exp2f(s[i] + bias) : 0.f;
              }
            }
            float ls = 0.f;
#pragma unroll
            for (int i = 0; i < 16; ++i) ls += s[i];
            if (c == 0) { l0 += ls; P0[0] = pack8(s, 0); P0[1] = pack8(s, 1); }
            else        { l1 += ls; P1[0] = pack8(s, 0); P1[1] = pack8(s, 1); }
          }
        } else {
          f32x16 s = zero16;
#pragma unroll
          for (int ks = 0; ks < 8; ++ks) {
            const int ch = (2 * ks + h) ^ (krow & 15);
            s = mfma32(*reinterpret_cast<const LAS bf16x8*>(krp + ch * 16), qf[ks], s);
          }
          float ls = 0.f;
#pragma unroll
          for (int i = 0; i < 16; ++i) { s[i] = __builtin_amdgcn_exp2f(s[i] - M2); ls += s[i]; }
          l0 += ls; P0[0] = pack8(s, 0); P0[1] = pack8(s, 1);
        }
#pragma unroll
        for (int et = 0; et < 4; ++et) {
          const int vrow = 32 * et + r;
#pragma unroll
          for (int sp = 0; sp < 2; ++sp) {
            const int ch = (2 * (2 * kt + sp) + h) ^ ((vrow >> 1) & 7);
            const bf16x8 vf = *reinterpret_cast<const LAS bf16x8*>(vb + vrow * 128 + ch * 16);
            O0[et] = mfma32(vf, P0[sp], O0[et]);
            if (DIFF) O1[et] = mfma32(vf, P1[sp], O1[et]);
          }
        }
      }
    }
    asm volatile("s_waitcnt vmcnt(0)" ::: "memory");
    __syncthreads();
  }
  if (act) {
    l0 += __shfl_xor(l0, 32);
    const float i0 = 1.f / l0;
    float i1 = 0.f;
    if (DIFF) { l1 += __shfl_xor(l1, 32); i1 = lam / l1; }
    float ss = 0.f;
#pragma unroll
    for (int et = 0; et < 4; ++et)
#pragma unroll
      for (int i = 0; i < 16; ++i) {
        float o = O0[et][i] * i0;
        if (DIFF) o -= O1[et][i] * i1;
        O0[et][i] = o; ss += o * o;
      }
    float rs = 1.f;
    if (DIFF) { ss += __shfl_xor(ss, 32); rs = rsqrtf(ss * (1.f / 128.f) + EPS) * 0.8f; }
    u16* grow = G + (size_t)(32 * w + r) * 512;
    u32x2 gt[16]; float4 sv[16];
#pragma unroll
    for (int q = 0; q < 16; ++q) {
      const int e0 = 32 * (q >> 2) + 8 * (q & 3) + 4 * h;
      gt[q] = *reinterpret_cast<const u32x2*>(grow + e0);
      if (DIFF) sv[q] = *reinterpret_cast<const float4*>(subg + e0); else sv[q] = float4{1.f, 1.f, 1.f, 1.f};
    }
#pragma unroll
    for (int q = 0; q < 16; ++q) {
      const int et = q >> 2, g = q & 3;
      const int e0 = 32 * et + 8 * g + 4 * h;
      const float a0 = O0[et][4 * g + 0] * rs * sv[q].x * bflo(gt[q][0]);
      const float a1 = O0[et][4 * g + 1] * rs * sv[q].y * bfhi(gt[q][0]);
      const float a2 = O0[et][4 * g + 2] * rs * sv[q].z * bflo(gt[q][1]);
      const float a3 = O0[et][4 * g + 3] * rs * sv[q].w * bfhi(gt[q][1]);
      u32x2 o = {cvtpk(a0, a1), cvtpk(a2, a3)};
      *reinterpret_cast<u32x2*>(grow + e0) = o;
    }
  }
}

DEVI float max_abs64(const float* g, int n, int lane) { float v = 0.f; for (int i = lane; i < n; i += 64) v = fmaxf(v, fabsf(g[i])); return wmax(v); }

DEVI float scan_add(float v, int lane) { for (int o = 1; o < 64; o <<= 1) { const float t = __shfl_up(v, o); if (lane >= o) v += t; } return v; }
DEVI float scan_max(float v, int lane) { for (int o = 1; o < 64; o <<= 1) { const float t = __shfl_up(v, o); if (lane >= o) v = fmaxf(v, t); } return v; }
DEVI float bfe(const bf16x8& v, int j) { return __uint_as_float(((unsigned)(u16)v[j]) << 16); }

template <int NT>
DEVI void mlstm_local(LAS char* lds, const float* gates, int hd, const u16* KT, const u16* VT, int ldt,
                            f32x16 (&acc)[4], float& nh, float& bL, float& amax) {
  const int tid = threadIdx.x, lane = tid & 63, w = tid >> 6, r = lane & 31, h = lane >> 5;
  constexpr int L = 32 * NT;
  const float lf = lane < L ? gates[lane * 8 + 4 + hd] : 0.f;
  const float ig = lane < L ? gates[lane * 8 + hd] : -INFINITY;
  const float b = scan_add(lf, lane);
  const float a = ig - b;
  amax = wmax(a);
  bL = __shfl(b, L - 1);
  LAS float* wt = (LAS float*)(lds + 4096) + w * 64;
  wt[lane] = __expf(a - amax);
#pragma unroll
  for (int e = 0; e < 4; ++e)
#pragma unroll
    for (int i = 0; i < 16; ++i) acc[e][i] = 0.f;
  nh = 0.f;
#pragma unroll
  for (int ks = 0; ks < 2 * NT; ++ks) {
    const bf16x8 kf = ldg8(KT + (size_t)(32 * w + r) * ldt + 16 * ks + 8 * h);
    float wv[8];
#pragma unroll
    for (int j = 0; j < 8; ++j) { wv[j] = wt[16 * ks + 8 * h + j]; nh += bfe(kf, j) * wv[j]; }
#pragma unroll
    for (int et = 0; et < 4; ++et) {
      const bf16x8 vf = ldg8(VT + (size_t)(32 * et + r) * ldt + 16 * ks + 8 * h);
      u32x4 sv = {cvtpk(bfe(vf, 0) * wv[0], bfe(vf, 1) * wv[1]), cvtpk(bfe(vf, 2) * wv[2], bfe(vf, 3) * wv[3]),
                  cvtpk(bfe(vf, 4) * wv[4], bfe(vf, 5) * wv[5]), cvtpk(bfe(vf, 6) * wv[6], bfe(vf, 7) * wv[7])};
      acc[et] = mfma32(kf, *reinterpret_cast<bf16x8*>(&sv), acc[et]);
    }
  }
  nh += __shfl_xor(nh, 32);
}

template <int NT>
DEVI void mlstm_out(LAS char* lds, const float* gates, int hd, const u16* Qg, const u16* Kg, const u16* VT, int ldv,
                          const u16* CT, const float* n0, float m0, const float* mg, u16* G) {
  const int tid = threadIdx.x, lane = tid & 63, w = tid >> 6, r = lane & 31, h = lane >> 5;
  constexpr int L = 32 * NT;
  const float lf = lane < L ? gates[lane * 8 + 4 + hd] : 0.f;
  const float ig = lane < L ? gates[lane * 8 + hd] : -INFINITY;
  const float b = scan_add(lf, lane);
  const float a = ig - b;
  const float Mrow = fmaxf(m0, scan_max(a, lane));
  const float mt = b + Mrow;
  LAS float* at = (LAS float*)lds + w * 64;
  LAS float* red = (LAS float*)(lds + 1024);
  at[lane] = a;
  const int prow = pi32(r);
#pragma unroll 1
  for (int tt = 0; tt < NT; ++tt) {
    const int t = 32 * tt + r;
    const float Mrow_t = __shfl(Mrow, t), mt_t = __shfl(mt, t);
    const float winter = __expf(m0 - Mrow_t);
    bf16x8 qf[8];
    float qn = 0.f;
#pragma unroll
    for (int i = 0; i < 8; ++i) {
      qf[i] = ldg8(Qg + (size_t)t * 512 + 16 * i + 8 * h);
      const float4 na = *reinterpret_cast<const float4*>(n0 + 16 * i + 8 * h), nb = *reinterpret_cast<const float4*>(n0 + 16 * i + 8 * h + 4);
      qn += bfe(qf[i], 0) * na.x + bfe(qf[i], 1) * na.y + bfe(qf[i], 2) * na.z + bfe(qf[i], 3) * na.w
          + bfe(qf[i], 4) * nb.x + bfe(qf[i], 5) * nb.y + bfe(qf[i], 6) * nb.z + bfe(qf[i], 7) * nb.w;
    }
    qn += __shfl_xor(qn, 32);
    f32x16 H;
#pragma unroll
    for (int i = 0; i < 16; ++i) H[i] = 0.f;
#pragma unroll
    for (int ks = 0; ks < 8; ++ks) H = mfma32(ldg8(CT + (size_t)(32 * w + r) * 128 + 16 * ks + 8 * h), qf[ks], H);
#pragma unroll
    for (int i = 0; i < 16; ++i) H[i] *= winter;
    float dsum = 0.f;
    for (int st = 0; st <= tt; ++st) {
      f32x16 S;
#pragma unroll
      for (int i = 0; i < 16; ++i) S[i] = 0.f;
#pragma unroll
      for (int ks = 0; ks < 8; ++ks) S = mfma32(ldg8(Kg + (size_t)(32 * st + prow) * 512 + 16 * ks + 8 * h), qf[ks], S);
#pragma unroll
      for (int i = 0; i < 16; ++i) {
        const int s = 32 * st + klocal(i, h);
        const float wg = (s <= t) ? __expf(at[s] - Mrow_t) : 0.f;
        S[i] *= wg; dsum += S[i];
      }
#pragma unroll
      for (int sp = 0; sp < 2; ++sp)
        H = mfma32(ldg8(VT + (size_t)(32 * w + r) * ldv + 32 * st + 16 * sp + 8 * h), pack8(S, sp), H);
    }
    dsum += __shfl_xor(dsum, 32);
    const float den = winter * qn + dsum;
    const float inv = 1.f / fmaxf(fabsf(den), __expf(-mt_t));
    float ss = 0.f;
#pragma unroll
    for (int i = 0; i < 16; ++i) { H[i] *= inv; ss += H[i] * H[i]; }
    ss += __shfl_xor(ss, 32);
    if (h == 0) red[w * 64 + t] = ss;
    __syncthreads();
    const float tot = red[t] + red[64 + t] + red[128 + t] + red[192 + t];
    const float rs = rsqrtf(tot * (1.f / 128.f) + EPS);
    u16* grow = G + (size_t)t * 512;
    u32x2 gt[4]; float4 mv[4];
#pragma unroll
    for (int g = 0; g < 4; ++g) {
      const int e0 = 32 * w + 8 * g + 4 * h;
      gt[g] = *reinterpret_cast<const u32x2*>(grow + e0);
      mv[g] = *reinterpret_cast<const float4*>(mg + e0);
    }
#pragma unroll
    for (int g = 0; g < 4; ++g) {
      const int e0 = 32 * w + 8 * g + 4 * h;
      u32x2 o = {cvtpk(H[4 * g + 0] * rs * mv[g].x * bflo(gt[g][0]), H[4 * g + 1] * rs * mv[g].y * bfhi(gt[g][0])),
                 cvtpk(H[4 * g + 2] * rs * mv[g].z * bflo(gt[g][1]), H[4 * g + 3] * rs * mv[g].w * bfhi(gt[g][1]))};
      *reinterpret_cast<u32x2*>(grow + e0) = o;
    }
    __syncthreads();
  }
}

DEVI void m1_item(const Params& p, LAS char* lds, int item) {
  const int tid = threadIdx.x, lane = tid & 63, w = tid >> 6, r = lane & 31, h = lane >> 5;
  const int bh = item >> 7, c = item & 127, b = bh >> 2, hd = bh & 3;
  const size_t row0 = (size_t)b * SEQ + c * 64;
  f32x16 acc[4]; float nh, bL, amax;
  __syncthreads();
  mlstm_local<2>(lds, p.gates + row0 * 8, hd, p.KaT + (size_t)bh * 128 * SEQ + c * 64, p.VaT + (size_t)bh * 128 * SEQ + c * 64, SEQ, acc, nh, bL, amax);
  u16* Chat = p.xb + ((size_t)item * 128) * 128;
#pragma unroll
  for (int et = 0; et < 4; ++et)
#pragma unroll
    for (int g = 0; g < 4; ++g) {
      const int d0 = 32 * w + 8 * g + 4 * h, e = 32 * et + r;
      u32x2 o = {cvtpk(acc[et][4 * g], acc[et][4 * g + 1]), cvtpk(acc[et][4 * g + 2], acc[et][4 * g + 3])};
      *reinterpret_cast<u32x2*>(Chat + (size_t)e * 128 + d0) = o;
    }
  if (h == 0) p.nhat[(size_t)item * 128 + 32 * w + r] = nh;
  if (tid == 0) { p.tabA[item] = bL; p.tabB[item] = bL + amax; }
}

DEVI void phase_scan(const Params& p, LAS char* lds) {
  const int tid = threadIdx.x, lane = tid & 63;
  LAS float* al = (LAS float*)lds; LAS float* be = al + 128; LAS float* ms = al + 256;
  for (int u = blockIdx.x; u < 16 * 32; u += gridDim.x) {
    const int bh = u >> 5, part = u & 31;
    __syncthreads();
    if (tid < 64) {
      const float A0 = p.tabA[bh * 128 + 2 * lane], A1 = p.tabA[bh * 128 + 2 * lane + 1];
      const float B0 = p.tabB[bh * 128 + 2 * lane], B1 = p.tabB[bh * 128 + 2 * lane + 1];
      const float SAi = scan_add(A0 + A1, lane);
      const float SA0 = SAi - A1, SA1 = SAi;
      const float D0 = B0 - SA0, D1 = B1 - SA1;
      const float PMi = scan_max(fmaxf(D0, D1), lane);
      float PMx = __shfl_up(PMi, 1); if (lane == 0) PMx = -INFINITY;
      const float mn0 = SA0 + fmaxf(0.f, fmaxf(PMx, D0));
      const float mn1 = SA1 + fmaxf(0.f, PMi);
      float mprev = __shfl_up(mn1, 1); if (lane == 0) mprev = 0.f;
      al[2 * lane] = __expf(A0 + mprev - mn0); be[2 * lane] = __expf(B0 - mn0);
      al[2 * lane + 1] = __expf(A1 + mn0 - mn1); be[2 * lane + 1] = __expf(B1 - mn1);
      ms[2 * lane] = mprev; ms[2 * lane + 1] = mn0;
      if (lane == 63) ms[128] = mn1;
    }
    __syncthreads();
    if (part == 0) {
      if (tid < 129) p.mtab[bh * 129 + tid] = ms[tid];
      if (tid == 0) p.out[O_PM + bh] = ms[128];
    }
    u16* base = p.xb + (size_t)bh * 128 * 16384 + part * 512 + tid * 2;
    float c0 = 0.f, c1 = 0.f;
    for (int c = 0; c < 128; c += 8) {
      unsigned v[8];
#pragma unroll
      for (int j = 0; j < 8; ++j) v[j] = *reinterpret_cast<const unsigned*>(base + (size_t)(c + j) * 16384);
#pragma unroll
      for (int j = 0; j < 8; ++j) {
        *reinterpret_cast<unsigned*>(base + (size_t)(c + j) * 16384) = cvtpk(c0, c1);
        const float a_ = al[c + j], b_ = be[c + j];
        c0 = a_ * c0 + b_ * bflo(v[j]); c1 = a_ * c1 + b_ * bfhi(v[j]);
      }
    }
    { const int idx = part * 512 + tid * 2, e = idx >> 7, d = idx & 127;
      p.out[O_PC + ((size_t)bh * 128 + d) * 128 + e] = c0;
      p.out[O_PC + ((size_t)bh * 128 + d + 1) * 128 + e] = c1; }
    if (part == 0 && tid < 128) {
      float n = 0.f;
      for (int c = 0; c < 128; c += 16) {
        float nv[16];
#pragma unroll
        for (int j = 0; j < 16; ++j) nv[j] = p.nhat[((size_t)bh * 128 + c + j) * 128 + tid];
#pragma unroll
        for (int j = 0; j < 16; ++j) {
          p.nstate[((size_t)bh * 128 + c + j) * 128 + tid] = n;
          n = al[c + j] * n + be[c + j] * nv[j];
        }
      }
      p.out[O_PN + bh * 128 + tid] = n;
    }
  }
}

DEVI void m3_item(const Params& p, LAS char* lds, int item) {
  const int bh = item >> 7, c = item & 127, b = bh >> 2, hd = bh & 3;
  const size_t row0 = (size_t)b * SEQ + c * 64;
  __syncthreads();
  mlstm_out<2>(lds, p.gates + row0 * 8, hd, p.Qa + row0 * 512 + hd * 128, p.Ka + row0 * 512 + hd * 128,
               p.VaT + (size_t)bh * 128 * SEQ + c * 64, SEQ, p.xb + (size_t)item * 16384, p.nstate + (size_t)item * 128,
               p.mtab[bh * 129 + c], p.in[15] + hd * 128, p.Ga + row0 * 512 + hd * 128);
}

DEVI void ms_item(const Params& p, LAS char* lds, int bh) {
  const int tid = threadIdx.x, lane = tid & 63, w = tid >> 6, r = lane & 31, h = lane >> 5;
  const int b = bh >> 2, hd = bh & 3;
  const size_t row0 = (size_t)NTOKP + b * 32;
  const float m0 = p.in[9][bh];
  const float* n0 = p.in[8] + bh * 128;
  const u16* KTs = p.KaT + (size_t)NTOKP * 512 + (size_t)bh * 128 * 32;
  const u16* VTs = p.VaT + (size_t)NTOKP * 512 + (size_t)bh * 128 * 32;
  __syncthreads();
  mlstm_out<1>(lds, p.gates + row0 * 8, hd, p.Qa + row0 * 512 + hd * 128, p.Ka + row0 * 512 + hd * 128, VTs, 32,
               p.C0sT + (size_t)bh * 16384, n0, m0, p.in[15] + hd * 128, p.Ga + row0 * 512 + hd * 128);
  f32x16 acc[4]; float nh, bL, amax;
  mlstm_local<1>(lds, p.gates + row0 * 8, hd, KTs, VTs, 32, acc, nh, bL, amax);
  const float mlast = bL + fmaxf(m0, amax);
  const float decay = __expf(bL + m0 - mlast), beta = __expf(bL + amax - mlast);
#pragma unroll
  for (int et = 0; et < 4; ++et)
#pragma unroll
    for (int i = 0; i < 16; ++i) {
      const int d = 32 * w + crow(i, h), e = 32 * et + r;
      const size_t o = ((size_t)bh * 128 + d) * 128 + e;
      p.out[O_SC + o] = decay * p.in[7][o] + beta * acc[et][i];
    }
  if (h == 0) { const int d = 32 * w + r; p.out[O_SN + bh * 128 + d] = decay * n0[d] + beta * nh; }
  if (tid == 0) p.out[O_SM + bh] = mlast;
}

DEVI void phase_conv(const Params& p, LAS char* lds) {
  const int tid = threadIdx.x, lane = tid & 63, w = tid >> 6;
  const u16* U = p.Qa; u16* Gc = p.KaT;
  LAS u16* win = (LAS u16*)lds;
  LAS float* cs = (LAS float*)(lds + 40960);
  LAS float* st = (LAS float*)(lds + 40960 + 32768);
  float cw[4][31], cb[4], lg[4], lb[4];
#pragma unroll
  for (int c = 0; c < 4; ++c) {
    const int chn = c * 256 + tid;
#pragma unroll
    for (int j = 0; j < 31; ++j) cw[c][j] = p.in[25][j * 1024 + chn];
    cb[c] = p.in[26][chn]; lg[c] = p.in[27][chn]; lb[c] = p.in[28][chn];
  }
  const int ntile = NTOK / 8;
  auto fetch = [=](int tile, int cgp, u32x4 (&rg)[5]) __attribute__((always_inline)) {
    const int row0 = tile * 8;
    const bool samp = row0 >= NTOKP;
    const int t0 = samp ? ((row0 - NTOKP) & 31) : (row0 & 8191);
    const int bs = samp ? ((row0 - NTOKP) >> 5) : 0;
    const int seqbase = row0 - t0;
#pragma unroll
    for (int q = 0; q < 5; ++q) {
      const int pch = tid + 256 * q, rr = pch >> 5, ch = pch & 31, t = t0 - 30 + rr;
      u32x4 v = {0, 0, 0, 0};
      if (pch < 38 * 32) {
        if (t >= 0) v = *reinterpret_cast<const u32x4*>(U + (size_t)(seqbase + t) * 1024 + cgp * 256 + ch * 8);
        else if (samp) {
          const float4* sc = reinterpret_cast<const float4*>(p.in[10] + ((size_t)(bs * 30 + 30 + t)) * 1024 + cgp * 256 + ch * 8);
          const float4 a = sc[0], c = sc[1];
          v = u32x4{cvtpk(a.x, a.y), cvtpk(a.z, a.w), cvtpk(c.x, c.y), cvtpk(c.z, c.w)};
        }
      }
      rg[q] = v;
    }
  };
  auto commit = [=](int buf, const u32x4 (&rg)[5]) __attribute__((always_inline)) {
#pragma unroll
    for (int q = 0; q < 5; ++q) {
      const int pch = tid + 256 * q;
      if (pch < 38 * 32) *reinterpret_cast<LAS u32x4*>(win + buf * (38 * 256) + (pch >> 5) * 256 + (pch & 31) * 8) = rg[q];
    }
  };
  int tile = blockIdx.x;
  if (tile >= ntile) return;
  u32x4 rg[5];
  __syncthreads();
  fetch(tile, 0, rg);
  commit(0, rg);
  __syncthreads();
  for (; tile < ntile; tile += gridDim.x) {
    const int row0 = tile * 8;
    const int ntl = tile + gridDim.x;
#pragma unroll
    for (int cgp = 0; cgp < 4; ++cgp) {
      const bool more = (cgp < 3) || (ntl < ntile);
      if (more) fetch(cgp < 3 ? tile : ntl, cgp < 3 ? cgp + 1 : 0, rg);
      const LAS u16* wb = win + (cgp & 1) * (38 * 256);
      float wv[38];
#pragma unroll
      for (int rr = 0; rr < 38; ++rr) wv[rr] = bf2f(wb[rr * 256 + tid]);
#pragma unroll
      for (int i = 0; i < 8; ++i) {
        float a = cb[cgp];
#pragma unroll
        for (int j = 0; j < 31; ++j) a += cw[cgp][j] * wv[i + j];
        cs[i * 1024 + cgp * 256 + tid] = a;
      }
      if (more) commit((cgp + 1) & 1, rg);
      __syncthreads();
    }
    u16 gv[4][8];
#pragma unroll
    for (int c = 0; c < 4; ++c)
#pragma unroll
      for (int i = 0; i < 8; ++i) gv[c][i] = Gc[(size_t)(row0 + i) * 1024 + c * 256 + tid];
#pragma unroll
    for (int q = 0; q < 2; ++q) {
      const int i = 2 * w + q;
      float a1 = 0.f, a2 = 0.f;
#pragma unroll
      for (int k = 0; k < 16; ++k) { const float v = cs[i * 1024 + lane + 64 * k]; a1 += v; a2 += v * v; }
      a1 = wsum(a1); a2 = wsum(a2);
      if (lane == 0) {
        const float mu = a1 * (1.f / 1024.f);
        const float var = fmaxf(a2 * (1.f / 1024.f) - mu * mu, 0.f);
        st[2 * i] = mu; st[2 * i + 1] = rsqrtf(var + EPS);
      }
    }
    __syncthreads();
#pragma unroll
    for (int c = 0; c < 4; ++c) {
      const int chn = c * 256 + tid;
#pragma unroll
      for (int i = 0; i < 8; ++i) {
        const float y = (cs[i * 1024 + chn] - st[2 * i]) * st[2 * i + 1] * lg[c] + lb[c];
        Gc[(size_t)(row0 + i) * 1024 + chn] = f2bf(siluf_(y) * bf2f(gv[c][i]));
      }
    }
    __syncthreads();
  }
}

struct AttnConst { float M2d, M2x, lam; };
DEVI AttnConst attn_consts(const Params& p, int layer) {
  const int lane = threadIdx.x & 63;
  AttnConst c;
  const float gq = max_abs64(p.in[16], 64, lane), gk = max_abs64(p.in[17], 64, lane);
  float kd = 0.f, kx = 0.f;
  for (int i = lane; i < (int)gridDim.x * 4; i += 64) { kd = fmaxf(kd, p.kmaxp[i]); kx = fmaxf(kx, p.kmaxp[1024 * (1 + layer) + i]); }
  kd = wmax(kd); kx = wmax(kx);
  c.M2d = (8.f * gq * 0.125f * LOG2E) * fmaxf(8.f * gk, sqrtf(kd)) * 1.01f;
  const float xq = max_abs64(p.in[32] + layer * 128, 128, lane), xk = max_abs64(p.in[33] + layer * 128, 128, lane);
  c.M2x = (11.313708f * xq * 0.08838834764831845f * LOG2E) * fmaxf(11.313708f * xk, sqrtf(kx)) * 1.01f;
  float d1 = p.in[18][lane] * p.in[19][lane], d2 = p.in[20][lane] * p.in[21][lane];
  d1 = wsum(d1); d2 = wsum(d2);
  c.lam = __expf(d1) - __expf(d2) + 0.2f;
  return c;
}

DEVI void cross_item(const Params& p, LAS char* lds, int layer, int it, float M2x) {
  const int hd = it & 3;
  size_t row0; int mb, nw;
  if (it < 1024) { const int rb = it >> 2; row0 = (size_t)rb * 128; mb = rb >> 6; nw = 4; }
  else { const int bs = (it - 1024) >> 2; row0 = (size_t)NTOKP + bs * 32; mb = 4 + bs; nw = 1; }
  attn_block<false>(lds, p.Qx + row0 * 512 + hd * 128, p.XK + ((size_t)(layer * 12 + mb) * 256) * 512 + hd * 128,
                    p.XVT + ((size_t)((layer * 12 + mb) * 4 + hd) * 128) * 256, 256, 0, 4, nw, 0, 256, 0.f, M2x, 0.f, nullptr,
                    p.Gx + row0 * 512 + hd * 128);
}

DEVI void diff_item(const Params& p, LAS char* lds, int it, float M2d, float lam) {
  const bool pr = it < 1024;
  const int hd = pr ? 3 - (it >> 8) : (it - 1024) & 3;
  const int qb = pr ? 63 - ((it >> 2) & 63) : 0;
  const int b = pr ? (it & 3) : (it - 1024) >> 2;
  const int bh = b * 4 + hd;
  const size_t row0 = pr ? (size_t)b * SEQ + qb * 128 : (size_t)NTOKP + b * 32;
  const float slope2 = exp2f(-2.f * (hd + 1)) * LOG2E;
  const u16* Kp = pr ? p.Kb + (size_t)b * SEQ * 512 + hd * 128 : p.Ks + (size_t)b * SKP * 512 + hd * 128;
  const u16* Vp = pr ? p.VbT + (size_t)bh * 128 * SEQ : p.VsT + (size_t)bh * 128 * SKP;
  const int qpos0 = pr ? qb * 128 : PAST;
  const float kcut = (float)qpos0 - (2.f * M2d + 64.f) / slope2;
  int j0 = (int)floorf((kcut - 63.f) * (1.f / 64.f));
  j0 = max(j0, 0);
  attn_block<true>(lds, p.Qb + row0 * 512 + hd * 128, Kp, Vp, pr ? SEQ : SKP, j0, pr ? 2 * qb + 2 : 33, pr ? 4 : 1,
                   qpos0, pr ? SEQ : PAST + 32, slope2, M2d, lam, p.in[22], p.Gb + row0 * 512 + hd * 128);
}

DEVI int snake(int k, int g, int G) { return (k & 1) ? (k * G + (G - 1 - g)) : (k * G + g); }

constexpr int NPHASE = 9;
DEVI void run_phase(const Params& p, LAS char* lds, int ph) {
  const int G = gridDim.x, g = blockIdx.x;
  switch (ph) {
    case 0: phase_prep(p); break;
    case 1: phase_gemm<0>(p, lds); break;
    case 2: {
      const AttnConst c = attn_consts(p, 0);
      for (int it = g; it < 1056; it += G) cross_item(p, lds, 0, it, c.M2x);
      for (int it = g; it < 2048; it += G) m1_item(p, lds, it);
    } break;
    case 3: {
      const AttnConst c = attn_consts(p, 0);
      (void)c;
      phase_scan(p, lds);
    } break;
    case 4: {
      const AttnConst c = attn_consts(p, 0);
      unsigned* qhead = reinterpret_cast<unsigned*>(p.kmaxp + 3 * 1024) + 16;
      volatile LAS int* slot = (volatile LAS int*)(lds + LDS_BYTES - 16);
      for (;;) {
        __syncthreads();
        if (threadIdx.x == 0) *slot = (int)__hip_atomic_fetch_add(qhead, 1u, __ATOMIC_RELAXED, __HIP_MEMORY_SCOPE_AGENT);
        __syncthreads();
        const int it = *slot;
        if (it >= 1056) break;
        diff_item(p, lds, it, c.M2d, c.lam);
      }
      for (;;) {
        __syncthreads();
        if (threadIdx.x == 0) *slot = (int)__hip_atomic_fetch_add(qhead + 16, 1u, __ATOMIC_RELAXED, __HIP_MEMORY_SCOPE_AGENT);
        __syncthreads();
        const int it = *slot;
        if (it >= 2048) break;
        m3_item(p, lds, it);
      }
      for (int it = G - 1 - g; it < 32; it += G) ms_item(p, lds, it);
    } break;
    case 5: phase_gemm<1>(p, lds); break;
    case 6: phase_gemm<2>(p, lds); break;
    case 7: {
      const AttnConst c = attn_consts(p, 1);
      phase_conv(p, lds);
      for (int it = g; it < 1056; it += G) cross_item(p, lds, 1, it, c.M2x);
    } break;
    case 8: phase_gemm<3>(p, lds); break;
  }
}

DEVI void grid_bar(unsigned* ctr, unsigned& epoch) {
  asm volatile("s_waitcnt vmcnt(0)" ::: "memory");
  __syncthreads();
  if (threadIdx.x == 0) {
    __builtin_amdgcn_fence(__ATOMIC_RELEASE, "agent");
    asm volatile("s_waitcnt vmcnt(0)" ::: "memory");
    __hip_atomic_fetch_add(ctr, 1u, __ATOMIC_RELAXED, __HIP_MEMORY_SCOPE_AGENT);
    epoch += 1u;
    const unsigned target = epoch * gridDim.x;
    while (__hip_atomic_load(ctr, __ATOMIC_RELAXED, __HIP_MEMORY_SCOPE_AGENT) < target) __builtin_amdgcn_s_sleep(1);
    __builtin_amdgcn_fence(__ATOMIC_ACQUIRE, "agent");
    asm volatile("s_waitcnt vmcnt(0)" ::: "memory");
  }
  __syncthreads();
}

__global__ void __launch_bounds__(256, 1) mega(Params p, int ph_lo, int ph_hi) {
  extern __shared__ __attribute__((aligned(16))) char smem[];
  LAS char* lds = (LAS char*)smem;
  cg::grid_group grid = cg::this_grid();
  unsigned epoch = 0;
  unsigned* ctr = reinterpret_cast<unsigned*>(p.kmaxp + 3 * 1024);
#define RUNPH(k) if (ph_lo <= (k) && (k) < ph_hi) { if ((k) > ph_lo) { if ((k) == 1) grid.sync(); else grid_bar(ctr, epoch); } run_phase(p, lds, (k)); }
  RUNPH(0) RUNPH(1) RUNPH(2) RUNPH(3) RUNPH(4) RUNPH(5) RUNPH(6) RUNPH(7) RUNPH(8)
#undef RUNPH
}

#ifndef MULTI_LAUNCH
#define MULTI_LAUNCH 0
#endif

extern "C" void kernel_launch(void* const* d_in, const int* in_sizes, int n_in, void* d_out, int out_size, void* d_ws, size_t ws_size,
                              hipStream_t stream) {
  static int grid_blocks = 0;
  if (!grid_blocks) {
    int dev = 0, cus = 0, per_cu = 0;
    hipGetDevice(&dev);
    hipDeviceGetAttribute(&cus, hipDeviceAttributeMultiprocessorCount, dev);
    hipFuncSetAttribute((const void*)mega, hipFuncAttributeMaxDynamicSharedMemorySize, LDS_BYTES);
    hipOccupancyMaxActiveBlocksPerMultiprocessor(&per_cu, (const void*)mega, 256, LDS_BYTES);
    if (per_cu < 1) per_cu = 1;
    if (per_cu > 1) per_cu = 1;
    grid_blocks = (cus * per_cu) & ~7;
    if (grid_blocks < 8) grid_blocks = 8;
  }
  Params p{};
  for (int i = 0; i < 34; ++i) p.in[i] = (const float*)d_in[i];
  p.out = (float*)d_out;
  char* ws = (char*)d_ws;
  size_t off = 0;
  auto take = [&](size_t bytes) { char* q = ws + off; off += (bytes + 255) & ~(size_t)255; return q; };
  p.WtInA = (u16*)take((size_t)NPAD_A * 1024 * 2);
  p.WtOutA = (u16*)take((size_t)1024 * 1536 * 2);
  p.WtInC = (u16*)take((size_t)4096 * 1024 * 2);
  p.WtOutC = (u16*)take((size_t)1024 * 1536 * 2);
  p.WtMem = (u16*)take((size_t)2 * 1024 * 1024 * 2);
  p.xb = (u16*)take((size_t)NTOK * 1024 * 2);
  p.memb = (u16*)take((size_t)1024 * 1024 * 2);
  u16* segs = (u16*)take(SEG * 2 * 11);
  p.Qa = segs; p.Ka = segs + SEG; p.KaT = segs + 2 * SEG; p.VaT = segs + 3 * SEG; p.Ga = segs + 4 * SEG; p.Qb = segs + 5 * SEG;
  p.Kb = segs + 6 * SEG; p.VbT = segs + 7 * SEG; p.Gb = segs + 8 * SEG; p.Qx = segs + 9 * SEG; p.Gx = segs + 10 * SEG;
  p.Ks = (u16*)take((size_t)8 * SKP * 512 * 2);
  p.VsT = (u16*)take((size_t)4096 * SKP * 2);
  p.XK = (u16*)take((size_t)2 * 12 * 256 * 512 * 2);
  p.XVT = (u16*)take((size_t)2 * 12 * 256 * 512 * 2);
  p.C0sT = (u16*)take((size_t)32 * 16384 * 2);
  p.rs0 = (float*)take((size_t)NTOK * 4);
  p.ssq1 = (float*)take((size_t)NTOK * 4);
  p.rsmem = (float*)take((size_t)(1024 + 64) * 4);
  p.gates = (float*)take((size_t)NTOK * 8 * 4);
  p.tabA = (float*)take(2048 * 4);
  p.tabB = (float*)take(2048 * 4);
  p.mtab = (float*)take(16 * 129 * 4);
  p.nhat = (float*)take((size_t)2048 * 128 * 4);
  p.nstate = (float*)take((size_t)2048 * 128 * 4);
  p.kmaxp = (float*)take((size_t)3 * 1024 * 4 + 256);
  if (off > ws_size) { fprintf(stderr, "workspace too small: need %zu have %zu\n", off, ws_size); return; }
  (void)hipMemsetAsync(p.kmaxp + 3 * 1024, 0, 256, stream);
#if MULTI_LAUNCH
  for (int ph = 0; ph < NPHASE; ++ph) {
    hipLaunchKernelGGL(mega, dim3(grid_blocks), dim3(256), LDS_BYTES, stream, p, ph, ph + 1);
  }
#else
  int lo = 0, hi = NPHASE;
  void* args[] = {&p, &lo, &hi};
  hipError_t e = hipLaunchCooperativeKernel((const void*)mega, dim3(grid_blocks), dim3(256), args, LDS_BYTES, stream);
  if (e != hipSuccess) fprintf(stderr, "cooperative launch failed: %s (grid %d)\n", hipGetErrorString(e), grid_blocks);
#endif
}
```

```cpp
#include <hip/hip_runtime.h>
#include <hip/hip_cooperative_groups.h>
#include <stdint.h>
#include <stdio.h>
namespace cg = cooperative_groups;

typedef unsigned short u16;
using bf16x8 = __attribute__((ext_vector_type(8))) short;
using f32x4  = __attribute__((ext_vector_type(4))) float;
using f32x16 = __attribute__((ext_vector_type(16))) float;
using u32x4  = __attribute__((ext_vector_type(4))) unsigned;
using u32x2  = __attribute__((ext_vector_type(2))) unsigned;
#define LAS __attribute__((address_space(3)))
#define DEVI __device__ __forceinline__

constexpr int NTOKP = 32768, NTOKS = 256, NTOK = 33024;
constexpr int SEQ = 8192, LSAMP = 32, PAST = 2048, SKP = 2112;
constexpr size_t SEG = (size_t)NTOK * 512;
constexpr int NPAD_A = 5760;
constexpr float EPS = 1e-6f;
constexpr float LOG2E = 1.4426950408889634f;
constexpr size_t O_YP = 0, O_PXK = 33816576, O_PXV = 34865152, O_PK = 35913728, O_PV = 52690944,
  O_PC = 69468160, O_PN = 69730304, O_PM = 69732352, O_PCONV = 69732368, O_SK = 69855248, O_SV = 69986320,
  O_SC = 70117392, O_SN = 70641680, O_SM = 70645776, O_SCONV = 70645808;

constexpr int LDS_BYTES = 147456;

struct Params {
  const float* in[34];
  float* out;
  u16 *WtInA, *WtOutA, *WtInC, *WtOutC, *WtMem;
  u16 *xb, *memb;
  u16 *Qa, *Ka, *KaT, *VaT, *Ga, *Qb, *Kb, *VbT, *Gb, *Qx, *Gx;
  u16 *Ks, *VsT, *XK, *XVT, *C0sT;
  float *rs0, *ssq1, *rsmem, *gates, *tabA, *tabB, *mtab, *nhat, *nstate, *kmaxp;
};

DEVI unsigned cvtpk(float lo, float hi) { unsigned r; asm volatile("v_cvt_pk_bf16_f32 %0, %1, %2" : "=v"(r) : "v"(lo), "v"(hi)); return r; }
DEVI float bflo(unsigned u) { return __uint_as_float(u << 16); }
DEVI float bfhi(unsigned u) { return __uint_as_float(u & 0xffff0000u); }
DEVI float bf2f(u16 h) { return __uint_as_float(((unsigned)h) << 16); }
DEVI u16 f2bf(float f) { return (u16)(cvtpk(f, 0.f) & 0xffffu); }
DEVI float sigmoidf_(float x) { return 1.f / (1.f + __expf(-x)); }
DEVI float siluf_(float x) { return x / (1.f + __expf(-x)); }
DEVI float logsigmoidf_(float x) { return fminf(x, 0.f) - log1pf(__expf(-fabsf(x))); }
DEVI float wsum(float v) { for (int o = 32; o; o >>= 1) v += __shfl_xor(v, o); return v; }
DEVI float wmax(float v) { for (int o = 32; o; o >>= 1) v = fmaxf(v, __shfl_xor(v, o)); return v; }
DEVI int pi32(int r) { return (r & ~12) | ((r & 4) << 1) | ((r & 8) >> 1); }
DEVI int klocal(int reg, int h) { return (reg & 3) + 4 * ((reg >> 2) & 1) + 8 * h + 16 * (reg >> 3); }
DEVI int crow(int reg, int h) { return (reg & 3) + 8 * (reg >> 2) + 4 * h; }
DEVI bf16x8 ldg8(const u16* p) { return *reinterpret_cast<const bf16x8*>(p); }
DEVI f32x16 mfma32(bf16x8 a, bf16x8 b, f32x16 c) { return __builtin_amdgcn_mfma_f32_32x32x16_bf16(a, b, c, 0, 0, 0); }
DEVI bf16x8 pack8(const f32x16& x, int s) {
  u32x4 w = {cvtpk(x[8 * s + 0], x[8 * s + 1]), cvtpk(x[8 * s + 2], x[8 * s + 3]), cvtpk(x[8 * s + 4], x[8 * s + 5]), cvtpk(x[8 * s + 6], x[8 * s + 7])};
  return *reinterpret_cast<bf16x8*>(&w);
}
DEVI void lds_barrier() { asm volatile("s_waitcnt lgkmcnt(0)" ::: "memory"); __builtin_amdgcn_s_barrier(); asm volatile("" ::: "memory"); }
DEVI void glds16(const void* g, LAS void* l) { __builtin_amdgcn_global_load_lds((const unsigned*)g, (LAS unsigned*)l, 16, 0, 0); }

template <class F>
DEVI void wtrans(u16* dst, const float* src, const float* g, int K, int Npad, int ldn, F srccol, int gtid, int gsz) {
  const int total = Npad * (K / 32);
  for (int i = gtid; i < total; i += gsz) {
    const int n = i % Npad, kb = i / Npad;
    const int sc = srccol(n);
    float v[32];
#pragma unroll
    for (int j = 0; j < 32; ++j) v[j] = (sc >= 0) ? src[(size_t)(kb * 32 + j) * ldn + sc] : 0.f;
    if (g) {
#pragma unroll
      for (int j = 0; j < 32; ++j) v[j] *= g[kb * 32 + j];
    }
#pragma unroll
    for (int q = 0; q < 4; ++q) {
      u32x4 w = {cvtpk(v[8 * q + 0], v[8 * q + 1]), cvtpk(v[8 * q + 2], v[8 * q + 3]), cvtpk(v[8 * q + 4], v[8 * q + 5]), cvtpk(v[8 * q + 6], v[8 * q + 7])};
      *reinterpret_cast<u32x4*>(dst + (size_t)n * K + kb * 32 + q * 8) = w;
    }
  }
}

DEVI int srccol_in_a(int n) {
  const int t = n >> 7, c = n & 127;
  if (t < 12) return n;
  if (t < 20) { const int j = t - 12; return c < 64 ? 1536 + 64 * j + c : 2048 + 64 * j + (c - 64); }
  if (t < 44) return 2568 + (t - 20) * 128 + c;
  if (t == 44) return c < 8 ? 2560 + c : -1;
  return -1;
}
DEVI int srccol_in_c(int n) {
  const int t = n >> 7, c = n & 127;
  if (t < 16) return c < 64 ? 64 * t + c : 1024 + 64 * t + (c - 64);
  return n;
}

DEVI void phase_prep(const Params& p) {
  const int tid = threadIdx.x, lane = tid & 63;
  const int gtid = blockIdx.x * 256 + tid, gsz = gridDim.x * 256;
  const int gwave = gtid >> 6, nwaves = gsz >> 6;
  wtrans(p.WtInA, p.in[12], p.in[11], 1024, NPAD_A, 5640, [](int n) { return srccol_in_a(n); }, gtid, gsz);
  wtrans(p.WtOutA, p.in[23], nullptr, 1536, 1024, 1024, [](int n) { return n; }, gtid, gsz);
  wtrans(p.WtInC, p.in[24], p.in[11] + 1024, 1024, 4096, 4096, [](int n) { return srccol_in_c(n); }, gtid, gsz);
  wtrans(p.WtOutC, p.in[29], nullptr, 1536, 1024, 1024, [](int n) { return n; }, gtid, gsz);
  for (int l = 0; l < 2; ++l)
    wtrans(p.WtMem + (size_t)l * 1024 * 1024, p.in[31] + (size_t)l * 1024 * 1024, p.in[30] + l * 1024, 1024, 1024, 1024,
           [](int n) { return n; }, gtid, gsz);
  for (int row0 = gwave; row0 < NTOK + 1024; row0 += 4 * nwaves) {
    float4 v[4][4];
    const float* xr[4];
#pragma unroll
    for (int u = 0; u < 4; ++u) {
      const int row = min(row0 + u * nwaves, NTOK + 1023);
      xr[u] = row < NTOKP ? p.in[0] + (size_t)row * 1024 : (row < NTOK ? p.in[1] + (size_t)(row - NTOKP) * 1024 : p.in[2] + (size_t)(row - NTOK) * 1024);
    }
#pragma unroll
    for (int u = 0; u < 4; ++u)
#pragma unroll
      for (int i = 0; i < 4; ++i) v[u][i] = reinterpret_cast<const float4*>(xr[u])[lane + 64 * i];
#pragma unroll
    for (int u = 0; u < 4; ++u) {
      const int row = row0 + u * nwaves;
      float ss = 0.f;
#pragma unroll
      for (int i = 0; i < 4; ++i) ss += v[u][i].x * v[u][i].x + v[u][i].y * v[u][i].y + v[u][i].z * v[u][i].z + v[u][i].w * v[u][i].w;
      ss = wsum(ss);
      if (row < NTOK + 1024) {
        u16* dst = row < NTOK ? p.xb + (size_t)row * 1024 : p.memb + (size_t)(row - NTOK) * 1024;
        float* rsd = row < NTOK ? p.rs0 + row : p.rsmem + (row - NTOK);
        if (lane == 0) *rsd = rsqrtf(ss * (1.f / 1024.f) + EPS);
#pragma unroll
        for (int i = 0; i < 4; ++i) { u32x2 w = {cvtpk(v[u][i].x, v[u][i].y), cvtpk(v[u][i].z, v[u][i].w)}; reinterpret_cast<u32x2*>(dst)[lane + 64 * i] = w; }
      }
    }
  }
  float km0 = 0.f, km1 = 0.f, km2 = 0.f;
  for (int i0 = gtid; i0 < 8 * PAST * 64; i0 += 4 * gsz) {
    float4 a[4], c[4];
#pragma unroll
    for (int u = 0; u < 4; ++u) {
      const int i = i0 + u * gsz;
      const int c8 = i & 63, pp = (i >> 6) & (PAST - 1), b = (i >> 17) & 7;
      const float4* sp = reinterpret_cast<const float4*>(p.in[5] + ((size_t)(b * PAST + pp) * 512 + c8 * 8));
      a[u] = sp[0]; c[u] = sp[1];
    }
#pragma unroll
    for (int u = 0; u < 4; ++u) {
      const int i = i0 + u * gsz;
      if (i < 8 * PAST * 64) {
        const int c8 = i & 63, pp = (i >> 6) & (PAST - 1), b = i >> 17;
        u32x4 w = {cvtpk(a[u].x, a[u].y), cvtpk(a[u].z, a[u].w), cvtpk(c[u].x, c[u].y), cvtpk(c[u].z, c[u].w)};
        *reinterpret_cast<u32x4*>(p.Ks + ((size_t)(b * SKP + pp) * 512 + c8 * 8)) = w;
        float ss = a[u].x * a[u].x + a[u].y * a[u].y + a[u].z * a[u].z + a[u].w * a[u].w + c[u].x * c[u].x + c[u].y * c[u].y + c[u].z * c[u].z + c[u].w * c[u].w;
        ss += __shfl_xor(ss, 1); ss += __shfl_xor(ss, 2); ss += __shfl_xor(ss, 4);
        km0 = fmaxf(km0, ss);
      }
    }
  }
  for (int i0 = gtid; i0 < 8 * 4 * 256 * 128; i0 += 2 * gsz) {
    float v[2][8];
#pragma unroll
    for (int u = 0; u < 2; ++u) {
      const int i = (i0 + u * gsz) & (8 * 4 * 256 * 128 - 1);
      const int dv = i & 127, p8 = (i >> 7) & 255, h = (i >> 15) & 3, b = i >> 17;
#pragma unroll
      for (int j = 0; j < 8; ++j) v[u][j] = p.in[6][((size_t)(b * PAST + p8 * 8 + j) * 4 + h) * 128 + dv];
    }
#pragma unroll
    for (int u = 0; u < 2; ++u) {
      const int i = i0 + u * gsz;
      if (i < 8 * 4 * 256 * 128) {
        const int dv = i & 127, p8 = (i >> 7) & 255, h = (i >> 15) & 3, b = i >> 17;
        u32x4 w = {cvtpk(v[u][0], v[u][1]), cvtpk(v[u][2], v[u][3]), cvtpk(v[u][4], v[u][5]), cvtpk(v[u][6], v[u][7])};
        *reinterpret_cast<u32x4*>(p.VsT + ((size_t)((b * 4 + h) * 128 + dv) * SKP + p8 * 8)) = w;
      }
    }
  }
  for (int i = gtid; i < 4096 * 4; i += gsz) {
    u32x4 z = {0, 0, 0, 0};
    *reinterpret_cast<u32x4*>(p.VsT + ((size_t)(i >> 2) * SKP + 2080 + (i & 3) * 8)) = z;
  }
  for (int i = gtid; i < 8 * 32 * 64; i += gsz) {
    u32x4 z = {0, 0, 0, 0};
    const int c8 = i & 63, r = (i >> 6) & 31, b = i >> 11;
    *reinterpret_cast<u32x4*>(p.Ks + ((size_t)(b * SKP + 2080 + r) * 512 + c8 * 8)) = z;
  }
  for (int i = gtid; i < 2 * 8 * 256 * 64; i += gsz) {
    const int c8 = i & 63, m = (i >> 6) & 255, b = (i >> 14) & 7, l = i >> 17;
    const float4* s = reinterpret_cast<const float4*>(p.in[3] + ((size_t)((l * 8 + b) * 256 + m) * 512 + c8 * 8));
    const float4 a = s[0], c = s[1];
    u32x4 w = {cvtpk(a.x, a.y), cvtpk(a.z, a.w), cvtpk(c.x, c.y), cvtpk(c.z, c.w)};
    *reinterpret_cast<u32x4*>(p.XK + ((size_t)((l * 12 + 4 + b) * 256 + m) * 512 + c8 * 8)) = w;
    float ss = a.x * a.x + a.y * a.y + a.z * a.z + a.w * a.w + c.x * c.x + c.y * c.y + c.z * c.z + c.w * c.w;
    ss += __shfl_xor(ss, 1); ss += __shfl_xor(ss, 2); ss += __shfl_xor(ss, 4); ss += __shfl_xor(ss, 8);
    if (l == 0) km1 = fmaxf(km1, ss); else km2 = fmaxf(km2, ss);
  }
  for (int i = gtid; i < 2 * 8 * 4 * 32 * 128; i += gsz) {
    const int dv = i & 127, m8 = (i >> 7) & 31, h = (i >> 12) & 3, b = (i >> 14) & 7, l = i >> 17;
    float v[8];
#pragma unroll
    for (int j = 0; j < 8; ++j) v[j] = p.in[4][((size_t)((l * 8 + b) * 256 + m8 * 8 + j) * 4 + h) * 128 + dv];
    u32x4 w = {cvtpk(v[0], v[1]), cvtpk(v[2], v[3]), cvtpk(v[4], v[5]), cvtpk(v[6], v[7])};
    *reinterpret_cast<u32x4*>(p.XVT + ((size_t)(((l * 12 + 4 + b) * 4 + h) * 128 + dv) * 256 + m8 * 8)) = w;
  }
  for (int i = gtid; i < 32 * 16 * 128; i += gsz) {
    const int e = i & 127, d8 = (i >> 7) & 15, bh = i >> 11;
    float v[8];
#pragma unroll
    for (int j = 0; j < 8; ++j) v[j] = p.in[7][((size_t)bh * 128 + d8 * 8 + j) * 128 + e];
    u32x4 w = {cvtpk(v[0], v[1]), cvtpk(v[2], v[3]), cvtpk(v[4], v[5]), cvtpk(v[6], v[7])};
    *reinterpret_cast<u32x4*>(p.C0sT + ((size_t)bh * 128 + e) * 128 + d8 * 8) = w;
  }
  for (int i = gtid; i < NTOK; i += gsz) p.ssq1[i] = 0.f;
  km0 = wmax(km0); km1 = wmax(km1); km2 = wmax(km2);
  if (lane == 0) {
    const int slot = blockIdx.x * 4 + (tid >> 6);
    p.kmaxp[slot] = km0; p.kmaxp[1024 + slot] = km1; p.kmaxp[2048 + slot] = km2;
  }
}

DEVI void gemm_core(LAS char* lds, const u16* A0, const u16* A1, const u16* A2, int lda0, int lda1, int lda2, int segK,
                    const u16* Bt, int K, int brow, int bcol, f32x4 (&acc)[4][4]) {
  const int tid = threadIdx.x, lane = tid & 63, wid = tid >> 6, wr = wid >> 1, wc = wid & 1, fr = lane & 15, fq = lane >> 4;
  LAS char* SA = lds; LAS char* SB = lds + 8192;
#pragma unroll
  for (int m = 0; m < 4; ++m)
#pragma unroll
    for (int n = 0; n < 4; ++n) acc[m][n] = f32x4{0.f, 0.f, 0.f, 0.f};
  const int nkt = K / 32;
  for (int kt = 0; kt < nkt; ++kt) {
    const int k0 = kt * 32;
    const int seg = k0 / segK;
    const u16* Ab = (seg == 0 ? A0 : (seg == 1 ? A1 : A2)) + (k0 - seg * segK);
    const int lda = (seg == 0 ? lda0 : (seg == 1 ? lda1 : lda2));
#pragma unroll
    for (int i = 0; i < 2; ++i) {
      const int b = tid * 16 + i * 4096, r = b >> 6, c = (b & 63) >> 1;
      glds16(Ab + (size_t)(brow + r) * lda + c, SA + b);
      glds16(Bt + (size_t)(bcol + r) * K + k0 + c, SB + b);
    }
    asm volatile("s_waitcnt vmcnt(0)" ::: "memory");
    __syncthreads();
    bf16x8 af[4], bfr[4];
#pragma unroll
    for (int m = 0; m < 4; ++m) af[m] = *reinterpret_cast<const LAS bf16x8*>(SA + (wr * 64 + m * 16 + fr) * 64 + fq * 16);
#pragma unroll
    for (int n = 0; n < 4; ++n) bfr[n] = *reinterpret_cast<const LAS bf16x8*>(SB + (wc * 64 + n * 16 + fr) * 64 + fq * 16);
#pragma unroll
    for (int m = 0; m < 4; ++m)
#pragma unroll
      for (int n = 0; n < 4; ++n) acc[m][n] = __builtin_amdgcn_mfma_f32_16x16x32_bf16(af[m], bfr[n], acc[m][n], 0, 0, 0);
    __syncthreads();
  }
}

DEVI void gemm_stage_c(LAS char* lds, const f32x4 (&acc)[4][4], const float* rowscale, int mode, int brow) {
  const int tid = threadIdx.x, lane = tid & 63, wid = tid >> 6, wr = wid >> 1, wc = wid & 1, fr = lane & 15, fq = lane >> 4;
  LAS float* Cs = (LAS float*)lds;
#pragma unroll
  for (int m = 0; m < 4; ++m)
#pragma unroll
    for (int j = 0; j < 4; ++j) {
      const int r = wr * 64 + m * 16 + fq * 4 + j;
      float s = 1.f;
      if (mode == 1) s = rowscale[brow + r];
      else if (mode == 2) s = rsqrtf(rowscale[brow + r] * (1.f / 1024.f) + EPS);
#pragma unroll
      for (int n = 0; n < 4; ++n) Cs[r * 132 + wc * 64 + n * 16 + fr] = acc[m][n][j] * s;
    }
  __syncthreads();
}

DEVI void st_bf8(u16* dst, const float (&v)[8]) {
  u32x4 w = {cvtpk(v[0], v[1]), cvtpk(v[2], v[3]), cvtpk(v[4], v[5]), cvtpk(v[6], v[7])};
  *reinterpret_cast<u32x4*>(dst) = w;
}
DEVI void st_f8(float* dst, const float (&v)[8]) {
  reinterpret_cast<float4*>(dst)[0] = float4{v[0], v[1], v[2], v[3]};
  reinterpret_cast<float4*>(dst)[1] = float4{v[4], v[5], v[6], v[7]};
}
DEVI void store_transposed(LAS char* lds, u16* dst, size_t ldt, float scale) {
  const LAS float* Cs = (const LAS float*)lds;
  const int c = threadIdx.x & 127, rh = (threadIdx.x >> 7) * 64;
#pragma unroll
  for (int it = 0; it < 8; ++it) {
    const int r0 = rh + it * 8;
    float v[8];
#pragma unroll
    for (int j = 0; j < 8; ++j) v[j] = Cs[(r0 + j) * 132 + c] * scale;
    st_bf8(dst + (size_t)c * ldt + r0, v);
  }
}

DEVI void epi_in_a(const Params& p, LAS char* lds, int brow, int n) {
  const LAS float* Cs = (const LAS float*)lds;
  const int tid = threadIdx.x, cgp = tid & 15, c0 = cgp * 8;
  const bool samp = brow >= NTOKP;
  const int seg = n >> 2, hd = n & 3;
  if (n >= 4 && n < 12) {
    u16* base = (n < 8 ? p.KaT : p.VaT);
    const float sc = (n < 8 ? 0.08838834764831845f : 1.f);
    if (!samp) { const int b = brow >> 13, t0 = brow & 8191; store_transposed(lds, base + ((size_t)(b * 4 + hd) * 128) * SEQ + t0, SEQ, sc); }
    else {
      const int c = tid & 127, rh = (tid >> 7) * 64;
#pragma unroll
      for (int it = 0; it < 8; ++it) {
        const int r0 = rh + it * 8; const int bs = ((brow - NTOKP) + r0) >> 5, t0 = r0 & 31;
        float v[8];
#pragma unroll
        for (int j = 0; j < 8; ++j) v[j] = Cs[(r0 + j) * 132 + c] * sc;
        st_bf8(base + (size_t)NTOKP * 512 + ((size_t)(bs * 4 + hd) * 128 + c) * 32 + t0, v);
      }
    }
  }
  if (seg == 7) {
    if (!samp) { const int b = brow >> 13, t0 = brow & 8191; store_transposed(lds, p.VbT + ((size_t)(b * 4 + hd) * 128) * SEQ + t0, SEQ, 1.f); }
    else {
      const int c = tid & 127, rh = (tid >> 7) * 64;
#pragma unroll
      for (int it = 0; it < 8; ++it) {
        const int r0 = rh + it * 8; const int bs = ((brow - NTOKP) + r0) >> 5, t0 = r0 & 31;
        float v[8];
#pragma unroll
        for (int j = 0; j < 8; ++j) v[j] = Cs[(r0 + j) * 132 + c];
        st_bf8(p.VsT + ((size_t)(bs * 4 + hd) * 128 + c) * SKP + PAST + t0, v);
      }
    }
  }
  float gn[8];
  {
    const float* gp = nullptr;
    if (n >= 20 && n < 24) gp = p.in[16] + (c0 & 63);
    else if (n >= 24 && n < 28) gp = p.in[17] + (c0 & 63);
    else if (n >= 36 && n < 40) gp = p.in[32] + c0;
    else if (n == 44) gp = (cgp == 0) ? nullptr : nullptr;
#pragma unroll
    for (int j = 0; j < 8; ++j) gn[j] = gp ? gp[j] : 0.f;
    if (n == 44) {
#pragma unroll
      for (int j = 0; j < 4; ++j) { gn[j] = p.in[13][j]; gn[4 + j] = p.in[14][j]; }
    }
  }
#pragma unroll 4
  for (int it = 0; it < 8; ++it) {
    const int r = it * 16 + (tid >> 4);
    const size_t grow = (size_t)brow + r;
    float v[8];
#pragma unroll
    for (int j = 0; j < 8; ++j) v[j] = Cs[r * 132 + c0 + j];
    if (n < 4) { st_bf8(p.Qa + grow * 512 + hd * 128 + c0, v); }
    else if (n < 8) {
#pragma unroll
      for (int j = 0; j < 8; ++j) v[j] *= 0.08838834764831845f;
      st_bf8(p.Ka + grow * 512 + hd * 128 + c0, v);
    }
    else if (n < 12) {   }
    else if (n < 20) {
      if (cgp < 8) {
        float g[8];
#pragma unroll
        for (int j = 0; j < 8; ++j) g[j] = sigmoidf_(v[j]) * siluf_(Cs[r * 132 + 64 + c0 + j]);
        st_bf8(p.Ga + grow * 512 + (n - 12) * 64 + c0, g);
      }
    }
    else if (n < 28) {
      float ss = 0.f;
#pragma unroll
      for (int j = 0; j < 8; ++j) ss += v[j] * v[j];
      ss += __shfl_xor(ss, 1); ss += __shfl_xor(ss, 2); ss += __shfl_xor(ss, 4);
      const float rs = rsqrtf(ss * (1.f / 64.f) + EPS);
      const float* g = gn;
      if (n < 24) {
#pragma unroll
        for (int j = 0; j < 8; ++j) v[j] = v[j] * rs * g[j] * (0.125f * LOG2E);
        st_bf8(p.Qb + grow * 512 + hd * 128 + c0, v);
      } else {
#pragma unroll
        for (int j = 0; j < 8; ++j) v[j] = v[j] * rs * g[j];
        if (!samp) { st_f8(p.out + O_PK + grow * 512 + hd * 128 + c0, v); st_bf8(p.Kb + grow * 512 + hd * 128 + c0, v); }
        else {
          const int sr = (int)grow - NTOKP, bs = sr >> 5, t = sr & 31;
          st_f8(p.out + O_SK + (size_t)sr * 512 + hd * 128 + c0, v);
          st_bf8(p.Ks + ((size_t)(bs * SKP + PAST + t)) * 512 + hd * 128 + c0, v);
        }
      }
    }
    else if (n < 32) {
      if (!samp) st_f8(p.out + O_PV + grow * 512 + hd * 128 + c0, v);
      else st_f8(p.out + O_SV + (size_t)((int)grow - NTOKP) * 512 + hd * 128 + c0, v);
    }
    else if (n < 36) {
#pragma unroll
      for (int j = 0; j < 8; ++j) v[j] = siluf_(v[j]);
      st_bf8(p.Gb + grow * 512 + hd * 128 + c0, v);
    }
    else if (n < 40) {
      float ss = 0.f;
#pragma unroll
      for (int j = 0; j < 8; ++j) ss += v[j] * v[j];
      ss += __shfl_xor(ss, 1); ss += __shfl_xor(ss, 2); ss += __shfl_xor(ss, 4); ss += __shfl_xor(ss, 8);
      const float rs = rsqrtf(ss * (1.f / 128.f) + EPS);
      const float* g = gn;
#pragma unroll
      for (int j = 0; j < 8; ++j) v[j] = v[j] * rs * g[j] * (0.08838834764831845f * LOG2E);
      st_bf8(p.Qx + grow * 512 + hd * 128 + c0, v);
    }
    else if (n < 44) {
#pragma unroll
      for (int j = 0; j < 8; ++j) v[j] = siluf_(v[j]);
      st_bf8(p.Gx + grow * 512 + hd * 128 + c0, v);
    }
    else {
      if (cgp == 0) {
        float g[8];
#pragma unroll
        for (int j = 0; j < 4; ++j) { g[j] = v[j] + gn[j]; g[4 + j] = logsigmoidf_(v[4 + j] + gn[4 + j]); }
        st_f8(p.gates + grow * 8, g);
      }
    }
  }
}

DEVI void epi_mem(const Params& p, LAS char* lds, int l, int brow, int n) {
  const LAS float* Cs = (const LAS float*)lds;
  const int tid = threadIdx.x, cgp = tid & 15, c0 = cgp * 8;
  const int hd = n & 3;
  if (n >= 4) {
    const int b = brow >> 8, m0 = brow & 255;
    store_transposed(lds, p.XVT + ((size_t)((l * 12 + b) * 4 + hd) * 128) * 256 + m0, 256, 1.f);
  }
  float gk[8];
#pragma unroll
  for (int j = 0; j < 8; ++j) gk[j] = p.in[33][l * 128 + c0 + j];
#pragma unroll 4
  for (int it = 0; it < 8; ++it) {
    const int r = it * 16 + (tid >> 4);
    const size_t grow = (size_t)brow + r;
    float v[8];
#pragma unroll
    for (int j = 0; j < 8; ++j) v[j] = Cs[r * 132 + c0 + j];
    if (n < 4) {
      float ss = 0.f;
#pragma unroll
      for (int j = 0; j < 8; ++j) ss += v[j] * v[j];
      ss += __shfl_xor(ss, 1); ss += __shfl_xor(ss, 2); ss += __shfl_xor(ss, 4); ss += __shfl_xor(ss, 8);
      const float rs = rsqrtf(ss * (1.f / 128.f) + EPS);
      const float* g = gk;
#pragma unroll
      for (int j = 0; j < 8; ++j) v[j] = v[j] * rs * g[j];
      st_f8(p.out + O_PXK + ((size_t)l * 1024 + grow) * 512 + hd * 128 + c0, v);
      const int b = (int)grow >> 8, m = (int)grow & 255;
      st_bf8(p.XK + ((size_t)((l * 12 + b) * 256 + m)) * 512 + hd * 128 + c0, v);
    } else {
      st_f8(p.out + O_PXV + ((size_t)l * 1024 + grow) * 512 + hd * 128 + c0, v);
    }
  }
}

DEVI void load_resid(const Params& p, int layer, int brow, int n, float4 (&ra)[8], float4 (&rb)[8]) {
  const int tid = threadIdx.x, c0 = (tid & 15) * 8;
#pragma unroll
  for (int it = 0; it < 8; ++it) {
    const size_t grow = (size_t)brow + it * 16 + (tid >> 4);
    const float* res;
    if (layer == 0) res = (grow < NTOKP ? p.in[0] + grow * 1024 : p.in[1] + (grow - NTOKP) * 1024) + n * 128 + c0;
    else res = p.out + grow * 1024 + n * 128 + c0;
    ra[it] = reinterpret_cast<const float4*>(res)[0]; rb[it] = reinterpret_cast<const float4*>(res)[1];
  }
}
DEVI void epi_out(const Params& p, LAS char* lds, int layer, int brow, int n, const float4 (&ra)[8], const float4 (&rb)[8]) {
  const LAS float* Cs = (const LAS float*)lds;
  const int tid = threadIdx.x, cgp = tid & 15, c0 = cgp * 8;
#pragma unroll
  for (int q = 0; q < 8; ++q) {
    const int r = q * 16 + (tid >> 4);
    const size_t grow = (size_t)brow + r;
    float v[8];
#pragma unroll
    for (int j = 0; j < 8; ++j) v[j] = Cs[r * 132 + c0 + j];
    v[0] += ra[q].x; v[1] += ra[q].y; v[2] += ra[q].z; v[3] += ra[q].w; v[4] += rb[q].x; v[5] += rb[q].y; v[6] += rb[q].z; v[7] += rb[q].w;
    st_f8(p.out + grow * 1024 + n * 128 + c0, v);
    if (layer == 0) {
      st_bf8(p.xb + grow * 1024 + n * 128 + c0, v);
      float ss = 0.f;
#pragma unroll
      for (int j = 0; j < 8; ++j) ss += v[j] * v[j];
      ss += __shfl_xor(ss, 1); ss += __shfl_xor(ss, 2); ss += __shfl_xor(ss, 4); ss += __shfl_xor(ss, 8);
      if (cgp == 0) atomicAdd(p.ssq1 + grow, ss);
    }
  }
}

DEVI void epi_in_c(const Params& p, LAS char* lds, int brow, int n) {
  const LAS float* Cs = (const LAS float*)lds;
  const int tid = threadIdx.x, cgp = tid & 15, c0 = cgp * 8;
  u16* U = p.Qa;
  u16* Gc = p.KaT;
  float gx[8];
#pragma unroll
  for (int j = 0; j < 8; ++j) gx[j] = p.in[32][128 + c0 + j];
#pragma unroll 4
  for (int it = 0; it < 8; ++it) {
    const int r = it * 16 + (tid >> 4);
    const size_t grow = (size_t)brow + r;
    float v[8];
#pragma unroll
    for (int j = 0; j < 8; ++j) v[j] = Cs[r * 132 + c0 + j];
    if (n < 16) {
      if (cgp < 8) {
        float u[8];
#pragma unroll
        for (int j = 0; j < 8; ++j) u[j] = v[j] * sigmoidf_(Cs[r * 132 + 64 + c0 + j]);
        st_bf8(U + grow * 1024 + n * 64 + c0, u);
        if (grow < NTOKP) { const int t = (int)grow & 8191, b = (int)grow >> 13; if (t >= SEQ - 30) st_f8(p.out + O_PCONV + ((size_t)(b * 30 + t - (SEQ - 30))) * 1024 + n * 64 + c0, u); }
        else { const int sr = (int)grow - NTOKP, t = sr & 31, b = sr >> 5; if (t >= 2) st_f8(p.out + O_SCONV + ((size_t)(b * 30 + t - 2)) * 1024 + n * 64 + c0, u); }
      }
    } else if (n < 24) {
#pragma unroll
      for (int j = 0; j < 8; ++j) v[j] = siluf_(v[j]);
      st_bf8(Gc + grow * 1024 + (n - 16) * 128 + c0, v);
    } else if (n < 28) {
      float ss = 0.f;
#pragma unroll
      for (int j = 0; j < 8; ++j) ss += v[j] * v[j];
      ss += __shfl_xor(ss, 1); ss += __shfl_xor(ss, 2); ss += __shfl_xor(ss, 4); ss += __shfl_xor(ss, 8);
      const float rs = rsqrtf(ss * (1.f / 128.f) + EPS);
      const float* g = gx;
#pragma unroll
      for (int j = 0; j < 8; ++j) v[j] = v[j] * rs * g[j] * (0.08838834764831845f * LOG2E);
      st_bf8(p.Qx + grow * 512 + (n - 24) * 128 + c0, v);
    } else {
#pragma unroll
      for (int j = 0; j < 8; ++j) v[j] = siluf_(v[j]);
      st_bf8(p.Gx + grow * 512 + (n - 28) * 128 + c0, v);
    }
  }
}

DEVI void gemm_core(LAS char* lds, const u16* A0, const u16* A1, const u16* A2, int lda0, int lda1, int lda2, int segK,
                    const u16* Bt, int K, int brow, int bcol, f32x16 (&acc)[4][2]) {
  const int tid = threadIdx.x, lane = tid & 63, w = tid >> 6, wr = w >> 1, wc = w & 1, r = lane & 31, h = lane >> 5;
#pragma unroll
  for (int i = 0; i < 4; ++i)
#pragma unroll
    for (int j = 0; j < 2; ++j)
#pragma unroll
      for (int e = 0; e < 16; ++e) acc[i][j][e] = 0.f;
  const int nkt = K / 64;
  auto stage_part = [=](int kt, int buf, int part) __attribute__((always_inline)) {
    const int k0 = kt * 64;
    const int seg = k0 / segK;
    const u16* Ab = (seg == 0 ? A0 : (seg == 1 ? A1 : A2)) + (k0 - seg * segK);
    const int lda = (seg == 0 ? lda0 : (seg == 1 ? lda1 : lda2));
    LAS char* sa = lds + buf * 49152;
    LAS char* sb = sa + 32768;
#pragma unroll
    for (int q = 0; q < 2; ++q) {
      const int i = 2 * part + q;
      const int pch = i * 256 + tid, row = pch >> 3, lg = (pch & 7) ^ ((row >> 1) & 7);
      glds16(Ab + (size_t)(brow + row) * lda + lg * 8, sa + pch * 16);
    }
    {
      const int pch = part * 256 + tid, row = pch >> 3, lg = (pch & 7) ^ ((row >> 1) & 7);
      glds16(Bt + (size_t)(bcol + row) * K + k0 + lg * 8, sb + pch * 16);
    }
  };
  lds_barrier();
#pragma unroll
  for (int part = 0; part < 4; ++part) stage_part(0, 0, part);
#pragma unroll
  for (int part = 0; part < 4; ++part) stage_part(1, 1, part);
  int buf = 0;
  for (int kt = 0; kt < nkt; ++kt) {
    if (kt + 1 < nkt) asm volatile("s_waitcnt vmcnt(12)" ::: "memory"); else asm volatile("s_waitcnt vmcnt(0)" ::: "memory");
    asm volatile("s_waitcnt lgkmcnt(0)" ::: "memory");
    __builtin_amdgcn_s_barrier();
    int nb = buf + 2; if (nb >= 3) nb -= 3;
    const bool more = kt + 2 < nkt;
    const LAS char* sa = lds + buf * 49152;
    const LAS char* sb = sa + 32768;
    bf16x8 af[2][4], bfr[2][2];
#pragma unroll
    for (int i = 0; i < 4; ++i) {
      const int row = 32 * (2 * i + wr) + r, ch = h ^ ((row >> 1) & 7);
      af[0][i] = *reinterpret_cast<const LAS bf16x8*>(sa + row * 128 + ch * 16);
    }
#pragma unroll
    for (int j = 0; j < 2; ++j) {
      const int row = 32 * (2 * j + wc) + r, ch = h ^ ((row >> 1) & 7);
      bfr[0][j] = *reinterpret_cast<const LAS bf16x8*>(sb + row * 128 + ch * 16);
    }
#pragma unroll
    for (int ks = 0; ks < 4; ++ks) {
      const int cur = ks & 1, nxt = cur ^ 1;
      if (ks < 3) {
#pragma unroll
        for (int i = 0; i < 4; ++i) {
          const int row = 32 * (2 * i + wr) + r, ch = (2 * (ks + 1) + h) ^ ((row >> 1) & 7);
          af[nxt][i] = *reinterpret_cast<const LAS bf16x8*>(sa + row * 128 + ch * 16);
        }
#pragma unroll
        for (int j = 0; j < 2; ++j) {
          const int row = 32 * (2 * j + wc) + r, ch = (2 * (ks + 1) + h) ^ ((row >> 1) & 7);
          bfr[nxt][j] = *reinterpret_cast<const LAS bf16x8*>(sb + row * 128 + ch * 16);
        }
      }
#pragma unroll
      for (int i = 0; i < 4; ++i)
#pragma unroll
        for (int j = 0; j < 2; ++j) acc[i][j] = mfma32(af[cur][i], bfr[cur][j], acc[i][j]);
      if (more) stage_part(kt + 2, nb, ks);
    }
    if (++buf == 3) buf = 0;
  }
}

DEVI void stage_all(LAS char* lds, const f32x16 (&acc)[4][2], bool scaled) {
  const int tid = threadIdx.x, lane = tid & 63, w = tid >> 6, wr = w >> 1, wc = w & 1, r = lane & 31, h = lane >> 5;
  const LAS float* RS = (const LAS float*)(lds + 135168);
#pragma unroll
  for (int i = 0; i < 4; ++i) {
    LAS float* Cs = (LAS float*)(lds + (i >> 1) * 67584);
#pragma unroll
    for (int e = 0; e < 16; ++e) {
      const int row = 32 * (2 * (i & 1) + wr) + crow(e, h);
      const float s = scaled ? RS[128 * (i >> 1) + row] : 1.f;
#pragma unroll
      for (int jj = 0; jj < 2; ++jj) Cs[row * 132 + 32 * (2 * jj + wc) + r] = acc[i][jj][e] * s;
    }
  }
}

DEVI void gemm_tile_run(const Params& p, LAS char* lds, int which, int aux, int mt, int n, f32x16 (&acc)[4][2]) {
  const int brow = mt * 256, bcol = n * 128;
  const float* rsc = nullptr; int mode = 0;
  if (which == 0) { gemm_core(lds, p.xb, p.xb, p.xb, 1024, 1024, 1024, 1024, p.WtInA, 1024, brow, bcol, acc); rsc = p.rs0; mode = 1; }
  else if (which == 1) gemm_core(lds, p.Ga, p.Gb, p.Gx, 512, 512, 512, 512, p.WtOutA, 1536, brow, bcol, acc);
  else if (which == 2) { gemm_core(lds, p.xb, p.xb, p.xb, 1024, 1024, 1024, 1024, p.WtInC, 1024, brow, bcol, acc); rsc = p.ssq1; mode = 2; }
  else if (which == 3) gemm_core(lds, p.KaT, p.KaT + 512, p.Gx, 1024, 1024, 512, 512, p.WtOutC, 1536, brow, bcol, acc);
  else { gemm_core(lds, p.memb, p.memb, p.memb, 1024, 1024, 1024, 1024, p.WtMem + (size_t)aux * 1024 * 1024, 1024, brow, bcol, acc); rsc = p.rsmem; mode = 1; }
  lds_barrier();
  if (mode) {
    float sc = rsc[brow + threadIdx.x];
    if (mode == 2) sc = rsqrtf(sc * (1.f / 1024.f) + EPS);
    ((LAS float*)(lds + 135168))[threadIdx.x] = sc;
    lds_barrier();
  }
  if (which == 1 || which == 3) {
    float4 ra0[8], rb0[8], ra1[8], rb1[8];
    load_resid(p, which == 1 ? 0 : 1, brow, n, ra0, rb0);
    load_resid(p, which == 1 ? 0 : 1, brow + 128, n, ra1, rb1);
    stage_all(lds, acc, false);
    lds_barrier();
    epi_out(p, lds, which == 1 ? 0 : 1, brow, n, ra0, rb0);
    epi_out(p, lds + 67584, which == 1 ? 0 : 1, brow + 128, n, ra1, rb1);
    return;
  }
  stage_all(lds, acc, mode != 0);
  lds_barrier();
#pragma unroll 1
  for (int sub = 0; sub < 2; ++sub) {
    LAS char* cs = lds + sub * 67584;
    const int sr = brow + 128 * sub;
    if (which == 0) epi_in_a(p, cs, sr, n);
    else if (which == 2) epi_in_c(p, cs, sr, n);
    else epi_mem(p, cs, aux, sr, n);
  }
}

template <int which>
DEVI void phase_gemm(const Params& p, LAS char* lds) {
  constexpr int nN = (which == 0 ? 45 : (which == 2 ? 32 : 8));
  constexpr int ntiles = 128 * nN;
  const int G = gridDim.x;
  const int xcd = blockIdx.x & 7, lb = blockIdx.x >> 3, slots = G >> 3;
  f32x16 acc[4][2];
  int round = 0, t_extra = blockIdx.x, t_mem = G - 1 - (int)blockIdx.x;
  if (which == 0 && G == 256) {
    const int idx = (xcd >= 4) ? lb * 4 + (xcd - 4) : 1 << 20;
    t_extra = idx < 45 ? idx : 1 << 20;
    t_mem = (idx >= 45 && idx < 109) ? idx - 45 : 1 << 20;
  }
  bool main_done = false;
  for (;;) {
    int mt, n;
    if (!main_done) {
      const int q = lb + slots * round; ++round;
      const int L = 32 * (xcd + 8 * (q >> 5)) + (q & 31);
      if (L >= ntiles) { main_done = true; continue; }
      const int mg = L / (4 * nN), rem = L - mg * 4 * nN;
      n = rem >> 2; mt = mg * 4 + (rem & 3);
    } else {
      if (t_extra >= nN) break;
      mt = 128; n = t_extra; t_extra += G;
    }
    gemm_tile_run(p, lds, which, 0, mt, n, acc);
  }
  if (which == 0) {
    for (int t = t_mem; t < 64; t += G) gemm_tile_run(p, lds, 4, t >> 5, (t >> 3) & 3, t & 7, acc);
  }
}

template <bool DIFF>
DEVI void attn_block(LAS char* lds, const u16* Q, const u16* Kg, const u16* VT, int ldv, int j0, int ntiles, int nwact,
                           int qpos0, int nkeys, float slope2, float M2, float lam, const float* subg, u16* G) {
  const int tid = threadIdx.x, lane = tid & 63, w = tid >> 6, r = lane & 31, h = lane >> 5;
  const bool act = w < nwact;
  const int qpos = qpos0 + 32 * w + r;
  const int cw = (qpos0 + 32 * w) >> 6;
  bf16x8 qf[8];
#pragma unroll
  for (int i = 0; i < 8; ++i) qf[i] = ldg8(Q + (size_t)(32 * w + r) * 512 + 16 * i + 8 * h);
  f32x16 O0[4], O1[4];
#pragma unroll
  for (int e = 0; e < 4; ++e)
#pragma unroll
    for (int i = 0; i < 16; ++i) { O0[e][i] = 0.f; O1[e][i] = 0.f; }
  float l0 = 0.f, l1 = 0.f;
  f32x16 cinit, zero16;
#pragma unroll
  for (int i = 0; i < 16; ++i) { cinit[i] = slope2 * (float)klocal(i, h); zero16[i] = 0.f; }
  const float tq = -slope2 * (float)qpos - M2;
  const int prow = pi32(r);

  auto stage = [=](int j, int buf) __attribute__((always_inline)) {
    LAS char* kb = lds + buf * 32768;
#pragma unroll
    for (int i = 0; i < 4; ++i) {
      const int pch = i * 256 + tid;
      { const int row = pch >> 4, ph = pch & 15, lg = ph ^ (row & 15);
        glds16(Kg + (size_t)(j * 64 + row) * 512 + lg * 8, kb + pch * 16); }
      { const int row = pch >> 3, ph = pch & 7, lg = ph ^ ((row >> 1) & 7);
        glds16(VT + (size_t)row * ldv + j * 64 + lg * 8, kb + 16384 + pch * 16); }
    }
  };
  lds_barrier();
  stage(j0, 0);
  asm volatile("s_waitcnt vmcnt(0)" ::: "memory");
  __syncthreads();
  for (int j = j0; j < ntiles; ++j) {
    const int buf = (j - j0) & 1;
    if (j + 1 < ntiles) stage(j + 1, buf ^ 1);
    {
      const LAS char* kb = lds + buf * 32768;
      const LAS char* vb = kb + 16384;
      const bool fast = DIFF && (j < cw);
#pragma unroll
      for (int kt = 0; kt < 2; ++kt) {
        const int krow = 32 * kt + prow;
        const LAS char* krp = kb + krow * 256;
        bf16x8 P0[2], P1[2];
        if (DIFF) {
#pragma unroll
          for (int c = 0; c < 2; ++c) {
            f32x16 s;
            if (fast) {
              s = cinit;
#pragma unroll
              for (int ks = 0; ks < 4; ++ks) {
                const int ch = (2 * (4 * c + ks) + h) ^ (krow & 15);
                s = mfma32(*reinterpret_cast<const LAS bf16x8*>(krp + ch * 16), qf[4 * c + ks], s);
              }
              const float t = tq + slope2 * (float)(j * 64 + kt * 32);
#pragma unroll
              for (int i = 0; i < 16; ++i) s[i] = __builtin_amdgcn_exp2f(s[i] + t);
            } else {
              s = zero16;
#pragma unroll
              for (int ks = 0; ks < 4; ++ks) {
                const int ch = (2 * (4 * c + ks) + h) ^ (krow & 15);
                s = mfma32(*reinterpret_cast<const LAS bf16x8*>(krp + ch * 16), qf[4 * c + ks], s);
              }
#pragma unroll
              for (int i = 0; i < 16; ++i) {
                const int kp = j * 64 + kt * 32 + klocal(i, h);
                const float bias = -slope2 * fabsf((float)(qpos - kp)) - M2;
                s[i] = (kp < nkeys && j <= cw) ? __builtin_amdgcn_exp2f(s[i] + bias) : 0.f;
              }
            }
            float ls = 0.f;
#pragma unroll
            for (int i = 0; i < 16; ++i) ls += s[i];
            if (c == 0) { l0 += ls; P0[0] = pack8(s, 0); P0[1] = pack8(s, 1); }
            else        { l1 += ls; P1[0] = pack8(s, 0); P1[1] = pack8(s, 1); }
          }
        } else {
          f32x16 s = zero16;
#pragma unroll
          for (int ks = 0; ks < 8; ++ks) {
            const int ch = (2 * ks + h) ^ (krow & 15);
            s = mfma32(*reinterpret_cast<const LAS bf16x8*>(krp + ch * 16), qf[ks], s);
          }
          float ls = 0.f;
#pragma unroll
          for (int i = 0; i < 16; ++i) { s[i] = __builtin_amdgcn_exp2f(s[i] - M2); ls += s[i]; }
          l0 += ls; P0[0] = pack8(s, 0); P0[1] = pack8(s, 1);
        }
#pragma unroll
        for (int et = 0; et < 4; ++et) {
          const int vrow = 32 * et + r;
#pragma unroll
          for (int sp = 0; sp < 2; ++sp) {
            const int ch = (2 * (2 * kt + sp) + h) ^ ((vrow >> 1) & 7);
            const bf16x8 vf = *reinterpret_cast<const LAS bf16x8*>(vb + vrow * 128 + ch * 16);
            O0[et] = mfma32(vf, P0[sp], O0[et]);
            if (DIFF) O1[et] = mfma32(vf, P1[sp], O1[et]);
          }
        }
      }
    }
    asm volatile("s_waitcnt vmcnt(0)" ::: "memory");
    __syncthreads();
  }
  if (act) {
    l0 += __shfl_xor(l0, 32);
    const float i0 = 1.f / l0;
    float i1 = 0.f;
    if (DIFF) { l1 += __shfl_xor(l1, 32); i1 = lam / l1; }
    float ss = 0.f;
#pragma unroll
    for (int et = 0; et < 4; ++et)
#pragma unroll
      for (int i = 0; i < 16; ++i) {
        float o = O0[et][i] * i0;
        if (DIFF) o -= O1[et][i] * i1;
        O0[et][i] = o; ss += o * o;
      }
    float rs = 1.f;
    if (DIFF) { ss += __shfl_xor(ss, 32); rs = rsqrtf(ss * (1.f / 128.f) + EPS) * 0.8f; }
    u16* grow = G + (size_t)(32 * w + r) * 512;
    u32x2 gt[16]; float4 sv[16];
#pragma unroll
    for (int q = 0; q < 16; ++q) {
      const int e0 = 32 * (q >> 2) + 8 * (q & 3) + 4 * h;
      gt[q] = *reinterpret_cast<const u32x2*>(grow + e0);
      if (DIFF) sv[q] = *reinterpret_cast<const float4*>(subg + e0); else sv[q] = float4{1.f, 1.f, 1.f, 1.f};
    }
#pragma unroll
    for (int q = 0; q < 16; ++q) {
      const int et = q >> 2, g = q & 3;
      const int e0 = 32 * et + 8 * g + 4 * h;
      const float a0 = O0[et][4 * g + 0] * rs * sv[q].x * bflo(gt[q][0]);
      const float a1 = O0[et][4 * g + 1] * rs * sv[q].y * bfhi(gt[q][0]);
      const float a2 = O0[et][4 * g + 2] * rs * sv[q].z * bflo(gt[q][1]);
      const float a3 = O0[et][4 * g + 3] * rs * sv[q].w * bfhi(gt[q][1]);
      u32x2 o = {cvtpk(a0, a1), cvtpk(a2, a3)};
      *reinterpret_cast<u32x2*>(grow + e0) = o;
    }
  }
}

DEVI float max_abs64(const float* g, int n, int lane) { float v = 0.f; for (int i = lane; i < n; i += 64) v = fmaxf(v, fabsf(g[i])); return wmax(v); }

DEVI float scan_add(float v, int lane) { for (int o = 1; o < 64; o <<= 1) { const float t = __shfl_up(v, o); if (lane >= o) v += t; } return v; }
DEVI float scan_max(float v, int lane) { for (int o = 1; o < 64; o <<= 1) { const float t = __shfl_up(v, o); if (lane >= o) v = fmaxf(v, t); } return v; }
DEVI float bfe(const bf16x8& v, int j) { return __uint_as_float(((unsigned)(u16)v[j]) << 16); }

template <int NT>
DEVI void mlstm_local(LAS char* lds, const float* gates, int hd, const u16* KT, const u16* VT, int ldt,
                            f32x16 (&acc)[4], float& nh, float& bL, float& amax) {
  const int tid = threadIdx.x, lane = tid & 63, w = tid >> 6, r = lane & 31, h = lane >> 5;
  constexpr int L = 32 * NT;
  const float lf = lane < L ? gates[lane * 8 + 4 + hd] : 0.f;
  const float ig = lane < L ? gates[lane * 8 + hd] : -INFINITY;
  const float b = scan_add(lf, lane);
  const float a = ig - b;
  amax = wmax(a);
  bL = __shfl(b, L - 1);
  LAS float* wt = (LAS float*)(lds + 4096) + w * 64;
  wt[lane] = __expf(a - amax);
#pragma unroll
  for (int e = 0; e < 4; ++e)
#pragma unroll
    for (int i = 0; i < 16; ++i) acc[e][i] = 0.f;
  nh = 0.f;
#pragma unroll
  for (int ks = 0; ks < 2 * NT; ++ks) {
    const bf16x8 kf = ldg8(KT + (size_t)(32 * w + r) * ldt + 16 * ks + 8 * h);
    float wv[8];
#pragma unroll
    for (int j = 0; j < 8; ++j) { wv[j] = wt[16 * ks + 8 * h + j]; nh += bfe(kf, j) * wv[j]; }
#pragma unroll
    for (int et = 0; et < 4; ++et) {
      const bf16x8 vf = ldg8(VT + (size_t)(32 * et + r) * ldt + 16 * ks + 8 * h);
      u32x4 sv = {cvtpk(bfe(vf, 0) * wv[0], bfe(vf, 1) * wv[1]), cvtpk(bfe(vf, 2) * wv[2], bfe(vf, 3) * wv[3]),
                  cvtpk(bfe(vf, 4) * wv[4], bfe(vf, 5) * wv[5]), cvtpk(bfe(vf, 6) * wv[6], bfe(vf, 7) * wv[7])};
      acc[et] = mfma32(kf, *reinterpret_cast<bf16x8*>(&sv), acc[et]);
    }
  }
  nh += __shfl_xor(nh, 32);
}

template <int NT>
DEVI void mlstm_out(LAS char* lds, const float* gates, int hd, const u16* Qg, const u16* Kg, const u16* VT, int ldv,
                          const u16* CT, const float* n0, float m0, const float* mg, u16* G) {
  const int tid = threadIdx.x, lane = tid & 63, w = tid >> 6, r = lane & 31, h = lane >> 5;
  constexpr int L = 32 * NT;
  const float lf = lane < L ? gates[lane * 8 + 4 + hd] : 0.f;
  const float ig = lane < L ? gates[lane * 8 + hd] : -INFINITY;
  const float b = scan_add(lf, lane);
  const float a = ig - b;
  const float Mrow = fmaxf(m0, scan_max(a, lane));
  const float mt = b + Mrow;
  LAS float* at = (LAS float*)lds + w * 64;
  LAS float* red = (LAS float*)(lds + 1024);
  at[lane] = a;
  const int prow = pi32(r);
#pragma unroll 1
  for (int tt = 0; tt < NT; ++tt) {
    const int t = 32 * tt + r;
    const float Mrow_t = __shfl(Mrow, t), mt_t = __shfl(mt, t);
    const float winter = __expf(m0 - Mrow_t);
    bf16x8 qf[8];
    float qn = 0.f;
#pragma unroll
    for (int i = 0; i < 8; ++i) {
      qf[i] = ldg8(Qg + (size_t)t * 512 + 16 * i + 8 * h);
      const float4 na = *reinterpret_cast<const float4*>(n0 + 16 * i + 8 * h), nb = *reinterpret_cast<const float4*>(n0 + 16 * i + 8 * h + 4);
      qn += bfe(qf[i], 0) * na.x + bfe(qf[i], 1) * na.y + bfe(qf[i], 2) * na.z + bfe(qf[i], 3) * na.w
          + bfe(qf[i], 4) * nb.x + bfe(qf[i], 5) * nb.y + bfe(qf[i], 6) * nb.z + bfe(qf[i], 7) * nb.w;
    }
    qn += __shfl_xor(qn, 32);
    f32x16 H;
#pragma unroll
    for (int i = 0; i < 16; ++i) H[i] = 0.f;
#pragma unroll
    for (int ks = 0; ks < 8; ++ks) H = mfma32(ldg8(CT + (size_t)(32 * w + r) * 128 + 16 * ks + 8 * h), qf[ks], H);
#pragma unroll
    for (int i = 0; i < 16; ++i) H[i] *= winter;
    float dsum = 0.f;
    for (int st = 0; st <= tt; ++st) {
      f32x16 S;
#pragma unroll
      for (int i = 0; i < 16; ++i) S[i] = 0.f;
#pragma unroll
      for (int ks = 0; ks < 8; ++ks) S = mfma32(ldg8(Kg + (size_t)(32 * st + prow) * 512 + 16 * ks + 8 * h), qf[ks], S);
#pragma unroll
      for (int i = 0; i < 16; ++i) {
        const int s = 32 * st + klocal(i, h);
        const float wg = (s <= t) ? __expf(at[s] - Mrow_t) : 0.f;
        S[i] *= wg; dsum += S[i];
      }
#pragma unroll
      for (int sp = 0; sp < 2; ++sp)
        H = mfma32(ldg8(VT + (size_t)(32 * w + r) * ldv + 32 * st + 16 * sp + 8 * h), pack8(S, sp), H);
    }
    dsum += __shfl_xor(dsum, 32);
    const float den = winter * qn + dsum;
    const float inv = 1.f / fmaxf(fabsf(den), __expf(-mt_t));
    float ss = 0.f;
#pragma unroll
    for (int i = 0; i < 16; ++i) { H[i] *= inv; ss += H[i] * H[i]; }
    ss += __shfl_xor(ss, 32);
    if (h == 0) red[w * 64 + t] = ss;
    lds_barrier();
    const float tot = red[t] + red[64 + t] + red[128 + t] + red[192 + t];
    const float rs = rsqrtf(tot * (1.f / 128.f) + EPS);
    u16* grow = G + (size_t)t * 512;
    u32x2 gt[4]; float4 mv[4];
#pragma unroll
    for (int g = 0; g < 4; ++g) {
      const int e0 = 32 * w + 8 * g + 4 * h;
      gt[g] = *reinterpret_cast<const u32x2*>(grow + e0);
      mv[g] = *reinterpret_cast<const float4*>(mg + e0);
    }
#pragma unroll
    for (int g = 0; g < 4; ++g) {
      const int e0 = 32 * w + 8 * g + 4 * h;
      u32x2 o = {cvtpk(H[4 * g + 0] * rs * mv[g].x * bflo(gt[g][0]), H[4 * g + 1] * rs * mv[g].y * bfhi(gt[g][0])),
                 cvtpk(H[4 * g + 2] * rs * mv[g].z * bflo(gt[g][1]), H[4 * g + 3] * rs * mv[g].w * bfhi(gt[g][1]))};
      *reinterpret_cast<u32x2*>(grow + e0) = o;
    }
    lds_barrier();
  }
}

DEVI void m1_item(const Params& p, LAS char* lds, int item) {
  const int tid = threadIdx.x, lane = tid & 63, w = tid >> 6, r = lane & 31, h = lane >> 5;
  const int bh = item >> 7, c = item & 127, b = bh >> 2, hd = bh & 3;
  const size_t row0 = (size_t)b * SEQ + c * 64;
  f32x16 acc[4]; float nh, bL, amax;
  lds_barrier();
  mlstm_local<2>(lds, p.gates + row0 * 8, hd, p.KaT + (size_t)bh * 128 * SEQ + c * 64, p.VaT + (size_t)bh * 128 * SEQ + c * 64, SEQ, acc, nh, bL, amax);
  u16* Chat = p.xb + ((size_t)item * 128) * 128;
#pragma unroll
  for (int et = 0; et < 4; ++et)
#pragma unroll
    for (int g = 0; g < 4; ++g) {
      const int d0 = 32 * w + 8 * g + 4 * h, e = 32 * et + r;
      u32x2 o = {cvtpk(acc[et][4 * g], acc[et][4 * g + 1]), cvtpk(acc[et][4 * g + 2], acc[et][4 * g + 3])};
      *reinterpret_cast<u32x2*>(Chat + (size_t)e * 128 + d0) = o;
    }
  if (h == 0) p.nhat[(size_t)item * 128 + 32 * w + r] = nh;
  if (tid == 0) { p.tabA[item] = bL; p.tabB[item] = bL + amax; }
}

DEVI void phase_scan(const Params& p, LAS char* lds) {
  const int tid = threadIdx.x, lane = tid & 63;
  LAS float* al = (LAS float*)lds; LAS float* be = al + 128; LAS float* ms = al + 256;
  for (int u = blockIdx.x; u < 16 * 32; u += gridDim.x) {
    const int bh = u >> 5, part = u & 31;
    __syncthreads();
    if (tid < 64) {
      const float A0 = p.tabA[bh * 128 + 2 * lane], A1 = p.tabA[bh * 128 + 2 * lane + 1];
      const float B0 = p.tabB[bh * 128 + 2 * lane], B1 = p.tabB[bh * 128 + 2 * lane + 1];
      const float SAi = scan_add(A0 + A1, lane);
      const float SA0 = SAi - A1, SA1 = SAi;
      const float D0 = B0 - SA0, D1 = B1 - SA1;
      const float PMi = scan_max(fmaxf(D0, D1), lane);
      float PMx = __shfl_up(PMi, 1); if (lane == 0) PMx = -INFINITY;
      const float mn0 = SA0 + fmaxf(0.f, fmaxf(PMx, D0));
      const float mn1 = SA1 + fmaxf(0.f, PMi);
      float mprev = __shfl_up(mn1, 1); if (lane == 0) mprev = 0.f;
      al[2 * lane] = __expf(A0 + mprev - mn0); be[2 * lane] = __expf(B0 - mn0);
      al[2 * lane + 1] = __expf(A1 + mn0 - mn1); be[2 * lane + 1] = __expf(B1 - mn1);
      ms[2 * lane] = mprev; ms[2 * lane + 1] = mn0;
      if (lane == 63) ms[128] = mn1;
    }
    __syncthreads();
    if (part == 0) {
      if (tid < 129) p.mtab[bh * 129 + tid] = ms[tid];
      if (tid == 0) p.out[O_PM + bh] = ms[128];
    }
    u16* base = p.xb + (size_t)bh * 128 * 16384 + part * 512 + tid * 2;
    float c0 = 0.f, c1 = 0.f;
    for (int c = 0; c < 128; c += 8) {
      unsigned v[8];
#pragma unroll
      for (int j = 0; j < 8; ++j) v[j] = *reinterpret_cast<const unsigned*>(base + (size_t)(c + j) * 16384);
#pragma unroll
      for (int j = 0; j < 8; ++j) {
        *reinterpret_cast<unsigned*>(base + (size_t)(c + j) * 16384) = cvtpk(c0, c1);
        const float a_ = al[c + j], b_ = be[c + j];
        c0 = a_ * c0 + b_ * bflo(v[j]); c1 = a_ * c1 + b_ * bfhi(v[j]);
      }
    }
    { const int idx = part * 512 + tid * 2, e = idx >> 7, d = idx & 127;
      p.out[O_PC + ((size_t)bh * 128 + d) * 128 + e] = c0;
      p.out[O_PC + ((size_t)bh * 128 + d + 1) * 128 + e] = c1; }
    if (part == 0 && tid < 128) {
      float n = 0.f;
      for (int c = 0; c < 128; c += 16) {
        float nv[16];
#pragma unroll
        for (int j = 0; j < 16; ++j) nv[j] = p.nhat[((size_t)bh * 128 + c + j) * 128 + tid];
#pragma unroll
        for (int j = 0; j < 16; ++j) {
          p.nstate[((size_t)bh * 128 + c + j) * 128 + tid] = n;
          n = al[c + j] * n + be[c + j] * nv[j];
        }
      }
      p.out[O_PN + bh * 128 + tid] = n;
    }
  }
}

DEVI void m3_item(const Params& p, LAS char* lds, int item) {
  const int bh = item >> 7, c = item & 127, b = bh >> 2, hd = bh & 3;
  const size_t row0 = (size_t)b * SEQ + c * 64;
  lds_barrier();
  mlstm_out<2>(lds, p.gates + row0 * 8, hd, p.Qa + row0 * 512 + hd * 128, p.Ka + row0 * 512 + hd * 128,
               p.VaT + (size_t)bh * 128 * SEQ + c * 64, SEQ, p.xb + (size_t)item * 16384, p.nstate + (size_t)item * 128,
               p.mtab[bh * 129 + c], p.in[15] + hd * 128, p.Ga + row0 * 512 + hd * 128);
}

DEVI void ms_item(const Params& p, LAS char* lds, int bh) {
  const int tid = threadIdx.x, lane = tid & 63, w = tid >> 6, r = lane & 31, h = lane >> 5;
  const int b = bh >> 2, hd = bh & 3;
  const size_t row0 = (size_t)NTOKP + b * 32;
  const float m0 = p.in[9][bh];
  const float* n0 = p.in[8] + bh * 128;
  const u16* KTs = p.KaT + (size_t)NTOKP * 512 + (size_t)bh * 128 * 32;
  const u16* VTs = p.VaT + (size_t)NTOKP * 512 + (size_t)bh * 128 * 32;
  lds_barrier();
  mlstm_out<1>(lds, p.gates + row0 * 8, hd, p.Qa + row0 * 512 + hd * 128, p.Ka + row0 * 512 + hd * 128, VTs, 32,
               p.C0sT + (size_t)bh * 16384, n0, m0, p.in[15] + hd * 128, p.Ga + row0 * 512 + hd * 128);
  f32x16 acc[4]; float nh, bL, amax;
  mlstm_local<1>(lds, p.gates + row0 * 8, hd, KTs, VTs, 32, acc, nh, bL, amax);
  const float mlast = bL + fmaxf(m0, amax);
  const float decay = __expf(bL + m0 - mlast), beta = __expf(bL + amax - mlast);
#pragma unroll
  for (int et = 0; et < 4; ++et)
#pragma unroll
    for (int i = 0; i < 16; ++i) {
      const int d = 32 * w + crow(i, h), e = 32 * et + r;
      const size_t o = ((size_t)bh * 128 + d) * 128 + e;
      p.out[O_SC + o] = decay * p.in[7][o] + beta * acc[et][i];
    }
  if (h == 0) { const int d = 32 * w + r; p.out[O_SN + bh * 128 + d] = decay * n0[d] + beta * nh; }
  if (tid == 0) p.out[O_SM + bh] = mlast;
}

DEVI void phase_conv(const Params& p, LAS char* lds) {
  const int tid = threadIdx.x, lane = tid & 63, w = tid >> 6;
  const u16* U = p.Qa; u16* Gc = p.KaT;
  LAS u16* win = (LAS u16*)lds;
  LAS float* cs = (LAS float*)(lds + 40960);
  LAS float* st = (LAS float*)(lds + 40960 + 32768);
  float cw[4][31], cb[4], lg[4], lb[4];
#pragma unroll
  for (int c = 0; c < 4; ++c) {
    const int chn = c * 256 + tid;
#pragma unroll
    for (int j = 0; j < 31; ++j) cw[c][j] = p.in[25][j * 1024 + chn];
    cb[c] = p.in[26][chn]; lg[c] = p.in[27][chn]; lb[c] = p.in[28][chn];
  }
  const int ntile = NTOK / 8;
  auto fetch = [=](int tile, int cgp, u32x4 (&rg)[5]) __attribute__((always_inline)) {
    const int row0 = tile * 8;
    const bool samp = row0 >= NTOKP;
    const int t0 = samp ? ((row0 - NTOKP) & 31) : (row0 & 8191);
    const int bs = samp ? ((row0 - NTOKP) >> 5) : 0;
    const int seqbase = row0 - t0;
#pragma unroll
    for (int q = 0; q < 5; ++q) {
      const int pch = tid + 256 * q, rr = pch >> 5, ch = pch & 31, t = t0 - 30 + rr;
      u32x4 v = {0, 0, 0, 0};
      if (pch < 38 * 32) {
        if (t >= 0) v = *reinterpret_cast<const u32x4*>(U + (size_t)(seqbase + t) * 1024 + cgp * 256 + ch * 8);
        else if (samp) {
          const float4* sc = reinterpret_cast<const float4*>(p.in[10] + ((size_t)(bs * 30 + 30 + t)) * 1024 + cgp * 256 + ch * 8);
          const float4 a = sc[0], c = sc[1];
          v = u32x4{cvtpk(a.x, a.y), cvtpk(a.z, a.w), cvtpk(c.x, c.y), cvtpk(c.z, c.w)};
        }
      }
      rg[q] = v;
    }
  };
  auto commit = [=](int buf, const u32x4 (&rg)[5]) __attribute__((always_inline)) {
#pragma unroll
    for (int q = 0; q < 5; ++q) {
      const int pch = tid + 256 * q;
      if (pch < 38 * 32) *reinterpret_cast<LAS u32x4*>(win + buf * (38 * 256) + (pch >> 5) * 256 + (pch & 31) * 8) = rg[q];
    }
  };
  int tile = blockIdx.x;
  if (tile >= ntile) return;
  u32x4 rg[5];
  __syncthreads();
  fetch(tile, 0, rg);
  commit(0, rg);
  __syncthreads();
  for (; tile < ntile; tile += gridDim.x) {
    const int row0 = tile * 8;
    const int ntl = tile + gridDim.x;
#pragma unroll
    for (int cgp = 0; cgp < 4; ++cgp) {
      const bool more = (cgp < 3) || (ntl < ntile);
      if (more) fetch(cgp < 3 ? tile : ntl, cgp < 3 ? cgp + 1 : 0, rg);
      const LAS u16* wb = win + (cgp & 1) * (38 * 256);
      float wv[38];
#pragma unroll
      for (int rr = 0; rr < 38; ++rr) wv[rr] = bf2f(wb[rr * 256 + tid]);
#pragma unroll
      for (int i = 0; i < 8; ++i) {
        float a = cb[cgp];
#pragma unroll
        for (int j = 0; j < 31; ++j) a += cw[cgp][j] * wv[i + j];
        cs[i * 1024 + cgp * 256 + tid] = a;
      }
      if (more) commit((cgp + 1) & 1, rg);
      lds_barrier();
    }
    u16 gv[4][8];
#pragma unroll
    for (int c = 0; c < 4; ++c)
#pragma unroll
      for (int i = 0; i < 8; ++i) gv[c][i] = Gc[(size_t)(row0 + i) * 1024 + c * 256 + tid];
#pragma unroll
    for (int q = 0; q < 2; ++q) {
      const int i = 2 * w + q;
      float a1 = 0.f, a2 = 0.f;
#pragma unroll
      for (int k = 0; k < 16; ++k) { const float v = cs[i * 1024 + lane + 64 * k]; a1 += v; a2 += v * v; }
      a1 = wsum(a1); a2 = wsum(a2);
      if (lane == 0) {
        const float mu = a1 * (1.f / 1024.f);
        const float var = fmaxf(a2 * (1.f / 1024.f) - mu * mu, 0.f);
        st[2 * i] = mu; st[2 * i + 1] = rsqrtf(var + EPS);
      }
    }
    lds_barrier();
#pragma unroll
    for (int c = 0; c < 4; ++c) {
      const int chn = c * 256 + tid;
#pragma unroll
      for (int i = 0; i < 8; ++i) {
        const float y = (cs[i * 1024 + chn] - st[2 * i]) * st[2 * i + 1] * lg[c] + lb[c];
        Gc[(size_t)(row0 + i) * 1024 + chn] = f2bf(siluf_(y) * bf2f(gv[c][i]));
      }
    }
    lds_barrier();
  }
}

struct AttnConst { float M2d, M2x, lam; };
DEVI AttnConst attn_consts(const Params& p, int layer) {
  const int lane = threadIdx.x & 63;
  AttnConst c;
  const float gq = max_abs64(p.in[16], 64, lane), gk = max_abs64(p.in[17], 64, lane);
  float kd = 0.f, kx = 0.f;
  for (int i = lane; i < (int)gridDim.x * 4; i += 64) { kd = fmaxf(kd, p.kmaxp[i]); kx = fmaxf(kx, p.kmaxp[1024 * (1 + layer) + i]); }
  kd = wmax(kd); kx = wmax(kx);
  c.M2d = (8.f * gq * 0.125f * LOG2E) * fmaxf(8.f * gk, sqrtf(kd)) * 1.01f;
  const float xq = max_abs64(p.in[32] + layer * 128, 128, lane), xk = max_abs64(p.in[33] + layer * 128, 128, lane);
  c.M2x = (11.313708f * xq * 0.08838834764831845f * LOG2E) * fmaxf(11.313708f * xk, sqrtf(kx)) * 1.01f;
  float d1 = p.in[18][lane] * p.in[19][lane], d2 = p.in[20][lane] * p.in[21][lane];
  d1 = wsum(d1); d2 = wsum(d2);
  c.lam = __expf(d1) - __expf(d2) + 0.2f;
  return c;
}

DEVI void cross_item(const Params& p, LAS char* lds, int layer, int it, float M2x) {
  const int hd = it & 3;
  size_t row0; int mb, nw;
  if (it < 1024) { const int rb = it >> 2; row0 = (size_t)rb * 128; mb = rb >> 6; nw = 4; }
  else { const int bs = (it - 1024) >> 2; row0 = (size_t)NTOKP + bs * 32; mb = 4 + bs; nw = 1; }
  attn_block<false>(lds, p.Qx + row0 * 512 + hd * 128, p.XK + ((size_t)(layer * 12 + mb) * 256) * 512 + hd * 128,
                    p.XVT + ((size_t)((layer * 12 + mb) * 4 + hd) * 128) * 256, 256, 0, 4, nw, 0, 256, 0.f, M2x, 0.f, nullptr,
                    p.Gx + row0 * 512 + hd * 128);
}

DEVI void diff_item(const Params& p, LAS char* lds, int it, float M2d, float lam) {
  const bool pr = it < 1024;
  const int hd = pr ? 3 - (it >> 8) : (it - 1024) & 3;
  const int qb = pr ? 63 - ((it >> 2) & 63) : 0;
  const int b = pr ? (it & 3) : (it - 1024) >> 2;
  const int bh = b * 4 + hd;
  const size_t row0 = pr ? (size_t)b * SEQ + qb * 128 : (size_t)NTOKP + b * 32;
  const float slope2 = exp2f(-2.f * (hd + 1)) * LOG2E;
  const u16* Kp = pr ? p.Kb + (size_t)b * SEQ * 512 + hd * 128 : p.Ks + (size_t)b * SKP * 512 + hd * 128;
  const u16* Vp = pr ? p.VbT + (size_t)bh * 128 * SEQ : p.VsT + (size_t)bh * 128 * SKP;
  const int qpos0 = pr ? qb * 128 : PAST;
  const float kcut = (float)qpos0 - (2.f * M2d + 64.f) / slope2;
  int j0 = (int)floorf((kcut - 63.f) * (1.f / 64.f));
  j0 = max(j0, 0);
  attn_block<true>(lds, p.Qb + row0 * 512 + hd * 128, Kp, Vp, pr ? SEQ : SKP, j0, pr ? 2 * qb + 2 : 33, pr ? 4 : 1,
                   qpos0, pr ? SEQ : PAST + 32, slope2, M2d, lam, p.in[22], p.Gb + row0 * 512 + hd * 128);
}

DEVI int snake(int k, int g, int G) { return (k & 1) ? (k * G + (G - 1 - g)) : (k * G + g); }

constexpr int NPHASE = 9;
DEVI void run_phase(const Params& p, LAS char* lds, int ph) {
  const int G = gridDim.x, g = blockIdx.x;
  switch (ph) {
    case 0: phase_prep(p); break;
    case 1: phase_gemm<0>(p, lds); break;
    case 2: {
      const AttnConst c = attn_consts(p, 0);
      for (int it = g; it < 1056; it += G) cross_item(p, lds, 0, it, c.M2x);
      for (int it = g; it < 2048; it += G) m1_item(p, lds, it);
    } break;
    case 3: {
      const AttnConst c = attn_consts(p, 0);
      (void)c;
      phase_scan(p, lds);
    } break;
    case 4: {
      const AttnConst c = attn_consts(p, 0);
      unsigned* qhead = reinterpret_cast<unsigned*>(p.kmaxp + 3 * 1024) + 16;
      volatile LAS int* slot = (volatile LAS int*)(lds + LDS_BYTES - 16);
      for (;;) {
        lds_barrier();
        if (threadIdx.x == 0) *slot = (int)__hip_atomic_fetch_add(qhead, 1u, __ATOMIC_RELAXED, __HIP_MEMORY_SCOPE_AGENT);
        lds_barrier();
        const int it = *slot;
        if (it >= 1056) break;
        diff_item(p, lds, it, c.M2d, c.lam);
      }
      for (;;) {
        lds_barrier();
        if (threadIdx.x == 0) *slot = (int)__hip_atomic_fetch_add(qhead + 16, 1u, __ATOMIC_RELAXED, __HIP_MEMORY_SCOPE_AGENT);
        lds_barrier();
        const int it = *slot;
        if (it >= 2048) break;
        m3_item(p, lds, it);
      }
      for (int it = G - 1 - g; it < 32; it += G) ms_item(p, lds, it);
    } break;
    case 5: phase_gemm<1>(p, lds); break;
    case 6: phase_gemm<2>(p, lds); break;
    case 7: {
      const AttnConst c = attn_consts(p, 1);
      phase_conv(p, lds);
      for (int it = g; it < 1056; it += G) cross_item(p, lds, 1, it, c.M2x);
    } break;
    case 8: phase_gemm<3>(p, lds); break;
  }
}

DEVI void grid_bar(unsigned* ctr, unsigned& epoch) {
  asm volatile("s_waitcnt vmcnt(0)" ::: "memory");
  __syncthreads();
  if (threadIdx.x == 0) {
    __builtin_amdgcn_fence(__ATOMIC_RELEASE, "agent");
    asm volatile("s_waitcnt vmcnt(0)" ::: "memory");
    __hip_atomic_fetch_add(ctr, 1u, __ATOMIC_RELAXED, __HIP_MEMORY_SCOPE_AGENT);
    epoch += 1u;
    const unsigned target = epoch * gridDim.x;
    while (__hip_atomic_load(ctr, __ATOMIC_RELAXED, __HIP_MEMORY_SCOPE_AGENT) < target) __builtin_amdgcn_s_sleep(1);
    __builtin_amdgcn_fence(__ATOMIC_ACQUIRE, "agent");
    asm volatile("s_waitcnt vmcnt(0)" ::: "memory");
  }
  __syncthreads();
}

__global__ void __launch_bounds__(256, 1) mega(Params p, int ph_lo, int ph_hi) {
  extern __shared__ __attribute__((aligned(16))) char smem[];
  LAS char* lds = (LAS char*)smem;
  cg::grid_group grid = cg::this_grid();
  unsigned epoch = 0;
  unsigned* ctr = reinterpret_cast<unsigned*>(p.kmaxp + 3 * 1024);
#define RUNPH(k) if (ph_lo <= (k) && (k) < ph_hi) { if ((k) > ph_lo) { if ((k) == 1) grid.sync(); else grid_bar(ctr, epoch); } run_phase(p, lds, (k)); }
  RUNPH(0) RUNPH(1) RUNPH(2) RUNPH(3) RUNPH(4) RUNPH(5) RUNPH(6) RUNPH(7) RUNPH(8)
#undef RUNPH
}

#ifndef MULTI_LAUNCH
#define MULTI_LAUNCH 0
#endif

extern "C" void kernel_launch(void* const* d_in, const int* in_sizes, int n_in, void* d_out, int out_size, void* d_ws, size_t ws_size,
                              hipStream_t stream) {
  static int grid_blocks = 0;
  if (!grid_blocks) {
    int dev = 0, cus = 0, per_cu = 0;
    hipGetDevice(&dev);
    hipDeviceGetAttribute(&cus, hipDeviceAttributeMultiprocessorCount, dev);
    hipFuncSetAttribute((const void*)mega, hipFuncAttributeMaxDynamicSharedMemorySize, LDS_BYTES);
    hipOccupancyMaxActiveBlocksPerMultiprocessor(&per_cu, (const void*)mega, 256, LDS_BYTES);
    if (per_cu < 1) per_cu = 1;
    if (per_cu > 1) per_cu = 1;
    grid_blocks = (cus * per_cu) & ~7;
    if (grid_blocks < 8) grid_blocks = 8;
  }
  Params p{};
  for (int i = 0; i < 34; ++i) p.in[i] = (const float*)d_in[i];
  p.out = (float*)d_out;
  char* ws = (char*)d_ws;
  size_t off = 0;
  auto take = [&](size_t bytes) { char* q = ws + off; off += (bytes + 255) & ~(size_t)255; return q; };
  p.WtInA = (u16*)take((size_t)NPAD_A * 1024 * 2);
  p.WtOutA = (u16*)take((size_t)1024 * 1536 * 2);
  p.WtInC = (u16*)take((size_t)4096 * 1024 * 2);
  p.WtOutC = (u16*)take((size_t)1024 * 1536 * 2);
  p.WtMem = (u16*)take((size_t)2 * 1024 * 1024 * 2);
  p.xb = (u16*)take((size_t)NTOK * 1024 * 2);
  p.memb = (u16*)take((size_t)1024 * 1024 * 2);
  u16* segs = (u16*)take(SEG * 2 * 11);
  p.Qa = segs; p.Ka = segs + SEG; p.KaT = segs + 2 * SEG; p.VaT = segs + 3 * SEG; p.Ga = segs + 4 * SEG; p.Qb = segs + 5 * SEG;
  p.Kb = segs + 6 * SEG; p.VbT = segs + 7 * SEG; p.Gb = segs + 8 * SEG; p.Qx = segs + 9 * SEG; p.Gx = segs + 10 * SEG;
  p.Ks = (u16*)take((size_t)8 * SKP * 512 * 2);
  p.VsT = (u16*)take((size_t)4096 * SKP * 2);
  p.XK = (u16*)take((size_t)2 * 12 * 256 * 512 * 2);
  p.XVT = (u16*)take((size_t)2 * 12 * 256 * 512 * 2);
  p.C0sT = (u16*)take((size_t)32 * 16384 * 2);
  p.rs0 = (float*)take((size_t)NTOK * 4);
  p.ssq1 = (float*)take((size_t)NTOK * 4);
  p.rsmem = (float*)take((size_t)(1024 + 64) * 4);
  p.gates = (float*)take((size_t)NTOK * 8 * 4);
  p.tabA = (float*)take(2048 * 4);
  p.tabB = (float*)take(2048 * 4);
  p.mtab = (float*)take(16 * 129 * 4);
  p.nhat = (float*)take((size_t)2048 * 128 * 4);
  p.nstate = (float*)take((size_t)2048 * 128 * 4);
  p.kmaxp = (float*)take((size_t)3 * 1024 * 4 + 256);
  if (off > ws_size) { fprintf(stderr, "workspace too small: need %zu have %zu\n", off, ws_size); return; }
  (void)hipMemsetAsync(p.kmaxp + 3 * 1024, 0, 256, stream);
#if MULTI_LAUNCH
  for (int ph = 0; ph < NPHASE; ++ph) {
    hipLaunchKernelGGL(mega, dim3(grid_blocks), dim3(256), LDS_BYTES, stream, p, ph, ph + 1);
  }
#else
  int lo = 0, hi = NPHASE;
  void* args[] = {&p, &lo, &hi};
  hipError_t e = hipLaunchCooperativeKernel((const void*)mega, dim3(grid_blocks), dim3(256), args, LDS_BYTES, stream);
  if (e != hipSuccess) fprintf(stderr, "cooperative launch failed: %s (grid %d)\n", hipGetErrorString(e), grid_blocks);
#endif
}
```

```cpp
#include <hip/hip_runtime.h>
#include <hip/hip_cooperative_groups.h>
#include <stdint.h>
#include <stdio.h>
namespace cg = cooperative_groups;

typedef unsigned short u16;
using bf16x8 = __attribute__((ext_vector_type(8))) short;
using f32x4  = __attribute__((ext_vector_type(4))) float;
using f32x16 = __attribute__((ext_vector_type(16))) float;
using u32x4  = __attribute__((ext_vector_type(4))) unsigned;
using u32x2  = __attribute__((ext_vector_type(2))) unsigned;
#define LAS __attribute__((address_space(3)))
#define DEVI __device__ __forceinline__

constexpr int NTOKP = 32768, NTOKS = 256, NTOK = 33024;
constexpr int SEQ = 8192, LSAMP = 32, PAST = 2048, SKP = 2112;
constexpr size_t SEG = (size_t)NTOK * 512;
constexpr int NPAD_A = 5760;
constexpr float EPS = 1e-6f;
constexpr float LOG2E = 1.4426950408889634f;
constexpr size_t O_YP = 0, O_PXK = 33816576, O_PXV = 34865152, O_PK = 35913728, O_PV = 52690944,
  O_PC = 69468160, O_PN = 69730304, O_PM = 69732352, O_PCONV = 69732368, O_SK = 69855248, O_SV = 69986320,
  O_SC = 70117392, O_SN = 70641680, O_SM = 70645776, O_SCONV = 70645808;

constexpr int LDS_BYTES = 147456;

struct Params {
  const float* in[34];
  float* out;
  u16 *WtInA, *WtOutA, *WtInC, *WtOutC, *WtMem;
  u16 *xb, *memb;
  u16 *Qa, *Ka, *KaT, *VaT, *Ga, *Qb, *Kb, *VbT, *Gb, *Qx, *Gx;
  u16 *Ks, *VsT, *XK, *XVT, *C0sT;
  float *rs0, *ssq1, *rsmem, *gates, *tabA, *tabB, *mtab, *nhat, *nstate, *kmaxp;
};

DEVI unsigned cvtpk(float lo, float hi) { unsigned r; asm volatile("v_cvt_pk_bf16_f32 %0, %1, %2" : "=v"(r) : "v"(lo), "v"(hi)); return r; }
DEVI float bflo(unsigned u) { return __uint_as_float(u << 16); }
DEVI float bfhi(unsigned u) { return __uint_as_float(u & 0xffff0000u); }
DEVI float bf2f(u16 h) { return __uint_as_float(((unsigned)h) << 16); }
DEVI u16 f2bf(float f) { return (u16)(cvtpk(f, 0.f) & 0xffffu); }
DEVI float sigmoidf_(float x) { return 1.f / (1.f + __expf(-x)); }
DEVI float siluf_(float x) { return x / (1.f + __expf(-x)); }
DEVI float logsigmoidf_(float x) { return fminf(x, 0.f) - log1pf(__expf(-fabsf(x))); }
DEVI float wsum(float v) { for (int o = 32; o; o >>= 1) v += __shfl_xor(v, o); return v; }
DEVI float wmax(float v) { for (int o = 32; o; o >>= 1) v = fmaxf(v, __shfl_xor(v, o)); return v; }
DEVI int pi32(int r) { return (r & ~12) | ((r & 4) << 1) | ((r & 8) >> 1); }
DEVI int klocal(int reg, int h) { return (reg & 3) + 4 * ((reg >> 2) & 1) + 8 * h + 16 * (reg >> 3); }
DEVI int crow(int reg, int h) { return (reg & 3) + 8 * (reg >> 2) + 4 * h; }
DEVI bf16x8 ldg8(const u16* p) { return *reinterpret_cast<const bf16x8*>(p); }
DEVI f32x16 mfma32(bf16x8 a, bf16x8 b, f32x16 c) { return __builtin_amdgcn_mfma_f32_32x32x16_bf16(a, b, c, 0, 0, 0); }
DEVI bf16x8 pack8(const f32x16& x, int s) {
  u32x4 w = {cvtpk(x[8 * s + 0], x[8 * s + 1]), cvtpk(x[8 * s + 2], x[8 * s + 3]), cvtpk(x[8 * s + 4], x[8 * s + 5]), cvtpk(x[8 * s + 6], x[8 * s + 7])};
  return *reinterpret_cast<bf16x8*>(&w);
}
DEVI void lds_barrier() { asm volatile("s_waitcnt lgkmcnt(0)" ::: "memory"); __builtin_amdgcn_s_barrier(); asm volatile("" ::: "memory"); }
DEVI void glds16(const void* g, LAS void* l) { __builtin_amdgcn_global_load_lds((const unsigned*)g, (LAS unsigned*)l, 16, 0, 0); }

template <class F>
DEVI void wtrans(u16* dst, const float* src, const float* g, int K, int Npad, int ldn, F srccol, int gtid, int gsz) {
  const int total = Npad * (K / 64);
  for (int i = gtid; i < total; i += gsz) {
    const int n = i % Npad, kb = i / Npad;
    const int sc = srccol(n);
    float v[64];
#pragma unroll
    for (int j = 0; j < 64; ++j) v[j] = (sc >= 0) ? src[(size_t)(kb * 64 + j) * ldn + sc] : 0.f;
    if (g) {
#pragma unroll
      for (int j = 0; j < 64; ++j) v[j] *= g[kb * 64 + j];
    }
#pragma unroll
    for (int q = 0; q < 8; ++q) {
      u32x4 w = {cvtpk(v[8 * q + 0], v[8 * q + 1]), cvtpk(v[8 * q + 2], v[8 * q + 3]), cvtpk(v[8 * q + 4], v[8 * q + 5]), cvtpk(v[8 * q + 6], v[8 * q + 7])};
      *reinterpret_cast<u32x4*>(dst + (size_t)n * K + kb * 64 + q * 8) = w;
    }
  }
}

DEVI int srccol_in_a(int n) {
  const int t = n >> 7, c = n & 127;
  if (t < 12) return n;
  if (t < 20) { const int j = t - 12; return c < 64 ? 1536 + 64 * j + c : 2048 + 64 * j + (c - 64); }
  if (t < 44) return 2568 + (t - 20) * 128 + c;
  if (t == 44) return c < 8 ? 2560 + c : -1;
  return -1;
}
DEVI int srccol_in_c(int n) {
  const int t = n >> 7, c = n & 127;
  if (t < 16) return c < 64 ? 64 * t + c : 1024 + 64 * t + (c - 64);
  return n;
}

DEVI void phase_prep(const Params& p) {
  const int tid = threadIdx.x, lane = tid & 63;
  const int gtid = blockIdx.x * 256 + tid, gsz = gridDim.x * 256;
  const int gwave = gtid >> 6, nwaves = gsz >> 6;
  wtrans(p.WtInA, p.in[12], p.in[11], 1024, NPAD_A, 5640, [](int n) { return srccol_in_a(n); }, gtid, gsz);
  wtrans(p.WtOutA, p.in[23], nullptr, 1536, 1024, 1024, [](int n) { return n; }, gtid, gsz);
  wtrans(p.WtInC, p.in[24], p.in[11] + 1024, 1024, 4096, 4096, [](int n) { return srccol_in_c(n); }, gtid, gsz);
  wtrans(p.WtOutC, p.in[29], nullptr, 1536, 1024, 1024, [](int n) { return n; }, gtid, gsz);
  for (int l = 0; l < 2; ++l)
    wtrans(p.WtMem + (size_t)l * 1024 * 1024, p.in[31] + (size_t)l * 1024 * 1024, p.in[30] + l * 1024, 1024, 1024, 1024,
           [](int n) { return n; }, gtid, gsz);
  for (int row0 = gwave; row0 < NTOK + 1024; row0 += 8 * nwaves) {
    float4 v[8][4];
    const float* xr[8];
#pragma unroll
    for (int u = 0; u < 8; ++u) {
      const int row = min(row0 + u * nwaves, NTOK + 1023);
      xr[u] = row < NTOKP ? p.in[0] + (size_t)row * 1024 : (row < NTOK ? p.in[1] + (size_t)(row - NTOKP) * 1024 : p.in[2] + (size_t)(row - NTOK) * 1024);
    }
#pragma unroll
    for (int u = 0; u < 8; ++u)
#pragma unroll
      for (int i = 0; i < 4; ++i) v[u][i] = reinterpret_cast<const float4*>(xr[u])[lane + 64 * i];
#pragma unroll
    for (int u = 0; u < 8; ++u) {
      const int row = row0 + u * nwaves;
      float ss = 0.f;
#pragma unroll
      for (int i = 0; i < 4; ++i) ss += v[u][i].x * v[u][i].x + v[u][i].y * v[u][i].y + v[u][i].z * v[u][i].z + v[u][i].w * v[u][i].w;
      ss = wsum(ss);
      if (row < NTOK + 1024) {
        u16* dst = row < NTOK ? p.xb + (size_t)row * 1024 : p.memb + (size_t)(row - NTOK) * 1024;
        float* rsd = row < NTOK ? p.rs0 + row : p.rsmem + (row - NTOK);
        if (lane == 0) *rsd = rsqrtf(ss * (1.f / 1024.f) + EPS);
#pragma unroll
        for (int i = 0; i < 4; ++i) { u32x2 w = {cvtpk(v[u][i].x, v[u][i].y), cvtpk(v[u][i].z, v[u][i].w)}; reinterpret_cast<u32x2*>(dst)[lane + 64 * i] = w; }
      }
    }
  }
  float km0 = 0.f, km1 = 0.f, km2 = 0.f;
  for (int i0 = gtid; i0 < 8 * PAST * 64; i0 += 4 * gsz) {
    float4 a[4], c[4];
#pragma unroll
    for (int u = 0; u < 4; ++u) {
      const int i = i0 + u * gsz;
      const int c8 = i & 63, pp = (i >> 6) & (PAST - 1), b = (i >> 17) & 7;
      const float4* sp = reinterpret_cast<const float4*>(p.in[5] + ((size_t)(b * PAST + pp) * 512 + c8 * 8));
      a[u] = sp[0]; c[u] = sp[1];
    }
#pragma unroll
    for (int u = 0; u < 4; ++u) {
      const int i = i0 + u * gsz;
      if (i < 8 * PAST * 64) {
        const int c8 = i & 63, pp = (i >> 6) & (PAST - 1), b = i >> 17;
        u32x4 w = {cvtpk(a[u].x, a[u].y), cvtpk(a[u].z, a[u].w), cvtpk(c[u].x, c[u].y), cvtpk(c[u].z, c[u].w)};
        *reinterpret_cast<u32x4*>(p.Ks + ((size_t)(b * SKP + pp) * 512 + c8 * 8)) = w;
        float ss = a[u].x * a[u].x + a[u].y * a[u].y + a[u].z * a[u].z + a[u].w * a[u].w + c[u].x * c[u].x + c[u].y * c[u].y + c[u].z * c[u].z + c[u].w * c[u].w;
        ss += __shfl_xor(ss, 1); ss += __shfl_xor(ss, 2); ss += __shfl_xor(ss, 4);
        km0 = fmaxf(km0, ss);
      }
    }
  }
  for (int i0 = gtid; i0 < 8 * 4 * 256 * 128; i0 += 4 * gsz) {
    float v[4][8];
#pragma unroll
    for (int u = 0; u < 4; ++u) {
      const int i = (i0 + u * gsz) & (8 * 4 * 256 * 128 - 1);
      const int dv = i & 127, p8 = (i >> 7) & 255, h = (i >> 15) & 3, b = i >> 17;
#pragma unroll
      for (int j = 0; j < 8; ++j) v[u][j] = p.in[6][((size_t)(b * PAST + p8 * 8 + j) * 4 + h) * 128 + dv];
    }
#pragma unroll
    for (int u = 0; u < 4; ++u) {
      const int i = i0 + u * gsz;
      if (i < 8 * 4 * 256 * 128) {
        const int dv = i & 127, p8 = (i >> 7) & 255, h = (i >> 15) & 3, b = i >> 17;
        u32x4 w = {cvtpk(v[u][0], v[u][1]), cvtpk(v[u][2], v[u][3]), cvtpk(v[u][4], v[u][5]), cvtpk(v[u][6], v[u][7])};
        *reinterpret_cast<u32x4*>(p.VsT + ((size_t)((b * 4 + h) * 128 + dv) * SKP + p8 * 8)) = w;
      }
    }
  }
  for (int i = gtid; i < 4096 * 4; i += gsz) {
    u32x4 z = {0, 0, 0, 0};
    *reinterpret_cast<u32x4*>(p.VsT + ((size_t)(i >> 2) * SKP + 2080 + (i & 3) * 8)) = z;
  }
  for (int i = gtid; i < 8 * 32 * 64; i += gsz) {
    u32x4 z = {0, 0, 0, 0};
    const int c8 = i & 63, r = (i >> 6) & 31, b = i >> 11;
    *reinterpret_cast<u32x4*>(p.Ks + ((size_t)(b * SKP + 2080 + r) * 512 + c8 * 8)) = z;
  }
  for (int i = gtid; i < 2 * 8 * 256 * 64; i += gsz) {
    const int c8 = i & 63, m = (i >> 6) & 255, b = (i >> 14) & 7, l = i >> 17;
    const float4* s = reinterpret_cast<const float4*>(p.in[3] + ((size_t)((l * 8 + b) * 256 + m) * 512 + c8 * 8));
    const float4 a = s[0], c = s[1];
    u32x4 w = {cvtpk(a.x, a.y), cvtpk(a.z, a.w), cvtpk(c.x, c.y), cvtpk(c.z, c.w)};
    *reinterpret_cast<u32x4*>(p.XK + ((size_t)((l * 12 + 4 + b) * 256 + m) * 512 + c8 * 8)) = w;
    float ss = a.x * a.x + a.y * a.y + a.z * a.z + a.w * a.w + c.x * c.x + c.y * c.y + c.z * c.z + c.w * c.w;
    ss += __shfl_xor(ss, 1); ss += __shfl_xor(ss, 2); ss += __shfl_xor(ss, 4); ss += __shfl_xor(ss, 8);
    if (l == 0) km1 = fmaxf(km1, ss); else km2 = fmaxf(km2, ss);
  }
  for (int i = gtid; i < 2 * 8 * 4 * 32 * 128; i += gsz) {
    const int dv = i & 127, m8 = (i >> 7) & 31, h = (i >> 12) & 3, b = (i >> 14) & 7, l = i >> 17;
    float v[8];
#pragma unroll
    for (int j = 0; j < 8; ++j) v[j] = p.in[4][((size_t)((l * 8 + b) * 256 + m8 * 8 + j) * 4 + h) * 128 + dv];
    u32x4 w = {cvtpk(v[0], v[1]), cvtpk(v[2], v[3]), cvtpk(v[4], v[5]), cvtpk(v[6], v[7])};
    *reinterpret_cast<u32x4*>(p.XVT + ((size_t)(((l * 12 + 4 + b) * 4 + h) * 128 + dv) * 256 + m8 * 8)) = w;
  }
  for (int i = gtid; i < 32 * 16 * 128; i += gsz) {
    const int e = i & 127, d8 = (i >> 7) & 15, bh = i >> 11;
    float v[8];
#pragma unroll
    for (int j = 0; j < 8; ++j) v[j] = p.in[7][((size_t)bh * 128 + d8 * 8 + j) * 128 + e];
    u32x4 w = {cvtpk(v[0], v[1]), cvtpk(v[2], v[3]), cvtpk(v[4], v[5]), cvtpk(v[6], v[7])};
    *reinterpret_cast<u32x4*>(p.C0sT + ((size_t)bh * 128 + e) * 128 + d8 * 8) = w;
  }
  for (int i = gtid; i < NTOK; i += gsz) p.ssq1[i] = 0.f;
  km0 = wmax(km0); km1 = wmax(km1); km2 = wmax(km2);
  if (lane == 0) {
    const int slot = blockIdx.x * 4 + (tid >> 6);
    p.kmaxp[slot] = km0; p.kmaxp[1024 + slot] = km1; p.kmaxp[2048 + slot] = km2;
  }
}

DEVI void gemm_core(LAS char* lds, const u16* A0, const u16* A1, const u16* A2, int lda0, int lda1, int lda2, int segK,
                    const u16* Bt, int K, int brow, int bcol, f32x4 (&acc)[4][4]) {
  const int tid = threadIdx.x, lane = tid & 63, wid = tid >> 6, wr = wid >> 1, wc = wid & 1, fr = lane & 15, fq = lane >> 4;
  LAS char* SA = lds; LAS char* SB = lds + 8192;
#pragma unroll
  for (int m = 0; m < 4; ++m)
#pragma unroll
    for (int n = 0; n < 4; ++n) acc[m][n] = f32x4{0.f, 0.f, 0.f, 0.f};
  const int nkt = K / 32;
  for (int kt = 0; kt < nkt; ++kt) {
    const int k0 = kt * 32;
    const int seg = k0 / segK;
    const u16* Ab = (seg == 0 ? A0 : (seg == 1 ? A1 : A2)) + (k0 - seg * segK);
    const int lda = (seg == 0 ? lda0 : (seg == 1 ? lda1 : lda2));
#pragma unroll
    for (int i = 0; i < 2; ++i) {
      const int b = tid * 16 + i * 4096, r = b >> 6, c = (b & 63) >> 1;
      glds16(Ab + (size_t)(brow + r) * lda + c, SA + b);
      glds16(Bt + (size_t)(bcol + r) * K + k0 + c, SB + b);
    }
    asm volatile("s_waitcnt vmcnt(0)" ::: "memory");
    __syncthreads();
    bf16x8 af[4], bfr[4];
#pragma unroll
    for (int m = 0; m < 4; ++m) af[m] = *reinterpret_cast<const LAS bf16x8*>(SA + (wr * 64 + m * 16 + fr) * 64 + fq * 16);
#pragma unroll
    for (int n = 0; n < 4; ++n) bfr[n] = *reinterpret_cast<const LAS bf16x8*>(SB + (wc * 64 + n * 16 + fr) * 64 + fq * 16);
#pragma unroll
    for (int m = 0; m < 4; ++m)
#pragma unroll
      for (int n = 0; n < 4; ++n) acc[m][n] = __builtin_amdgcn_mfma_f32_16x16x32_bf16(af[m], bfr[n], acc[m][n], 0, 0, 0);
    __syncthreads();
  }
}

DEVI void gemm_stage_c(LAS char* lds, const f32x4 (&acc)[4][4], const float* rowscale, int mode, int brow) {
  const int tid = threadIdx.x, lane = tid & 63, wid = tid >> 6, wr = wid >> 1, wc = wid & 1, fr = lane & 15, fq = lane >> 4;
  LAS float* Cs = (LAS float*)lds;
#pragma unroll
  for (int m = 0; m < 4; ++m)
#pragma unroll
    for (int j = 0; j < 4; ++j) {
      const int r = wr * 64 + m * 16 + fq * 4 + j;
      float s = 1.f;
      if (mode == 1) s = rowscale[brow + r];
      else if (mode == 2) s = rsqrtf(rowscale[brow + r] * (1.f / 1024.f) + EPS);
#pragma unroll
      for (int n = 0; n < 4; ++n) Cs[r * 132 + wc * 64 + n * 16 + fr] = acc[m][n][j] * s;
    }
  __syncthreads();
}

DEVI void st_bf8(u16* dst, const float (&v)[8]) {
  u32x4 w = {cvtpk(v[0], v[1]), cvtpk(v[2], v[3]), cvtpk(v[4], v[5]), cvtpk(v[6], v[7])};
  *reinterpret_cast<u32x4*>(dst) = w;
}
DEVI void st_f8(float* dst, const float (&v)[8]) {
  reinterpret_cast<float4*>(dst)[0] = float4{v[0], v[1], v[2], v[3]};
  reinterpret_cast<float4*>(dst)[1] = float4{v[4], v[5], v[6], v[7]};
}
DEVI void store_transposed(LAS char* lds, u16* dst, size_t ldt, float scale) {
  const LAS float* Cs = (const LAS float*)lds;
  const int c = threadIdx.x & 127, rh = (threadIdx.x >> 7) * 64;
#pragma unroll
  for (int it = 0; it < 8; ++it) {
    const int r0 = rh + it * 8;
    float v[8];
#pragma unroll
    for (int j = 0; j < 8; ++j) v[j] = Cs[(r0 + j) * 132 + c] * scale;
    st_bf8(dst + (size_t)c * ldt + r0, v);
  }
}

DEVI void epi_in_a(const Params& p, LAS char* lds, int brow, int n, const float (&gn)[8]) {
  const LAS float* Cs = (const LAS float*)lds;
  const int tid = threadIdx.x, cgp = tid & 15, c0 = cgp * 8;
  const bool samp = brow >= NTOKP;
  const int seg = n >> 2, hd = n & 3;
  if (n >= 4 && n < 12) {
    u16* base = (n < 8 ? p.KaT : p.VaT);
    const float sc = (n < 8 ? 0.08838834764831845f : 1.f);
    if (!samp) { const int b = brow >> 13, t0 = brow & 8191; store_transposed(lds, base + ((size_t)(b * 4 + hd) * 128) * SEQ + t0, SEQ, sc); }
    else {
      const int c = tid & 127, rh = (tid >> 7) * 64;
#pragma unroll
      for (int it = 0; it < 8; ++it) {
        const int r0 = rh + it * 8; const int bs = ((brow - NTOKP) + r0) >> 5, t0 = r0 & 31;
        float v[8];
#pragma unroll
        for (int j = 0; j < 8; ++j) v[j] = Cs[(r0 + j) * 132 + c] * sc;
        st_bf8(base + (size_t)NTOKP * 512 + ((size_t)(bs * 4 + hd) * 128 + c) * 32 + t0, v);
      }
    }
  }
  if (seg == 7) {
    if (!samp) { const int b = brow >> 13, t0 = brow & 8191; store_transposed(lds, p.VbT + ((size_t)(b * 4 + hd) * 128) * SEQ + t0, SEQ, 1.f); }
    else {
      const int c = tid & 127, rh = (tid >> 7) * 64;
#pragma unroll
      for (int it = 0; it < 8; ++it) {
        const int r0 = rh + it * 8; const int bs = ((brow - NTOKP) + r0) >> 5, t0 = r0 & 31;
        float v[8];
#pragma unroll
        for (int j = 0; j < 8; ++j) v[j] = Cs[(r0 + j) * 132 + c];
        st_bf8(p.VsT + ((size_t)(bs * 4 + hd) * 128 + c) * SKP + PAST + t0, v);
      }
    }
  }
#pragma unroll 4
  for (int it = 0; it < 8; ++it) {
    const int r = it * 16 + (tid >> 4);
    const size_t grow = (size_t)brow + r;
    float v[8];
#pragma unroll
    for (int j = 0; j < 8; ++j) v[j] = Cs[r * 132 + c0 + j];
    if (n < 4) { st_bf8(p.Qa + grow * 512 + hd * 128 + c0, v); }
    else if (n < 8) {
#pragma unroll
      for (int j = 0; j < 8; ++j) v[j] *= 0.08838834764831845f;
      st_bf8(p.Ka + grow * 512 + hd * 128 + c0, v);
    }
    else if (n < 12) {   }
    else if (n < 20) {
      if (cgp < 8) {
        float g[8];
#pragma unroll
        for (int j = 0; j < 8; ++j) g[j] = sigmoidf_(v[j]) * siluf_(Cs[r * 132 + 64 + c0 + j]);
        st_bf8(p.Ga + grow * 512 + (n - 12) * 64 + c0, g);
      }
    }
    else if (n < 28) {
      float ss = 0.f;
#pragma unroll
      for (int j = 0; j < 8; ++j) ss += v[j] * v[j];
      ss += __shfl_xor(ss, 1); ss += __shfl_xor(ss, 2); ss += __shfl_xor(ss, 4);
      const float rs = rsqrtf(ss * (1.f / 64.f) + EPS);
      const float* g = gn;
      if (n < 24) {
#pragma unroll
        for (int j = 0; j < 8; ++j) v[j] = v[j] * rs * g[j] * (0.125f * LOG2E);
        st_bf8(p.Qb + grow * 512 + hd * 128 + c0, v);
      } else {
#pragma unroll
        for (int j = 0; j < 8; ++j) v[j] = v[j] * rs * g[j];
        if (!samp) { st_f8(p.out + O_PK + grow * 512 + hd * 128 + c0, v); st_bf8(p.Kb + grow * 512 + hd * 128 + c0, v); }
        else {
          const int sr = (int)grow - NTOKP, bs = sr >> 5, t = sr & 31;
          st_f8(p.out + O_SK + (size_t)sr * 512 + hd * 128 + c0, v);
          st_bf8(p.Ks + ((size_t)(bs * SKP + PAST + t)) * 512 + hd * 128 + c0, v);
        }
      }
    }
    else if (n < 32) {
      if (!samp) st_f8(p.out + O_PV + grow * 512 + hd * 128 + c0, v);
      else st_f8(p.out + O_SV + (size_t)((int)grow - NTOKP) * 512 + hd * 128 + c0, v);
    }
    else if (n < 36) {
#pragma unroll
      for (int j = 0; j < 8; ++j) v[j] = siluf_(v[j]);
      st_bf8(p.Gb + grow * 512 + hd * 128 + c0, v);
    }
    else if (n < 40) {
      float ss = 0.f;
#pragma unroll
      for (int j = 0; j < 8; ++j) ss += v[j] * v[j];
      ss += __shfl_xor(ss, 1); ss += __shfl_xor(ss, 2); ss += __shfl_xor(ss, 4); ss += __shfl_xor(ss, 8);
      const float rs = rsqrtf(ss * (1.f / 128.f) + EPS);
      const float* g = gn;
#pragma unroll
      for (int j = 0; j < 8; ++j) v[j] = v[j] * rs * g[j] * (0.08838834764831845f * LOG2E);
      st_bf8(p.Qx + grow * 512 + hd * 128 + c0, v);
    }
    else if (n < 44) {
#pragma unroll
      for (int j = 0; j < 8; ++j) v[j] = siluf_(v[j]);
      st_bf8(p.Gx + grow * 512 + hd * 128 + c0, v);
    }
    else {
      if (cgp == 0) {
        float g[8];
#pragma unroll
        for (int j = 0; j < 4; ++j) { g[j] = v[j] + gn[j]; g[4 + j] = logsigmoidf_(v[4 + j] + gn[4 + j]); }
        st_f8(p.gates + grow * 8, g);
      }
    }
  }
}

DEVI void epi_mem(const Params& p, LAS char* lds, int l, int brow, int n, const float (&gk)[8]) {
  const LAS float* Cs = (const LAS float*)lds;
  const int tid = threadIdx.x, cgp = tid & 15, c0 = cgp * 8;
  const int hd = n & 3;
  if (n >= 4) {
    const int b = brow >> 8, m0 = brow & 255;
    store_transposed(lds, p.XVT + ((size_t)((l * 12 + b) * 4 + hd) * 128) * 256 + m0, 256, 1.f);
  }
#pragma unroll 4
  for (int it = 0; it < 8; ++it) {
    const int r = it * 16 + (tid >> 4);
    const size_t grow = (size_t)brow + r;
    float v[8];
#pragma unroll
    for (int j = 0; j < 8; ++j) v[j] = Cs[r * 132 + c0 + j];
    if (n < 4) {
      float ss = 0.f;
#pragma unroll
      for (int j = 0; j < 8; ++j) ss += v[j] * v[j];
      ss += __shfl_xor(ss, 1); ss += __shfl_xor(ss, 2); ss += __shfl_xor(ss, 4); ss += __shfl_xor(ss, 8);
      const float rs = rsqrtf(ss * (1.f / 128.f) + EPS);
      const float* g = gk;
#pragma unroll
      for (int j = 0; j < 8; ++j) v[j] = v[j] * rs * g[j];
      st_f8(p.out + O_PXK + ((size_t)l * 1024 + grow) * 512 + hd * 128 + c0, v);
      const int b = (int)grow >> 8, m = (int)grow & 255;
      st_bf8(p.XK + ((size_t)((l * 12 + b) * 256 + m)) * 512 + hd * 128 + c0, v);
    } else {
      st_f8(p.out + O_PXV + ((size_t)l * 1024 + grow) * 512 + hd * 128 + c0, v);
    }
  }
}

DEVI void load_resid(const Params& p, int layer, int brow, int n, float4 (&ra)[8], float4 (&rb)[8]) {
  const int tid = threadIdx.x, c0 = (tid & 15) * 8;
#pragma unroll
  for (int it = 0; it < 8; ++it) {
    const size_t grow = (size_t)brow + it * 16 + (tid >> 4);
    const float* res;
    if (layer == 0) res = (grow < NTOKP ? p.in[0] + grow * 1024 : p.in[1] + (grow - NTOKP) * 1024) + n * 128 + c0;
    else res = p.out + grow * 1024 + n * 128 + c0;
    ra[it] = reinterpret_cast<const float4*>(res)[0]; rb[it] = reinterpret_cast<const float4*>(res)[1];
  }
}
DEVI void epi_out(const Params& p, LAS char* lds, int layer, int brow, int n, const float4 (&ra)[8], const float4 (&rb)[8]) {
  const LAS float* Cs = (const LAS float*)lds;
  const int tid = threadIdx.x, cgp = tid & 15, c0 = cgp * 8;
#pragma unroll
  for (int q = 0; q < 8; ++q) {
    const int r = q * 16 + (tid >> 4);
    const size_t grow = (size_t)brow + r;
    float v[8];
#pragma unroll
    for (int j = 0; j < 8; ++j) v[j] = Cs[r * 132 + c0 + j];
    v[0] += ra[q].x; v[1] += ra[q].y; v[2] += ra[q].z; v[3] += ra[q].w; v[4] += rb[q].x; v[5] += rb[q].y; v[6] += rb[q].z; v[7] += rb[q].w;
    st_f8(p.out + grow * 1024 + n * 128 + c0, v);
    if (layer == 0) {
      st_bf8(p.xb + grow * 1024 + n * 128 + c0, v);
      float ss = 0.f;
#pragma unroll
      for (int j = 0; j < 8; ++j) ss += v[j] * v[j];
      ss += __shfl_xor(ss, 1); ss += __shfl_xor(ss, 2); ss += __shfl_xor(ss, 4); ss += __shfl_xor(ss, 8);
      if (cgp == 0) atomicAdd(p.ssq1 + grow, ss);
    }
  }
}

DEVI void epi_in_c(const Params& p, LAS char* lds, int brow, int n, const float (&gx)[8]) {
  const LAS float* Cs = (const LAS float*)lds;
  const int tid = threadIdx.x, cgp = tid & 15, c0 = cgp * 8;
  u16* U = p.Qa;
  u16* Gc = p.KaT;
#pragma unroll 4
  for (int it = 0; it < 8; ++it) {
    const int r = it * 16 + (tid >> 4);
    const size_t grow = (size_t)brow + r;
    float v[8];
#pragma unroll
    for (int j = 0; j < 8; ++j) v[j] = Cs[r * 132 + c0 + j];
    if (n < 16) {
      if (cgp < 8) {
        float u[8];
#pragma unroll
        for (int j = 0; j < 8; ++j) u[j] = v[j] * sigmoidf_(Cs[r * 132 + 64 + c0 + j]);
        st_bf8(U + grow * 1024 + n * 64 + c0, u);
        if (grow < NTOKP) { const int t = (int)grow & 8191, b = (int)grow >> 13; if (t >= SEQ - 30) st_f8(p.out + O_PCONV + ((size_t)(b * 30 + t - (SEQ - 30))) * 1024 + n * 64 + c0, u); }
        else { const int sr = (int)grow - NTOKP, t = sr & 31, b = sr >> 5; if (t >= 2) st_f8(p.out + O_SCONV + ((size_t)(b * 30 + t - 2)) * 1024 + n * 64 + c0, u); }
      }
    } else if (n < 24) {
#pragma unroll
      for (int j = 0; j < 8; ++j) v[j] = siluf_(v[j]);
      st_bf8(Gc + grow * 1024 + (n - 16) * 128 + c0, v);
    } else if (n < 28) {
      float ss = 0.f;
#pragma unroll
      for (int j = 0; j < 8; ++j) ss += v[j] * v[j];
      ss += __shfl_xor(ss, 1); ss += __shfl_xor(ss, 2); ss += __shfl_xor(ss, 4); ss += __shfl_xor(ss, 8);
      const float rs = rsqrtf(ss * (1.f / 128.f) + EPS);
      const float* g = gx;
#pragma unroll
      for (int j = 0; j < 8; ++j) v[j] = v[j] * rs * g[j] * (0.08838834764831845f * LOG2E);
      st_bf8(p.Qx + grow * 512 + (n - 24) * 128 + c0, v);
    } else {
#pragma unroll
      for (int j = 0; j < 8; ++j) v[j] = siluf_(v[j]);
      st_bf8(p.Gx + grow * 512 + (n - 28) * 128 + c0, v);
    }
  }
}

DEVI void gemm_core(LAS char* lds, const u16* A0, const u16* A1, const u16* A2, int lda0, int lda1, int lda2, int segK,
                    const u16* Bt, int K, int brow, int bcol, f32x16 (&acc)[4][2]) {
  const int tid = threadIdx.x, lane = tid & 63, w = tid >> 6, wr = w >> 1, wc = w & 1, r = lane & 31, h = lane >> 5;
#pragma unroll
  for (int i = 0; i < 4; ++i)
#pragma unroll
    for (int j = 0; j < 2; ++j)
#pragma unroll
      for (int e = 0; e < 16; ++e) acc[i][j][e] = 0.f;
  const int nkt = K / 64;
  auto stage_part = [=](int kt, int buf, int part) __attribute__((always_inline)) {
    const int k0 = kt * 64;
    const int seg = k0 / segK;
    const u16* Ab = (seg == 0 ? A0 : (seg == 1 ? A1 : A2)) + (k0 - seg * segK);
    const int lda = (seg == 0 ? lda0 : (seg == 1 ? lda1 : lda2));
    LAS char* sa = lds + buf * 49152;
    LAS char* sb = sa + 32768;
#pragma unroll
    for (int q = 0; q < 2; ++q) {
      const int i = 2 * part + q;
      const int pch = i * 256 + tid, row = pch >> 3, lg = (pch & 7) ^ ((row >> 1) & 7);
      glds16(Ab + (size_t)(brow + row) * lda + lg * 8, sa + pch * 16);
    }
    {
      const int pch = part * 256 + tid, row = pch >> 3, lg = (pch & 7) ^ ((row >> 1) & 7);
      glds16(Bt + (size_t)(bcol + row) * K + k0 + lg * 8, sb + pch * 16);
    }
  };
  lds_barrier();
#pragma unroll
  for (int part = 0; part < 4; ++part) stage_part(0, 0, part);
#pragma unroll
  for (int part = 0; part < 4; ++part) stage_part(1, 1, part);
  int buf = 0;
  for (int kt = 0; kt < nkt; ++kt) {
    if (kt + 1 < nkt) asm volatile("s_waitcnt vmcnt(12)" ::: "memory"); else asm volatile("s_waitcnt vmcnt(0)" ::: "memory");
    asm volatile("s_waitcnt lgkmcnt(0)" ::: "memory");
    __builtin_amdgcn_s_barrier();
    int nb = buf + 2; if (nb >= 3) nb -= 3;
    const bool more = kt + 2 < nkt;
    const LAS char* sa = lds + buf * 49152;
    const LAS char* sb = sa + 32768;
    bf16x8 af[2][4], bfr[2][2];
#pragma unroll
    for (int i = 0; i < 4; ++i) {
      const int row = 32 * (2 * i + wr) + r, ch = h ^ ((row >> 1) & 7);
      af[0][i] = *reinterpret_cast<const LAS bf16x8*>(sa + row * 128 + ch * 16);
    }
#pragma unroll
    for (int j = 0; j < 2; ++j) {
      const int row = 32 * (2 * j + wc) + r, ch = h ^ ((row >> 1) & 7);
      bfr[0][j] = *reinterpret_cast<const LAS bf16x8*>(sb + row * 128 + ch * 16);
    }
#pragma unroll
    for (int ks = 0; ks < 4; ++ks) {
      const int cur = ks & 1, nxt = cur ^ 1;
      if (ks < 3) {
#pragma unroll
        for (int i = 0; i < 4; ++i) {
          const int row = 32 * (2 * i + wr) + r, ch = (2 * (ks + 1) + h) ^ ((row >> 1) & 7);
          af[nxt][i] = *reinterpret_cast<const LAS bf16x8*>(sa + row * 128 + ch * 16);
        }
#pragma unroll
        for (int j = 0; j < 2; ++j) {
          const int row = 32 * (2 * j + wc) + r, ch = (2 * (ks + 1) + h) ^ ((row >> 1) & 7);
          bfr[nxt][j] = *reinterpret_cast<const LAS bf16x8*>(sb + row * 128 + ch * 16);
        }
      }
#pragma unroll
      for (int i = 0; i < 4; ++i)
#pragma unroll
        for (int j = 0; j < 2; ++j) acc[i][j] = mfma32(af[cur][i], bfr[cur][j], acc[i][j]);
      if (more) stage_part(kt + 2, nb, ks);
    }
    if (++buf == 3) buf = 0;
  }
}

DEVI void stage_all(LAS char* lds, const f32x16 (&acc)[4][2], bool scaled) {
  const int tid = threadIdx.x, lane = tid & 63, w = tid >> 6, wr = w >> 1, wc = w & 1, r = lane & 31, h = lane >> 5;
  const LAS float* RS = (const LAS float*)(lds + 135168);
#pragma unroll
  for (int i = 0; i < 4; ++i) {
    LAS float* Cs = (LAS float*)(lds + (i >> 1) * 67584);
#pragma unroll
    for (int e = 0; e < 16; ++e) {
      const int row = 32 * (2 * (i & 1) + wr) + crow(e, h);
      const float s = scaled ? RS[128 * (i >> 1) + row] : 1.f;
#pragma unroll
      for (int jj = 0; jj < 2; ++jj) Cs[row * 132 + 32 * (2 * jj + wc) + r] = acc[i][jj][e] * s;
    }
  }
}

DEVI void gemm_tile_run(const Params& p, LAS char* lds, int which, int aux, int mt, int n, f32x16 (&acc)[4][2]) {
  const int brow = mt * 256, bcol = n * 128;
  const float* rsc = nullptr; int mode = 0;
  if (which == 0) { gemm_core(lds, p.xb, p.xb, p.xb, 1024, 1024, 1024, 1024, p.WtInA, 1024, brow, bcol, acc); rsc = p.rs0; mode = 1; }
  else if (which == 1) gemm_core(lds, p.Ga, p.Gb, p.Gx, 512, 512, 512, 512, p.WtOutA, 1536, brow, bcol, acc);
  else if (which == 2) { gemm_core(lds, p.xb, p.xb, p.xb, 1024, 1024, 1024, 1024, p.WtInC, 1024, brow, bcol, acc); rsc = p.ssq1; mode = 2; }
  else if (which == 3) gemm_core(lds, p.KaT, p.KaT + 512, p.Gx, 1024, 1024, 512, 512, p.WtOutC, 1536, brow, bcol, acc);
  else { gemm_core(lds, p.memb, p.memb, p.memb, 1024, 1024, 1024, 1024, p.WtMem + (size_t)aux * 1024 * 1024, 1024, brow, bcol, acc); rsc = p.rsmem; mode = 1; }
  lds_barrier();
  if (mode) {
    float sc = rsc[brow + threadIdx.x];
    if (mode == 2) sc = rsqrtf(sc * (1.f / 1024.f) + EPS);
    ((LAS float*)(lds + 135168))[threadIdx.x] = sc;
    lds_barrier();
  }
  if (which == 1 || which == 3) {
    float4 ra0[8], rb0[8], ra1[8], rb1[8];
    load_resid(p, which == 1 ? 0 : 1, brow, n, ra0, rb0);
    load_resid(p, which == 1 ? 0 : 1, brow + 128, n, ra1, rb1);
    stage_all(lds, acc, false);
    lds_barrier();
    epi_out(p, lds, which == 1 ? 0 : 1, brow, n, ra0, rb0);
    epi_out(p, lds + 67584, which == 1 ? 0 : 1, brow + 128, n, ra1, rb1);
    return;
  }
  float gpre[8];
  {
    const int c0 = (threadIdx.x & 15) * 8;
    const float* gp = nullptr;
    if (which == 0) {
      if (n >= 20 && n < 24) gp = p.in[16] + (c0 & 63);
      else if (n >= 24 && n < 28) gp = p.in[17] + (c0 & 63);
      else if (n >= 36 && n < 40) gp = p.in[32] + c0;
    } else if (which == 2) gp = p.in[32] + 128 + c0;
    else gp = p.in[33] + aux * 128 + c0;
#pragma unroll
    for (int j = 0; j < 8; ++j) gpre[j] = gp ? gp[j] : 0.f;
    if (which == 0 && n == 44) {
#pragma unroll
      for (int j = 0; j < 4; ++j) { gpre[j] = p.in[13][j]; gpre[4 + j] = p.in[14][j]; }
    }
  }
  stage_all(lds, acc, mode != 0);
  lds_barrier();
#pragma unroll 1
  for (int sub = 0; sub < 2; ++sub) {
    LAS char* cs = lds + sub * 67584;
    const int sr = brow + 128 * sub;
    if (which == 0) epi_in_a(p, cs, sr, n, gpre);
    else if (which == 2) epi_in_c(p, cs, sr, n, gpre);
    else epi_mem(p, cs, aux, sr, n, gpre);
  }
}

template <int which>
DEVI void phase_gemm(const Params& p, LAS char* lds) {
  constexpr int nN = (which == 0 ? 45 : (which == 2 ? 32 : 8));
  constexpr int ntiles = 128 * nN;
  const int G = gridDim.x;
  const int xcd = blockIdx.x & 7, lb = blockIdx.x >> 3, slots = G >> 3;
  f32x16 acc[4][2];
  int round = 0, t_extra = blockIdx.x, t_mem = G - 1 - (int)blockIdx.x;
  if (which == 0 && G == 256) {
    const int idx = (xcd >= 4) ? lb * 4 + (xcd - 4) : 1 << 20;
    t_extra = idx < 45 ? idx : 1 << 20;
    t_mem = (idx >= 45 && idx < 109) ? idx - 45 : 1 << 20;
  }
  bool main_done = false;
  for (;;) {
    int mt, n;
    if (!main_done) {
      const int q = lb + slots * round; ++round;
      const int L = 32 * (xcd + 8 * (q >> 5)) + (q & 31);
      if (L >= ntiles) { main_done = true; continue; }
      const int mg = L / (4 * nN), rem = L - mg * 4 * nN;
      n = rem >> 2; mt = mg * 4 + (rem & 3);
    } else {
      if (t_extra >= nN) break;
      mt = 128; n = t_extra; t_extra += G;
    }
    gemm_tile_run(p, lds, which, 0, mt, n, acc);
  }
  if (which == 0) {
    for (int t = t_mem; t < 64; t += G) gemm_tile_run(p, lds, 4, t >> 5, (t >> 3) & 3, t & 7, acc);
  }
}

template <bool DIFF>
DEVI void attn_block(LAS char* lds, const u16* Q, const u16* Kg, const u16* VT, int ldv, int j0, int ntiles, int nwact,
                           int qpos0, int nkeys, float slope2, float M2, float lam, const float* subg, u16* G) {
  const int tid = threadIdx.x, lane = tid & 63, w = tid >> 6, r = lane & 31, h = lane >> 5;
  const bool act = w < nwact;
  const int qpos = qpos0 + 32 * w + r;
  const int cw = (qpos0 + 32 * w) >> 6;
  bf16x8 qf[8];
#pragma unroll
  for (int i = 0; i < 8; ++i) qf[i] = ldg8(Q + (size_t)(32 * w + r) * 512 + 16 * i + 8 * h);
  f32x16 O0[4], O1[4];
#pragma unroll
  for (int e = 0; e < 4; ++e)
#pragma unroll
    for (int i = 0; i < 16; ++i) { O0[e][i] = 0.f; O1[e][i] = 0.f; }
  float l0 = 0.f, l1 = 0.f;
  f32x16 cinit, zero16;
#pragma unroll
  for (int i = 0; i < 16; ++i) { cinit[i] = slope2 * (float)klocal(i, h); zero16[i] = 0.f; }
  const float tq = -slope2 * (float)qpos - M2;
  const int prow = pi32(r);

  auto stage = [=](int j, int buf) __attribute__((always_inline)) {
    LAS char* kb = lds + buf * 32768;
#pragma unroll
    for (int i = 0; i < 4; ++i) {
      const int pch = i * 256 + tid;
      { const int row = pch >> 4, ph = pch & 15, lg = ph ^ (row & 15);
        glds16(Kg + (size_t)(j * 64 + row) * 512 + lg * 8, kb + pch * 16); }
      { const int row = pch >> 3, ph = pch & 7, lg = ph ^ ((row >> 1) & 7);
        glds16(VT + (size_t)row * ldv + j * 64 + lg * 8, kb + 16384 + pch * 16); }
    }
  };
  lds_barrier();
  stage(j0, 0);
  asm volatile("s_waitcnt vmcnt(0)" ::: "memory");
  __syncthreads();
  for (int j = j0; j < ntiles; ++j) {
    const int buf = (j - j0) & 1;
    if (j + 1 < ntiles) stage(j + 1, buf ^ 1);
    {
      const LAS char* kb = lds + buf * 32768;
      const LAS char* vb = kb + 16384;
      const bool fast = DIFF && (j < cw);
#pragma unroll
      for (int kt = 0; kt < 2; ++kt) {
        const int krow = 32 * kt + prow;
        const LAS char* krp = kb + krow * 256;
        bf16x8 P0[2], P1[2];
        if (DIFF) {
#pragma unroll
          for (int c = 0; c < 2; ++c) {
            f32x16 s;
            if (fast) {
              s = cinit;
#pragma unroll
              for (int ks = 0; ks < 4; ++ks) {
                const int ch = (2 * (4 * c + ks) + h) ^ (krow & 15);
                s = mfma32(*reinterpret_cast<const LAS bf16x8*>(krp + ch * 16), qf[4 * c + ks], s);
              }
              const float t = tq + slope2 * (float)(j * 64 + kt * 32);
#pragma unroll
              for (int i = 0; i < 16; ++i) s[i] = __builtin_amdgcn_exp2f(s[i] + t);
            } else {
              s = zero16;
#pragma unroll
              for (int ks = 0; ks < 4; ++ks) {
                const int ch = (2 * (4 * c + ks) + h) ^ (krow & 15);
                s = mfma32(*reinterpret_cast<const LAS bf16x8*>(krp + ch * 16), qf[4 * c + ks], s);
              }
#pragma unroll
              for (int i = 0; i < 16; ++i) {
                const int kp = j * 64 + kt * 32 + klocal(i, h);
                const float bias = -slope2 * fabsf((float)(qpos - kp)) - M2;
                s[i] = (kp < nkeys && j <= cw) ? __builtin_amdgcn_exp2f(s[i] + bias) : 0.f;
              }
            }
            float ls = 0.f;
#pragma unroll
            for (int i = 0; i < 16; ++i) ls += s[i];
            if (c == 0) { l0 += ls; P0[0] = pack8(s, 0); P0[1] = pack8(s, 1); }
            else        { l1 += ls; P1[0] = pack8(s, 0); P1[1] = pack8(s, 1); }
          }
        } else {
          f32x16 s = zero16;
#pragma unroll
          for (int ks = 0; ks < 8; ++ks) {
            const int ch = (2 * ks + h) ^ (krow & 15);
            s = mfma32(*reinterpret_cast<const LAS bf16x8*>(krp + ch * 16), qf[ks], s);
          }
          float ls = 0.f;
#pragma unroll
          for (int i = 0; i < 16; ++i) { s[i] = __builtin_amdgcn_exp2f(s[i] - M2); ls += s[i]; }
          l0 += ls; P0[0] = pack8(s, 0); P0[1] = pack8(s, 1);
        }
#pragma unroll
        for (int et = 0; et < 4; ++et) {
          const int vrow = 32 * et + r;
#pragma unroll
          for (int sp = 0; sp < 2; ++sp) {
            const int ch = (2 * (2 * kt + sp) + h) ^ ((vrow >> 1) & 7);
            const bf16x8 vf = *reinterpret_cast<const LAS bf16x8*>(vb + vrow * 128 + ch * 16);
            O0[et] = mfma32(vf, P0[sp], O0[et]);
            if (DIFF) O1[et] = mfma32(vf, P1[sp], O1[et]);
          }
        }
      }
    }
    asm volatile("s_waitcnt vmcnt(0)" ::: "memory");
    __syncthreads();
  }
  if (act) {
    l0 += __shfl_xor(l0, 32);
    const float i0 = 1.f / l0;
    float i1 = 0.f;
    if (DIFF) { l1 += __shfl_xor(l1, 32); i1 = lam / l1; }
    float ss = 0.f;
#pragma unroll
    for (int et = 0; et < 4; ++et)
#pragma unroll
      for (int i = 0; i < 16; ++i) {
        float o = O0[et][i] * i0;
        if (DIFF) o -= O1[et][i] * i1;
        O0[et][i] = o; ss += o * o;
      }
    float rs = 1.f;
    if (DIFF) { ss += __shfl_xor(ss, 32); rs = rsqrtf(ss * (1.f / 128.f) + EPS) * 0.8f; }
    u16* grow = G + (size_t)(32 * w + r) * 512;
    u32x2 gt[16]; float4 sv[16];
#pragma unroll
    for (int q = 0; q < 16; ++q) {
      const int e0 = 32 * (q >> 2) + 8 * (q & 3) + 4 * h;
      gt[q] = *reinterpret_cast<const u32x2*>(grow + e0);
      if (DIFF) sv[q] = *reinterpret_cast<const float4*>(subg + e0); else sv[q] = float4{1.f, 1.f, 1.f, 1.f};
    }
#pragma unroll
    for (int q = 0; q < 16; ++q) {
      const int et = q >> 2, g = q & 3;
      const int e0 = 32 * et + 8 * g + 4 * h;
      const float a0 = O0[et][4 * g + 0] * rs * sv[q].x * bflo(gt[q][0]);
      const float a1 = O0[et][4 * g + 1] * rs * sv[q].y * bfhi(gt[q][0]);
      const float a2 = O0[et][4 * g + 2] * rs * sv[q].z * bflo(gt[q][1]);
      const float a3 = O0[et][4 * g + 3] * rs * sv[q].w * bfhi(gt[q][1]);
      u32x2 o = {cvtpk(a0, a1), cvtpk(a2, a3)};
      *reinterpret_cast<u32x2*>(grow + e0) = o;
    }
  }
}

DEVI float max_abs64(const float* g, int n, int lane) { float v = 0.f; for (int i = lane; i < n; i += 64) v = fmaxf(v, fabsf(g[i])); return wmax(v); }

DEVI float scan_add(float v, int lane) { for (int o = 1; o < 64; o <<= 1) { const float t = __shfl_up(v, o); if (lane >= o) v += t; } return v; }
DEVI float scan_max(float v, int lane) { for (int o = 1; o < 64; o <<= 1) { const float t = __shfl_up(v, o); if (lane >= o) v = fmaxf(v, t); } return v; }
DEVI float bfe(const bf16x8& v, int j) { return __uint_as_float(((unsigned)(u16)v[j]) << 16); }

template <int NT>
DEVI void mlstm_local(LAS char* lds, const float* gates, int hd, const u16* KT, const u16* VT, int ldt,
                            f32x16 (&acc)[4], float& nh, float& bL, float& amax) {
  const int tid = threadIdx.x, lane = tid & 63, w = tid >> 6, r = lane & 31, h = lane >> 5;
  constexpr int L = 32 * NT;
  const float lf = lane < L ? gates[lane * 8 + 4 + hd] : 0.f;
  const float ig = lane < L ? gates[lane * 8 + hd] : -INFINITY;
  const float b = scan_add(lf, lane);
  const float a = ig - b;
  amax = wmax(a);
  bL = __shfl(b, L - 1);
  LAS float* wt = (LAS float*)(lds + 4096) + w * 64;
  wt[lane] = __expf(a - amax);
#pragma unroll
  for (int e = 0; e < 4; ++e)
#pragma unroll
    for (int i = 0; i < 16; ++i) acc[e][i] = 0.f;
  nh = 0.f;
  bf16x8 kfa[2 * NT], vfa[2 * NT][4];
#pragma unroll
  for (int ks = 0; ks < 2 * NT; ++ks) {
    kfa[ks] = ldg8(KT + (size_t)(32 * w + r) * ldt + 16 * ks + 8 * h);
#pragma unroll
    for (int et = 0; et < 4; ++et) vfa[ks][et] = ldg8(VT + (size_t)(32 * et + r) * ldt + 16 * ks + 8 * h);
  }
#pragma unroll
  for (int ks = 0; ks < 2 * NT; ++ks) {
    const bf16x8 kf = kfa[ks];
    float wv[8];
#pragma unroll
    for (int j = 0; j < 8; ++j) { wv[j] = wt[16 * ks + 8 * h + j]; nh += bfe(kf, j) * wv[j]; }
#pragma unroll
    for (int et = 0; et < 4; ++et) {
      const bf16x8 vf = vfa[ks][et];
      u32x4 sv = {cvtpk(bfe(vf, 0) * wv[0], bfe(vf, 1) * wv[1]), cvtpk(bfe(vf, 2) * wv[2], bfe(vf, 3) * wv[3]),
                  cvtpk(bfe(vf, 4) * wv[4], bfe(vf, 5) * wv[5]), cvtpk(bfe(vf, 6) * wv[6], bfe(vf, 7) * wv[7])};
      acc[et] = mfma32(kf, *reinterpret_cast<bf16x8*>(&sv), acc[et]);
    }
  }
  nh += __shfl_xor(nh, 32);
}

template <int NT>
DEVI void mlstm_out(LAS char* lds, const float* gates, int hd, const u16* Qg, const u16* Kg, const u16* VT, int ldv,
                          const u16* CT, const float* n0, float m0, const float* mg, u16* G) {
  const int tid = threadIdx.x, lane = tid & 63, w = tid >> 6, r = lane & 31, h = lane >> 5;
  constexpr int L = 32 * NT;
  const float lf = lane < L ? gates[lane * 8 + 4 + hd] : 0.f;
  const float ig = lane < L ? gates[lane * 8 + hd] : -INFINITY;
  const float b = scan_add(lf, lane);
  const float a = ig - b;
  const float Mrow = fmaxf(m0, scan_max(a, lane));
  const float mt = b + Mrow;
  LAS float* at = (LAS float*)lds + w * 64;
  LAS float* red = (LAS float*)(lds + 1024);
  at[lane] = a;
  const int prow = pi32(r);
#pragma unroll 1
  for (int tt = 0; tt < NT; ++tt) {
    const int t = 32 * tt + r;
    const float Mrow_t = __shfl(Mrow, t), mt_t = __shfl(mt, t);
    const float winter = __expf(m0 - Mrow_t);
    bf16x8 qf[8], cfa[8], kfa[NT][8], vfa[NT][2];
    float4 na[8], nb[8];
#pragma unroll
    for (int i = 0; i < 8; ++i) {
      qf[i] = ldg8(Qg + (size_t)t * 512 + 16 * i + 8 * h);
      na[i] = *reinterpret_cast<const float4*>(n0 + 16 * i + 8 * h); nb[i] = *reinterpret_cast<const float4*>(n0 + 16 * i + 8 * h + 4);
      cfa[i] = ldg8(CT + (size_t)(32 * w + r) * 128 + 16 * i + 8 * h);
    }
#pragma unroll
    for (int st = 0; st < NT; ++st) {
      const int sc = st <= tt ? st : tt;
#pragma unroll
      for (int ks = 0; ks < 8; ++ks) kfa[st][ks] = ldg8(Kg + (size_t)(32 * sc + prow) * 512 + 16 * ks + 8 * h);
#pragma unroll
      for (int sp = 0; sp < 2; ++sp) vfa[st][sp] = ldg8(VT + (size_t)(32 * w + r) * ldv + 32 * sc + 16 * sp + 8 * h);
    }
    float qn = 0.f;
#pragma unroll
    for (int i = 0; i < 8; ++i) {
      qn += bfe(qf[i], 0) * na[i].x + bfe(qf[i], 1) * na[i].y + bfe(qf[i], 2) * na[i].z + bfe(qf[i], 3) * na[i].w
          + bfe(qf[i], 4) * nb[i].x + bfe(qf[i], 5) * nb[i].y + bfe(qf[i], 6) * nb[i].z + bfe(qf[i], 7) * nb[i].w;
    }
    qn += __shfl_xor(qn, 32);
    f32x16 H;
#pragma unroll
    for (int i = 0; i < 16; ++i) H[i] = 0.f;
#pragma unroll
    for (int ks = 0; ks < 8; ++ks) H = mfma32(cfa[ks], qf[ks], H);
#pragma unroll
    for (int i = 0; i < 16; ++i) H[i] *= winter;
    float dsum = 0.f;
#pragma unroll
    for (int st = 0; st < NT; ++st) {
      if (st <= tt) {
        f32x16 S;
#pragma unroll
        for (int i = 0; i < 16; ++i) S[i] = 0.f;
#pragma unroll
        for (int ks = 0; ks < 8; ++ks) S = mfma32(kfa[st][ks], qf[ks], S);
#pragma unroll
        for (int i = 0; i < 16; ++i) {
          const int s_ = 32 * st + klocal(i, h);
          const float wg = (s_ <= t) ? __expf(at[s_] - Mrow_t) : 0.f;
          S[i] *= wg; dsum += S[i];
        }
#pragma unroll
        for (int sp = 0; sp < 2; ++sp) H = mfma32(vfa[st][sp], pack8(S, sp), H);
      }
    }
    dsum += __shfl_xor(dsum, 32);
    const float den = winter * qn + dsum;
    const float inv = 1.f / fmaxf(fabsf(den), __expf(-mt_t));
    float ss = 0.f;
#pragma unroll
    for (int i = 0; i < 16; ++i) { H[i] *= inv; ss += H[i] * H[i]; }
    ss += __shfl_xor(ss, 32);
    if (h == 0) red[w * 64 + t] = ss;
    lds_barrier();
    const float tot = red[t] + red[64 + t] + red[128 + t] + red[192 + t];
    const float rs = rsqrtf(tot * (1.f / 128.f) + EPS);
    u16* grow = G + (size_t)t * 512;
    u32x2 gt[4]; float4 mv[4];
#pragma unroll
    for (int g = 0; g < 4; ++g) {
      const int e0 = 32 * w + 8 * g + 4 * h;
      gt[g] = *reinterpret_cast<const u32x2*>(grow + e0);
      mv[g] = *reinterpret_cast<const float4*>(mg + e0);
    }
#pragma unroll
    for (int g = 0; g < 4; ++g) {
      const int e0 = 32 * w + 8 * g + 4 * h;
      u32x2 o = {cvtpk(H[4 * g + 0] * rs * mv[g].x * bflo(gt[g][0]), H[4 * g + 1] * rs * mv[g].y * bfhi(gt[g][0])),
                 cvtpk(H[4 * g + 2] * rs * mv[g].z * bflo(gt[g][1]), H[4 * g + 3] * rs * mv[g].w * bfhi(gt[g][1]))};
      *reinterpret_cast<u32x2*>(grow + e0) = o;
    }
    lds_barrier();
  }
}

DEVI void m1_item(const Params& p, LAS char* lds, int item) {
  const int tid = threadIdx.x, lane = tid & 63, w = tid >> 6, r = lane & 31, h = lane >> 5;
  const int bh = item >> 7, c = item & 127, b = bh >> 2, hd = bh & 3;
  const size_t row0 = (size_t)b * SEQ + c * 64;
  f32x16 acc[4]; float nh, bL, amax;
  lds_barrier();
  mlstm_local<2>(lds, p.gates + row0 * 8, hd, p.KaT + (size_t)bh * 128 * SEQ + c * 64, p.VaT + (size_t)bh * 128 * SEQ + c * 64, SEQ, acc, nh, bL, amax);
  u16* Chat = p.xb + ((size_t)item * 128) * 128;
#pragma unroll
  for (int et = 0; et < 4; ++et)
#pragma unroll
    for (int g = 0; g < 4; ++g) {
      const int d0 = 32 * w + 8 * g + 4 * h, e = 32 * et + r;
      u32x2 o = {cvtpk(acc[et][4 * g], acc[et][4 * g + 1]), cvtpk(acc[et][4 * g + 2], acc[et][4 * g + 3])};
      *reinterpret_cast<u32x2*>(Chat + (size_t)e * 128 + d0) = o;
    }
  if (h == 0) p.nhat[(size_t)item * 128 + 32 * w + r] = nh;
  if (tid == 0) { p.tabA[item] = bL; p.tabB[item] = bL + amax; }
}

DEVI void phase_scan(const Params& p, LAS char* lds) {
  const int tid = threadIdx.x, lane = tid & 63;
  LAS float* al = (LAS float*)lds; LAS float* be = al + 128; LAS float* ms = al + 256;
  for (int u = blockIdx.x; u < 16 * 32; u += gridDim.x) {
    const int bh = u >> 5, part = u & 31;
    __syncthreads();
    if (tid < 64) {
      const float A0 = p.tabA[bh * 128 + 2 * lane], A1 = p.tabA[bh * 128 + 2 * lane + 1];
      const float B0 = p.tabB[bh * 128 + 2 * lane], B1 = p.tabB[bh * 128 + 2 * lane + 1];
      const float SAi = scan_add(A0 + A1, lane);
      const float SA0 = SAi - A1, SA1 = SAi;
      const float D0 = B0 - SA0, D1 = B1 - SA1;
      const float PMi = scan_max(fmaxf(D0, D1), lane);
      float PMx = __shfl_up(PMi, 1); if (lane == 0) PMx = -INFINITY;
      const float mn0 = SA0 + fmaxf(0.f, fmaxf(PMx, D0));
      const float mn1 = SA1 + fmaxf(0.f, PMi);
      float mprev = __shfl_up(mn1, 1); if (lane == 0) mprev = 0.f;
      al[2 * lane] = __expf(A0 + mprev - mn0); be[2 * lane] = __expf(B0 - mn0);
      al[2 * lane + 1] = __expf(A1 + mn0 - mn1); be[2 * lane + 1] = __expf(B1 - mn1);
      ms[2 * lane] = mprev; ms[2 * lane + 1] = mn0;
      if (lane == 63) ms[128] = mn1;
    }
    __syncthreads();
    if (part == 0) {
      if (tid < 129) p.mtab[bh * 129 + tid] = ms[tid];
      if (tid == 0) p.out[O_PM + bh] = ms[128];
    }
    u16* base = p.xb + (size_t)bh * 128 * 16384 + part * 512 + tid * 2;
    float c0 = 0.f, c1 = 0.f;
    for (int c = 0; c < 128; c += 8) {
      unsigned v[8];
#pragma unroll
      for (int j = 0; j < 8; ++j) v[j] = *reinterpret_cast<const unsigned*>(base + (size_t)(c + j) * 16384);
#pragma unroll
      for (int j = 0; j < 8; ++j) {
        *reinterpret_cast<unsigned*>(base + (size_t)(c + j) * 16384) = cvtpk(c0, c1);
        const float a_ = al[c + j], b_ = be[c + j];
        c0 = a_ * c0 + b_ * bflo(v[j]); c1 = a_ * c1 + b_ * bfhi(v[j]);
      }
    }
    { const int idx = part * 512 + tid * 2, e = idx >> 7, d = idx & 127;
      p.out[O_PC + ((size_t)bh * 128 + d) * 128 + e] = c0;
      p.out[O_PC + ((size_t)bh * 128 + d + 1) * 128 + e] = c1; }
    if (part == 0 && tid < 128) {
      float n = 0.f;
      for (int c = 0; c < 128; c += 16) {
        float nv[16];
#pragma unroll
        for (int j = 0; j < 16; ++j) nv[j] = p.nhat[((size_t)bh * 128 + c + j) * 128 + tid];
#pragma unroll
        for (int j = 0; j < 16; ++j) {
          p.nstate[((size_t)bh * 128 + c + j) * 128 + tid] = n;
          n = al[c + j] * n + be[c + j] * nv[j];
        }
      }
      p.out[O_PN + bh * 128 + tid] = n;
    }
  }
}

DEVI void m3_item(const Params& p, LAS char* lds, int item) {
  const int bh = item >> 7, c = item & 127, b = bh >> 2, hd = bh & 3;
  const size_t row0 = (size_t)b * SEQ + c * 64;
  lds_barrier();
  mlstm_out<2>(lds, p.gates + row0 * 8, hd, p.Qa + row0 * 512 + hd * 128, p.Ka + row0 * 512 + hd * 128,
               p.VaT + (size_t)bh * 128 * SEQ + c * 64, SEQ, p.xb + (size_t)item * 16384, p.nstate + (size_t)item * 128,
               p.mtab[bh * 129 + c], p.in[15] + hd * 128, p.Ga + row0 * 512 + hd * 128);
}

DEVI void ms_item(const Params& p, LAS char* lds, int bh) {
  const int tid = threadIdx.x, lane = tid & 63, w = tid >> 6, r = lane & 31, h = lane >> 5;
  const int b = bh >> 2, hd = bh & 3;
  const size_t row0 = (size_t)NTOKP + b * 32;
  const float m0 = p.in[9][bh];
  const float* n0 = p.in[8] + bh * 128;
  const u16* KTs = p.KaT + (size_t)NTOKP * 512 + (size_t)bh * 128 * 32;
  const u16* VTs = p.VaT + (size_t)NTOKP * 512 + (size_t)bh * 128 * 32;
  lds_barrier();
  mlstm_out<1>(lds, p.gates + row0 * 8, hd, p.Qa + row0 * 512 + hd * 128, p.Ka + row0 * 512 + hd * 128, VTs, 32,
               p.C0sT + (size_t)bh * 16384, n0, m0, p.in[15] + hd * 128, p.Ga + row0 * 512 + hd * 128);
  f32x16 acc[4]; float nh, bL, amax;
  mlstm_local<1>(lds, p.gates + row0 * 8, hd, KTs, VTs, 32, acc, nh, bL, amax);
  const float mlast = bL + fmaxf(m0, amax);
  const float decay = __expf(bL + m0 - mlast), beta = __expf(bL + amax - mlast);
#pragma unroll
  for (int et = 0; et < 4; ++et)
#pragma unroll
    for (int i = 0; i < 16; ++i) {
      const int d = 32 * w + crow(i, h), e = 32 * et + r;
      const size_t o = ((size_t)bh * 128 + d) * 128 + e;
      p.out[O_SC + o] = decay * p.in[7][o] + beta * acc[et][i];
    }
  if (h == 0) { const int d = 32 * w + r; p.out[O_SN + bh * 128 + d] = decay * n0[d] + beta * nh; }
  if (tid == 0) p.out[O_SM + bh] = mlast;
}

DEVI void phase_conv(const Params& p, LAS char* lds) {
  const int tid = threadIdx.x, lane = tid & 63, w = tid >> 6;
  const u16* U = p.Qa; u16* Gc = p.KaT;
  LAS u16* win = (LAS u16*)lds;
  LAS float* cs = (LAS float*)(lds + 40960);
  LAS float* st = (LAS float*)(lds + 40960 + 32768);
  float cw[4][31], cb[4], lg[4], lb[4];
#pragma unroll
  for (int c = 0; c < 4; ++c) {
    const int chn = c * 256 + tid;
#pragma unroll
    for (int j = 0; j < 31; ++j) cw[c][j] = p.in[25][j * 1024 + chn];
    cb[c] = p.in[26][chn]; lg[c] = p.in[27][chn]; lb[c] = p.in[28][chn];
  }
  const int ntile = NTOK / 8;
  auto fetch = [=](int tile, int cgp, u32x4 (&rg)[5]) __attribute__((always_inline)) {
    const int row0 = tile * 8;
    const bool samp = row0 >= NTOKP;
    const int t0 = samp ? ((row0 - NTOKP) & 31) : (row0 & 8191);
    const int bs = samp ? ((row0 - NTOKP) >> 5) : 0;
    const int seqbase = row0 - t0;
#pragma unroll
    for (int q = 0; q < 5; ++q) {
      const int pch = tid + 256 * q, rr = pch >> 5, ch = pch & 31, t = t0 - 30 + rr;
      u32x4 v = {0, 0, 0, 0};
      if (pch < 38 * 32) {
        if (t >= 0) v = *reinterpret_cast<const u32x4*>(U + (size_t)(seqbase + t) * 1024 + cgp * 256 + ch * 8);
        else if (samp) {
          const float4* sc = reinterpret_cast<const float4*>(p.in[10] + ((size_t)(bs * 30 + 30 + t)) * 1024 + cgp * 256 + ch * 8);
          const float4 a = sc[0], c = sc[1];
          v = u32x4{cvtpk(a.x, a.y), cvtpk(a.z, a.w), cvtpk(c.x, c.y), cvtpk(c.z, c.w)};
        }
      }
      rg[q] = v;
    }
  };
  auto commit = [=](int buf, const u32x4 (&rg)[5]) __attribute__((always_inline)) {
#pragma unroll
    for (int q = 0; q < 5; ++q) {
      const int pch = tid + 256 * q;
      if (pch < 38 * 32) *reinterpret_cast<LAS u32x4*>(win + buf * (38 * 256) + (pch >> 5) * 256 + (pch & 31) * 8) = rg[q];
    }
  };
  int tile = blockIdx.x;
  if (tile >= ntile) return;
  u32x4 rg[5];
  __syncthreads();
  fetch(tile, 0, rg);
  commit(0, rg);
  __syncthreads();
  for (; tile < ntile; tile += gridDim.x) {
    const int row0 = tile * 8;
    const int ntl = tile + gridDim.x;
#pragma unroll
    for (int cgp = 0; cgp < 4; ++cgp) {
      const bool more = (cgp < 3) || (ntl < ntile);
      if (more) fetch(cgp < 3 ? tile : ntl, cgp < 3 ? cgp + 1 : 0, rg);
      const LAS u16* wb = win + (cgp & 1) * (38 * 256);
      float wv[38];
#pragma unroll
      for (int rr = 0; rr < 38; ++rr) wv[rr] = bf2f(wb[rr * 256 + tid]);
#pragma unroll
      for (int i = 0; i < 8; ++i) {
        float a = cb[cgp];
#pragma unroll
        for (int j = 0; j < 31; ++j) a += cw[cgp][j] * wv[i + j];
        cs[i * 1024 + cgp * 256 + tid] = a;
      }
      if (more) commit((cgp + 1) & 1, rg);
      lds_barrier();
    }
    u16 gv[4][8];
#pragma unroll
    for (int c = 0; c < 4; ++c)
#pragma unroll
      for (int i = 0; i < 8; ++i) gv[c][i] = Gc[(size_t)(row0 + i) * 1024 + c * 256 + tid];
#pragma unroll
    for (int q = 0; q < 2; ++q) {
      const int i = 2 * w + q;
      float a1 = 0.f, a2 = 0.f;
#pragma unroll
      for (int k = 0; k < 16; ++k) { const float v = cs[i * 1024 + lane + 64 * k]; a1 += v; a2 += v * v; }
      a1 = wsum(a1); a2 = wsum(a2);
      if (lane == 0) {
        const float mu = a1 * (1.f / 1024.f);
        const float var = fmaxf(a2 * (1.f / 1024.f) - mu * mu, 0.f);
        st[2 * i] = mu; st[2 * i + 1] = rsqrtf(var + EPS);
      }
    }
    lds_barrier();
#pragma unroll
    for (int c = 0; c < 4; ++c) {
      const int chn = c * 256 + tid;
#pragma unroll
      for (int i = 0; i < 8; ++i) {
        const float y = (cs[i * 1024 + chn] - st[2 * i]) * st[2 * i + 1] * lg[c] + lb[c];
        Gc[(size_t)(row0 + i) * 1024 + chn] = f2bf(siluf_(y) * bf2f(gv[c][i]));
      }
    }
    lds_barrier();
  }
}

struct AttnConst { float M2d, M2x, lam; };
DEVI AttnConst attn_consts(const Params& p, int layer) {
  const int lane = threadIdx.x & 63;
  AttnConst c;
  const float gq = max_abs64(p.in[16], 64, lane), gk = max_abs64(p.in[17], 64, lane);
  float kd = 0.f, kx = 0.f;
  for (int i = lane; i < (int)gridDim.x * 4; i += 64) { kd = fmaxf(kd, p.kmaxp[i]); kx = fmaxf(kx, p.kmaxp[1024 * (1 + layer) + i]); }
  kd = wmax(kd); kx = wmax(kx);
  c.M2d = (8.f * gq * 0.125f * LOG2E) * fmaxf(8.f * gk, sqrtf(kd)) * 1.01f;
  const float xq = max_abs64(p.in[32] + layer * 128, 128, lane), xk = max_abs64(p.in[33] + layer * 128, 128, lane);
  c.M2x = (11.313708f * xq * 0.08838834764831845f * LOG2E) * fmaxf(11.313708f * xk, sqrtf(kx)) * 1.01f;
  float d1 = p.in[18][lane] * p.in[19][lane], d2 = p.in[20][lane] * p.in[21][lane];
  d1 = wsum(d1); d2 = wsum(d2);
  c.lam = __expf(d1) - __expf(d2) + 0.2f;
  return c;
}

DEVI void cross_item(const Params& p, LAS char* lds, int layer, int it, float M2x) {
  const int hd = it & 3;
  size_t row0; int mb, nw;
  if (it < 1024) { const int rb = it >> 2; row0 = (size_t)rb * 128; mb = rb >> 6; nw = 4; }
  else { const int bs = (it - 1024) >> 2; row0 = (size_t)NTOKP + bs * 32; mb = 4 + bs; nw = 1; }
  attn_block<false>(lds, p.Qx + row0 * 512 + hd * 128, p.XK + ((size_t)(layer * 12 + mb) * 256) * 512 + hd * 128,
                    p.XVT + ((size_t)((layer * 12 + mb) * 4 + hd) * 128) * 256, 256, 0, 4, nw, 0, 256, 0.f, M2x, 0.f, nullptr,
                    p.Gx + row0 * 512 + hd * 128);
}

DEVI void diff_item(const Params& p, LAS char* lds, int it, float M2d, float lam) {
  const bool pr = it < 1024;
  const int hd = pr ? 3 - (it >> 8) : (it - 1024) & 3;
  const int qb = pr ? 63 - ((it >> 2) & 63) : 0;
  const int b = pr ? (it & 3) : (it - 1024) >> 2;
  const int bh = b * 4 + hd;
  const size_t row0 = pr ? (size_t)b * SEQ + qb * 128 : (size_t)NTOKP + b * 32;
  const float slope2 = exp2f(-2.f * (hd + 1)) * LOG2E;
  const u16* Kp = pr ? p.Kb + (size_t)b * SEQ * 512 + hd * 128 : p.Ks + (size_t)b * SKP * 512 + hd * 128;
  const u16* Vp = pr ? p.VbT + (size_t)bh * 128 * SEQ : p.VsT + (size_t)bh * 128 * SKP;
  const int qpos0 = pr ? qb * 128 : PAST;
  const float kcut = (float)qpos0 - (2.f * M2d + 64.f) / slope2;
  int j0 = (int)floorf((kcut - 63.f) * (1.f / 64.f));
  j0 = max(j0, 0);
  attn_block<true>(lds, p.Qb + row0 * 512 + hd * 128, Kp, Vp, pr ? SEQ : SKP, j0, pr ? 2 * qb + 2 : 33, pr ? 4 : 1,
                   qpos0, pr ? SEQ : PAST + 32, slope2, M2d, lam, p.in[22], p.Gb + row0 * 512 + hd * 128);
}

DEVI int snake(int k, int g, int G) { return (k & 1) ? (k * G + (G - 1 - g)) : (k * G + g); }

constexpr int NPHASE = 9;
DEVI void run_phase(const Params& p, LAS char* lds, int ph) {
  const int G = gridDim.x, g = blockIdx.x;
  switch (ph) {
    case 0: phase_prep(p); break;
    case 1: phase_gemm<0>(p, lds); break;
    case 2: {
      const AttnConst c = attn_consts(p, 0);
      for (int it = g; it < 1056; it += G) cross_item(p, lds, 0, it, c.M2x);
      for (int it = g; it < 2048; it += G) m1_item(p, lds, it);
    } break;
    case 3: {
      const AttnConst c = attn_consts(p, 0);
      (void)c;
      phase_scan(p, lds);
    } break;
    case 4: {
      const AttnConst c = attn_consts(p, 0);
      unsigned* qhead = reinterpret_cast<unsigned*>(p.kmaxp + 3 * 1024) + 16;
      volatile LAS int* slot = (volatile LAS int*)(lds + LDS_BYTES - 16);
      for (;;) {
        lds_barrier();
        if (threadIdx.x == 0) *slot = (int)__hip_atomic_fetch_add(qhead, 1u, __ATOMIC_RELAXED, __HIP_MEMORY_SCOPE_AGENT);
        lds_barrier();
        const int it = *slot;
        if (it >= 1056) break;
        diff_item(p, lds, it, c.M2d, c.lam);
      }
      for (;;) {
        lds_barrier();
        if (threadIdx.x == 0) *slot = (int)__hip_atomic_fetch_add(qhead + 16, 1u, __ATOMIC_RELAXED, __HIP_MEMORY_SCOPE_AGENT);
        lds_barrier();
        const int it = *slot;
        if (it >= 2048) break;
        m3_item(p, lds, it);
      }
      for (int it = G - 1 - g; it < 32; it += G) ms_item(p, lds, it);
    } break;
    case 5: phase_gemm<1>(p, lds); break;
    case 6: phase_gemm<2>(p, lds); break;
    case 7: {
      const AttnConst c = attn_consts(p, 1);
      phase_conv(p, lds);
      for (int it = g; it < 1056; it += G) cross_item(p, lds, 1, it, c.M2x);
    } break;
    case 8: phase_gemm<3>(p, lds); break;
  }
}

DEVI void grid_bar(unsigned* ctr, unsigned& epoch) {
  asm volatile("s_waitcnt vmcnt(0)" ::: "memory");
  __syncthreads();
  if (threadIdx.x == 0) {
    __builtin_amdgcn_fence(__ATOMIC_RELEASE, "agent");
    asm volatile("s_waitcnt vmcnt(0)" ::: "memory");
    __hip_atomic_fetch_add(ctr, 1u, __ATOMIC_RELAXED, __HIP_MEMORY_SCOPE_AGENT);
    epoch += 1u;
    const unsigned target = epoch * gridDim.x;
    while (__hip_atomic_load(ctr, __ATOMIC_RELAXED, __HIP_MEMORY_SCOPE_AGENT) < target) __builtin_amdgcn_s_sleep(1);
    __builtin_amdgcn_fence(__ATOMIC_ACQUIRE, "agent");
    asm volatile("s_waitcnt vmcnt(0)" ::: "memory");
  }
  __syncthreads();
}

__global__ void __launch_bounds__(256, 1) mega(Params p, int ph_lo, int ph_hi) {
  extern __shared__ __attribute__((aligned(16))) char smem[];
  LAS char* lds = (LAS char*)smem;
  cg::grid_group grid = cg::this_grid();
  unsigned epoch = 0;
  unsigned* ctr = reinterpret_cast<unsigned*>(p.kmaxp + 3 * 1024);
#define RUNPH(k) if (ph_lo <= (k) && (k) < ph_hi) { if ((k) > ph_lo) { if ((k) == 1) grid.sync(); else grid_bar(ctr, epoch); } run_phase(p, lds, (k)); }
  RUNPH(0) RUNPH(1) RUNPH(2) RUNPH(3) RUNPH(4) RUNPH(5) RUNPH(6) RUNPH(7) RUNPH(8)
#undef RUNPH
}

#ifndef MULTI_LAUNCH
#define MULTI_LAUNCH 0
#endif

extern "C" void kernel_launch(void* const* d_in, const int* in_sizes, int n_in, void* d_out, int out_size, void* d_ws, size_t ws_size,
                              hipStream_t stream) {
  static int grid_blocks = 0;
  if (!grid_blocks) {
    int dev = 0, cus = 0, per_cu = 0;
    hipGetDevice(&dev);
    hipDeviceGetAttribute(&cus, hipDeviceAttributeMultiprocessorCount, dev);
    hipFuncSetAttribute((const void*)mega, hipFuncAttributeMaxDynamicSharedMemorySize, LDS_BYTES);
    hipOccupancyMaxActiveBlocksPerMultiprocessor(&per_cu, (const void*)mega, 256, LDS_BYTES);
    if (per_cu < 1) per_cu = 1;
    if (per_cu > 1) per_cu = 1;
    grid_blocks = (cus * per_cu) & ~7;
    if (grid_blocks < 8) grid_blocks = 8;
  }
  Params p{};
  for (int i = 0; i < 34; ++i) p.in[i] = (const float*)d_in[i];
  p.out = (float*)d_out;
  char* ws = (char*)d_ws;
  size_t off = 0;
  auto take = [&](size_t bytes) { char* q = ws + off; off += (bytes + 255) & ~(size_t)255; return q; };
  p.WtInA = (u16*)take((size_t)NPAD_A * 1024 * 2);
  p.WtOutA = (u16*)take((size_t)1024 * 1536 * 2);
  p.WtInC = (u16*)take((size_t)4096 * 1024 * 2);
  p.WtOutC = (u16*)take((size_t)1024 * 1536 * 2);
  p.WtMem = (u16*)take((size_t)2 * 1024 * 1024 * 2);
  p.xb = (u16*)take((size_t)NTOK * 1024 * 2);
  p.memb = (u16*)take((size_t)1024 * 1024 * 2);
  u16* segs = (u16*)take(SEG * 2 * 11);
  p.Qa = segs; p.Ka = segs + SEG; p.KaT = segs + 2 * SEG; p.VaT = segs + 3 * SEG; p.Ga = segs + 4 * SEG; p.Qb = segs + 5 * SEG;
  p.Kb = segs + 6 * SEG; p.VbT = segs + 7 * SEG; p.Gb = segs + 8 * SEG; p.Qx = segs + 9 * SEG; p.Gx = segs + 10 * SEG;
  p.Ks = (u16*)take((size_t)8 * SKP * 512 * 2);
  p.VsT = (u16*)take((size_t)4096 * SKP * 2);
  p.XK = (u16*)take((size_t)2 * 12 * 256 * 512 * 2);
  p.XVT = (u16*)take((size_t)2 * 12 * 256 * 512 * 2);
  p.C0sT = (u16*)take((size_t)32 * 16384 * 2);
  p.rs0 = (float*)take((size_t)NTOK * 4);
  p.ssq1 = (float*)take((size_t)NTOK * 4);
  p.rsmem = (float*)take((size_t)(1024 + 64) * 4);
  p.gates = (float*)take((size_t)NTOK * 8 * 4);
  p.tabA = (float*)take(2048 * 4);
  p.tabB = (float*)take(2048 * 4);
  p.mtab = (float*)take(16 * 129 * 4);
  p.nhat = (float*)take((size_t)2048 * 128 * 4);
  p.nstate = (float*)take((size_t)2048 * 128 * 4);
  p.kmaxp = (float*)take((size_t)3 * 1024 * 4 + 256);
  if (off > ws_size) { fprintf(stderr, "workspace too small: need %zu have %zu\n", off, ws_size); return; }
  (void)hipMemsetAsync(p.kmaxp + 3 * 1024, 0, 256, stream);
#if MULTI_LAUNCH
  for (int ph = 0; ph < NPHASE; ++ph) {
    hipLaunchKernelGGL(mega, dim3(grid_blocks), dim3(256), LDS_BYTES, stream, p, ph, ph + 1);
  }
#else
  int lo = 0, hi = NPHASE;
  void* args[] = {&p, &lo, &hi};
  hipError_t e = hipLaunchCooperativeKernel((const void*)mega, dim3(grid_blocks), dim3(256), args, LDS_BYTES, stream);
  if (e != hipSuccess) fprintf(stderr, "cooperative launch failed: %s (grid %d)\n", hipGetErrorString(e), grid_blocks);
#endif
}
```

```cpp
#include <hip/hip_runtime.h>
#include <hip/hip_cooperative_groups.h>
#include <stdint.h>
#include <stdio.h>
namespace cg = cooperative_groups;

typedef unsigned short u16;
using bf16x8 = __attribute__((ext_vector_type(8))) short;
using f32x4  = __attribute__((ext_vector_type(4))) float;
using f32x16 = __attribute__((ext_vector_type(16))) float;
using u32x4  = __attribute__((ext_vector_type(4))) unsigned;
using u32x2  = __attribute__((ext_vector_type(2))) unsigned;
#define LAS __attribute__((address_space(3)))
#define DEVI __device__ __forceinline__

constexpr int NTOKP = 32768, NTOKS = 256, NTOK = 33024;
constexpr int SEQ = 8192, LSAMP = 32, PAST = 2048, SKP = 2112;
constexpr size_t SEG = (size_t)NTOK * 512;
constexpr int NPAD_A = 5760;
constexpr float EPS = 1e-6f;
constexpr float LOG2E = 1.4426950408889634f;
constexpr size_t O_YP = 0, O_PXK = 33816576, O_PXV = 34865152, O_PK = 35913728, O_PV = 52690944,
  O_PC = 69468160, O_PN = 69730304, O_PM = 69732352, O_PCONV = 69732368, O_SK = 69855248, O_SV = 69986320,
  O_SC = 70117392, O_SN = 70641680, O_SM = 70645776, O_SCONV = 70645808;

constexpr int LDS_BYTES = 147456;

struct Params {
  const float* in[34];
  float* out;
  u16 *WtInA, *WtOutA, *WtInC, *WtOutC, *WtMem;
  u16 *xb, *memb;
  u16 *Qa, *Ka, *KaT, *VaT, *Ga, *Qb, *Kb, *VbT, *Gb, *Qx, *Gx;
  u16 *Ks, *VsT, *XK, *XVT, *C0sT;
  float *rs0, *ssq1, *rsmem, *gates, *tabA, *tabB, *mtab, *nhat, *nstate, *kmaxp;
};

DEVI unsigned cvtpk(float lo, float hi) { unsigned r; asm volatile("v_cvt_pk_bf16_f32 %0, %1, %2" : "=v"(r) : "v"(lo), "v"(hi)); return r; }
DEVI float bflo(unsigned u) { return __uint_as_float(u << 16); }
DEVI float bfhi(unsigned u) { return __uint_as_float(u & 0xffff0000u); }
DEVI float bf2f(u16 h) { return __uint_as_float(((unsigned)h) << 16); }
DEVI u16 f2bf(float f) { return (u16)(cvtpk(f, 0.f) & 0xffffu); }
DEVI float sigmoidf_(float x) { return 1.f / (1.f + __expf(-x)); }
DEVI float siluf_(float x) { return x / (1.f + __expf(-x)); }
DEVI float logsigmoidf_(float x) { return fminf(x, 0.f) - log1pf(__expf(-fabsf(x))); }
DEVI float wsum(float v) { for (int o = 32; o; o >>= 1) v += __shfl_xor(v, o); return v; }
DEVI float wmax(float v) { for (int o = 32; o; o >>= 1) v = fmaxf(v, __shfl_xor(v, o)); return v; }
DEVI int pi32(int r) { return (r & ~12) | ((r & 4) << 1) | ((r & 8) >> 1); }
DEVI int klocal(int reg, int h) { return (reg & 3) + 4 * ((reg >> 2) & 1) + 8 * h + 16 * (reg >> 3); }
DEVI int crow(int reg, int h) { return (reg & 3) + 8 * (reg >> 2) + 4 * h; }
DEVI bf16x8 ldg8(const u16* p) { return *reinterpret_cast<const bf16x8*>(p); }
DEVI f32x16 mfma32(bf16x8 a, bf16x8 b, f32x16 c) { return __builtin_amdgcn_mfma_f32_32x32x16_bf16(a, b, c, 0, 0, 0); }
DEVI bf16x8 pack8(const f32x16& x, int s) {
  u32x4 w = {cvtpk(x[8 * s + 0], x[8 * s + 1]), cvtpk(x[8 * s + 2], x[8 * s + 3]), cvtpk(x[8 * s + 4], x[8 * s + 5]), cvtpk(x[8 * s + 6], x[8 * s + 7])};
  return *reinterpret_cast<bf16x8*>(&w);
}
DEVI void lds_barrier() { asm volatile("s_waitcnt lgkmcnt(0)" ::: "memory"); __builtin_amdgcn_s_barrier(); asm volatile("" ::: "memory"); }
DEVI void glds16(const void* g, LAS void* l) { __builtin_amdgcn_global_load_lds((const unsigned*)g, (LAS unsigned*)l, 16, 0, 0); }

template <class F>
DEVI void wtrans(u16* dst, const float* src, const float* g, int K, int Npad, int ldn, F srccol, int gtid, int gsz) {
  const int total = Npad * (K / 64);
  for (int i = gtid; i < total; i += gsz) {
    const int n = i % Npad, kb = i / Npad;
    const int sc = srccol(n);
    float v[64];
#pragma unroll
    for (int j = 0; j < 64; ++j) v[j] = (sc >= 0) ? src[(size_t)(kb * 64 + j) * ldn + sc] : 0.f;
    if (g) {
#pragma unroll
      for (int j = 0; j < 64; ++j) v[j] *= g[kb * 64 + j];
    }
#pragma unroll
    for (int q = 0; q < 8; ++q) {
      u32x4 w = {cvtpk(v[8 * q + 0], v[8 * q + 1]), cvtpk(v[8 * q + 2], v[8 * q + 3]), cvtpk(v[8 * q + 4], v[8 * q + 5]), cvtpk(v[8 * q + 6], v[8 * q + 7])};
      *reinterpret_cast<u32x4*>(dst + (size_t)n * K + kb * 64 + q * 8) = w;
    }
  }
}

DEVI int srccol_in_a(int n) {
  const int t = n >> 7, c = n & 127;
  if (t < 12) return n;
  if (t < 20) { const int j = t - 12; return c < 64 ? 1536 + 64 * j + c : 2048 + 64 * j + (c - 64); }
  if (t < 44) return 2568 + (t - 20) * 128 + c;
  if (t == 44) return c < 8 ? 2560 + c : -1;
  return -1;
}
DEVI int srccol_in_c(int n) {
  const int t = n >> 7, c = n & 127;
  if (t < 16) return c < 64 ? 64 * t + c : 1024 + 64 * t + (c - 64);
  return n;
}

DEVI void phase_prep(const Params& p) {
  const int tid = threadIdx.x, lane = tid & 63;
  const int gtid = blockIdx.x * 256 + tid, gsz = gridDim.x * 256;
  const int gwave = gtid >> 6, nwaves = gsz >> 6;
  wtrans(p.WtInA, p.in[12], p.in[11], 1024, NPAD_A, 5640, [](int n) { return srccol_in_a(n); }, gtid, gsz);
  wtrans(p.WtOutA, p.in[23], nullptr, 1536, 1024, 1024, [](int n) { return n; }, gtid, gsz);
  wtrans(p.WtInC, p.in[24], p.in[11] + 1024, 1024, 4096, 4096, [](int n) { return srccol_in_c(n); }, gtid, gsz);
  wtrans(p.WtOutC, p.in[29], nullptr, 1536, 1024, 1024, [](int n) { return n; }, gtid, gsz);
  for (int l = 0; l < 2; ++l)
    wtrans(p.WtMem + (size_t)l * 1024 * 1024, p.in[31] + (size_t)l * 1024 * 1024, p.in[30] + l * 1024, 1024, 1024, 1024,
           [](int n) { return n; }, gtid, gsz);
  for (int row0 = gwave; row0 < NTOK + 1024; row0 += 8 * nwaves) {
    float4 v[8][4];
    const float* xr[8];
#pragma unroll
    for (int u = 0; u < 8; ++u) {
      const int row = min(row0 + u * nwaves, NTOK + 1023);
      xr[u] = row < NTOKP ? p.in[0] + (size_t)row * 1024 : (row < NTOK ? p.in[1] + (size_t)(row - NTOKP) * 1024 : p.in[2] + (size_t)(row - NTOK) * 1024);
    }
#pragma unroll
    for (int u = 0; u < 8; ++u)
#pragma unroll
      for (int i = 0; i < 4; ++i) v[u][i] = reinterpret_cast<const float4*>(xr[u])[lane + 64 * i];
#pragma unroll
    for (int u = 0; u < 8; ++u) {
      const int row = row0 + u * nwaves;
      float ss = 0.f;
#pragma unroll
      for (int i = 0; i < 4; ++i) ss += v[u][i].x * v[u][i].x + v[u][i].y * v[u][i].y + v[u][i].z * v[u][i].z + v[u][i].w * v[u][i].w;
      ss = wsum(ss);
      if (row < NTOK + 1024) {
        u16* dst = row < NTOK ? p.xb + (size_t)row * 1024 : p.memb + (size_t)(row - NTOK) * 1024;
        float* rsd = row < NTOK ? p.rs0 + row : p.rsmem + (row - NTOK);
        if (lane == 0) *rsd = rsqrtf(ss * (1.f / 1024.f) + EPS);
#pragma unroll
        for (int i = 0; i < 4; ++i) { u32x2 w = {cvtpk(v[u][i].x, v[u][i].y), cvtpk(v[u][i].z, v[u][i].w)}; reinterpret_cast<u32x2*>(dst)[lane + 64 * i] = w; }
      }
    }
  }
  float km0 = 0.f, km1 = 0.f, km2 = 0.f;
  for (int i0 = gtid; i0 < 8 * PAST * 64; i0 += 4 * gsz) {
    float4 a[4], c[4];
#pragma unroll
    for (int u = 0; u < 4; ++u) {
      const int i = i0 + u * gsz;
      const int c8 = i & 63, pp = (i >> 6) & (PAST - 1), b = (i >> 17) & 7;
      const float4* sp = reinterpret_cast<const float4*>(p.in[5] + ((size_t)(b * PAST + pp) * 512 + c8 * 8));
      a[u] = sp[0]; c[u] = sp[1];
    }
#pragma unroll
    for (int u = 0; u < 4; ++u) {
      const int i = i0 + u * gsz;
      if (i < 8 * PAST * 64) {
        const int c8 = i & 63, pp = (i >> 6) & (PAST - 1), b = i >> 17;
        u32x4 w = {cvtpk(a[u].x, a[u].y), cvtpk(a[u].z, a[u].w), cvtpk(c[u].x, c[u].y), cvtpk(c[u].z, c[u].w)};
        *reinterpret_cast<u32x4*>(p.Ks + ((size_t)(b * SKP + pp) * 512 + c8 * 8)) = w;
        float ss = a[u].x * a[u].x + a[u].y * a[u].y + a[u].z * a[u].z + a[u].w * a[u].w + c[u].x * c[u].x + c[u].y * c[u].y + c[u].z * c[u].z + c[u].w * c[u].w;
        ss += __shfl_xor(ss, 1); ss += __shfl_xor(ss, 2); ss += __shfl_xor(ss, 4);
        km0 = fmaxf(km0, ss);
      }
    }
  }
  for (int i0 = gtid; i0 < 8 * 4 * 256 * 128; i0 += 4 * gsz) {
    float v[4][8];
#pragma unroll
    for (int u = 0; u < 4; ++u) {
      const int i = (i0 + u * gsz) & (8 * 4 * 256 * 128 - 1);
      const int dv = i & 127, p8 = (i >> 7) & 255, h = (i >> 15) & 3, b = i >> 17;
#pragma unroll
      for (int j = 0; j < 8; ++j) v[u][j] = p.in[6][((size_t)(b * PAST + p8 * 8 + j) * 4 + h) * 128 + dv];
    }
#pragma unroll
    for (int u = 0; u < 4; ++u) {
      const int i = i0 + u * gsz;
      if (i < 8 * 4 * 256 * 128) {
        const int dv = i & 127, p8 = (i >> 7) & 255, h = (i >> 15) & 3, b = i >> 17;
        u32x4 w = {cvtpk(v[u][0], v[u][1]), cvtpk(v[u][2], v[u][3]), cvtpk(v[u][4], v[u][5]), cvtpk(v[u][6], v[u][7])};
        *reinterpret_cast<u32x4*>(p.VsT + ((size_t)((b * 4 + h) * 128 + dv) * SKP + p8 * 8)) = w;
      }
    }
  }
  for (int i = gtid; i < 4096 * 4; i += gsz) {
    u32x4 z = {0, 0, 0, 0};
    *reinterpret_cast<u32x4*>(p.VsT + ((size_t)(i >> 2) * SKP + 2080 + (i & 3) * 8)) = z;
  }
  for (int i = gtid; i < 8 * 32 * 64; i += gsz) {
    u32x4 z = {0, 0, 0, 0};
    const int c8 = i & 63, r = (i >> 6) & 31, b = i >> 11;
    *reinterpret_cast<u32x4*>(p.Ks + ((size_t)(b * SKP + 2080 + r) * 512 + c8 * 8)) = z;
  }
  for (int i = gtid; i < 2 * 8 * 256 * 64; i += gsz) {
    const int c8 = i & 63, m = (i >> 6) & 255, b = (i >> 14) & 7, l = i >> 17;
    const float4* s = reinterpret_cast<const float4*>(p.in[3] + ((size_t)((l * 8 + b) * 256 + m) * 512 + c8 * 8));
    const float4 a = s[0], c = s[1];
    u32x4 w = {cvtpk(a.x, a.y), cvtpk(a.z, a.w), cvtpk(c.x, c.y), cvtpk(c.z, c.w)};
    *reinterpret_cast<u32x4*>(p.XK + ((size_t)((l * 12 + 4 + b) * 256 + m) * 512 + c8 * 8)) = w;
    float ss = a.x * a.x + a.y * a.y + a.z * a.z + a.w * a.w + c.x * c.x + c.y * c.y + c.z * c.z + c.w * c.w;
    ss += __shfl_xor(ss, 1); ss += __shfl_xor(ss, 2); ss += __shfl_xor(ss, 4); ss += __shfl_xor(ss, 8);
    if (l == 0) km1 = fmaxf(km1, ss); else km2 = fmaxf(km2, ss);
  }
  for (int i = gtid; i < 2 * 8 * 4 * 32 * 128; i += gsz) {
    const int dv = i & 127, m8 = (i >> 7) & 31, h = (i >> 12) & 3, b = (i >> 14) & 7, l = i >> 17;
    float v[8];
#pragma unroll
    for (int j = 0; j < 8; ++j) v[j] = p.in[4][((size_t)((l * 8 + b) * 256 + m8 * 8 + j) * 4 + h) * 128 + dv];
    u32x4 w = {cvtpk(v[0], v[1]), cvtpk(v[2], v[3]), cvtpk(v[4], v[5]), cvtpk(v[6], v[7])};
    *reinterpret_cast<u32x4*>(p.XVT + ((size_t)(((l * 12 + 4 + b) * 4 + h) * 128 + dv) * 256 + m8 * 8)) = w;
  }
  for (int i = gtid; i < 32 * 16 * 128; i += gsz) {
    const int e = i & 127, d8 = (i >> 7) & 15, bh = i >> 11;
    float v[8];
#pragma unroll
    for (int j = 0; j < 8; ++j) v[j] = p.in[7][((size_t)bh * 128 + d8 * 8 + j) * 128 + e];
    u32x4 w = {cvtpk(v[0], v[1]), cvtpk(v[2], v[3]), cvtpk(v[4], v[5]), cvtpk(v[6], v[7])};
    *reinterpret_cast<u32x4*>(p.C0sT + ((size_t)bh * 128 + e) * 128 + d8 * 8) = w;
  }
  for (int i = gtid; i < NTOK; i += gsz) p.ssq1[i] = 0.f;
  km0 = wmax(km0); km1 = wmax(km1); km2 = wmax(km2);
  if (lane == 0) {
    const int slot = blockIdx.x * 4 + (tid >> 6);
    p.kmaxp[slot] = km0; p.kmaxp[1024 + slot] = km1; p.kmaxp[2048 + slot] = km2;
  }
}

DEVI void st_bf8(u16* dst, const float (&v)[8]) {
  u32x4 w = {cvtpk(v[0], v[1]), cvtpk(v[2], v[3]), cvtpk(v[4], v[5]), cvtpk(v[6], v[7])};
  *reinterpret_cast<u32x4*>(dst) = w;
}
DEVI void st_f8(float* dst, const float (&v)[8]) {
  reinterpret_cast<float4*>(dst)[0] = float4{v[0], v[1], v[2], v[3]};
  reinterpret_cast<float4*>(dst)[1] = float4{v[4], v[5], v[6], v[7]};
}
DEVI void store_transposed(LAS char* lds, u16* dst, size_t ldt, float scale) {
  const LAS float* Cs = (const LAS float*)lds;
  const int c = threadIdx.x & 127, rh = (threadIdx.x >> 7) * 64;
#pragma unroll
  for (int it = 0; it < 8; ++it) {
    const int r0 = rh + it * 8;
    float v[8];
#pragma unroll
    for (int j = 0; j < 8; ++j) v[j] = Cs[(r0 + j) * 132 + c] * scale;
    st_bf8(dst + (size_t)c * ldt + r0, v);
  }
}

DEVI void epi_in_a(const Params& p, LAS char* lds, int brow, int n, const float (&gn)[8]) {
  const LAS float* Cs = (const LAS float*)lds;
  const int tid = threadIdx.x, cgp = tid & 15, c0 = cgp * 8;
  const bool samp = brow >= NTOKP;
  const int seg = n >> 2, hd = n & 3;
  if (n >= 4 && n < 12) {
    u16* base = (n < 8 ? p.KaT : p.VaT);
    const float sc = (n < 8 ? 0.08838834764831845f : 1.f);
    if (!samp) { const int b = brow >> 13, t0 = brow & 8191; store_transposed(lds, base + ((size_t)(b * 4 + hd) * 128) * SEQ + t0, SEQ, sc); }
    else {
      const int c = tid & 127, rh = (tid >> 7) * 64;
#pragma unroll
      for (int it = 0; it < 8; ++it) {
        const int r0 = rh + it * 8; const int bs = ((brow - NTOKP) + r0) >> 5, t0 = r0 & 31;
        float v[8];
#pragma unroll
        for (int j = 0; j < 8; ++j) v[j] = Cs[(r0 + j) * 132 + c] * sc;
        st_bf8(base + (size_t)NTOKP * 512 + ((size_t)(bs * 4 + hd) * 128 + c) * 32 + t0, v);
      }
    }
  }
  if (seg == 7) {
    if (!samp) { const int b = brow >> 13, t0 = brow & 8191; store_transposed(lds, p.VbT + ((size_t)(b * 4 + hd) * 128) * SEQ + t0, SEQ, 1.f); }
    else {
      const int c = tid & 127, rh = (tid >> 7) * 64;
#pragma unroll
      for (int it = 0; it < 8; ++it) {
        const int r0 = rh + it * 8; const int bs = ((brow - NTOKP) + r0) >> 5, t0 = r0 & 31;
        float v[8];
#pragma unroll
        for (int j = 0; j < 8; ++j) v[j] = Cs[(r0 + j) * 132 + c];
        st_bf8(p.VsT + ((size_t)(bs * 4 + hd) * 128 + c) * SKP + PAST + t0, v);
      }
    }
  }
#pragma unroll 4
  for (int it = 0; it < 8; ++it) {
    const int r = it * 16 + (tid >> 4);
    const size_t grow = (size_t)brow + r;
    float v[8];
#pragma unroll
    for (int j = 0; j < 8; ++j) v[j] = Cs[r * 132 + c0 + j];
    if (n < 4) { st_bf8(p.Qa + grow * 512 + hd * 128 + c0, v); }
    else if (n < 8) {
#pragma unroll
      for (int j = 0; j < 8; ++j) v[j] *= 0.08838834764831845f;
      st_bf8(p.Ka + grow * 512 + hd * 128 + c0, v);
    }
    else if (n < 12) {   }
    else if (n < 20) {
      if (cgp < 8) {
        float g[8];
#pragma unroll
        for (int j = 0; j < 8; ++j) g[j] = sigmoidf_(v[j]) * siluf_(Cs[r * 132 + 64 + c0 + j]);
        st_bf8(p.Ga + grow * 512 + (n - 12) * 64 + c0, g);
      }
    }
    else if (n < 28) {
      float ss = 0.f;
#pragma unroll
      for (int j = 0; j < 8; ++j) ss += v[j] * v[j];
      ss += __shfl_xor(ss, 1); ss += __shfl_xor(ss, 2); ss += __shfl_xor(ss, 4);
      const float rs = rsqrtf(ss * (1.f / 64.f) + EPS);
      const float* g = gn;
      if (n < 24) {
#pragma unroll
        for (int j = 0; j < 8; ++j) v[j] = v[j] * rs * g[j] * (0.125f * LOG2E);
        st_bf8(p.Qb + grow * 512 + hd * 128 + c0, v);
      } else {
#pragma unroll
        for (int j = 0; j < 8; ++j) v[j] = v[j] * rs * g[j];
        if (!samp) { st_f8(p.out + O_PK + grow * 512 + hd * 128 + c0, v); st_bf8(p.Kb + grow * 512 + hd * 128 + c0, v); }
        else {
          const int sr = (int)grow - NTOKP, bs = sr >> 5, t = sr & 31;
          st_f8(p.out + O_SK + (size_t)sr * 512 + hd * 128 + c0, v);
          st_bf8(p.Ks + ((size_t)(bs * SKP + PAST + t)) * 512 + hd * 128 + c0, v);
        }
      }
    }
    else if (n < 32) {
      if (!samp) st_f8(p.out + O_PV + grow * 512 + hd * 128 + c0, v);
      else st_f8(p.out + O_SV + (size_t)((int)grow - NTOKP) * 512 + hd * 128 + c0, v);
    }
    else if (n < 36) {
#pragma unroll
      for (int j = 0; j < 8; ++j) v[j] = siluf_(v[j]);
      st_bf8(p.Gb + grow * 512 + hd * 128 + c0, v);
    }
    else if (n < 40) {
      float ss = 0.f;
#pragma unroll
      for (int j = 0; j < 8; ++j) ss += v[j] * v[j];
      ss += __shfl_xor(ss, 1); ss += __shfl_xor(ss, 2); ss += __shfl_xor(ss, 4); ss += __shfl_xor(ss, 8);
      const float rs = rsqrtf(ss * (1.f / 128.f) + EPS);
      const float* g = gn;
#pragma unroll
      for (int j = 0; j < 8; ++j) v[j] = v[j] * rs * g[j] * (0.08838834764831845f * LOG2E);
      st_bf8(p.Qx + grow * 512 + hd * 128 + c0, v);
    }
    else if (n < 44) {
#pragma unroll
      for (int j = 0; j < 8; ++j) v[j] = siluf_(v[j]);
      st_bf8(p.Gx + grow * 512 + hd * 128 + c0, v);
    }
    else {
      if (cgp == 0) {
        float g[8];
#pragma unroll
        for (int j = 0; j < 4; ++j) { g[j] = v[j] + gn[j]; g[4 + j] = logsigmoidf_(v[4 + j] + gn[4 + j]); }
        st_f8(p.gates + grow * 8, g);
      }
    }
  }
}

DEVI void epi_mem(const Params& p, LAS char* lds, int l, int brow, int n, const float (&gk)[8]) {
  const LAS float* Cs = (const LAS float*)lds;
  const int tid = threadIdx.x, cgp = tid & 15, c0 = cgp * 8;
  const int hd = n & 3;
  if (n >= 4) {
    const int b = brow >> 8, m0 = brow & 255;
    store_transposed(lds, p.XVT + ((size_t)((l * 12 + b) * 4 + hd) * 128) * 256 + m0, 256, 1.f);
  }
#pragma unroll 4
  for (int it = 0; it < 8; ++it) {
    const int r = it * 16 + (tid >> 4);
    const size_t grow = (size_t)brow + r;
    float v[8];
#pragma unroll
    for (int j = 0; j < 8; ++j) v[j] = Cs[r * 132 + c0 + j];
    if (n < 4) {
      float ss = 0.f;
#pragma unroll
      for (int j = 0; j < 8; ++j) ss += v[j] * v[j];
      ss += __shfl_xor(ss, 1); ss += __shfl_xor(ss, 2); ss += __shfl_xor(ss, 4); ss += __shfl_xor(ss, 8);
      const float rs = rsqrtf(ss * (1.f / 128.f) + EPS);
      const float* g = gk;
#pragma unroll
      for (int j = 0; j < 8; ++j) v[j] = v[j] * rs * g[j];
      st_f8(p.out + O_PXK + ((size_t)l * 1024 + grow) * 512 + hd * 128 + c0, v);
      const int b = (int)grow >> 8, m = (int)grow & 255;
      st_bf8(p.XK + ((size_t)((l * 12 + b) * 256 + m)) * 512 + hd * 128 + c0, v);
    } else {
      st_f8(p.out + O_PXV + ((size_t)l * 1024 + grow) * 512 + hd * 128 + c0, v);
    }
  }
}

DEVI void load_resid(const Params& p, int layer, int brow, int n, float4 (&ra)[8], float4 (&rb)[8]) {
  const int tid = threadIdx.x, c0 = (tid & 15) * 8;
#pragma unroll
  for (int it = 0; it < 8; ++it) {
    const size_t grow = (size_t)brow + it * 16 + (tid >> 4);
    const float* res;
    if (layer == 0) res = (grow < NTOKP ? p.in[0] + grow * 1024 : p.in[1] + (grow - NTOKP) * 1024) + n * 128 + c0;
    else res = p.out + grow * 1024 + n * 128 + c0;
    ra[it] = reinterpret_cast<const float4*>(res)[0]; rb[it] = reinterpret_cast<const float4*>(res)[1];
  }
}
DEVI void epi_out(const Params& p, LAS char* lds, int layer, int brow, int n, const float4 (&ra)[8], const float4 (&rb)[8]) {
  const LAS float* Cs = (const LAS float*)lds;
  const int tid = threadIdx.x, cgp = tid & 15, c0 = cgp * 8;
#pragma unroll
  for (int q = 0; q < 8; ++q) {
    const int r = q * 16 + (tid >> 4);
    const size_t grow = (size_t)brow + r;
    float v[8];
#pragma unroll
    for (int j = 0; j < 8; ++j) v[j] = Cs[r * 132 + c0 + j];
    v[0] += ra[q].x; v[1] += ra[q].y; v[2] += ra[q].z; v[3] += ra[q].w; v[4] += rb[q].x; v[5] += rb[q].y; v[6] += rb[q].z; v[7] += rb[q].w;
    st_f8(p.out + grow * 1024 + n * 128 + c0, v);
    if (layer == 0) {
      st_bf8(p.xb + grow * 1024 + n * 128 + c0, v);
      float ss = 0.f;
#pragma unroll
      for (int j = 0; j < 8; ++j) ss += v[j] * v[j];
      ss += __shfl_xor(ss, 1); ss += __shfl_xor(ss, 2); ss += __shfl_xor(ss, 4); ss += __shfl_xor(ss, 8);
      if (cgp == 0) atomicAdd(p.ssq1 + grow, ss);
    }
  }
}

DEVI void epi_in_c(const Params& p, LAS char* lds, int brow, int n, const float (&gx)[8]) {
  const LAS float* Cs = (const LAS float*)lds;
  const int tid = threadIdx.x, cgp = tid & 15, c0 = cgp * 8;
  u16* U = p.Qa;
  u16* Gc = p.KaT;
#pragma unroll 4
  for (int it = 0; it < 8; ++it) {
    const int r = it * 16 + (tid >> 4);
    const size_t grow = (size_t)brow + r;
    float v[8];
#pragma unroll
    for (int j = 0; j < 8; ++j) v[j] = Cs[r * 132 + c0 + j];
    if (n < 16) {
      if (cgp < 8) {
        float u[8];
#pragma unroll
        for (int j = 0; j < 8; ++j) u[j] = v[j] * sigmoidf_(Cs[r * 132 + 64 + c0 + j]);
        st_bf8(U + grow * 1024 + n * 64 + c0, u);
        if (grow < NTOKP) { const int t = (int)grow & 8191, b = (int)grow >> 13; if (t >= SEQ - 30) st_f8(p.out + O_PCONV + ((size_t)(b * 30 + t - (SEQ - 30))) * 1024 + n * 64 + c0, u); }
        else { const int sr = (int)grow - NTOKP, t = sr & 31, b = sr >> 5; if (t >= 2) st_f8(p.out + O_SCONV + ((size_t)(b * 30 + t - 2)) * 1024 + n * 64 + c0, u); }
      }
    } else if (n < 24) {
#pragma unroll
      for (int j = 0; j < 8; ++j) v[j] = siluf_(v[j]);
      st_bf8(Gc + grow * 1024 + (n - 16) * 128 + c0, v);
    } else if (n < 28) {
      float ss = 0.f;
#pragma unroll
      for (int j = 0; j < 8; ++j) ss += v[j] * v[j];
      ss += __shfl_xor(ss, 1); ss += __shfl_xor(ss, 2); ss += __shfl_xor(ss, 4); ss += __shfl_xor(ss, 8);
      const float rs = rsqrtf(ss * (1.f / 128.f) + EPS);
      const float* g = gx;
#pragma unroll
      for (int j = 0; j < 8; ++j) v[j] = v[j] * rs * g[j] * (0.08838834764831845f * LOG2E);
      st_bf8(p.Qx + grow * 512 + (n - 24) * 128 + c0, v);
    } else {
#pragma unroll
      for (int j = 0; j < 8; ++j) v[j] = siluf_(v[j]);
      st_bf8(p.Gx + grow * 512 + (n - 28) * 128 + c0, v);
    }
  }
}

DEVI void gemm_core(LAS char* lds, const u16* A0, const u16* A1, const u16* A2, int lda0, int lda1, int lda2, int segK,
                    const u16* Bt, int K, int brow, int bcol, f32x16 (&acc)[4][2]) {
  const int tid = threadIdx.x, lane = tid & 63, w = tid >> 6, wr = w >> 1, wc = w & 1, r = lane & 31, h = lane >> 5;
#pragma unroll
  for (int i = 0; i < 4; ++i)
#pragma unroll
    for (int j = 0; j < 2; ++j)
#pragma unroll
      for (int e = 0; e < 16; ++e) acc[i][j][e] = 0.f;
  const int nkt = K / 64;
  auto stage_part = [=](int kt, int buf, int part) __attribute__((always_inline)) {
    const int k0 = kt * 64;
    const int seg = k0 / segK;
    const u16* Ab = (seg == 0 ? A0 : (seg == 1 ? A1 : A2)) + (k0 - seg * segK);
    const int lda = (seg == 0 ? lda0 : (seg == 1 ? lda1 : lda2));
    LAS char* sa = lds + buf * 49152;
    LAS char* sb = sa + 32768;
#pragma unroll
    for (int q = 0; q < 2; ++q) {
      const int i = 2 * part + q;
      const int pch = i * 256 + tid, row = pch >> 3, lg = (pch & 7) ^ ((row >> 1) & 7);
      glds16(Ab + (size_t)(brow + row) * lda + lg * 8, sa + pch * 16);
    }
    {
      const int pch = part * 256 + tid, row = pch >> 3, lg = (pch & 7) ^ ((row >> 1) & 7);
      glds16(Bt + (size_t)(bcol + row) * K + k0 + lg * 8, sb + pch * 16);
    }
  };
  lds_barrier();
#pragma unroll
  for (int part = 0; part < 4; ++part) stage_part(0, 0, part);
#pragma unroll
  for (int part = 0; part < 4; ++part) stage_part(1, 1, part);
  int buf = 0;
  for (int kt = 0; kt < nkt; ++kt) {
    if (kt + 1 < nkt) asm volatile("s_waitcnt vmcnt(12)" ::: "memory"); else asm volatile("s_waitcnt vmcnt(0)" ::: "memory");
    asm volatile("s_waitcnt lgkmcnt(0)" ::: "memory");
    __builtin_amdgcn_s_barrier();
    int nb = buf + 2; if (nb >= 3) nb -= 3;
    const bool more = kt + 2 < nkt;
    const LAS char* sa = lds + buf * 49152;
    const LAS char* sb = sa + 32768;
    bf16x8 af[2][4], bfr[2][2];
#pragma unroll
    for (int i = 0; i < 4; ++i) {
      const int row = 32 * (2 * i + wr) + r, ch = h ^ ((row >> 1) & 7);
      af[0][i] = *reinterpret_cast<const LAS bf16x8*>(sa + row * 128 + ch * 16);
    }
#pragma unroll
    for (int j = 0; j < 2; ++j) {
      const int row = 32 * (2 * j + wc) + r, ch = h ^ ((row >> 1) & 7);
      bfr[0][j] = *reinterpret_cast<const LAS bf16x8*>(sb + row * 128 + ch * 16);
    }
#pragma unroll
    for (int ks = 0; ks < 4; ++ks) {
      const int cur = ks & 1, nxt = cur ^ 1;
      if (ks < 3) {
#pragma unroll
        for (int i = 0; i < 4; ++i) {
          const int row = 32 * (2 * i + wr) + r, ch = (2 * (ks + 1) + h) ^ ((row >> 1) & 7);
          af[nxt][i] = *reinterpret_cast<const LAS bf16x8*>(sa + row * 128 + ch * 16);
        }
#pragma unroll
        for (int j = 0; j < 2; ++j) {
          const int row = 32 * (2 * j + wc) + r, ch = (2 * (ks + 1) + h) ^ ((row >> 1) & 7);
          bfr[nxt][j] = *reinterpret_cast<const LAS bf16x8*>(sb + row * 128 + ch * 16);
        }
      }
#pragma unroll
      for (int i = 0; i < 4; ++i)
#pragma unroll
        for (int j = 0; j < 2; ++j) acc[i][j] = mfma32(af[cur][i], bfr[cur][j], acc[i][j]);
      if (more) stage_part(kt + 2, nb, ks);
    }
    if (++buf == 3) buf = 0;
  }
}

DEVI void stage_all(LAS char* lds, const f32x16 (&acc)[4][2], bool scaled) {
  const int tid = threadIdx.x, lane = tid & 63, w = tid >> 6, wr = w >> 1, wc = w & 1, r = lane & 31, h = lane >> 5;
  const LAS float* RS = (const LAS float*)(lds + 135168);
#pragma unroll
  for (int i = 0; i < 4; ++i) {
    LAS float* Cs = (LAS float*)(lds + (i >> 1) * 67584);
#pragma unroll
    for (int e = 0; e < 16; ++e) {
      const int row = 32 * (2 * (i & 1) + wr) + crow(e, h);
      const float s = scaled ? RS[128 * (i >> 1) + row] : 1.f;
#pragma unroll
      for (int jj = 0; jj < 2; ++jj) Cs[row * 132 + 32 * (2 * jj + wc) + r] = acc[i][jj][e] * s;
    }
  }
}

DEVI void gemm_tile_run(const Params& p, LAS char* lds, int which, int aux, int mt, int n, f32x16 (&acc)[4][2]) {
  const int brow = mt * 256, bcol = n * 128;
  const float* rsc = nullptr; int mode = 0;
  if (which == 0) { gemm_core(lds, p.xb, p.xb, p.xb, 1024, 1024, 1024, 1024, p.WtInA, 1024, brow, bcol, acc); rsc = p.rs0; mode = 1; }
  else if (which == 1) gemm_core(lds, p.Ga, p.Gb, p.Gx, 512, 512, 512, 512, p.WtOutA, 1536, brow, bcol, acc);
  else if (which == 2) { gemm_core(lds, p.xb, p.xb, p.xb, 1024, 1024, 1024, 1024, p.WtInC, 1024, brow, bcol, acc); rsc = p.ssq1; mode = 2; }
  else if (which == 3) gemm_core(lds, p.KaT, p.KaT + 512, p.Gx, 1024, 1024, 512, 512, p.WtOutC, 1536, brow, bcol, acc);
  else { gemm_core(lds, p.memb, p.memb, p.memb, 1024, 1024, 1024, 1024, p.WtMem + (size_t)aux * 1024 * 1024, 1024, brow, bcol, acc); rsc = p.rsmem; mode = 1; }
  lds_barrier();
  if (mode) {
    float sc = rsc[brow + threadIdx.x];
    if (mode == 2) sc = rsqrtf(sc * (1.f / 1024.f) + EPS);
    ((LAS float*)(lds + 135168))[threadIdx.x] = sc;
    lds_barrier();
  }
  if (which == 1 || which == 3) {
    float4 ra0[8], rb0[8], ra1[8], rb1[8];
    load_resid(p, which == 1 ? 0 : 1, brow, n, ra0, rb0);
    load_resid(p, which == 1 ? 0 : 1, brow + 128, n, ra1, rb1);
    stage_all(lds, acc, false);
    lds_barrier();
    epi_out(p, lds, which == 1 ? 0 : 1, brow, n, ra0, rb0);
    epi_out(p, lds + 67584, which == 1 ? 0 : 1, brow + 128, n, ra1, rb1);
    return;
  }
  float gpre[8];
  {
    const int c0 = (threadIdx.x & 15) * 8;
    const float* gp = nullptr;
    if (which == 0) {
      if (n >= 20 && n < 24) gp = p.in[16] + (c0 & 63);
      else if (n >= 24 && n < 28) gp = p.in[17] + (c0 & 63);
      else if (n >= 36 && n < 40) gp = p.in[32] + c0;
    } else if (which == 2) gp = p.in[32] + 128 + c0;
    else gp = p.in[33] + aux * 128 + c0;
#pragma unroll
    for (int j = 0; j < 8; ++j) gpre[j] = gp ? gp[j] : 0.f;
    if (which == 0 && n == 44) {
#pragma unroll
      for (int j = 0; j < 4; ++j) { gpre[j] = p.in[13][j]; gpre[4 + j] = p.in[14][j]; }
    }
  }
  stage_all(lds, acc, mode != 0);
  lds_barrier();
#pragma unroll 1
  for (int sub = 0; sub < 2; ++sub) {
    LAS char* cs = lds + sub * 67584;
    const int sr = brow + 128 * sub;
    if (which == 0) epi_in_a(p, cs, sr, n, gpre);
    else if (which == 2) epi_in_c(p, cs, sr, n, gpre);
    else epi_mem(p, cs, aux, sr, n, gpre);
  }
}

template <int which>
DEVI void phase_gemm(const Params& p, LAS char* lds) {
  constexpr int nN = (which == 0 ? 45 : (which == 2 ? 32 : 8));
  constexpr int ntiles = 128 * nN;
  const int G = gridDim.x;
  const int xcd = blockIdx.x & 7, lb = blockIdx.x >> 3, slots = G >> 3;
  f32x16 acc[4][2];
  int round = 0, t_extra = blockIdx.x, t_mem = G - 1 - (int)blockIdx.x;
  if (which == 0 && G == 256) {
    const int idx = (xcd >= 4) ? lb * 4 + (xcd - 4) : 1 << 20;
    t_extra = idx < 45 ? idx : 1 << 20;
    t_mem = (idx >= 45 && idx < 109) ? idx - 45 : 1 << 20;
  }
  bool main_done = false;
  for (;;) {
    int mt, n;
    if (!main_done) {
      const int q = lb + slots * round; ++round;
      const int L = 32 * (xcd + 8 * (q >> 5)) + (q & 31);
      if (L >= ntiles) { main_done = true; continue; }
      const int mg = L / (4 * nN), rem = L - mg * 4 * nN;
      n = rem >> 2; mt = mg * 4 + (rem & 3);
    } else {
      if (t_extra >= nN) break;
      mt = 128; n = t_extra; t_extra += G;
    }
    gemm_tile_run(p, lds, which, 0, mt, n, acc);
  }
  if (which == 0) {
    for (int t = t_mem; t < 64; t += G) gemm_tile_run(p, lds, 4, t >> 5, (t >> 3) & 3, t & 7, acc);
  }
}

template <bool DIFF>
DEVI void attn_block(LAS char* lds, const u16* Q, const u16* Kg, const u16* VT, int ldv, int j0, int ntiles, int nwact,
                           int qpos0, int nkeys, float slope2, float M2, float lam, const float* subg, u16* G) {
  const int tid = threadIdx.x, lane = tid & 63, w = tid >> 6, r = lane & 31, h = lane >> 5;
  const bool act = w < nwact;
  const int qpos = qpos0 + 32 * w + r;
  const int cw = (qpos0 + 32 * w) >> 6;
  bf16x8 qf[8];
#pragma unroll
  for (int i = 0; i < 8; ++i) qf[i] = ldg8(Q + (size_t)(32 * w + r) * 512 + 16 * i + 8 * h);
  f32x16 O0[4], O1[4];
#pragma unroll
  for (int e = 0; e < 4; ++e)
#pragma unroll
    for (int i = 0; i < 16; ++i) { O0[e][i] = 0.f; O1[e][i] = 0.f; }
  float l0 = 0.f, l1 = 0.f;
  f32x16 cinit, zero16;
#pragma unroll
  for (int i = 0; i < 16; ++i) { cinit[i] = slope2 * (float)klocal(i, h); zero16[i] = 0.f; }
  const float tq = -slope2 * (float)qpos - M2;
  const int prow = pi32(r);

  auto stage = [=](int j, int buf) __attribute__((always_inline)) {
    LAS char* kb = lds + buf * 32768;
#pragma unroll
    for (int i = 0; i < 4; ++i) {
      const int pch = i * 256 + tid;
      { const int row = pch >> 4, ph = pch & 15, lg = ph ^ (row & 15);
        glds16(Kg + (size_t)(j * 64 + row) * 512 + lg * 8, kb + pch * 16); }
      { const int row = pch >> 3, ph = pch & 7, lg = ph ^ ((row >> 1) & 7);
        glds16(VT + (size_t)row * ldv + j * 64 + lg * 8, kb + 16384 + pch * 16); }
    }
  };
  lds_barrier();
  stage(j0, 0);
  asm volatile("s_waitcnt vmcnt(0)" ::: "memory");
  __syncthreads();
  for (int j = j0; j < ntiles; ++j) {
    const int buf = (j - j0) & 1;
    if (j + 1 < ntiles) stage(j + 1, buf ^ 1);
    {
      const LAS char* kb = lds + buf * 32768;
      const LAS char* vb = kb + 16384;
      const bool fast = DIFF && (j < cw);
#pragma unroll
      for (int kt = 0; kt < 2; ++kt) {
        const int krow = 32 * kt + prow;
        const LAS char* krp = kb + krow * 256;
        bf16x8 P0[2], P1[2];
        if (DIFF) {
#pragma unroll
          for (int c = 0; c < 2; ++c) {
            f32x16 s;
            if (fast) {
              s = cinit;
#pragma unroll
              for (int ks = 0; ks < 4; ++ks) {
                const int ch = (2 * (4 * c + ks) + h) ^ (krow & 15);
                s = mfma32(*reinterpret_cast<const LAS bf16x8*>(krp + ch * 16), qf[4 * c + ks], s);
              }
              const float t = tq + slope2 * (float)(j * 64 + kt * 32);
#pragma unroll
              for (int i = 0; i < 16; ++i) s[i] = __builtin_amdgcn_exp2f(s[i] + t);
            } else {
              s = zero16;
#pragma unroll
              for (int ks = 0; ks < 4; ++ks) {
                const int ch = (2 * (4 * c + ks) + h) ^ (krow & 15);
                s = mfma32(*reinterpret_cast<const LAS bf16x8*>(krp + ch * 16), qf[4 * c + ks], s);
              }
#pragma unroll
              for (int i = 0; i < 16; ++i) {
                const int kp = j * 64 + kt * 32 + klocal(i, h);
                const float bias = -slope2 * fabsf((float)(qpos - kp)) - M2;
                s[i] = (kp < nkeys && j <= cw) ? __builtin_amdgcn_exp2f(s[i] + bias) : 0.f;
              }
            }
            float ls = 0.f;
#pragma unroll
            for (int i = 0; i < 16; ++i) ls += s[i];
            if (c == 0) { l0 += ls; P0[0] = pack8(s, 0); P0[1] = pack8(s, 1); }
            else        { l1 += ls; P1[0] = pack8(s, 0); P1[1] = pack8(s, 1); }
          }
        } else {
          f32x16 s = zero16;
#pragma unroll
          for (int ks = 0; ks < 8; ++ks) {
            const int ch = (2 * ks + h) ^ (krow & 15);
            s = mfma32(*reinterpret_cast<const LAS bf16x8*>(krp + ch * 16), qf[ks], s);
          }
          float ls = 0.f;
#pragma unroll
          for (int i = 0; i < 16; ++i) { s[i] = __builtin_amdgcn_exp2f(s[i] - M2); ls += s[i]; }
          l0 += ls; P0[0] = pack8(s, 0); P0[1] = pack8(s, 1);
        }
#pragma unroll
        for (int et = 0; et < 4; ++et) {
          const int vrow = 32 * et + r;
#pragma unroll
          for (int sp = 0; sp < 2; ++sp) {
            const int ch = (2 * (2 * kt + sp) + h) ^ ((vrow >> 1) & 7);
            const bf16x8 vf = *reinterpret_cast<const LAS bf16x8*>(vb + vrow * 128 + ch * 16);
            O0[et] = mfma32(vf, P0[sp], O0[et]);
            if (DIFF) O1[et] = mfma32(vf, P1[sp], O1[et]);
          }
        }
      }
    }
    asm volatile("s_waitcnt vmcnt(0)" ::: "memory");
    __syncthreads();
  }
  if (act) {
    l0 += __shfl_xor(l0, 32);
    const float i0 = 1.f / l0;
    float i1 = 0.f;
    if (DIFF) { l1 += __shfl_xor(l1, 32); i1 = lam / l1; }
    float ss = 0.f;
#pragma unroll
    for (int et = 0; et < 4; ++et)
#pragma unroll
      for (int i = 0; i < 16; ++i) {
        float o = O0[et][i] * i0;
        if (DIFF) o -= O1[et][i] * i1;
        O0[et][i] = o; ss += o * o;
      }
    float rs = 1.f;
    if (DIFF) { ss += __shfl_xor(ss, 32); rs = rsqrtf(ss * (1.f / 128.f) + EPS) * 0.8f; }
    u16* grow = G + (size_t)(32 * w + r) * 512;
    u32x2 gt[16]; float4 sv[16];
#pragma unroll
    for (int q = 0; q < 16; ++q) {
      const int e0 = 32 * (q >> 2) + 8 * (q & 3) + 4 * h;
      gt[q] = *reinterpret_cast<const u32x2*>(grow + e0);
      if (DIFF) sv[q] = *reinterpret_cast<const float4*>(subg + e0); else sv[q] = float4{1.f, 1.f, 1.f, 1.f};
    }
#pragma unroll
    for (int q = 0; q < 16; ++q) {
      const int et = q >> 2, g = q & 3;
      const int e0 = 32 * et + 8 * g + 4 * h;
      const float a0 = O0[et][4 * g + 0] * rs * sv[q].x * bflo(gt[q][0]);
      const float a1 = O0[et][4 * g + 1] * rs * sv[q].y * bfhi(gt[q][0]);
      const float a2 = O0[et][4 * g + 2] * rs * sv[q].z * bflo(gt[q][1]);
      const float a3 = O0[et][4 * g + 3] * rs * sv[q].w * bfhi(gt[q][1]);
      u32x2 o = {cvtpk(a0, a1), cvtpk(a2, a3)};
      *reinterpret_cast<u32x2*>(grow + e0) = o;
    }
  }
}

DEVI float max_abs64(const float* g, int n, int lane) { float v = 0.f; for (int i = lane; i < n; i += 64) v = fmaxf(v, fabsf(g[i])); return wmax(v); }

DEVI float scan_add(float v, int lane) { for (int o = 1; o < 64; o <<= 1) { const float t = __shfl_up(v, o); if (lane >= o) v += t; } return v; }
DEVI float scan_max(float v, int lane) { for (int o = 1; o < 64; o <<= 1) { const float t = __shfl_up(v, o); if (lane >= o) v = fmaxf(v, t); } return v; }
DEVI float bfe(const bf16x8& v, int j) { return __uint_as_float(((unsigned)(u16)v[j]) << 16); }

template <int NT>
DEVI void mlstm_local(LAS char* lds, const float* gates, int hd, const u16* KT, const u16* VT, int ldt,
                            f32x16 (&acc)[4], float& nh, float& bL, float& amax) {
  const int tid = threadIdx.x, lane = tid & 63, w = tid >> 6, r = lane & 31, h = lane >> 5;
  constexpr int L = 32 * NT;
  const float lf = lane < L ? gates[lane * 8 + 4 + hd] : 0.f;
  const float ig = lane < L ? gates[lane * 8 + hd] : -INFINITY;
  const float b = scan_add(lf, lane);
  const float a = ig - b;
  amax = wmax(a);
  bL = __shfl(b, L - 1);
  LAS float* wt = (LAS float*)(lds + 4096) + w * 64;
  wt[lane] = __expf(a - amax);
#pragma unroll
  for (int e = 0; e < 4; ++e)
#pragma unroll
    for (int i = 0; i < 16; ++i) acc[e][i] = 0.f;
  nh = 0.f;
  bf16x8 kfa[2 * NT], vfa[2 * NT][4];
#pragma unroll
  for (int ks = 0; ks < 2 * NT; ++ks) {
    kfa[ks] = ldg8(KT + (size_t)(32 * w + r) * ldt + 16 * ks + 8 * h);
#pragma unroll
    for (int et = 0; et < 4; ++et) vfa[ks][et] = ldg8(VT + (size_t)(32 * et + r) * ldt + 16 * ks + 8 * h);
  }
#pragma unroll
  for (int ks = 0; ks < 2 * NT; ++ks) {
    const bf16x8 kf = kfa[ks];
    float wv[8];
#pragma unroll
    for (int j = 0; j < 8; ++j) { wv[j] = wt[16 * ks + 8 * h + j]; nh += bfe(kf, j) * wv[j]; }
#pragma unroll
    for (int et = 0; et < 4; ++et) {
      const bf16x8 vf = vfa[ks][et];
      u32x4 sv = {cvtpk(bfe(vf, 0) * wv[0], bfe(vf, 1) * wv[1]), cvtpk(bfe(vf, 2) * wv[2], bfe(vf, 3) * wv[3]),
                  cvtpk(bfe(vf, 4) * wv[4], bfe(vf, 5) * wv[5]), cvtpk(bfe(vf, 6) * wv[6], bfe(vf, 7) * wv[7])};
      acc[et] = mfma32(kf, *reinterpret_cast<bf16x8*>(&sv), acc[et]);
    }
  }
  nh += __shfl_xor(nh, 32);
}

template <int NT>
DEVI void mlstm_out(LAS char* lds, const float* gates, int hd, const u16* Qg, const u16* Kg, const u16* VT, int ldv,
                          const u16* CT, const float* n0, float m0, const float* mg, u16* G) {
  const int tid = threadIdx.x, lane = tid & 63, w = tid >> 6, r = lane & 31, h = lane >> 5;
  constexpr int L = 32 * NT;
  const float lf = lane < L ? gates[lane * 8 + 4 + hd] : 0.f;
  const float ig = lane < L ? gates[lane * 8 + hd] : -INFINITY;
  const float b = scan_add(lf, lane);
  const float a = ig - b;
  const float Mrow = fmaxf(m0, scan_max(a, lane));
  const float mt = b + Mrow;
  LAS float* at = (LAS float*)lds + w * 64;
  LAS float* red = (LAS float*)(lds + 1024);
  at[lane] = a;
  const int prow = pi32(r);
#pragma unroll 1
  for (int tt = 0; tt < NT; ++tt) {
    const int t = 32 * tt + r;
    const float Mrow_t = __shfl(Mrow, t), mt_t = __shfl(mt, t);
    const float winter = __expf(m0 - Mrow_t);
    bf16x8 qf[8], cfa[8], kfa[NT][8], vfa[NT][2];
    float4 na[8], nb[8];
#pragma unroll
    for (int i = 0; i < 8; ++i) {
      qf[i] = ldg8(Qg + (size_t)t * 512 + 16 * i + 8 * h);
      na[i] = *reinterpret_cast<const float4*>(n0 + 16 * i + 8 * h); nb[i] = *reinterpret_cast<const float4*>(n0 + 16 * i + 8 * h + 4);
      cfa[i] = ldg8(CT + (size_t)(32 * w + r) * 128 + 16 * i + 8 * h);
    }
#pragma unroll
    for (int st = 0; st < NT; ++st) {
      const int sc = st <= tt ? st : tt;
#pragma unroll
      for (int ks = 0; ks < 8; ++ks) kfa[st][ks] = ldg8(Kg + (size_t)(32 * sc + prow) * 512 + 16 * ks + 8 * h);
#pragma unroll
      for (int sp = 0; sp < 2; ++sp) vfa[st][sp] = ldg8(VT + (size_t)(32 * w + r) * ldv + 32 * sc + 16 * sp + 8 * h);
    }
    float qn = 0.f;
#pragma unroll
    for (int i = 0; i < 8; ++i) {
      qn += bfe(qf[i], 0) * na[i].x + bfe(qf[i], 1) * na[i].y + bfe(qf[i], 2) * na[i].z + bfe(qf[i], 3) * na[i].w
          + bfe(qf[i], 4) * nb[i].x + bfe(qf[i], 5) * nb[i].y + bfe(qf[i], 6) * nb[i].z + bfe(qf[i], 7) * nb[i].w;
    }
    qn += __shfl_xor(qn, 32);
    f32x16 H;
#pragma unroll
    for (int i = 0; i < 16; ++i) H[i] = 0.f;
#pragma unroll
    for (int ks = 0; ks < 8; ++ks) H = mfma32(cfa[ks], qf[ks], H);
#pragma unroll
    for (int i = 0; i < 16; ++i) H[i] *= winter;
    float dsum = 0.f;
#pragma unroll
    for (int st = 0; st < NT; ++st) {
      if (st <= tt) {
        f32x16 S;
#pragma unroll
        for (int i = 0; i < 16; ++i) S[i] = 0.f;
#pragma unroll
        for (int ks = 0; ks < 8; ++ks) S = mfma32(kfa[st][ks], qf[ks], S);
#pragma unroll
        for (int i = 0; i < 16; ++i) {
          const int s_ = 32 * st + klocal(i, h);
          const float wg = (s_ <= t) ? __expf(at[s_] - Mrow_t) : 0.f;
          S[i] *= wg; dsum += S[i];
        }
#pragma unroll
        for (int sp = 0; sp < 2; ++sp) H = mfma32(vfa[st][sp], pack8(S, sp), H);
      }
    }
    dsum += __shfl_xor(dsum, 32);
    const float den = winter * qn + dsum;
    const float inv = 1.f / fmaxf(fabsf(den), __expf(-mt_t));
    float ss = 0.f;
#pragma unroll
    for (int i = 0; i < 16; ++i) { H[i] *= inv; ss += H[i] * H[i]; }
    ss += __shfl_xor(ss, 32);
    if (h == 0) red[w * 64 + t] = ss;
    lds_barrier();
    const float tot = red[t] + red[64 + t] + red[128 + t] + red[192 + t];
    const float rs = rsqrtf(tot * (1.f / 128.f) + EPS);
    u16* grow = G + (size_t)t * 512;
    u32x2 gt[4]; float4 mv[4];
#pragma unroll
    for (int g = 0; g < 4; ++g) {
      const int e0 = 32 * w + 8 * g + 4 * h;
      gt[g] = *reinterpret_cast<const u32x2*>(grow + e0);
      mv[g] = *reinterpret_cast<const float4*>(mg + e0);
    }
#pragma unroll
    for (int g = 0; g < 4; ++g) {
      const int e0 = 32 * w + 8 * g + 4 * h;
      u32x2 o = {cvtpk(H[4 * g + 0] * rs * mv[g].x * bflo(gt[g][0]), H[4 * g + 1] * rs * mv[g].y * bfhi(gt[g][0])),
                 cvtpk(H[4 * g + 2] * rs * mv[g].z * bflo(gt[g][1]), H[4 * g + 3] * rs * mv[g].w * bfhi(gt[g][1]))};
      *reinterpret_cast<u32x2*>(grow + e0) = o;
    }
    lds_barrier();
  }
}

DEVI void m1_item(const Params& p, LAS char* lds, int item) {
  const int tid = threadIdx.x, lane = tid & 63, w = tid >> 6, r = lane & 31, h = lane >> 5;
  const int bh = item >> 7, c = item & 127, b = bh >> 2, hd = bh & 3;
  const size_t row0 = (size_t)b * SEQ + c * 64;
  f32x16 acc[4]; float nh, bL, amax;
  lds_barrier();
  mlstm_local<2>(lds, p.gates + row0 * 8, hd, p.KaT + (size_t)bh * 128 * SEQ + c * 64, p.VaT + (size_t)bh * 128 * SEQ + c * 64, SEQ, acc, nh, bL, amax);
  u16* Chat = p.xb + ((size_t)item * 128) * 128;
#pragma unroll
  for (int et = 0; et < 4; ++et)
#pragma unroll
    for (int g = 0; g < 4; ++g) {
      const int d0 = 32 * w + 8 * g + 4 * h, e = 32 * et + r;
      u32x2 o = {cvtpk(acc[et][4 * g], acc[et][4 * g + 1]), cvtpk(acc[et][4 * g + 2], acc[et][4 * g + 3])};
      *reinterpret_cast<u32x2*>(Chat + (size_t)e * 128 + d0) = o;
    }
  if (h == 0) p.nhat[(size_t)item * 128 + 32 * w + r] = nh;
  if (tid == 0) { p.tabA[item] = bL; p.tabB[item] = bL + amax; }
}

DEVI void phase_scan(const Params& p, LAS char* lds) {
  const int tid = threadIdx.x, lane = tid & 63;
  LAS float* al = (LAS float*)lds; LAS float* be = al + 128; LAS float* ms = al + 256;
  for (int u = blockIdx.x; u < 16 * 32; u += gridDim.x) {
    const int bh = u >> 5, part = u & 31;
    __syncthreads();
    if (tid < 64) {
      const float A0 = p.tabA[bh * 128 + 2 * lane], A1 = p.tabA[bh * 128 + 2 * lane + 1];
      const float B0 = p.tabB[bh * 128 + 2 * lane], B1 = p.tabB[bh * 128 + 2 * lane + 1];
      const float SAi = scan_add(A0 + A1, lane);
      const float SA0 = SAi - A1, SA1 = SAi;
      const float D0 = B0 - SA0, D1 = B1 - SA1;
      const float PMi = scan_max(fmaxf(D0, D1), lane);
      float PMx = __shfl_up(PMi, 1); if (lane == 0) PMx = -INFINITY;
      const float mn0 = SA0 + fmaxf(0.f, fmaxf(PMx, D0));
      const float mn1 = SA1 + fmaxf(0.f, PMi);
      float mprev = __shfl_up(mn1, 1); if (lane == 0) mprev = 0.f;
      al[2 * lane] = __expf(A0 + mprev - mn0); be[2 * lane] = __expf(B0 - mn0);
      al[2 * lane + 1] = __expf(A1 + mn0 - mn1); be[2 * lane + 1] = __expf(B1 - mn1);
      ms[2 * lane] = mprev; ms[2 * lane + 1] = mn0;
      if (lane == 63) ms[128] = mn1;
    }
    __syncthreads();
    if (part == 0) {
      if (tid < 129) p.mtab[bh * 129 + tid] = ms[tid];
      if (tid == 0) p.out[O_PM + bh] = ms[128];
    }
    u16* base = p.xb + (size_t)bh * 128 * 16384 + part * 512 + tid * 2;
    float c0 = 0.f, c1 = 0.f;
    for (int c = 0; c < 128; c += 8) {
      unsigned v[8];
#pragma unroll
      for (int j = 0; j < 8; ++j) v[j] = *reinterpret_cast<const unsigned*>(base + (size_t)(c + j) * 16384);
#pragma unroll
      for (int j = 0; j < 8; ++j) {
        *reinterpret_cast<unsigned*>(base + (size_t)(c + j) * 16384) = cvtpk(c0, c1);
        const float a_ = al[c + j], b_ = be[c + j];
        c0 = a_ * c0 + b_ * bflo(v[j]); c1 = a_ * c1 + b_ * bfhi(v[j]);
      }
    }
    { const int idx = part * 512 + tid * 2, e = idx >> 7, d = idx & 127;
      p.out[O_PC + ((size_t)bh * 128 + d) * 128 + e] = c0;
      p.out[O_PC + ((size_t)bh * 128 + d + 1) * 128 + e] = c1; }
    if (part == 0 && tid < 128) {
      float n = 0.f;
      for (int c = 0; c < 128; c += 16) {
        float nv[16];
#pragma unroll
        for (int j = 0; j < 16; ++j) nv[j] = p.nhat[((size_t)bh * 128 + c + j) * 128 + tid];
#pragma unroll
        for (int j = 0; j < 16; ++j) {
          p.nstate[((size_t)bh * 128 + c + j) * 128 + tid] = n;
          n = al[c + j] * n + be[c + j] * nv[j];
        }
      }
      p.out[O_PN + bh * 128 + tid] = n;
    }
  }
}

DEVI void m3_item(const Params& p, LAS char* lds, int item) {
  const int bh = item >> 7, c = item & 127, b = bh >> 2, hd = bh & 3;
  const size_t row0 = (size_t)b * SEQ + c * 64;
  lds_barrier();
  mlstm_out<2>(lds, p.gates + row0 * 8, hd, p.Qa + row0 * 512 + hd * 128, p.Ka + row0 * 512 + hd * 128,
               p.VaT + (size_t)bh * 128 * SEQ + c * 64, SEQ, p.xb + (size_t)item * 16384, p.nstate + (size_t)item * 128,
               p.mtab[bh * 129 + c], p.in[15] + hd * 128, p.Ga + row0 * 512 + hd * 128);
}

DEVI void ms_item(const Params& p, LAS char* lds, int bh) {
  const int tid = threadIdx.x, lane = tid & 63, w = tid >> 6, r = lane & 31, h = lane >> 5;
  const int b = bh >> 2, hd = bh & 3;
  const size_t row0 = (size_t)NTOKP + b * 32;
  const float m0 = p.in[9][bh];
  const float* n0 = p.in[8] + bh * 128;
  const u16* KTs = p.KaT + (size_t)NTOKP * 512 + (size_t)bh * 128 * 32;
  const u16* VTs = p.VaT + (size_t)NTOKP * 512 + (size_t)bh * 128 * 32;
  lds_barrier();
  mlstm_out<1>(lds, p.gates + row0 * 8, hd, p.Qa + row0 * 512 + hd * 128, p.Ka + row0 * 512 + hd * 128, VTs, 32,
               p.C0sT + (size_t)bh * 16384, n0, m0, p.in[15] + hd * 128, p.Ga + row0 * 512 + hd * 128);
  f32x16 acc[4]; float nh, bL, amax;
  mlstm_local<1>(lds, p.gates + row0 * 8, hd, KTs, VTs, 32, acc, nh, bL, amax);
  const float mlast = bL + fmaxf(m0, amax);
  const float decay = __expf(bL + m0 - mlast), beta = __expf(bL + amax - mlast);
#pragma unroll
  for (int et = 0; et < 4; ++et)
#pragma unroll
    for (int i = 0; i < 16; ++i) {
      const int d = 32 * w + crow(i, h), e = 32 * et + r;
      const size_t o = ((size_t)bh * 128 + d) * 128 + e;
      p.out[O_SC + o] = decay * p.in[7][o] + beta * acc[et][i];
    }
  if (h == 0) { const int d = 32 * w + r; p.out[O_SN + bh * 128 + d] = decay * n0[d] + beta * nh; }
  if (tid == 0) p.out[O_SM + bh] = mlast;
}

DEVI void phase_conv(const Params& p, LAS char* lds) {
  const int tid = threadIdx.x, lane = tid & 63, w = tid >> 6;
  const u16* U = p.Qa; u16* Gc = p.KaT;
  LAS u16* win = (LAS u16*)lds;
  LAS float* cs = (LAS float*)(lds + 40960);
  LAS float* st = (LAS float*)(lds + 40960 + 32768);
  float cw[4][31], cb[4], lg[4], lb[4];
#pragma unroll
  for (int c = 0; c < 4; ++c) {
    const int chn = c * 256 + tid;
#pragma unroll
    for (int j = 0; j < 31; ++j) cw[c][j] = p.in[25][j * 1024 + chn];
    cb[c] = p.in[26][chn]; lg[c] = p.in[27][chn]; lb[c] = p.in[28][chn];
  }
  const int ntile = NTOK / 8;
  auto fetch = [=](int tile, int cgp, u32x4 (&rg)[5]) __attribute__((always_inline)) {
    const int row0 = tile * 8;
    const bool samp = row0 >= NTOKP;
    const int t0 = samp ? ((row0 - NTOKP) & 31) : (row0 & 8191);
    const int bs = samp ? ((row0 - NTOKP) >> 5) : 0;
    const int seqbase = row0 - t0;
#pragma unroll
    for (int q = 0; q < 5; ++q) {
      const int pch = tid + 256 * q, rr = pch >> 5, ch = pch & 31, t = t0 - 30 + rr;
      u32x4 v = {0, 0, 0, 0};
      if (pch < 38 * 32) {
        if (t >= 0) v = *reinterpret_cast<const u32x4*>(U + (size_t)(seqbase + t) * 1024 + cgp * 256 + ch * 8);
        else if (samp) {
          const float4* sc = reinterpret_cast<const float4*>(p.in[10] + ((size_t)(bs * 30 + 30 + t)) * 1024 + cgp * 256 + ch * 8);
          const float4 a = sc[0], c = sc[1];
          v = u32x4{cvtpk(a.x, a.y), cvtpk(a.z, a.w), cvtpk(c.x, c.y), cvtpk(c.z, c.w)};
        }
      }
      rg[q] = v;
    }
  };
  auto commit = [=](int buf, const u32x4 (&rg)[5]) __attribute__((always_inline)) {
#pragma unroll
    for (int q = 0; q < 5; ++q) {
      const int pch = tid + 256 * q;
      if (pch < 38 * 32) *reinterpret_cast<LAS u32x4*>(win + buf * (38 * 256) + (pch >> 5) * 256 + (pch & 31) * 8) = rg[q];
    }
  };
  int tile = blockIdx.x;
  if (tile >= ntile) return;
  u32x4 rg[5];
  __syncthreads();
  fetch(tile, 0, rg);
  commit(0, rg);
  __syncthreads();
  for (; tile < ntile; tile += gridDim.x) {
    const int row0 = tile * 8;
    const int ntl = tile + gridDim.x;
#pragma unroll
    for (int cgp = 0; cgp < 4; ++cgp) {
      const bool more = (cgp < 3) || (ntl < ntile);
      if (more) fetch(cgp < 3 ? tile : ntl, cgp < 3 ? cgp + 1 : 0, rg);
      const LAS u16* wb = win + (cgp & 1) * (38 * 256);
      float wv[38];
#pragma unroll
      for (int rr = 0; rr < 38; ++rr) wv[rr] = bf2f(wb[rr * 256 + tid]);
#pragma unroll
      for (int i = 0; i < 8; ++i) {
        float a = cb[cgp];
#pragma unroll
        for (int j = 0; j < 31; ++j) a += cw[cgp][j] * wv[i + j];
        cs[i * 1024 + cgp * 256 + tid] = a;
      }
      if (more) commit((cgp + 1) & 1, rg);
      lds_barrier();
    }
    u16 gv[4][8];
#pragma unroll
    for (int c = 0; c < 4; ++c)
#pragma unroll
      for (int i = 0; i < 8; ++i) gv[c][i] = Gc[(size_t)(row0 + i) * 1024 + c * 256 + tid];
#pragma unroll
    for (int q = 0; q < 2; ++q) {
      const int i = 2 * w + q;
      float a1 = 0.f, a2 = 0.f;
#pragma unroll
      for (int k = 0; k < 16; ++k) { const float v = cs[i * 1024 + lane + 64 * k]; a1 += v; a2 += v * v; }
      a1 = wsum(a1); a2 = wsum(a2);
      if (lane == 0) {
        const float mu = a1 * (1.f / 1024.f);
        const float var = fmaxf(a2 * (1.f / 1024.f) - mu * mu, 0.f);
        st[2 * i] = mu; st[2 * i + 1] = rsqrtf(var + EPS);
      }
    }
    lds_barrier();
#pragma unroll
    for (int c = 0; c < 4; ++c) {
      const int chn = c * 256 + tid;
#pragma unroll
      for (int i = 0; i < 8; ++i) {
        const float y = (cs[i * 1024 + chn] - st[2 * i]) * st[2 * i + 1] * lg[c] + lb[c];
        Gc[(size_t)(row0 + i) * 1024 + chn] = f2bf(siluf_(y) * bf2f(gv[c][i]));
      }
    }
    lds_barrier();
  }
}

struct AttnConst { float M2d, M2x, lam; };
DEVI AttnConst attn_consts(const Params& p, int layer) {
  const int lane = threadIdx.x & 63;
  AttnConst c;
  const float gq = max_abs64(p.in[16], 64, lane), gk = max_abs64(p.in[17], 64, lane);
  float kd = 0.f, kx = 0.f;
  for (int i = lane; i < (int)gridDim.x * 4; i += 64) { kd = fmaxf(kd, p.kmaxp[i]); kx = fmaxf(kx, p.kmaxp[1024 * (1 + layer) + i]); }
  kd = wmax(kd); kx = wmax(kx);
  c.M2d = (8.f * gq * 0.125f * LOG2E) * fmaxf(8.f * gk, sqrtf(kd)) * 1.01f;
  const float xq = max_abs64(p.in[32] + layer * 128, 128, lane), xk = max_abs64(p.in[33] + layer * 128, 128, lane);
  c.M2x = (11.313708f * xq * 0.08838834764831845f * LOG2E) * fmaxf(11.313708f * xk, sqrtf(kx)) * 1.01f;
  float d1 = p.in[18][lane] * p.in[19][lane], d2 = p.in[20][lane] * p.in[21][lane];
  d1 = wsum(d1); d2 = wsum(d2);
  c.lam = __expf(d1) - __expf(d2) + 0.2f;
  return c;
}

DEVI void cross_item(const Params& p, LAS char* lds, int layer, int it, float M2x) {
  const int hd = it & 3;
  size_t row0; int mb, nw;
  if (it < 1024) { const int rb = it >> 2; row0 = (size_t)rb * 128; mb = rb >> 6; nw = 4; }
  else { const int bs = (it - 1024) >> 2; row0 = (size_t)NTOKP + bs * 32; mb = 4 + bs; nw = 1; }
  attn_block<false>(lds, p.Qx + row0 * 512 + hd * 128, p.XK + ((size_t)(layer * 12 + mb) * 256) * 512 + hd * 128,
                    p.XVT + ((size_t)((layer * 12 + mb) * 4 + hd) * 128) * 256, 256, 0, 4, nw, 0, 256, 0.f, M2x, 0.f, nullptr,
                    p.Gx + row0 * 512 + hd * 128);
}

DEVI void diff_item(const Params& p, LAS char* lds, int it, float M2d, float lam) {
  const bool pr = it < 1024;
  const int hd = pr ? 3 - (it >> 8) : (it - 1024) & 3;
  const int qb = pr ? 63 - ((it >> 2) & 63) : 0;
  const int b = pr ? (it & 3) : (it - 1024) >> 2;
  const int bh = b * 4 + hd;
  const size_t row0 = pr ? (size_t)b * SEQ + qb * 128 : (size_t)NTOKP + b * 32;
  const float slope2 = exp2f(-2.f * (hd + 1)) * LOG2E;
  const u16* Kp = pr ? p.Kb + (size_t)b * SEQ * 512 + hd * 128 : p.Ks + (size_t)b * SKP * 512 + hd * 128;
  const u16* Vp = pr ? p.VbT + (size_t)bh * 128 * SEQ : p.VsT + (size_t)bh * 128 * SKP;
  const int qpos0 = pr ? qb * 128 : PAST;
  const float kcut = (float)qpos0 - (2.f * M2d + 64.f) / slope2;
  int j0 = (int)floorf((kcut - 63.f) * (1.f / 64.f));
  j0 = max(j0, 0);
  attn_block<true>(lds, p.Qb + row0 * 512 + hd * 128, Kp, Vp, pr ? SEQ : SKP, j0, pr ? 2 * qb + 2 : 33, pr ? 4 : 1,
                   qpos0, pr ? SEQ : PAST + 32, slope2, M2d, lam, p.in[22], p.Gb + row0 * 512 + hd * 128);
}

constexpr int NPHASE = 9;
DEVI void run_phase(const Params& p, LAS char* lds, int ph) {
  const int G = gridDim.x, g = blockIdx.x;
  switch (ph) {
    case 0: phase_prep(p); break;
    case 1: phase_gemm<0>(p, lds); break;
    case 2: {
      const AttnConst c = attn_consts(p, 0);
      for (int it = g; it < 1056; it += G) cross_item(p, lds, 0, it, c.M2x);
      for (int it = g; it < 2048; it += G) m1_item(p, lds, it);
    } break;
    case 3: {
      const AttnConst c = attn_consts(p, 0);
      (void)c;
      phase_scan(p, lds);
    } break;
    case 4: {
      const AttnConst c = attn_consts(p, 0);
      unsigned* qhead = reinterpret_cast<unsigned*>(p.kmaxp + 3 * 1024) + 16;
      volatile LAS int* slot = (volatile LAS int*)(lds + LDS_BYTES - 16);
      for (;;) {
        lds_barrier();
        if (threadIdx.x == 0) *slot = (int)__hip_atomic_fetch_add(qhead, 1u, __ATOMIC_RELAXED, __HIP_MEMORY_SCOPE_AGENT);
        lds_barrier();
        const int it = *slot;
        if (it >= 1056) break;
        diff_item(p, lds, it, c.M2d, c.lam);
      }
      for (;;) {
        lds_barrier();
        if (threadIdx.x == 0) *slot = (int)__hip_atomic_fetch_add(qhead + 16, 1u, __ATOMIC_RELAXED, __HIP_MEMORY_SCOPE_AGENT);
        lds_barrier();
        const int it = *slot;
        if (it >= 2048) break;
        m3_item(p, lds, it);
      }
      for (int it = G - 1 - g; it < 32; it += G) ms_item(p, lds, it);
    } break;
    case 5: phase_gemm<1>(p, lds); break;
    case 6: phase_gemm<2>(p, lds); break;
    case 7: {
      const AttnConst c = attn_consts(p, 1);
      phase_conv(p, lds);
      for (int it = g; it < 1056; it += G) cross_item(p, lds, 1, it, c.M2x);
    } break;
    case 8: phase_gemm<3>(p, lds); break;
  }
}

DEVI void grid_bar(unsigned* ctr, unsigned& epoch) {
  asm volatile("s_waitcnt vmcnt(0)" ::: "memory");
  __syncthreads();
  if (threadIdx.x == 0) {
    __builtin_amdgcn_fence(__ATOMIC_RELEASE, "agent");
    asm volatile("s_waitcnt vmcnt(0)" ::: "memory");
    __hip_atomic_fetch_add(ctr, 1u, __ATOMIC_RELAXED, __HIP_MEMORY_SCOPE_AGENT);
    epoch += 1u;
    const unsigned target = epoch * gridDim.x;
    while (__hip_atomic_load(ctr, __ATOMIC_RELAXED, __HIP_MEMORY_SCOPE_AGENT) < target) __builtin_amdgcn_s_sleep(1);
    __builtin_amdgcn_fence(__ATOMIC_ACQUIRE, "agent");
    asm volatile("s_waitcnt vmcnt(0)" ::: "memory");
  }
  __syncthreads();
}

__global__ void __launch_bounds__(256, 1) mega(Params p, int ph_lo, int ph_hi) {
  extern __shared__ __attribute__((aligned(16))) char smem[];
  LAS char* lds = (LAS char*)smem;
  cg::grid_group grid = cg::this_grid();
  unsigned epoch = 0;
  unsigned* ctr = reinterpret_cast<unsigned*>(p.kmaxp + 3 * 1024);
#define RUNPH(k) if (ph_lo <= (k) && (k) < ph_hi) { if ((k) > ph_lo) { if ((k) == 1) grid.sync(); else grid_bar(ctr, epoch); } run_phase(p, lds, (k)); }
  RUNPH(0) RUNPH(1) RUNPH(2) RUNPH(3) RUNPH(4) RUNPH(5) RUNPH(6) RUNPH(7) RUNPH(8)
#undef RUNPH
}

#ifndef MULTI_LAUNCH
#define MULTI_LAUNCH 0
#endif

extern "C" void kernel_launch(void* const* d_in, const int* in_sizes, int n_in, void* d_out, int out_size, void* d_ws, size_t ws_size,
                              hipStream_t stream) {
  static int grid_blocks = 0;
  if (!grid_blocks) {
    int dev = 0, cus = 0, per_cu = 0;
    hipGetDevice(&dev);
    hipDeviceGetAttribute(&cus, hipDeviceAttributeMultiprocessorCount, dev);
    hipFuncSetAttribute((const void*)mega, hipFuncAttributeMaxDynamicSharedMemorySize, LDS_BYTES);
    hipOccupancyMaxActiveBlocksPerMultiprocessor(&per_cu, (const void*)mega, 256, LDS_BYTES);
    if (per_cu < 1) per_cu = 1;
    if (per_cu > 1) per_cu = 1;
    grid_blocks = (cus * per_cu) & ~7;
    if (grid_blocks < 8) grid_blocks = 8;
  }
  Params p{};
  for (int i = 0; i < 34; ++i) p.in[i] = (const float*)d_in[i];
  p.out = (float*)d_out;
  char* ws = (char*)d_ws;
  size_t off = 0;
  auto take = [&](size_t bytes) { char* q = ws + off; off += (bytes + 255) & ~(size_t)255; return q; };
  p.WtInA = (u16*)take((size_t)NPAD_A * 1024 * 2);
  p.WtOutA = (u16*)take((size_t)1024 * 1536 * 2);
  p.WtInC = (u16*)take((size_t)4096 * 1024 * 2);
  p.WtOutC = (u16*)take((size_t)1024 * 1536 * 2);
  p.WtMem = (u16*)take((size_t)2 * 1024 * 1024 * 2);
  p.xb = (u16*)take((size_t)NTOK * 1024 * 2);
  p.memb = (u16*)take((size_t)1024 * 1024 * 2);
  u16* segs = (u16*)take(SEG * 2 * 11);
  p.Qa = segs; p.Ka = segs + SEG; p.KaT = segs + 2 * SEG; p.VaT = segs + 3 * SEG; p.Ga = segs + 4 * SEG; p.Qb = segs + 5 * SEG;
  p.Kb = segs + 6 * SEG; p.VbT = segs + 7 * SEG; p.Gb = segs + 8 * SEG; p.Qx = segs + 9 * SEG; p.Gx = segs + 10 * SEG;
  p.Ks = (u16*)take((size_t)8 * SKP * 512 * 2);
  p.VsT = (u16*)take((size_t)4096 * SKP * 2);
  p.XK = (u16*)take((size_t)2 * 12 * 256 * 512 * 2);
  p.XVT = (u16*)take((size_t)2 * 12 * 256 * 512 * 2);
  p.C0sT = (u16*)take((size_t)32 * 16384 * 2);
  p.rs0 = (float*)take((size_t)NTOK * 4);
  p.ssq1 = (float*)take((size_t)NTOK * 4);
  p.rsmem = (float*)take((size_t)(1024 + 64) * 4);
  p.gates = (float*)take((size_t)NTOK * 8 * 4);
  p.tabA = (float*)take(2048 * 4);
  p.tabB = (float*)take(2048 * 4);
  p.mtab = (float*)take(16 * 129 * 4);
  p.nhat = (float*)take((size_t)2048 * 128 * 4);
  p.nstate = (float*)take((size_t)2048 * 128 * 4);
  p.kmaxp = (float*)take((size_t)3 * 1024 * 4 + 256);
  if (off > ws_size) { fprintf(stderr, "workspace too small: need %zu have %zu\n", off, ws_size); return; }
  (void)hipMemsetAsync(p.kmaxp + 3 * 1024, 0, 256, stream);
#if MULTI_LAUNCH
  for (int ph = 0; ph < NPHASE; ++ph) {
    hipLaunchKernelGGL(mega, dim3(grid_blocks), dim3(256), LDS_BYTES, stream, p, ph, ph + 1);
  }
#else
  int lo = 0, hi = NPHASE;
  void* args[] = {&p, &lo, &hi};
  hipError_t e = hipLaunchCooperativeKernel((const void*)mega, dim3(grid_blocks), dim3(256), args, LDS_BYTES, stream);
  if (e != hipSuccess) fprintf(stderr, "cooperative launch failed: %s (grid %d)\n", hipGetErrorString(e), grid_blocks);
#endif
}
```

```cpp
#include <hip/hip_runtime.h>
#include <hip/hip_cooperative_groups.h>
#include <stdint.h>
#include <stdio.h>
namespace cg = cooperative_groups;

typedef unsigned short u16;
using bf16x8 = __attribute__((ext_vector_type(8))) short;
using f32x4  = __attribute__((ext_vector_type(4))) float;
using f32x16 = __attribute__((ext_vector_type(16))) float;
using u32x4  = __attribute__((ext_vector_type(4))) unsigned;
using u32x2  = __attribute__((ext_vector_type(2))) unsigned;
#define LAS __attribute__((address_space(3)))
#define DEVI __device__ __forceinline__

constexpr int NTOKP = 32768, NTOKS = 256, NTOK = 33024;
constexpr int SEQ = 8192, LSAMP = 32, PAST = 2048, SKP = 2112;
constexpr size_t SEG = (size_t)NTOK * 512;
constexpr int NPAD_A = 5760;
constexpr float EPS = 1e-6f;
constexpr float LOG2E = 1.4426950408889634f;
constexpr size_t O_YP = 0, O_PXK = 33816576, O_PXV = 34865152, O_PK = 35913728, O_PV = 52690944,
  O_PC = 69468160, O_PN = 69730304, O_PM = 69732352, O_PCONV = 69732368, O_SK = 69855248, O_SV = 69986320,
  O_SC = 70117392, O_SN = 70641680, O_SM = 70645776, O_SCONV = 70645808;

constexpr int LDS_BYTES = 147456;

struct Params {
  const float* in[34];
  float* out;
  u16 *WtInA, *WtOutA, *WtInC, *WtOutC, *WtMem;
  u16 *xb, *memb;
  u16 *Qa, *Ka, *KaT, *VaT, *Ga, *Qb, *Kb, *VbT, *Gb, *Qx, *Gx;
  u16 *Ks, *VsT, *XK, *XVT, *C0sT;
  float *rs0, *ssq1, *rsmem, *gates, *tabA, *tabB, *mtab, *nhat, *nstate, *kmaxp;
};

DEVI unsigned cvtpk(float lo, float hi) { unsigned r; asm volatile("v_cvt_pk_bf16_f32 %0, %1, %2" : "=v"(r) : "v"(lo), "v"(hi)); return r; }
DEVI float bflo(unsigned u) { return __uint_as_float(u << 16); }
DEVI float bfhi(unsigned u) { return __uint_as_float(u & 0xffff0000u); }
DEVI float bf2f(u16 h) { return __uint_as_float(((unsigned)h) << 16); }
DEVI u16 f2bf(float f) { return (u16)(cvtpk(f, 0.f) & 0xffffu); }
DEVI float sigmoidf_(float x) { return 1.f / (1.f + __expf(-x)); }
DEVI float siluf_(float x) { return x / (1.f + __expf(-x)); }
DEVI float logsigmoidf_(float x) { return fminf(x, 0.f) - log1pf(__expf(-fabsf(x))); }
DEVI float wsum(float v) { for (int o = 32; o; o >>= 1) v += __shfl_xor(v, o); return v; }
DEVI float wmax(float v) { for (int o = 32; o; o >>= 1) v = fmaxf(v, __shfl_xor(v, o)); return v; }
DEVI int pi32(int r) { return (r & ~12) | ((r & 4) << 1) | ((r & 8) >> 1); }
DEVI int klocal(int reg, int h) { return (reg & 3) + 4 * ((reg >> 2) & 1) + 8 * h + 16 * (reg >> 3); }
DEVI int crow(int reg, int h) { return (reg & 3) + 8 * (reg >> 2) + 4 * h; }
DEVI bf16x8 ldg8(const u16* p) { return *reinterpret_cast<const bf16x8*>(p); }
DEVI f32x16 mfma32(bf16x8 a, bf16x8 b, f32x16 c) { return __builtin_amdgcn_mfma_f32_32x32x16_bf16(a, b, c, 0, 0, 0); }
DEVI bf16x8 pack8(const f32x16& x, int s) {
  u32x4 w = {cvtpk(x[8 * s + 0], x[8 * s + 1]), cvtpk(x[8 * s + 2], x[8 * s + 3]), cvtpk(x[8 * s + 4], x[8 * s + 5]), cvtpk(x[8 * s + 6], x[8 * s + 7])};
  return *reinterpret_cast<bf16x8*>(&w);
}
DEVI void lds_barrier() { asm volatile("s_waitcnt lgkmcnt(0)" ::: "memory"); __builtin_amdgcn_s_barrier(); asm volatile("" ::: "memory"); }
DEVI void glds16(const void* g, LAS void* l) { __builtin_amdgcn_global_load_lds((const unsigned*)g, (LAS unsigned*)l, 16, 0, 0); }

template <class F>
DEVI void wtrans(u16* dst, const float* src, const float* g, int K, int Npad, int ldn, F srccol, int gtid, int gsz) {
  const int total = Npad * (K / 64);
  for (int i = gtid; i < total; i += gsz) {
    const int n = i % Npad, kb = i / Npad;
    const int sc = srccol(n);
    float v[64];
#pragma unroll
    for (int j = 0; j < 64; ++j) v[j] = (sc >= 0) ? src[(size_t)(kb * 64 + j) * ldn + sc] : 0.f;
    if (g) {
#pragma unroll
      for (int j = 0; j < 64; ++j) v[j] *= g[kb * 64 + j];
    }
#pragma unroll
    for (int q = 0; q < 8; ++q) {
      u32x4 w = {cvtpk(v[8 * q + 0], v[8 * q + 1]), cvtpk(v[8 * q + 2], v[8 * q + 3]), cvtpk(v[8 * q + 4], v[8 * q + 5]), cvtpk(v[8 * q + 6], v[8 * q + 7])};
      *reinterpret_cast<u32x4*>(dst + (size_t)n * K + kb * 64 + q * 8) = w;
    }
  }
}

DEVI int srccol_in_a(int n) {
  const int t = n >> 7, c = n & 127;
  if (t < 12) return n;
  if (t < 20) { const int j = t - 12; return c < 64 ? 1536 + 64 * j + c : 2048 + 64 * j + (c - 64); }
  if (t < 44) return 2568 + (t - 20) * 128 + c;
  if (t == 44) return c < 8 ? 2560 + c : -1;
  return -1;
}
DEVI int srccol_in_c(int n) {
  const int t = n >> 7, c = n & 127;
  if (t < 16) return c < 64 ? 64 * t + c : 1024 + 64 * t + (c - 64);
  return n;
}

DEVI void phase_prep(const Params& p) {
  const int tid = threadIdx.x, lane = tid & 63;
  const int gtid = blockIdx.x * 256 + tid, gsz = gridDim.x * 256;
  const int gwave = gtid >> 6, nwaves = gsz >> 6;
  wtrans(p.WtInA, p.in[12], p.in[11], 1024, NPAD_A, 5640, [](int n) { return srccol_in_a(n); }, gtid, gsz);
  wtrans(p.WtOutA, p.in[23], nullptr, 1536, 1024, 1024, [](int n) { return n; }, gtid, gsz);
  wtrans(p.WtInC, p.in[24], p.in[11] + 1024, 1024, 4096, 4096, [](int n) { return srccol_in_c(n); }, gtid, gsz);
  wtrans(p.WtOutC, p.in[29], nullptr, 1536, 1024, 1024, [](int n) { return n; }, gtid, gsz);
  for (int l = 0; l < 2; ++l)
    wtrans(p.WtMem + (size_t)l * 1024 * 1024, p.in[31] + (size_t)l * 1024 * 1024, p.in[30] + l * 1024, 1024, 1024, 1024,
           [](int n) { return n; }, gtid, gsz);
  for (int row0 = gwave; row0 < NTOK + 1024; row0 += 8 * nwaves) {
    float4 v[8][4];
    const float* xr[8];
#pragma unroll
    for (int u = 0; u < 8; ++u) {
      const int row = min(row0 + u * nwaves, NTOK + 1023);
      xr[u] = row < NTOKP ? p.in[0] + (size_t)row * 1024 : (row < NTOK ? p.in[1] + (size_t)(row - NTOKP) * 1024 : p.in[2] + (size_t)(row - NTOK) * 1024);
    }
#pragma unroll
    for (int u = 0; u < 8; ++u)
#pragma unroll
      for (int i = 0; i < 4; ++i) v[u][i] = reinterpret_cast<const float4*>(xr[u])[lane + 64 * i];
#pragma unroll
    for (int u = 0; u < 8; ++u) {
      const int row = row0 + u * nwaves;
      float ss = 0.f;
#pragma unroll
      for (int i = 0; i < 4; ++i) ss += v[u][i].x * v[u][i].x + v[u][i].y * v[u][i].y + v[u][i].z * v[u][i].z + v[u][i].w * v[u][i].w;
      ss = wsum(ss);
      if (row < NTOK + 1024) {
        u16* dst = row < NTOK ? p.xb + (size_t)row * 1024 : p.memb + (size_t)(row - NTOK) * 1024;
        float* rsd = row < NTOK ? p.rs0 + row : p.rsmem + (row - NTOK);
        if (lane == 0) *rsd = rsqrtf(ss * (1.f / 1024.f) + EPS);
#pragma unroll
        for (int i = 0; i < 4; ++i) { u32x2 w = {cvtpk(v[u][i].x, v[u][i].y), cvtpk(v[u][i].z, v[u][i].w)}; reinterpret_cast<u32x2*>(dst)[lane + 64 * i] = w; }
      }
    }
  }
  float km0 = 0.f, km1 = 0.f, km2 = 0.f;
  for (int i0 = gtid; i0 < 8 * PAST * 64; i0 += 4 * gsz) {
    float4 a[4], c[4];
#pragma unroll
    for (int u = 0; u < 4; ++u) {
      const int i = i0 + u * gsz;
      const int c8 = i & 63, pp = (i >> 6) & (PAST - 1), b = (i >> 17) & 7;
      const float4* sp = reinterpret_cast<const float4*>(p.in[5] + ((size_t)(b * PAST + pp) * 512 + c8 * 8));
      a[u] = sp[0]; c[u] = sp[1];
    }
#pragma unroll
    for (int u = 0; u < 4; ++u) {
      const int i = i0 + u * gsz;
      if (i < 8 * PAST * 64) {
        const int c8 = i & 63, pp = (i >> 6) & (PAST - 1), b = i >> 17;
        u32x4 w = {cvtpk(a[u].x, a[u].y), cvtpk(a[u].z, a[u].w), cvtpk(c[u].x, c[u].y), cvtpk(c[u].z, c[u].w)};
        *reinterpret_cast<u32x4*>(p.Ks + ((size_t)(b * SKP + pp) * 512 + c8 * 8)) = w;
        float ss = a[u].x * a[u].x + a[u].y * a[u].y + a[u].z * a[u].z + a[u].w * a[u].w + c[u].x * c[u].x + c[u].y * c[u].y + c[u].z * c[u].z + c[u].w * c[u].w;
        ss += __shfl_xor(ss, 1); ss += __shfl_xor(ss, 2); ss += __shfl_xor(ss, 4);
        km0 = fmaxf(km0, ss);
      }
    }
  }
  for (int i0 = gtid; i0 < 8 * 4 * 256 * 128; i0 += 4 * gsz) {
    float v[4][8];
#pragma unroll
    for (int u = 0; u < 4; ++u) {
      const int i = (i0 + u * gsz) & (8 * 4 * 256 * 128 - 1);
      const int dv = i & 127, p8 = (i >> 7) & 255, h = (i >> 15) & 3, b = i >> 17;
#pragma unroll
      for (int j = 0; j < 8; ++j) v[u][j] = p.in[6][((size_t)(b * PAST + p8 * 8 + j) * 4 + h) * 128 + dv];
    }
#pragma unroll
    for (int u = 0; u < 4; ++u) {
      const int i = i0 + u * gsz;
      if (i < 8 * 4 * 256 * 128) {
        const int dv = i & 127, p8 = (i >> 7) & 255, h = (i >> 15) & 3, b = i >> 17;
        u32x4 w = {cvtpk(v[u][0], v[u][1]), cvtpk(v[u][2], v[u][3]), cvtpk(v[u][4], v[u][5]), cvtpk(v[u][6], v[u][7])};
        *reinterpret_cast<u32x4*>(p.VsT + ((size_t)((b * 4 + h) * 128 + dv) * SKP + p8 * 8)) = w;
      }
    }
  }
  for (int i = gtid; i < 4096 * 4; i += gsz) {
    u32x4 z = {0, 0, 0, 0};
    *reinterpret_cast<u32x4*>(p.VsT + ((size_t)(i >> 2) * SKP + 2080 + (i & 3) * 8)) = z;
  }
  for (int i = gtid; i < 8 * 32 * 64; i += gsz) {
    u32x4 z = {0, 0, 0, 0};
    const int c8 = i & 63, r = (i >> 6) & 31, b = i >> 11;
    *reinterpret_cast<u32x4*>(p.Ks + ((size_t)(b * SKP + 2080 + r) * 512 + c8 * 8)) = z;
  }
  for (int i = gtid; i < 2 * 8 * 256 * 64; i += gsz) {
    const int c8 = i & 63, m = (i >> 6) & 255, b = (i >> 14) & 7, l = i >> 17;
    const float4* s = reinterpret_cast<const float4*>(p.in[3] + ((size_t)((l * 8 + b) * 256 + m) * 512 + c8 * 8));
    const float4 a = s[0], c = s[1];
    u32x4 w = {cvtpk(a.x, a.y), cvtpk(a.z, a.w), cvtpk(c.x, c.y), cvtpk(c.z, c.w)};
    *reinterpret_cast<u32x4*>(p.XK + ((size_t)((l * 12 + 4 + b) * 256 + m) * 512 + c8 * 8)) = w;
    float ss = a.x * a.x + a.y * a.y + a.z * a.z + a.w * a.w + c.x * c.x + c.y * c.y + c.z * c.z + c.w * c.w;
    ss += __shfl_xor(ss, 1); ss += __shfl_xor(ss, 2); ss += __shfl_xor(ss, 4); ss += __shfl_xor(ss, 8);
    if (l == 0) km1 = fmaxf(km1, ss); else km2 = fmaxf(km2, ss);
  }
  for (int i = gtid; i < 2 * 8 * 4 * 32 * 128; i += gsz) {
    const int dv = i & 127, m8 = (i >> 7) & 31, h = (i >> 12) & 3, b = (i >> 14) & 7, l = i >> 17;
    float v[8];
#pragma unroll
    for (int j = 0; j < 8; ++j) v[j] = p.in[4][((size_t)((l * 8 + b) * 256 + m8 * 8 + j) * 4 + h) * 128 + dv];
    u32x4 w = {cvtpk(v[0], v[1]), cvtpk(v[2], v[3]), cvtpk(v[4], v[5]), cvtpk(v[6], v[7])};
    *reinterpret_cast<u32x4*>(p.XVT + ((size_t)(((l * 12 + 4 + b) * 4 + h) * 128 + dv) * 256 + m8 * 8)) = w;
  }
  for (int i = gtid; i < 32 * 16 * 128; i += gsz) {
    const int e = i & 127, d8 = (i >> 7) & 15, bh = i >> 11;
    float v[8];
#pragma unroll
    for (int j = 0; j < 8; ++j) v[j] = p.in[7][((size_t)bh * 128 + d8 * 8 + j) * 128 + e];
    u32x4 w = {cvtpk(v[0], v[1]), cvtpk(v[2], v[3]), cvtpk(v[4], v[5]), cvtpk(v[6], v[7])};
    *reinterpret_cast<u32x4*>(p.C0sT + ((size_t)bh * 128 + e) * 128 + d8 * 8) = w;
  }
  for (int i = gtid; i < NTOK; i += gsz) p.ssq1[i] = 0.f;
  km0 = wmax(km0); km1 = wmax(km1); km2 = wmax(km2);
  if (lane == 0) {
    const int slot = blockIdx.x * 4 + (tid >> 6);
    p.kmaxp[slot] = km0; p.kmaxp[1024 + slot] = km1; p.kmaxp[2048 + slot] = km2;
  }
}

DEVI void st_bf8(u16* dst, const float (&v)[8]) {
  u32x4 w = {cvtpk(v[0], v[1]), cvtpk(v[2], v[3]), cvtpk(v[4], v[5]), cvtpk(v[6], v[7])};
  *reinterpret_cast<u32x4*>(dst) = w;
}
DEVI void st_f8(float* dst, const float (&v)[8]) {
  reinterpret_cast<float4*>(dst)[0] = float4{v[0], v[1], v[2], v[3]};
  reinterpret_cast<float4*>(dst)[1] = float4{v[4], v[5], v[6], v[7]};
}
DEVI void store_transposed(LAS char* lds, u16* dst, size_t ldt, float scale) {
  const LAS float* Cs = (const LAS float*)lds;
  const int c = threadIdx.x & 127, rh = (threadIdx.x >> 7) * 64;
#pragma unroll
  for (int it = 0; it < 8; ++it) {
    const int r0 = rh + it * 8;
    float v[8];
#pragma unroll
    for (int j = 0; j < 8; ++j) v[j] = Cs[(r0 + j) * 132 + c] * scale;
    st_bf8(dst + (size_t)c * ldt + r0, v);
  }
}

DEVI void epi_in_a(const Params& p, LAS char* lds, int brow, int n, const float (&gn)[8]) {
  const LAS float* Cs = (const LAS float*)lds;
  const int tid = threadIdx.x, cgp = tid & 15, c0 = cgp * 8;
  const bool samp = brow >= NTOKP;
  const int seg = n >> 2, hd = n & 3;
  if (n >= 4 && n < 12) {
    u16* base = (n < 8 ? p.KaT : p.VaT);
    const float sc = (n < 8 ? 0.08838834764831845f : 1.f);
    if (!samp) { const int b = brow >> 13, t0 = brow & 8191; store_transposed(lds, base + ((size_t)(b * 4 + hd) * 128) * SEQ + t0, SEQ, sc); }
    else {
      const int c = tid & 127, rh = (tid >> 7) * 64;
#pragma unroll
      for (int it = 0; it < 8; ++it) {
        const int r0 = rh + it * 8; const int bs = ((brow - NTOKP) + r0) >> 5, t0 = r0 & 31;
        float v[8];
#pragma unroll
        for (int j = 0; j < 8; ++j) v[j] = Cs[(r0 + j) * 132 + c] * sc;
        st_bf8(base + (size_t)NTOKP * 512 + ((size_t)(bs * 4 + hd) * 128 + c) * 32 + t0, v);
      }
    }
  }
  if (seg == 7) {
    if (!samp) { const int b = brow >> 13, t0 = brow & 8191; store_transposed(lds, p.VbT + ((size_t)(b * 4 + hd) * 128) * SEQ + t0, SEQ, 1.f); }
    else {
      const int c = tid & 127, rh = (tid >> 7) * 64;
#pragma unroll
      for (int it = 0; it < 8; ++it) {
        const int r0 = rh + it * 8; const int bs = ((brow - NTOKP) + r0) >> 5, t0 = r0 & 31;
        float v[8];
#pragma unroll
        for (int j = 0; j < 8; ++j) v[j] = Cs[(r0 + j) * 132 + c];
        st_bf8(p.VsT + ((size_t)(bs * 4 + hd) * 128 + c) * SKP + PAST + t0, v);
      }
    }
  }
#pragma unroll 4
  for (int it = 0; it < 8; ++it) {
    const int r = it * 16 + (tid >> 4);
    const size_t grow = (size_t)brow + r;
    float v[8];
#pragma unroll
    for (int j = 0; j < 8; ++j) v[j] = Cs[r * 132 + c0 + j];
    if (n < 4) { st_bf8(p.Qa + grow * 512 + hd * 128 + c0, v); }
    else if (n < 8) {
#pragma unroll
      for (int j = 0; j < 8; ++j) v[j] *= 0.08838834764831845f;
      st_bf8(p.Ka + grow * 512 + hd * 128 + c0, v);
    }
    else if (n < 12) {   }
    else if (n < 20) {
      if (cgp < 8) {
        float g[8];
#pragma unroll
        for (int j = 0; j < 8; ++j) g[j] = sigmoidf_(v[j]) * siluf_(Cs[r * 132 + 64 + c0 + j]);
        st_bf8(p.Ga + grow * 512 + (n - 12) * 64 + c0, g);
      }
    }
    else if (n < 28) {
      float ss = 0.f;
#pragma unroll
      for (int j = 0; j < 8; ++j) ss += v[j] * v[j];
      ss += __shfl_xor(ss, 1); ss += __shfl_xor(ss, 2); ss += __shfl_xor(ss, 4);
      const float rs = rsqrtf(ss * (1.f / 64.f) + EPS);
      const float* g = gn;
      if (n < 24) {
#pragma unroll
        for (int j = 0; j < 8; ++j) v[j] = v[j] * rs * g[j] * (0.125f * LOG2E);
        st_bf8(p.Qb + grow * 512 + hd * 128 + c0, v);
      } else {
#pragma unroll
        for (int j = 0; j < 8; ++j) v[j] = v[j] * rs * g[j];
        if (!samp) { st_f8(p.out + O_PK + grow * 512 + hd * 128 + c0, v); st_bf8(p.Kb + grow * 512 + hd * 128 + c0, v); }
        else {
          const int sr = (int)grow - NTOKP, bs = sr >> 5, t = sr & 31;
          st_f8(p.out + O_SK + (size_t)sr * 512 + hd * 128 + c0, v);
          st_bf8(p.Ks + ((size_t)(bs * SKP + PAST + t)) * 512 + hd * 128 + c0, v);
        }
      }
    }
    else if (n < 32) {
      if (!samp) st_f8(p.out + O_PV + grow * 512 + hd * 128 + c0, v);
      else st_f8(p.out + O_SV + (size_t)((int)grow - NTOKP) * 512 + hd * 128 + c0, v);
    }
    else if (n < 36) {
#pragma unroll
      for (int j = 0; j < 8; ++j) v[j] = siluf_(v[j]);
      st_bf8(p.Gb + grow * 512 + hd * 128 + c0, v);
    }
    else if (n < 40) {
      float ss = 0.f;
#pragma unroll
      for (int j = 0; j < 8; ++j) ss += v[j] * v[j];
      ss += __shfl_xor(ss, 1); ss += __shfl_xor(ss, 2); ss += __shfl_xor(ss, 4); ss += __shfl_xor(ss, 8);
      const float rs = rsqrtf(ss * (1.f / 128.f) + EPS);
      const float* g = gn;
#pragma unroll
      for (int j = 0; j < 8; ++j) v[j] = v[j] * rs * g[j] * (0.08838834764831845f * LOG2E);
      st_bf8(p.Qx + grow * 512 + hd * 128 + c0, v);
    }
    else if (n < 44) {
#pragma unroll
      for (int j = 0; j < 8; ++j) v[j] = siluf_(v[j]);
      st_bf8(p.Gx + grow * 512 + hd * 128 + c0, v);
    }
    else {
      if (cgp == 0) {
        float g[8];
#pragma unroll
        for (int j = 0; j < 4; ++j) { g[j] = v[j] + gn[j]; g[4 + j] = logsigmoidf_(v[4 + j] + gn[4 + j]); }
        st_f8(p.gates + grow * 8, g);
      }
    }
  }
}

DEVI void epi_mem(const Params& p, LAS char* lds, int l, int brow, int n, const float (&gk)[8]) {
  const LAS float* Cs = (const LAS float*)lds;
  const int tid = threadIdx.x, cgp = tid & 15, c0 = cgp * 8;
  const int hd = n & 3;
  if (n >= 4) {
    const int b = brow >> 8, m0 = brow & 255;
    store_transposed(lds, p.XVT + ((size_t)((l * 12 + b) * 4 + hd) * 128) * 256 + m0, 256, 1.f);
  }
#pragma unroll 4
  for (int it = 0; it < 8; ++it) {
    const int r = it * 16 + (tid >> 4);
    const size_t grow = (size_t)brow + r;
    float v[8];
#pragma unroll
    for (int j = 0; j < 8; ++j) v[j] = Cs[r * 132 + c0 + j];
    if (n < 4) {
      float ss = 0.f;
#pragma unroll
      for (int j = 0; j < 8; ++j) ss += v[j] * v[j];
      ss += __shfl_xor(ss, 1); ss += __shfl_xor(ss, 2); ss += __shfl_xor(ss, 4); ss += __shfl_xor(ss, 8);
      const float rs = rsqrtf(ss * (1.f / 128.f) + EPS);
      const float* g = gk;
#pragma unroll
      for (int j = 0; j < 8; ++j) v[j] = v[j] * rs * g[j];
      st_f8(p.out + O_PXK + ((size_t)l * 1024 + grow) * 512 + hd * 128 + c0, v);
      const int b = (int)grow >> 8, m = (int)grow & 255;
      st_bf8(p.XK + ((size_t)((l * 12 + b) * 256 + m)) * 512 + hd * 128 + c0, v);
    } else {
      st_f8(p.out + O_PXV + ((size_t)l * 1024 + grow) * 512 + hd * 128 + c0, v);
    }
  }
}

DEVI void load_resid(const Params& p, int layer, int brow, int n, float4 (&ra)[8], float4 (&rb)[8]) {
  const int tid = threadIdx.x, c0 = (tid & 15) * 8;
#pragma unroll
  for (int it = 0; it < 8; ++it) {
    const size_t grow = (size_t)brow + it * 16 + (tid >> 4);
    const float* res;
    if (layer == 0) res = (grow < NTOKP ? p.in[0] + grow * 1024 : p.in[1] + (grow - NTOKP) * 1024) + n * 128 + c0;
    else res = p.out + grow * 1024 + n * 128 + c0;
    ra[it] = reinterpret_cast<const float4*>(res)[0]; rb[it] = reinterpret_cast<const float4*>(res)[1];
  }
}
DEVI void epi_out(const Params& p, LAS char* lds, int layer, int brow, int n, const float4 (&ra)[8], const float4 (&rb)[8]) {
  const LAS float* Cs = (const LAS float*)lds;
  const int tid = threadIdx.x, cgp = tid & 15, c0 = cgp * 8;
#pragma unroll
  for (int q = 0; q < 8; ++q) {
    const int r = q * 16 + (tid >> 4);
    const size_t grow = (size_t)brow + r;
    float v[8];
#pragma unroll
    for (int j = 0; j < 8; ++j) v[j] = Cs[r * 132 + c0 + j];
    v[0] += ra[q].x; v[1] += ra[q].y; v[2] += ra[q].z; v[3] += ra[q].w; v[4] += rb[q].x; v[5] += rb[q].y; v[6] += rb[q].z; v[7] += rb[q].w;
    st_f8(p.out + grow * 1024 + n * 128 + c0, v);
    if (layer == 0) {
      st_bf8(p.xb + grow * 1024 + n * 128 + c0, v);
      float ss = 0.f;
#pragma unroll
      for (int j = 0; j < 8; ++j) ss += v[j] * v[j];
      ss += __shfl_xor(ss, 1); ss += __shfl_xor(ss, 2); ss += __shfl_xor(ss, 4); ss += __shfl_xor(ss, 8);
      if (cgp == 0) atomicAdd(p.ssq1 + grow, ss);
    }
  }
}

DEVI void epi_in_c(const Params& p, LAS char* lds, int brow, int n, const float (&gx)[8]) {
  const LAS float* Cs = (const LAS float*)lds;
  const int tid = threadIdx.x, cgp = tid & 15, c0 = cgp * 8;
  u16* U = p.Qa;
  u16* Gc = p.KaT;
#pragma unroll 4
  for (int it = 0; it < 8; ++it) {
    const int r = it * 16 + (tid >> 4);
    const size_t grow = (size_t)brow + r;
    float v[8];
#pragma unroll
    for (int j = 0; j < 8; ++j) v[j] = Cs[r * 132 + c0 + j];
    if (n < 16) {
      if (cgp < 8) {
        float u[8];
#pragma unroll
        for (int j = 0; j < 8; ++j) u[j] = v[j] * sigmoidf_(Cs[r * 132 + 64 + c0 + j]);
        st_bf8(U + grow * 1024 + n * 64 + c0, u);
        if (grow < NTOKP) { const int t = (int)grow & 8191, b = (int)grow >> 13; if (t >= SEQ - 30) st_f8(p.out + O_PCONV + ((size_t)(b * 30 + t - (SEQ - 30))) * 1024 + n * 64 + c0, u); }
        else { const int sr = (int)grow - NTOKP, t = sr & 31, b = sr >> 5; if (t >= 2) st_f8(p.out + O_SCONV + ((size_t)(b * 30 + t - 2)) * 1024 + n * 64 + c0, u); }
      }
    } else if (n < 24) {
#pragma unroll
      for (int j = 0; j < 8; ++j) v[j] = siluf_(v[j]);
      st_bf8(Gc + grow * 1024 + (n - 16) * 128 + c0, v);
    } else if (n < 28) {
      float ss = 0.f;
#pragma unroll
      for (int j = 0; j < 8; ++j) ss += v[j] * v[j];
      ss += __shfl_xor(ss, 1); ss += __shfl_xor(ss, 2); ss += __shfl_xor(ss, 4); ss += __shfl_xor(ss, 8);
      const float rs = rsqrtf(ss * (1.f / 128.f) + EPS);
      const float* g = gx;
#pragma unroll
      for (int j = 0; j < 8; ++j) v[j] = v[j] * rs * g[j] * (0.08838834764831845f * LOG2E);
      st_bf8(p.Qx + grow * 512 + (n - 24) * 128 + c0, v);
    } else {
#pragma unroll
      for (int j = 0; j < 8; ++j) v[j] = siluf_(v[j]);
      st_bf8(p.Gx + grow * 512 + (n - 28) * 128 + c0, v);
    }
  }
}

DEVI void gemm_core(LAS char* lds, const u16* A0, const u16* A1, const u16* A2, int lda0, int lda1, int lda2, int segK,
                    const u16* Bt, int K, int brow, int bcol, f32x16 (&acc)[4][2]) {
  const int tid = threadIdx.x, lane = tid & 63, w = tid >> 6, wr = w >> 1, wc = w & 1, r = lane & 31, h = lane >> 5;
#pragma unroll
  for (int i = 0; i < 4; ++i)
#pragma unroll
    for (int j = 0; j < 2; ++j)
#pragma unroll
      for (int e = 0; e < 16; ++e) acc[i][j][e] = 0.f;
  const int nkt = K / 64;
  auto stage_part = [=](int kt, int buf, int part) __attribute__((always_inline)) {
    const int k0 = kt * 64;
    const int seg = k0 / segK;
    const u16* Ab = (seg == 0 ? A0 : (seg == 1 ? A1 : A2)) + (k0 - seg * segK);
    const int lda = (seg == 0 ? lda0 : (seg == 1 ? lda1 : lda2));
    LAS char* sa = lds + buf * 49152;
    LAS char* sb = sa + 32768;
#pragma unroll
    for (int q = 0; q < 2; ++q) {
      const int i = 2 * part + q;
      const int pch = i * 256 + tid, row = pch >> 3, lg = (pch & 7) ^ ((row >> 1) & 7);
      glds16(Ab + (size_t)(brow + row) * lda + lg * 8, sa + pch * 16);
    }
    {
      const int pch = part * 256 + tid, row = pch >> 3, lg = (pch & 7) ^ ((row >> 1) & 7);
      glds16(Bt + (size_t)(bcol + row) * K + k0 + lg * 8, sb + pch * 16);
    }
  };
  lds_barrier();
#pragma unroll
  for (int part = 0; part < 4; ++part) stage_part(0, 0, part);
#pragma unroll
  for (int part = 0; part < 4; ++part) stage_part(1, 1, part);
  int buf = 0;
  for (int kt = 0; kt < nkt; ++kt) {
    if (kt + 1 < nkt) asm volatile("s_waitcnt vmcnt(12)" ::: "memory"); else asm volatile("s_waitcnt vmcnt(0)" ::: "memory");
    asm volatile("s_waitcnt lgkmcnt(0)" ::: "memory");
    __builtin_amdgcn_s_barrier();
    int nb = buf + 2; if (nb >= 3) nb -= 3;
    const bool more = kt + 2 < nkt;
    const LAS char* sa = lds + buf * 49152;
    const LAS char* sb = sa + 32768;
    bf16x8 af[2][4], bfr[2][2];
#pragma unroll
    for (int i = 0; i < 4; ++i) {
      const int row = 32 * (2 * i + wr) + r, ch = h ^ ((row >> 1) & 7);
      af[0][i] = *reinterpret_cast<const LAS bf16x8*>(sa + row * 128 + ch * 16);
    }
#pragma unroll
    for (int j = 0; j < 2; ++j) {
      const int row = 32 * (2 * j + wc) + r, ch = h ^ ((row >> 1) & 7);
      bfr[0][j] = *reinterpret_cast<const LAS bf16x8*>(sb + row * 128 + ch * 16);
    }
#pragma unroll
    for (int ks = 0; ks < 4; ++ks) {
      const int cur = ks & 1, nxt = cur ^ 1;
      if (ks < 3) {
#pragma unroll
        for (int i = 0; i < 4; ++i) {
          const int row = 32 * (2 * i + wr) + r, ch = (2 * (ks + 1) + h) ^ ((row >> 1) & 7);
          af[nxt][i] = *reinterpret_cast<const LAS bf16x8*>(sa + row * 128 + ch * 16);
        }
#pragma unroll
        for (int j = 0; j < 2; ++j) {
          const int row = 32 * (2 * j + wc) + r, ch = (2 * (ks + 1) + h) ^ ((row >> 1) & 7);
          bfr[nxt][j] = *reinterpret_cast<const LAS bf16x8*>(sb + row * 128 + ch * 16);
        }
      }
#pragma unroll
      for (int i = 0; i < 2; ++i)
#pragma unroll
        for (int j = 0; j < 2; ++j) acc[i][j] = mfma32(af[cur][i], bfr[cur][j], acc[i][j]);
      if (more) stage_part(kt + 2, nb, ks);
#pragma unroll
      for (int i = 2; i < 4; ++i)
#pragma unroll
        for (int j = 0; j < 2; ++j) acc[i][j] = mfma32(af[cur][i], bfr[cur][j], acc[i][j]);
    }
    if (++buf == 3) buf = 0;
  }
}

DEVI void stage_all(LAS char* lds, const f32x16 (&acc)[4][2], bool scaled) {
  const int tid = threadIdx.x, lane = tid & 63, w = tid >> 6, wr = w >> 1, wc = w & 1, r = lane & 31, h = lane >> 5;
  const LAS float* RS = (const LAS float*)(lds + 135168);
#pragma unroll
  for (int i = 0; i < 4; ++i) {
    LAS float* Cs = (LAS float*)(lds + (i >> 1) * 67584);
#pragma unroll
    for (int e = 0; e < 16; ++e) {
      const int row = 32 * (2 * (i & 1) + wr) + crow(e, h);
      const float s = scaled ? RS[128 * (i >> 1) + row] : 1.f;
#pragma unroll
      for (int jj = 0; jj < 2; ++jj) Cs[row * 132 + 32 * (2 * jj + wc) + r] = acc[i][jj][e] * s;
    }
  }
}

DEVI void gemm_tile_run(const Params& p, LAS char* lds, int which, int aux, int mt, int n, f32x16 (&acc)[4][2]) {
  const int brow = mt * 256, bcol = n * 128;
  const float* rsc = nullptr; int mode = 0;
  if (which == 0) { gemm_core(lds, p.xb, p.xb, p.xb, 1024, 1024, 1024, 1024, p.WtInA, 1024, brow, bcol, acc); rsc = p.rs0; mode = 1; }
  else if (which == 1) gemm_core(lds, p.Ga, p.Gb, p.Gx, 512, 512, 512, 512, p.WtOutA, 1536, brow, bcol, acc);
  else if (which == 2) { gemm_core(lds, p.xb, p.xb, p.xb, 1024, 1024, 1024, 1024, p.WtInC, 1024, brow, bcol, acc); rsc = p.ssq1; mode = 2; }
  else if (which == 3) gemm_core(lds, p.KaT, p.KaT + 512, p.Gx, 1024, 1024, 512, 512, p.WtOutC, 1536, brow, bcol, acc);
  else { gemm_core(lds, p.memb, p.memb, p.memb, 1024, 1024, 1024, 1024, p.WtMem + (size_t)aux * 1024 * 1024, 1024, brow, bcol, acc); rsc = p.rsmem; mode = 1; }
  lds_barrier();
  if (mode) {
    float sc = rsc[brow + threadIdx.x];
    if (mode == 2) sc = rsqrtf(sc * (1.f / 1024.f) + EPS);
    ((LAS float*)(lds + 135168))[threadIdx.x] = sc;
    lds_barrier();
  }
  if (which == 1 || which == 3) {
    float4 ra0[8], rb0[8], ra1[8], rb1[8];
    load_resid(p, which == 1 ? 0 : 1, brow, n, ra0, rb0);
    load_resid(p, which == 1 ? 0 : 1, brow + 128, n, ra1, rb1);
    stage_all(lds, acc, false);
    lds_barrier();
    epi_out(p, lds, which == 1 ? 0 : 1, brow, n, ra0, rb0);
    epi_out(p, lds + 67584, which == 1 ? 0 : 1, brow + 128, n, ra1, rb1);
    return;
  }
  float gpre[8];
  {
    const int c0 = (threadIdx.x & 15) * 8;
    const float* gp = nullptr;
    if (which == 0) {
      if (n >= 20 && n < 24) gp = p.in[16] + (c0 & 63);
      else if (n >= 24 && n < 28) gp = p.in[17] + (c0 & 63);
      else if (n >= 36 && n < 40) gp = p.in[32] + c0;
    } else if (which == 2) gp = p.in[32] + 128 + c0;
    else gp = p.in[33] + aux * 128 + c0;
#pragma unroll
    for (int j = 0; j < 8; ++j) gpre[j] = gp ? gp[j] : 0.f;
    if (which == 0 && n == 44) {
#pragma unroll
      for (int j = 0; j < 4; ++j) { gpre[j] = p.in[13][j]; gpre[4 + j] = p.in[14][j]; }
    }
  }
  stage_all(lds, acc, mode != 0);
  lds_barrier();
#pragma unroll 1
  for (int sub = 0; sub < 2; ++sub) {
    LAS char* cs = lds + sub * 67584;
    const int sr = brow + 128 * sub;
    if (which == 0) epi_in_a(p, cs, sr, n, gpre);
    else if (which == 2) epi_in_c(p, cs, sr, n, gpre);
    else epi_mem(p, cs, aux, sr, n, gpre);
  }
}

template <int which>
DEVI void phase_gemm(const Params& p, LAS char* lds) {
  constexpr int nN = (which == 0 ? 45 : (which == 2 ? 32 : 8));
  constexpr int ntiles = 128 * nN;
  const int G = gridDim.x;
  const int xcd = blockIdx.x & 7, lb = blockIdx.x >> 3, slots = G >> 3;
  f32x16 acc[4][2];
  int round = 0, t_extra = blockIdx.x, t_mem = G - 1 - (int)blockIdx.x;
  if (which == 0 && G == 256) {
    const int idx = (xcd >= 4) ? lb * 4 + (xcd - 4) : 1 << 20;
    t_extra = idx < 45 ? idx : 1 << 20;
    t_mem = (idx >= 45 && idx < 109) ? idx - 45 : 1 << 20;
  }
  bool main_done = false;
  for (;;) {
    int mt, n;
    if (!main_done) {
      const int q = lb + slots * round; ++round;
      const int L = 32 * (xcd + 8 * (q >> 5)) + (q & 31);
      if (L >= ntiles) { main_done = true; continue; }
      const int mg = L / (4 * nN), rem = L - mg * 4 * nN;
      n = rem >> 2; mt = mg * 4 + (rem & 3);
    } else {
      if (t_extra >= nN) break;
      mt = 128; n = t_extra; t_extra += G;
    }
    gemm_tile_run(p, lds, which, 0, mt, n, acc);
  }
  if (which == 0) {
    for (int t = t_mem; t < 64; t += G) gemm_tile_run(p, lds, 4, t >> 5, (t >> 3) & 3, t & 7, acc);
  }
}

template <bool DIFF>
DEVI void attn_block(LAS char* lds, const u16* Q, const u16* Kg, const u16* VT, int ldv, int j0, int ntiles, int nwact,
                           int qpos0, int nkeys, float slope2, float M2, float lam, const float* subg, u16* G) {
  const int tid = threadIdx.x, lane = tid & 63, w = tid >> 6, r = lane & 31, h = lane >> 5;
  const bool act = w < nwact;
  const int qpos = qpos0 + 32 * w + r;
  const int cw = (qpos0 + 32 * w) >> 6;
  bf16x8 qf[8];
#pragma unroll
  for (int i = 0; i < 8; ++i) qf[i] = ldg8(Q + (size_t)(32 * w + r) * 512 + 16 * i + 8 * h);
  f32x16 O0[4], O1[4];
#pragma unroll
  for (int e = 0; e < 4; ++e)
#pragma unroll
    for (int i = 0; i < 16; ++i) { O0[e][i] = 0.f; O1[e][i] = 0.f; }
  float l0 = 0.f, l1 = 0.f;
  f32x16 cinit, zero16;
#pragma unroll
  for (int i = 0; i < 16; ++i) { cinit[i] = slope2 * (float)klocal(i, h); zero16[i] = 0.f; }
  const float tq = -slope2 * (float)qpos - M2;
  const int prow = pi32(r);

  auto stage = [=](int j, int buf) __attribute__((always_inline)) {
    LAS char* kb = lds + buf * 32768;
#pragma unroll
    for (int i = 0; i < 4; ++i) {
      const int pch = i * 256 + tid;
      { const int row = pch >> 4, ph = pch & 15, lg = ph ^ (row & 15);
        glds16(Kg + (size_t)(j * 64 + row) * 512 + lg * 8, kb + pch * 16); }
      { const int row = pch >> 3, ph = pch & 7, lg = ph ^ ((row >> 1) & 7);
        glds16(VT + (size_t)row * ldv + j * 64 + lg * 8, kb + 16384 + pch * 16); }
    }
  };
  lds_barrier();
  stage(j0, 0);
  asm volatile("s_waitcnt vmcnt(0)" ::: "memory");
  __syncthreads();
  for (int j = j0; j < ntiles; ++j) {
    const int buf = (j - j0) & 1;
    if (j + 1 < ntiles) stage(j + 1, buf ^ 1);
    {
      const LAS char* kb = lds + buf * 32768;
      const LAS char* vb = kb + 16384;
      const bool fast = DIFF && (j < cw);
#pragma unroll
      for (int kt = 0; kt < 2; ++kt) {
        const int krow = 32 * kt + prow;
        const LAS char* krp = kb + krow * 256;
        bf16x8 P0[2], P1[2];
        if (DIFF) {
#pragma unroll
          for (int c = 0; c < 2; ++c) {
            f32x16 s;
            if (fast) {
              s = cinit;
#pragma unroll
              for (int ks = 0; ks < 4; ++ks) {
                const int ch = (2 * (4 * c + ks) + h) ^ (krow & 15);
                s = mfma32(*reinterpret_cast<const LAS bf16x8*>(krp + ch * 16), qf[4 * c + ks], s);
              }
              const float t = tq + slope2 * (float)(j * 64 + kt * 32);
#pragma unroll
              for (int i = 0; i < 16; ++i) s[i] = __builtin_amdgcn_exp2f(s[i] + t);
            } else {
              s = zero16;
#pragma unroll
              for (int ks = 0; ks < 4; ++ks) {
                const int ch = (2 * (4 * c + ks) + h) ^ (krow & 15);
                s = mfma32(*reinterpret_cast<const LAS bf16x8*>(krp + ch * 16), qf[4 * c + ks], s);
              }
#pragma unroll
              for (int i = 0; i < 16; ++i) {
                const int kp = j * 64 + kt * 32 + klocal(i, h);
                const float bias = -slope2 * fabsf((float)(qpos - kp)) - M2;
                s[i] = (kp < nkeys && j <= cw) ? __builtin_amdgcn_exp2f(s[i] + bias) : 0.f;
              }
            }
            float ls = 0.f;
#pragma unroll
            for (int i = 0; i < 16; ++i) ls += s[i];
            if (c == 0) { l0 += ls; P0[0] = pack8(s, 0); P0[1] = pack8(s, 1); }
            else        { l1 += ls; P1[0] = pack8(s, 0); P1[1] = pack8(s, 1); }
          }
        } else {
          f32x16 s = zero16;
#pragma unroll
          for (int ks = 0; ks < 8; ++ks) {
            const int ch = (2 * ks + h) ^ (krow & 15);
            s = mfma32(*reinterpret_cast<const LAS bf16x8*>(krp + ch * 16), qf[ks], s);
          }
          float ls = 0.f;
#pragma unroll
          for (int i = 0; i < 16; ++i) { s[i] = __builtin_amdgcn_exp2f(s[i] - M2); ls += s[i]; }
          l0 += ls; P0[0] = pack8(s, 0); P0[1] = pack8(s, 1);
        }
#pragma unroll
        for (int et = 0; et < 4; ++et) {
          const int vrow = 32 * et + r;
#pragma unroll
          for (int sp = 0; sp < 2; ++sp) {
            const int ch = (2 * (2 * kt + sp) + h) ^ ((vrow >> 1) & 7);
            const bf16x8 vf = *reinterpret_cast<const LAS bf16x8*>(vb + vrow * 128 + ch * 16);
            O0[et] = mfma32(vf, P0[sp], O0[et]);
            if (DIFF) O1[et] = mfma32(vf, P1[sp], O1[et]);
          }
        }
      }
    }
    asm volatile("s_waitcnt vmcnt(0)" ::: "memory");
    __syncthreads();
  }
  if (act) {
    l0 += __shfl_xor(l0, 32);
    const float i0 = 1.f / l0;
    float i1 = 0.f;
    if (DIFF) { l1 += __shfl_xor(l1, 32); i1 = lam / l1; }
    float ss = 0.f;
#pragma unroll
    for (int et = 0; et < 4; ++et)
#pragma unroll
      for (int i = 0; i < 16; ++i) {
        float o = O0[et][i] * i0;
        if (DIFF) o -= O1[et][i] * i1;
        O0[et][i] = o; ss += o * o;
      }
    float rs = 1.f;
    if (DIFF) { ss += __shfl_xor(ss, 32); rs = rsqrtf(ss * (1.f / 128.f) + EPS) * 0.8f; }
    u16* grow = G + (size_t)(32 * w + r) * 512;
    u32x2 gt[16]; float4 sv[16];
#pragma unroll
    for (int q = 0; q < 16; ++q) {
      const int e0 = 32 * (q >> 2) + 8 * (q & 3) + 4 * h;
      gt[q] = *reinterpret_cast<const u32x2*>(grow + e0);
      if (DIFF) sv[q] = *reinterpret_cast<const float4*>(subg + e0); else sv[q] = float4{1.f, 1.f, 1.f, 1.f};
    }
#pragma unroll
    for (int q = 0; q < 16; ++q) {
      const int et = q >> 2, g = q & 3;
      const int e0 = 32 * et + 8 * g + 4 * h;
      const float a0 = O0[et][4 * g + 0] * rs * sv[q].x * bflo(gt[q][0]);
      const float a1 = O0[et][4 * g + 1] * rs * sv[q].y * bfhi(gt[q][0]);
      const float a2 = O0[et][4 * g + 2] * rs * sv[q].z * bflo(gt[q][1]);
      const float a3 = O0[et][4 * g + 3] * rs * sv[q].w * bfhi(gt[q][1]);
      u32x2 o = {cvtpk(a0, a1), cvtpk(a2, a3)};
      *reinterpret_cast<u32x2*>(grow + e0) = o;
    }
  }
}

DEVI float max_abs64(const float* g, int n, int lane) { float v = 0.f; for (int i = lane; i < n; i += 64) v = fmaxf(v, fabsf(g[i])); return wmax(v); }

DEVI float scan_add(float v, int lane) { for (int o = 1; o < 64; o <<= 1) { const float t = __shfl_up(v, o); if (lane >= o) v += t; } return v; }
DEVI float scan_max(float v, int lane) { for (int o = 1; o < 64; o <<= 1) { const float t = __shfl_up(v, o); if (lane >= o) v = fmaxf(v, t); } return v; }
DEVI float bfe(const bf16x8& v, int j) { return __uint_as_float(((unsigned)(u16)v[j]) << 16); }

template <int NT>
DEVI void mlstm_local(LAS char* lds, const float* gates, int hd, const u16* KT, const u16* VT, int ldt,
                            f32x16 (&acc)[4], float& nh, float& bL, float& amax) {
  const int tid = threadIdx.x, lane = tid & 63, w = tid >> 6, r = lane & 31, h = lane >> 5;
  constexpr int L = 32 * NT;
  const float lf = lane < L ? gates[lane * 8 + 4 + hd] : 0.f;
  const float ig = lane < L ? gates[lane * 8 + hd] : -INFINITY;
  const float b = scan_add(lf, lane);
  const float a = ig - b;
  amax = wmax(a);
  bL = __shfl(b, L - 1);
  LAS float* wt = (LAS float*)(lds + 4096) + w * 64;
  wt[lane] = __expf(a - amax);
#pragma unroll
  for (int e = 0; e < 4; ++e)
#pragma unroll
    for (int i = 0; i < 16; ++i) acc[e][i] = 0.f;
  nh = 0.f;
  bf16x8 kfa[2 * NT], vfa[2 * NT][4];
#pragma unroll
  for (int ks = 0; ks < 2 * NT; ++ks) {
    kfa[ks] = ldg8(KT + (size_t)(32 * w + r) * ldt + 16 * ks + 8 * h);
#pragma unroll
    for (int et = 0; et < 4; ++et) vfa[ks][et] = ldg8(VT + (size_t)(32 * et + r) * ldt + 16 * ks + 8 * h);
  }
#pragma unroll
  for (int ks = 0; ks < 2 * NT; ++ks) {
    const bf16x8 kf = kfa[ks];
    float wv[8];
#pragma unroll
    for (int j = 0; j < 8; ++j) { wv[j] = wt[16 * ks + 8 * h + j]; nh += bfe(kf, j) * wv[j]; }
#pragma unroll
    for (int et = 0; et < 4; ++et) {
      const bf16x8 vf = vfa[ks][et];
      u32x4 sv = {cvtpk(bfe(vf, 0) * wv[0], bfe(vf, 1) * wv[1]), cvtpk(bfe(vf, 2) * wv[2], bfe(vf, 3) * wv[3]),
                  cvtpk(bfe(vf, 4) * wv[4], bfe(vf, 5) * wv[5]), cvtpk(bfe(vf, 6) * wv[6], bfe(vf, 7) * wv[7])};
      acc[et] = mfma32(kf, *reinterpret_cast<bf16x8*>(&sv), acc[et]);
    }
  }
  nh += __shfl_xor(nh, 32);
}

template <int NT>
DEVI void mlstm_out(LAS char* lds, const float* gates, int hd, const u16* Qg, const u16* Kg, const u16* VT, int ldv,
                          const u16* CT, const float* n0, float m0, const float* mg, u16* G) {
  const int tid = threadIdx.x, lane = tid & 63, w = tid >> 6, r = lane & 31, h = lane >> 5;
  constexpr int L = 32 * NT;
  const float lf = lane < L ? gates[lane * 8 + 4 + hd] : 0.f;
  const float ig = lane < L ? gates[lane * 8 + hd] : -INFINITY;
  const float b = scan_add(lf, lane);
  const float a = ig - b;
  const float Mrow = fmaxf(m0, scan_max(a, lane));
  const float mt = b + Mrow;
  LAS float* at = (LAS float*)lds + w * 64;
  LAS float* red = (LAS float*)(lds + 1024);
  at[lane] = a;
  const int prow = pi32(r);
#pragma unroll 1
  for (int tt = 0; tt < NT; ++tt) {
    const int t = 32 * tt + r;
    const float Mrow_t = __shfl(Mrow, t), mt_t = __shfl(mt, t);
    const float winter = __expf(m0 - Mrow_t);
    bf16x8 qf[8], cfa[8], kfa[NT][8], vfa[NT][2];
    float4 na[8], nb[8];
#pragma unroll
    for (int i = 0; i < 8; ++i) {
      qf[i] = ldg8(Qg + (size_t)t * 512 + 16 * i + 8 * h);
      na[i] = *reinterpret_cast<const float4*>(n0 + 16 * i + 8 * h); nb[i] = *reinterpret_cast<const float4*>(n0 + 16 * i + 8 * h + 4);
      cfa[i] = ldg8(CT + (size_t)(32 * w + r) * 128 + 16 * i + 8 * h);
    }
#pragma unroll
    for (int st = 0; st < NT; ++st) {
      const int sc = st <= tt ? st : tt;
#pragma unroll
      for (int ks = 0; ks < 8; ++ks) kfa[st][ks] = ldg8(Kg + (size_t)(32 * sc + prow) * 512 + 16 * ks + 8 * h);
#pragma unroll
      for (int sp = 0; sp < 2; ++sp) vfa[st][sp] = ldg8(VT + (size_t)(32 * w + r) * ldv + 32 * sc + 16 * sp + 8 * h);
    }
    float qn = 0.f;
#pragma unroll
    for (int i = 0; i < 8; ++i) {
      qn += bfe(qf[i], 0) * na[i].x + bfe(qf[i], 1) * na[i].y + bfe(qf[i], 2) * na[i].z + bfe(qf[i], 3) * na[i].w
          + bfe(qf[i], 4) * nb[i].x + bfe(qf[i], 5) * nb[i].y + bfe(qf[i], 6) * nb[i].z + bfe(qf[i], 7) * nb[i].w;
    }
    qn += __shfl_xor(qn, 32);
    f32x16 H;
#pragma unroll
    for (int i = 0; i < 16; ++i) H[i] = 0.f;
#pragma unroll
    for (int ks = 0; ks < 8; ++ks) H = mfma32(cfa[ks], qf[ks], H);
#pragma unroll
    for (int i = 0; i < 16; ++i) H[i] *= winter;
    float dsum = 0.f;
#pragma unroll
    for (int st = 0; st < NT; ++st) {
      if (st <= tt) {
        f32x16 S;
#pragma unroll
        for (int i = 0; i < 16; ++i) S[i] = 0.f;
#pragma unroll
        for (int ks = 0; ks < 8; ++ks) S = mfma32(kfa[st][ks], qf[ks], S);
#pragma unroll
        for (int i = 0; i < 16; ++i) {
          const int s_ = 32 * st + klocal(i, h);
          const float wg = (s_ <= t) ? __expf(at[s_] - Mrow_t) : 0.f;
          S[i] *= wg; dsum += S[i];
        }
#pragma unroll
        for (int sp = 0; sp < 2; ++sp) H = mfma32(vfa[st][sp], pack8(S, sp), H);
      }
    }
    dsum += __shfl_xor(dsum, 32);
    const float den = winter * qn + dsum;
    const float inv = 1.f / fmaxf(fabsf(den), __expf(-mt_t));
    float ss = 0.f;
#pragma unroll
    for (int i = 0; i < 16; ++i) { H[i] *= inv; ss += H[i] * H[i]; }
    ss += __shfl_xor(ss, 32);
    if (h == 0) red[w * 64 + t] = ss;
    lds_barrier();
    const float tot = red[t] + red[64 + t] + red[128 + t] + red[192 + t];
    const float rs = rsqrtf(tot * (1.f / 128.f) + EPS);
    u16* grow = G + (size_t)t * 512;
    u32x2 gt[4]; float4 mv[4];
#pragma unroll
    for (int g = 0; g < 4; ++g) {
      const int e0 = 32 * w + 8 * g + 4 * h;
      gt[g] = *reinterpret_cast<const u32x2*>(grow + e0);
      mv[g] = *reinterpret_cast<const float4*>(mg + e0);
    }
#pragma unroll
    for (int g = 0; g < 4; ++g) {
      const int e0 = 32 * w + 8 * g + 4 * h;
      u32x2 o = {cvtpk(H[4 * g + 0] * rs * mv[g].x * bflo(gt[g][0]), H[4 * g + 1] * rs * mv[g].y * bfhi(gt[g][0])),
                 cvtpk(H[4 * g + 2] * rs * mv[g].z * bflo(gt[g][1]), H[4 * g + 3] * rs * mv[g].w * bfhi(gt[g][1]))};
      *reinterpret_cast<u32x2*>(grow + e0) = o;
    }
    lds_barrier();
  }
}

DEVI void m1_item(const Params& p, LAS char* lds, int item) {
  const int tid = threadIdx.x, lane = tid & 63, w = tid >> 6, r = lane & 31, h = lane >> 5;
  const int bh = item >> 7, c = item & 127, b = bh >> 2, hd = bh & 3;
  const size_t row0 = (size_t)b * SEQ + c * 64;
  f32x16 acc[4]; float nh, bL, amax;
  lds_barrier();
  mlstm_local<2>(lds, p.gates + row0 * 8, hd, p.KaT + (size_t)bh * 128 * SEQ + c * 64, p.VaT + (size_t)bh * 128 * SEQ + c * 64, SEQ, acc, nh, bL, amax);
  u16* Chat = p.xb + ((size_t)item * 128) * 128;
#pragma unroll
  for (int et = 0; et < 4; ++et)
#pragma unroll
    for (int g = 0; g < 4; ++g) {
      const int d0 = 32 * w + 8 * g + 4 * h, e = 32 * et + r;
      u32x2 o = {cvtpk(acc[et][4 * g], acc[et][4 * g + 1]), cvtpk(acc[et][4 * g + 2], acc[et][4 * g + 3])};
      *reinterpret_cast<u32x2*>(Chat + (size_t)e * 128 + d0) = o;
    }
  if (h == 0) p.nhat[(size_t)item * 128 + 32 * w + r] = nh;
  if (tid == 0) { p.tabA[item] = bL; p.tabB[item] = bL + amax; }
}

DEVI void phase_scan(const Params& p, LAS char* lds) {
  const int tid = threadIdx.x, lane = tid & 63;
  LAS float* al = (LAS float*)lds; LAS float* be = al + 128; LAS float* ms = al + 256;
  for (int u = blockIdx.x; u < 16 * 32; u += gridDim.x) {
    const int bh = u >> 5, part = u & 31;
    __syncthreads();
    if (tid < 64) {
      const float A0 = p.tabA[bh * 128 + 2 * lane], A1 = p.tabA[bh * 128 + 2 * lane + 1];
      const float B0 = p.tabB[bh * 128 + 2 * lane], B1 = p.tabB[bh * 128 + 2 * lane + 1];
      const float SAi = scan_add(A0 + A1, lane);
      const float SA0 = SAi - A1, SA1 = SAi;
      const float D0 = B0 - SA0, D1 = B1 - SA1;
      const float PMi = scan_max(fmaxf(D0, D1), lane);
      float PMx = __shfl_up(PMi, 1); if (lane == 0) PMx = -INFINITY;
      const float mn0 = SA0 + fmaxf(0.f, fmaxf(PMx, D0));
      const float mn1 = SA1 + fmaxf(0.f, PMi);
      float mprev = __shfl_up(mn1, 1); if (lane == 0) mprev = 0.f;
      al[2 * lane] = __expf(A0 + mprev - mn0); be[2 * lane] = __expf(B0 - mn0);
      al[2 * lane + 1] = __expf(A1 + mn0 - mn1); be[2 * lane + 1] = __expf(B1 - mn1);
      ms[2 * lane] = mprev; ms[2 * lane + 1] = mn0;
      if (lane == 63) ms[128] = mn1;
    }
    __syncthreads();
    if (part == 0) {
      if (tid < 129) p.mtab[bh * 129 + tid] = ms[tid];
      if (tid == 0) p.out[O_PM + bh] = ms[128];
    }
    u16* base = p.xb + (size_t)bh * 128 * 16384 + part * 512 + tid * 2;
    float c0 = 0.f, c1 = 0.f;
    for (int c = 0; c < 128; c += 8) {
      unsigned v[8];
#pragma unroll
      for (int j = 0; j < 8; ++j) v[j] = *reinterpret_cast<const unsigned*>(base + (size_t)(c + j) * 16384);
#pragma unroll
      for (int j = 0; j < 8; ++j) {
        *reinterpret_cast<unsigned*>(base + (size_t)(c + j) * 16384) = cvtpk(c0, c1);
        const float a_ = al[c + j], b_ = be[c + j];
        c0 = a_ * c0 + b_ * bflo(v[j]); c1 = a_ * c1 + b_ * bfhi(v[j]);
      }
    }
    { const int idx = part * 512 + tid * 2, e = idx >> 7, d = idx & 127;
      p.out[O_PC + ((size_t)bh * 128 + d) * 128 + e] = c0;
      p.out[O_PC + ((size_t)bh * 128 + d + 1) * 128 + e] = c1; }
    if (part == 0 && tid < 128) {
      float n = 0.f;
      for (int c = 0; c < 128; c += 16) {
        float nv[16];
#pragma unroll
        for (int j = 0; j < 16; ++j) nv[j] = p.nhat[((size_t)bh * 128 + c + j) * 128 + tid];
#pragma unroll
        for (int j = 0; j < 16; ++j) {
          p.nstate[((size_t)bh * 128 + c + j) * 128 + tid] = n;
          n = al[c + j] * n + be[c + j] * nv[j];
        }
      }
      p.out[O_PN + bh * 128 + tid] = n;
    }
  }
}

DEVI void m3_item(const Params& p, LAS char* lds, int item) {
  const int bh = item >> 7, c = item & 127, b = bh >> 2, hd = bh & 3;
  const size_t row0 = (size_t)b * SEQ + c * 64;
  lds_barrier();
  mlstm_out<2>(lds, p.gates + row0 * 8, hd, p.Qa + row0 * 512 + hd * 128, p.Ka + row0 * 512 + hd * 128,
               p.VaT + (size_t)bh * 128 * SEQ + c * 64, SEQ, p.xb + (size_t)item * 16384, p.nstate + (size_t)item * 128,
               p.mtab[bh * 129 + c], p.in[15] + hd * 128, p.Ga + row0 * 512 + hd * 128);
}

DEVI void ms_item(const Params& p, LAS char* lds, int bh) {
  const int tid = threadIdx.x, lane = tid & 63, w = tid >> 6, r = lane & 31, h = lane >> 5;
  const int b = bh >> 2, hd = bh & 3;
  const size_t row0 = (size_t)NTOKP + b * 32;
  const float m0 = p.in[9][bh];
  const float* n0 = p.in[8] + bh * 128;
  const u16* KTs = p.KaT + (size_t)NTOKP * 512 + (size_t)bh * 128 * 32;
  const u16* VTs = p.VaT + (size_t)NTOKP * 512 + (size_t)bh * 128 * 32;
  lds_barrier();
  mlstm_out<1>(lds, p.gates + row0 * 8, hd, p.Qa + row0 * 512 + hd * 128, p.Ka + row0 * 512 + hd * 128, VTs, 32,
               p.C0sT + (size_t)bh * 16384, n0, m0, p.in[15] + hd * 128, p.Ga + row0 * 512 + hd * 128);
  f32x16 acc[4]; float nh, bL, amax;
  mlstm_local<1>(lds, p.gates + row0 * 8, hd, KTs, VTs, 32, acc, nh, bL, amax);
  const float mlast = bL + fmaxf(m0, amax);
  const float decay = __expf(bL + m0 - mlast), beta = __expf(bL + amax - mlast);
#pragma unroll
  for (int et = 0; et < 4; ++et)
#pragma unroll
    for (int i = 0; i < 16; ++i) {
      const int d = 32 * w + crow(i, h), e = 32 * et + r;
      const size_t o = ((size_t)bh * 128 + d) * 128 + e;
      p.out[O_SC + o] = decay * p.in[7][o] + beta * acc[et][i];
    }
  if (h == 0) { const int d = 32 * w + r; p.out[O_SN + bh * 128 + d] = decay * n0[d] + beta * nh; }
  if (tid == 0) p.out[O_SM + bh] = mlast;
}

DEVI void phase_conv(const Params& p, LAS char* lds) {
  const int tid = threadIdx.x, lane = tid & 63, w = tid >> 6;
  const u16* U = p.Qa; u16* Gc = p.KaT;
  LAS u16* win = (LAS u16*)lds;
  LAS float* cs = (LAS float*)(lds + 40960);
  LAS float* st = (LAS float*)(lds + 40960 + 32768);
  float cw[4][31], cb[4], lg[4], lb[4];
#pragma unroll
  for (int c = 0; c < 4; ++c) {
    const int chn = c * 256 + tid;
#pragma unroll
    for (int j = 0; j < 31; ++j) cw[c][j] = p.in[25][j * 1024 + chn];
    cb[c] = p.in[26][chn]; lg[c] = p.in[27][chn]; lb[c] = p.in[28][chn];
  }
  const int ntile = NTOK / 8;
  auto fetch = [=](int tile, int cgp, u32x4 (&rg)[5]) __attribute__((always_inline)) {
    const int row0 = tile * 8;
    const bool samp = row0 >= NTOKP;
    const int t0 = samp ? ((row0 - NTOKP) & 31) : (row0 & 8191);
    const int bs = samp ? ((row0 - NTOKP) >> 5) : 0;
    const int seqbase = row0 - t0;
#pragma unroll
    for (int q = 0; q < 5; ++q) {
      const int pch = tid + 256 * q, rr = pch >> 5, ch = pch & 31, t = t0 - 30 + rr;
      u32x4 v = {0, 0, 0, 0};
      if (pch < 38 * 32) {
        if (t >= 0) v = *reinterpret_cast<const u32x4*>(U + (size_t)(seqbase + t) * 1024 + cgp * 256 + ch * 8);
        else if (samp) {
          const float4* sc = reinterpret_cast<const float4*>(p.in[10] + ((size_t)(bs * 30 + 30 + t)) * 1024 + cgp * 256 + ch * 8);
          const float4 a = sc[0], c = sc[1];
          v = u32x4{cvtpk(a.x, a.y), cvtpk(a.z, a.w), cvtpk(c.x, c.y), cvtpk(c.z, c.w)};
        }
      }
      rg[q] = v;
    }
  };
  auto commit = [=](int buf, const u32x4 (&rg)[5]) __attribute__((always_inline)) {
#pragma unroll
    for (int q = 0; q < 5; ++q) {
      const int pch = tid + 256 * q;
      if (pch < 38 * 32) *reinterpret_cast<LAS u32x4*>(win + buf * (38 * 256) + (pch >> 5) * 256 + (pch & 31) * 8) = rg[q];
    }
  };
  int tile = blockIdx.x;
  if (tile >= ntile) return;
  u32x4 rg[5];
  __syncthreads();
  fetch(tile, 0, rg);
  commit(0, rg);
  __syncthreads();
  for (; tile < ntile; tile += gridDim.x) {
    const int row0 = tile * 8;
    const int ntl = tile + gridDim.x;
#pragma unroll
    for (int cgp = 0; cgp < 4; ++cgp) {
      const bool more = (cgp < 3) || (ntl < ntile);
      if (more) fetch(cgp < 3 ? tile : ntl, cgp < 3 ? cgp + 1 : 0, rg);
      const LAS u16* wb = win + (cgp & 1) * (38 * 256);
      float wv[38];
#pragma unroll
      for (int rr = 0; rr < 38; ++rr) wv[rr] = bf2f(wb[rr * 256 + tid]);
#pragma unroll
      for (int i = 0; i < 8; ++i) {
        float a = cb[cgp];
#pragma unroll
        for (int j = 0; j < 31; ++j) a += cw[cgp][j] * wv[i + j];
        cs[i * 1024 + cgp * 256 + tid] = a;
      }
      if (more) commit((cgp + 1) & 1, rg);
      lds_barrier();
    }
    u16 gv[4][8];
#pragma unroll
    for (int c = 0; c < 4; ++c)
#pragma unroll
      for (int i = 0; i < 8; ++i) gv[c][i] = Gc[(size_t)(row0 + i) * 1024 + c * 256 + tid];
#pragma unroll
    for (int q = 0; q < 2; ++q) {
      const int i = 2 * w + q;
      float a1 = 0.f, a2 = 0.f;
#pragma unroll
      for (int k = 0; k < 16; ++k) { const float v = cs[i * 1024 + lane + 64 * k]; a1 += v; a2 += v * v; }
      a1 = wsum(a1); a2 = wsum(a2);
      if (lane == 0) {
        const float mu = a1 * (1.f / 1024.f);
        const float var = fmaxf(a2 * (1.f / 1024.f) - mu * mu, 0.f);
        st[2 * i] = mu; st[2 * i + 1] = rsqrtf(var + EPS);
      }
    }
    lds_barrier();
#pragma unroll
    for (int c = 0; c < 4; ++c) {
      const int chn = c * 256 + tid;
#pragma unroll
      for (int i = 0; i < 8; ++i) {
        const float y = (cs[i * 1024 + chn] - st[2 * i]) * st[2 * i + 1] * lg[c] + lb[c];
        Gc[(size_t)(row0 + i) * 1024 + chn] = f2bf(siluf_(y) * bf2f(gv[c][i]));
      }
    }
    lds_barrier();
  }
}

struct AttnConst { float M2d, M2x, lam; };
DEVI AttnConst attn_consts(const Params& p, int layer) {
  const int lane = threadIdx.x & 63;
  AttnConst c;
  const float gq = max_abs64(p.in[16], 64, lane), gk = max_abs64(p.in[17], 64, lane);
  float kd = 0.f, kx = 0.f;
  for (int i = lane; i < (int)gridDim.x * 4; i += 64) { kd = fmaxf(kd, p.kmaxp[i]); kx = fmaxf(kx, p.kmaxp[1024 * (1 + layer) + i]); }
  kd = wmax(kd); kx = wmax(kx);
  c.M2d = (8.f * gq * 0.125f * LOG2E) * fmaxf(8.f * gk, sqrtf(kd)) * 1.01f;
  const float xq = max_abs64(p.in[32] + layer * 128, 128, lane), xk = max_abs64(p.in[33] + layer * 128, 128, lane);
  c.M2x = (11.313708f * xq * 0.08838834764831845f * LOG2E) * fmaxf(11.313708f * xk, sqrtf(kx)) * 1.01f;
  float d1 = p.in[18][lane] * p.in[19][lane], d2 = p.in[20][lane] * p.in[21][lane];
  d1 = wsum(d1); d2 = wsum(d2);
  c.lam = __expf(d1) - __expf(d2) + 0.2f;
  return c;
}

DEVI void cross_item(const Params& p, LAS char* lds, int layer, int it, float M2x) {
  const int hd = it & 3;
  size_t row0; int mb, nw;
  if (it < 1024) { const int rb = it >> 2; row0 = (size_t)rb * 128; mb = rb >> 6; nw = 4; }
  else { const int bs = (it - 1024) >> 2; row0 = (size_t)NTOKP + bs * 32; mb = 4 + bs; nw = 1; }
  attn_block<false>(lds, p.Qx + row0 * 512 + hd * 128, p.XK + ((size_t)(layer * 12 + mb) * 256) * 512 + hd * 128,
                    p.XVT + ((size_t)((layer * 12 + mb) * 4 + hd) * 128) * 256, 256, 0, 4, nw, 0, 256, 0.f, M2x, 0.f, nullptr,
                    p.Gx + row0 * 512 + hd * 128);
}

DEVI void diff_item(const Params& p, LAS char* lds, int it, float M2d, float lam) {
  const bool pr = it < 1024;
  const int hd = pr ? 3 - (it >> 8) : (it - 1024) & 3;
  const int qb = pr ? 63 - ((it >> 2) & 63) : 0;
  const int b = pr ? (it & 3) : (it - 1024) >> 2;
  const int bh = b * 4 + hd;
  const size_t row0 = pr ? (size_t)b * SEQ + qb * 128 : (size_t)NTOKP + b * 32;
  const float slope2 = exp2f(-2.f * (hd + 1)) * LOG2E;
  const u16* Kp = pr ? p.Kb + (size_t)b * SEQ * 512 + hd * 128 : p.Ks + (size_t)b * SKP * 512 + hd * 128;
  const u16* Vp = pr ? p.VbT + (size_t)bh * 128 * SEQ : p.VsT + (size_t)bh * 128 * SKP;
  const int qpos0 = pr ? qb * 128 : PAST;
  const float kcut = (float)qpos0 - (2.f * M2d + 64.f) / slope2;
  int j0 = (int)floorf((kcut - 63.f) * (1.f / 64.f));
  j0 = max(j0, 0);
  attn_block<true>(lds, p.Qb + row0 * 512 + hd * 128, Kp, Vp, pr ? SEQ : SKP, j0, pr ? 2 * qb + 2 : 33, pr ? 4 : 1,
                   qpos0, pr ? SEQ : PAST + 32, slope2, M2d, lam, p.in[22], p.Gb + row0 * 512 + hd * 128);
}

constexpr int NPHASE = 9;
DEVI void run_phase(const Params& p, LAS char* lds, int ph) {
  const int G = gridDim.x, g = blockIdx.x;
  switch (ph) {
    case 0: phase_prep(p); break;
    case 1: phase_gemm<0>(p, lds); break;
    case 2: {
      const AttnConst c = attn_consts(p, 0);
      for (int it = g; it < 1056; it += G) cross_item(p, lds, 0, it, c.M2x);
      for (int it = g; it < 2048; it += G) m1_item(p, lds, it);
    } break;
    case 3: {
      const AttnConst c = attn_consts(p, 0);
      (void)c;
      phase_scan(p, lds);
    } break;
    case 4: {
      const AttnConst c = attn_consts(p, 0);
      unsigned* qhead = reinterpret_cast<unsigned*>(p.kmaxp + 3 * 1024) + 16;
      volatile LAS int* slot = (volatile LAS int*)(lds + LDS_BYTES - 16);
      for (;;) {
        lds_barrier();
        if (threadIdx.x == 0) *slot = (int)__hip_atomic_fetch_add(qhead, 1u, __ATOMIC_RELAXED, __HIP_MEMORY_SCOPE_AGENT);
        lds_barrier();
        const int it = *slot;
        if (it >= 1056) break;
        diff_item(p, lds, it, c.M2d, c.lam);
      }
      for (;;) {
        lds_barrier();
        if (threadIdx.x == 0) *slot = (int)__hip_atomic_fetch_add(qhead + 16, 1u, __ATOMIC_RELAXED, __HIP_MEMORY_SCOPE_AGENT);
        lds_barrier();
        const int it = *slot;
        if (it >= 2048) break;
        m3_item(p, lds, it);
      }
      for (int it = G - 1 - g; it < 32; it += G) ms_item(p, lds, it);
    } break;
    case 5: phase_gemm<1>(p, lds); break;
    case 6: phase_gemm<2>(p, lds); break;
    case 7: {
      const AttnConst c = attn_consts(p, 1);
      phase_conv(p, lds);
      for (int it = g; it < 1056; it += G) cross_item(p, lds, 1, it, c.M2x);
    } break;
    case 8: phase_gemm<3>(p, lds); break;
  }
}

DEVI void grid_bar(unsigned* ctr, unsigned& epoch) {
  asm volatile("s_waitcnt vmcnt(0)" ::: "memory");
  __syncthreads();
  if (threadIdx.x == 0) {
    __builtin_amdgcn_fence(__ATOMIC_RELEASE, "agent");
    asm volatile("s_waitcnt vmcnt(0)" ::: "memory");
    __hip_atomic_fetch_add(ctr, 1u, __ATOMIC_RELAXED, __HIP_MEMORY_SCOPE_AGENT);
    epoch += 1u;
    const unsigned target = epoch * gridDim.x;
    while (__hip_atomic_load(ctr, __ATOMIC_RELAXED, __HIP_MEMORY_SCOPE_AGENT) < target) __builtin_amdgcn_s_sleep(1);
    __builtin_amdgcn_fence(__ATOMIC_ACQUIRE, "agent");
    asm volatile("s_waitcnt vmcnt(0)" ::: "memory");
  }
  __syncthreads();
}

__global__ void __launch_bounds__(256, 1) mega(Params p, int ph_lo, int ph_hi) {
  extern __shared__ __attribute__((aligned(16))) char smem[];
  LAS char* lds = (LAS char*)smem;
  cg::grid_group grid = cg::this_grid();
  unsigned epoch = 0;
  unsigned* ctr = reinterpret_cast<unsigned*>(p.kmaxp + 3 * 1024);
#define RUNPH(k) if (ph_lo <= (k) && (k) < ph_hi) { if ((k) > ph_lo) { if ((k) == 1) grid.sync(); else grid_bar(ctr, epoch); } run_phase(p, lds, (k)); }
  RUNPH(0) RUNPH(1) RUNPH(2) RUNPH(3) RUNPH(4) RUNPH(5) RUNPH(6) RUNPH(7) RUNPH(8)
#undef RUNPH
}

#ifndef MULTI_LAUNCH
#define MULTI_LAUNCH 0
#endif

extern "C" void kernel_launch(void* const* d_in, const int* in_sizes, int n_in, void* d_out, int out_size, void* d_ws, size_t ws_size,
                              hipStream_t stream) {
  static int grid_blocks = 0;
  if (!grid_blocks) {
    int dev = 0, cus = 0, per_cu = 0;
    hipGetDevice(&dev);
    hipDeviceGetAttribute(&cus, hipDeviceAttributeMultiprocessorCount, dev);
    hipFuncSetAttribute((const void*)mega, hipFuncAttributeMaxDynamicSharedMemorySize, LDS_BYTES);
    hipOccupancyMaxActiveBlocksPerMultiprocessor(&per_cu, (const void*)mega, 256, LDS_BYTES);
    if (per_cu < 1) per_cu = 1;
    if (per_cu > 1) per_cu = 1;
    grid_blocks = (cus * per_cu) & ~7;
    if (grid_blocks < 8) grid_blocks = 8;
  }
  Params p{};
  for (int i = 0; i < 34; ++i) p.in[i] = (const float*)d_in[i];
  p.out = (float*)d_out;
  char* ws = (char*)d_ws;
  size_t off = 0;
  auto take = [&](size_t bytes) { char* q = ws + off; off += (bytes + 255) & ~(size_t)255; return q; };
  p.WtInA = (u16*)take((size_t)NPAD_A * 1024 * 2);
  p.WtOutA = (u16*)take((size_t)1024 * 1536 * 2);
  p.WtInC = (u16*)take((size_t)4096 * 1024 * 2);
  p.WtOutC = (u16*)take((size_t)1024 * 1536 * 2);
  p.WtMem = (u16*)take((size_t)2 * 1024 * 1024 * 2);
  p.xb = (u16*)take((size_t)NTOK * 1024 * 2);
  p.memb = (u16*)take((size_t)1024 * 1024 * 2);
  u16* segs = (u16*)take(SEG * 2 * 11);
  p.Qa = segs; p.Ka = segs + SEG; p.KaT = segs + 2 * SEG; p.VaT = segs + 3 * SEG; p.Ga = segs + 4 * SEG; p.Qb = segs + 5 * SEG;
  p.Kb = segs + 6 * SEG; p.VbT = segs + 7 * SEG; p.Gb = segs + 8 * SEG; p.Qx = segs + 9 * SEG; p.Gx = segs + 10 * SEG;
  p.Ks = (u16*)take((size_t)8 * SKP * 512 * 2);
  p.VsT = (u16*)take((size_t)4096 * SKP * 2);
  p.XK = (u16*)take((size_t)2 * 12 * 256 * 512 * 2);
  p.XVT = (u16*)take((size_t)2 * 12 * 256 * 512 * 2);
  p.C0sT = (u16*)take((size_t)32 * 16384 * 2);
  p.rs0 = (float*)take((size_t)NTOK * 4);
  p.ssq1 = (float*)take((size_t)NTOK * 4);
  p.rsmem = (float*)take((size_t)(1024 + 64) * 4);
  p.gates = (float*)take((size_t)NTOK * 8 * 4);
  p.tabA = (float*)take(2048 * 4);
  p.tabB = (float*)take(2048 * 4);
  p.mtab = (float*)take(16 * 129 * 4);
  p.nhat = (float*)take((size_t)2048 * 128 * 4);
  p.nstate = (float*)take((size_t)2048 * 128 * 4);
  p.kmaxp = (float*)take((size_t)3 * 1024 * 4 + 256);
  if (off > ws_size) { fprintf(stderr, "workspace too small: need %zu have %zu\n", off, ws_size); return; }
  (void)hipMemsetAsync(p.kmaxp + 3 * 1024, 0, 256, stream);
#if MULTI_LAUNCH
  for (int ph = 0; ph < NPHASE; ++ph) {
    hipLaunchKernelGGL(mega, dim3(grid_blocks), dim3(256), LDS_BYTES, stream, p, ph, ph + 1);
  }
#else
  int lo = 0, hi = NPHASE;
  void* args[] = {&p, &lo, &hi};
  hipError_t e = hipLaunchCooperativeKernel((const void*)mega, dim3(grid_blocks), dim3(256), args, LDS_BYTES, stream);
  if (e != hipSuccess) fprintf(stderr, "cooperative launch failed: %s (grid %d)\n", hipGetErrorString(e), grid_blocks);
#endif
}
```

```cpp
#include <hip/hip_runtime.h>
#include <hip/hip_cooperative_groups.h>
#include <stdint.h>
#include <stdio.h>
namespace cg = cooperative_groups;

typedef unsigned short u16;
using bf16x8 = __attribute__((ext_vector_type(8))) short;
using f32x4  = __attribute__((ext_vector_type(4))) float;
using f32x16 = __attribute__((ext_vector_type(16))) float;
using u32x4  = __attribute__((ext_vector_type(4))) unsigned;
using u32x2  = __attribute__((ext_vector_type(2))) unsigned;
#define LAS __attribute__((address_space(3)))
#define DEVI __device__ __forceinline__

constexpr int NTOKP = 32768, NTOKS = 256, NTOK = 33024;
constexpr int SEQ = 8192, LSAMP = 32, PAST = 2048, SKP = 2112;
constexpr size_t SEG = (size_t)NTOK * 512;
constexpr int NPAD_A = 5760;
constexpr float EPS = 1e-6f;
constexpr float LOG2E = 1.4426950408889634f;
constexpr size_t O_YP = 0, O_PXK = 33816576, O_PXV = 34865152, O_PK = 35913728, O_PV = 52690944,
  O_PC = 69468160, O_PN = 69730304, O_PM = 69732352, O_PCONV = 69732368, O_SK = 69855248, O_SV = 69986320,
  O_SC = 70117392, O_SN = 70641680, O_SM = 70645776, O_SCONV = 70645808;

constexpr int LDS_BYTES = 147456;

struct Params {
  const float* in[34];
  float* out;
  u16 *WtInA, *WtOutA, *WtInC, *WtOutC, *WtMem;
  u16 *xb, *memb;
  u16 *Qa, *Ka, *KaT, *VaT, *Ga, *Qb, *Kb, *VbT, *Gb, *Qx, *Gx;
  u16 *Ks, *VsT, *XK, *XVT, *C0sT;
  float *rs0, *ssq1, *rsmem, *gates, *tabA, *tabB, *mtab, *nhat, *nstate, *kmaxp;
};

DEVI unsigned cvtpk(float lo, float hi) { unsigned r; asm volatile("v_cvt_pk_bf16_f32 %0, %1, %2" : "=v"(r) : "v"(lo), "v"(hi)); return r; }
DEVI float bflo(unsigned u) { return __uint_as_float(u << 16); }
DEVI float bfhi(unsigned u) { return __uint_as_float(u & 0xffff0000u); }
DEVI float bf2f(u16 h) { return __uint_as_float(((unsigned)h) << 16); }
DEVI u16 f2bf(float f) { return (u16)(cvtpk(f, 0.f) & 0xffffu); }
DEVI float sigmoidf_(float x) { return 1.f / (1.f + __expf(-x)); }
DEVI float siluf_(float x) { return x / (1.f + __expf(-x)); }
DEVI float logsigmoidf_(float x) { return fminf(x, 0.f) - log1pf(__expf(-fabsf(x))); }
DEVI float wsum(float v) { for (int o = 32; o; o >>= 1) v += __shfl_xor(v, o); return v; }
DEVI float wmax(float v) { for (int o = 32; o; o >>= 1) v = fmaxf(v, __shfl_xor(v, o)); return v; }
DEVI int pi32(int r) { return (r & ~12) | ((r & 4) << 1) | ((r & 8) >> 1); }
DEVI int klocal(int reg, int h) { return (reg & 3) + 4 * ((reg >> 2) & 1) + 8 * h + 16 * (reg >> 3); }
DEVI int crow(int reg, int h) { return (reg & 3) + 8 * (reg >> 2) + 4 * h; }
DEVI bf16x8 ldg8(const u16* p) { return *reinterpret_cast<const bf16x8*>(p); }
DEVI f32x16 mfma32(bf16x8 a, bf16x8 b, f32x16 c) { return __builtin_amdgcn_mfma_f32_32x32x16_bf16(a, b, c, 0, 0, 0); }
DEVI bf16x8 pack8(const f32x16& x, int s) {
  u32x4 w = {cvtpk(x[8 * s + 0], x[8 * s + 1]), cvtpk(x[8 * s + 2], x[8 * s + 3]), cvtpk(x[8 * s + 4], x[8 * s + 5]), cvtpk(x[8 * s + 6], x[8 * s + 7])};
  return *reinterpret_cast<bf16x8*>(&w);
}
DEVI void lds_barrier() { asm volatile("s_waitcnt lgkmcnt(0)" ::: "memory"); __builtin_amdgcn_s_barrier(); asm volatile("" ::: "memory"); }
DEVI void glds16(const void* g, LAS void* l) { __builtin_amdgcn_global_load_lds((const unsigned*)g, (LAS unsigned*)l, 16, 0, 0); }

template <class F>
DEVI void wtrans(u16* dst, const float* src, const float* g, int K, int Npad, int ldn, F srccol, int gtid, int gsz) {
  const int total = Npad * (K / 64);
  for (int i = gtid; i < total; i += gsz) {
    const int n = i % Npad, kb = i / Npad;
    const int sc = srccol(n);
    float v[64];
#pragma unroll
    for (int j = 0; j < 64; ++j) v[j] = (sc >= 0) ? src[(size_t)(kb * 64 + j) * ldn + sc] : 0.f;
    if (g) {
#pragma unroll
      for (int j = 0; j < 64; ++j) v[j] *= g[kb * 64 + j];
    }
#pragma unroll
    for (int q = 0; q < 8; ++q) {
      u32x4 w = {cvtpk(v[8 * q + 0], v[8 * q + 1]), cvtpk(v[8 * q + 2], v[8 * q + 3]), cvtpk(v[8 * q + 4], v[8 * q + 5]), cvtpk(v[8 * q + 6], v[8 * q + 7])};
      *reinterpret_cast<u32x4*>(dst + (size_t)n * K + kb * 64 + q * 8) = w;
    }
  }
}

DEVI int srccol_in_a(int n) {
  const int t = n >> 7, c = n & 127;
  if (t < 12) return n;
  if (t < 20) { const int j = t - 12; return c < 64 ? 1536 + 64 * j + c : 2048 + 64 * j + (c - 64); }
  if (t < 44) return 2568 + (t - 20) * 128 + c;
  if (t == 44) return c < 8 ? 2560 + c : -1;
  return -1;
}
DEVI int srccol_in_c(int n) {
  const int t = n >> 7, c = n & 127;
  if (t < 16) return c < 64 ? 64 * t + c : 1024 + 64 * t + (c - 64);
  return n;
}

DEVI void phase_prep(const Params& p) {
  const int tid = threadIdx.x, lane = tid & 63;
  const int gtid = blockIdx.x * 256 + tid, gsz = gridDim.x * 256;
  const int gwave = gtid >> 6, nwaves = gsz >> 6;
  wtrans(p.WtInA, p.in[12], p.in[11], 1024, NPAD_A, 5640, [](int n) { return srccol_in_a(n); }, gtid, gsz);
  wtrans(p.WtOutA, p.in[23], nullptr, 1536, 1024, 1024, [](int n) { return n; }, gtid, gsz);
  wtrans(p.WtInC, p.in[24], p.in[11] + 1024, 1024, 4096, 4096, [](int n) { return srccol_in_c(n); }, gtid, gsz);
  wtrans(p.WtOutC, p.in[29], nullptr, 1536, 1024, 1024, [](int n) { return n; }, gtid, gsz);
  for (int l = 0; l < 2; ++l)
    wtrans(p.WtMem + (size_t)l * 1024 * 1024, p.in[31] + (size_t)l * 1024 * 1024, p.in[30] + l * 1024, 1024, 1024, 1024,
           [](int n) { return n; }, gtid, gsz);
  for (int row0 = gwave; row0 < NTOK + 1024; row0 += 8 * nwaves) {
    float4 v[8][4];
    const float* xr[8];
#pragma unroll
    for (int u = 0; u < 8; ++u) {
      const int row = min(row0 + u * nwaves, NTOK + 1023);
      xr[u] = row < NTOKP ? p.in[0] + (size_t)row * 1024 : (row < NTOK ? p.in[1] + (size_t)(row - NTOKP) * 1024 : p.in[2] + (size_t)(row - NTOK) * 1024);
    }
#pragma unroll
    for (int u = 0; u < 8; ++u)
#pragma unroll
      for (int i = 0; i < 4; ++i) v[u][i] = reinterpret_cast<const float4*>(xr[u])[lane + 64 * i];
#pragma unroll
    for (int u = 0; u < 8; ++u) {
      const int row = row0 + u * nwaves;
      float ss = 0.f;
#pragma unroll
      for (int i = 0; i < 4; ++i) ss += v[u][i].x * v[u][i].x + v[u][i].y * v[u][i].y + v[u][i].z * v[u][i].z + v[u][i].w * v[u][i].w;
      ss = wsum(ss);
      if (row < NTOK + 1024) {
        u16* dst = row < NTOK ? p.xb + (size_t)row * 1024 : p.memb + (size_t)(row - NTOK) * 1024;
        float* rsd = row < NTOK ? p.rs0 + row : p.rsmem + (row - NTOK);
        if (lane == 0) *rsd = rsqrtf(ss * (1.f / 1024.f) + EPS);
#pragma unroll
        for (int i = 0; i < 4; ++i) { u32x2 w = {cvtpk(v[u][i].x, v[u][i].y), cvtpk(v[u][i].z, v[u][i].w)}; reinterpret_cast<u32x2*>(dst)[lane + 64 * i] = w; }
      }
    }
  }
  float km0 = 0.f, km1 = 0.f, km2 = 0.f;
  for (int i0 = gtid; i0 < 8 * PAST * 64; i0 += 4 * gsz) {
    float4 a[4], c[4];
#pragma unroll
    for (int u = 0; u < 4; ++u) {
      const int i = i0 + u * gsz;
      const int c8 = i & 63, pp = (i >> 6) & (PAST - 1), b = (i >> 17) & 7;
      const float4* sp = reinterpret_cast<const float4*>(p.in[5] + ((size_t)(b * PAST + pp) * 512 + c8 * 8));
      a[u] = sp[0]; c[u] = sp[1];
    }
#pragma unroll
    for (int u = 0; u < 4; ++u) {
      const int i = i0 + u * gsz;
      if (i < 8 * PAST * 64) {
        const int c8 = i & 63, pp = (i >> 6) & (PAST - 1), b = i >> 17;
        u32x4 w = {cvtpk(a[u].x, a[u].y), cvtpk(a[u].z, a[u].w), cvtpk(c[u].x, c[u].y), cvtpk(c[u].z, c[u].w)};
        *reinterpret_cast<u32x4*>(p.Ks + ((size_t)(b * SKP + pp) * 512 + c8 * 8)) = w;
        float ss = a[u].x * a[u].x + a[u].y * a[u].y + a[u].z * a[u].z + a[u].w * a[u].w + c[u].x * c[u].x + c[u].y * c[u].y + c[u].z * c[u].z + c[u].w * c[u].w;
        ss += __shfl_xor(ss, 1); ss += __shfl_xor(ss, 2); ss += __shfl_xor(ss, 4);
        km0 = fmaxf(km0, ss);
      }
    }
  }
  for (int i0 = gtid; i0 < 8 * 4 * 256 * 128; i0 += 4 * gsz) {
    float v[4][8];
#pragma unroll
    for (int u = 0; u < 4; ++u) {
      const int i = (i0 + u * gsz) & (8 * 4 * 256 * 128 - 1);
      const int dv = i & 127, p8 = (i >> 7) & 255, h = (i >> 15) & 3, b = i >> 17;
#pragma unroll
      for (int j = 0; j < 8; ++j) v[u][j] = p.in[6][((size_t)(b * PAST + p8 * 8 + j) * 4 + h) * 128 + dv];
    }
#pragma unroll
    for (int u = 0; u < 4; ++u) {
      const int i = i0 + u * gsz;
      if (i < 8 * 4 * 256 * 128) {
        const int dv = i & 127, p8 = (i >> 7) & 255, h = (i >> 15) & 3, b = i >> 17;
        u32x4 w = {cvtpk(v[u][0], v[u][1]), cvtpk(v[u][2], v[u][3]), cvtpk(v[u][4], v[u][5]), cvtpk(v[u][6], v[u][7])};
        *reinterpret_cast<u32x4*>(p.VsT + ((size_t)((b * 4 + h) * 128 + dv) * SKP + p8 * 8)) = w;
      }
    }
  }
  for (int i = gtid; i < 4096 * 4; i += gsz) {
    u32x4 z = {0, 0, 0, 0};
    *reinterpret_cast<u32x4*>(p.VsT + ((size_t)(i >> 2) * SKP + 2080 + (i & 3) * 8)) = z;
  }
  for (int i = gtid; i < 8 * 32 * 64; i += gsz) {
    u32x4 z = {0, 0, 0, 0};
    const int c8 = i & 63, r = (i >> 6) & 31, b = i >> 11;
    *reinterpret_cast<u32x4*>(p.Ks + ((size_t)(b * SKP + 2080 + r) * 512 + c8 * 8)) = z;
  }
  for (int i = gtid; i < 2 * 8 * 256 * 64; i += gsz) {
    const int c8 = i & 63, m = (i >> 6) & 255, b = (i >> 14) & 7, l = i >> 17;
    const float4* s = reinterpret_cast<const float4*>(p.in[3] + ((size_t)((l * 8 + b) * 256 + m) * 512 + c8 * 8));
    const float4 a = s[0], c = s[1];
    u32x4 w = {cvtpk(a.x, a.y), cvtpk(a.z, a.w), cvtpk(c.x, c.y), cvtpk(c.z, c.w)};
    *reinterpret_cast<u32x4*>(p.XK + ((size_t)((l * 12 + 4 + b) * 256 + m) * 512 + c8 * 8)) = w;
    float ss = a.x * a.x + a.y * a.y + a.z * a.z + a.w * a.w + c.x * c.x + c.y * c.y + c.z * c.z + c.w * c.w;
    ss += __shfl_xor(ss, 1); ss += __shfl_xor(ss, 2); ss += __shfl_xor(ss, 4); ss += __shfl_xor(ss, 8);
    if (l == 0) km1 = fmaxf(km1, ss); else km2 = fmaxf(km2, ss);
  }
  for (int i = gtid; i < 2 * 8 * 4 * 32 * 128; i += gsz) {
    const int dv = i & 127, m8 = (i >> 7) & 31, h = (i >> 12) & 3, b = (i >> 14) & 7, l = i >> 17;
    float v[8];
#pragma unroll
    for (int j = 0; j < 8; ++j) v[j] = p.in[4][((size_t)((l * 8 + b) * 256 + m8 * 8 + j) * 4 + h) * 128 + dv];
    u32x4 w = {cvtpk(v[0], v[1]), cvtpk(v[2], v[3]), cvtpk(v[4], v[5]), cvtpk(v[6], v[7])};
    *reinterpret_cast<u32x4*>(p.XVT + ((size_t)(((l * 12 + 4 + b) * 4 + h) * 128 + dv) * 256 + m8 * 8)) = w;
  }
  for (int i = gtid; i < 32 * 16 * 128; i += gsz) {
    const int e = i & 127, d8 = (i >> 7) & 15, bh = i >> 11;
    float v[8];
#pragma unroll
    for (int j = 0; j < 8; ++j) v[j] = p.in[7][((size_t)bh * 128 + d8 * 8 + j) * 128 + e];
    u32x4 w = {cvtpk(v[0], v[1]), cvtpk(v[2], v[3]), cvtpk(v[4], v[5]), cvtpk(v[6], v[7])};
    *reinterpret_cast<u32x4*>(p.C0sT + ((size_t)bh * 128 + e) * 128 + d8 * 8) = w;
  }
  for (int i = gtid; i < NTOK; i += gsz) p.ssq1[i] = 0.f;
  km0 = wmax(km0); km1 = wmax(km1); km2 = wmax(km2);
  if (lane == 0) {
    const int slot = blockIdx.x * 4 + (tid >> 6);
    p.kmaxp[slot] = km0; p.kmaxp[1024 + slot] = km1; p.kmaxp[2048 + slot] = km2;
  }
}

DEVI void st_bf8(u16* dst, const float (&v)[8]) {
  u32x4 w = {cvtpk(v[0], v[1]), cvtpk(v[2], v[3]), cvtpk(v[4], v[5]), cvtpk(v[6], v[7])};
  *reinterpret_cast<u32x4*>(dst) = w;
}
DEVI void st_f8(float* dst, const float (&v)[8]) {
  reinterpret_cast<float4*>(dst)[0] = float4{v[0], v[1], v[2], v[3]};
  reinterpret_cast<float4*>(dst)[1] = float4{v[4], v[5], v[6], v[7]};
}
DEVI void store_transposed(LAS char* lds, u16* dst, size_t ldt, float scale) {
  const LAS float* Cs = (const LAS float*)lds;
  const int c = threadIdx.x & 127, rh = (threadIdx.x >> 7) * 64;
#pragma unroll
  for (int it = 0; it < 8; ++it) {
    const int r0 = rh + it * 8;
    float v[8];
#pragma unroll
    for (int j = 0; j < 8; ++j) v[j] = Cs[(r0 + j) * 132 + c] * scale;
    st_bf8(dst + (size_t)c * ldt + r0, v);
  }
}

DEVI void epi_in_a(const Params& p, LAS char* lds, int brow, int n, const float (&gn)[8]) {
  const LAS float* Cs = (const LAS float*)lds;
  const int tid = threadIdx.x, cgp = tid & 15, c0 = cgp * 8;
  const bool samp = brow >= NTOKP;
  const int seg = n >> 2, hd = n & 3;
  if (n >= 4 && n < 12) {
    u16* base = (n < 8 ? p.KaT : p.VaT);
    const float sc = (n < 8 ? 0.08838834764831845f : 1.f);
    if (!samp) { const int b = brow >> 13, t0 = brow & 8191; store_transposed(lds, base + ((size_t)(b * 4 + hd) * 128) * SEQ + t0, SEQ, sc); }
    else {
      const int c = tid & 127, rh = (tid >> 7) * 64;
#pragma unroll
      for (int it = 0; it < 8; ++it) {
        const int r0 = rh + it * 8; const int bs = ((brow - NTOKP) + r0) >> 5, t0 = r0 & 31;
        float v[8];
#pragma unroll
        for (int j = 0; j < 8; ++j) v[j] = Cs[(r0 + j) * 132 + c] * sc;
        st_bf8(base + (size_t)NTOKP * 512 + ((size_t)(bs * 4 + hd) * 128 + c) * 32 + t0, v);
      }
    }
  }
  if (seg == 7) {
    if (!samp) { const int b = brow >> 13, t0 = brow & 8191; store_transposed(lds, p.VbT + ((size_t)(b * 4 + hd) * 128) * SEQ + t0, SEQ, 1.f); }
    else {
      const int c = tid & 127, rh = (tid >> 7) * 64;
#pragma unroll
      for (int it = 0; it < 8; ++it) {
        const int r0 = rh + it * 8; const int bs = ((brow - NTOKP) + r0) >> 5, t0 = r0 & 31;
        float v[8];
#pragma unroll
        for (int j = 0; j < 8; ++j) v[j] = Cs[(r0 + j) * 132 + c];
        st_bf8(p.VsT + ((size_t)(bs * 4 + hd) * 128 + c) * SKP + PAST + t0, v);
      }
    }
  }
#pragma unroll 4
  for (int it = 0; it < 8; ++it) {
    const int r = it * 16 + (tid >> 4);
    const size_t grow = (size_t)brow + r;
    float v[8];
#pragma unroll
    for (int j = 0; j < 8; ++j) v[j] = Cs[r * 132 + c0 + j];
    if (n < 4) { st_bf8(p.Qa + grow * 512 + hd * 128 + c0, v); }
    else if (n < 8) {
#pragma unroll
      for (int j = 0; j < 8; ++j) v[j] *= 0.08838834764831845f;
      st_bf8(p.Ka + grow * 512 + hd * 128 + c0, v);
    }
    else if (n < 12) {   }
    else if (n < 20) {
      if (cgp < 8) {
        float g[8];
#pragma unroll
        for (int j = 0; j < 8; ++j) g[j] = sigmoidf_(v[j]) * siluf_(Cs[r * 132 + 64 + c0 + j]);
        st_bf8(p.Ga + grow * 512 + (n - 12) * 64 + c0, g);
      }
    }
    else if (n < 28) {
      float ss = 0.f;
#pragma unroll
      for (int j = 0; j < 8; ++j) ss += v[j] * v[j];
      ss += __shfl_xor(ss, 1); ss += __shfl_xor(ss, 2); ss += __shfl_xor(ss, 4);
      const float rs = rsqrtf(ss * (1.f / 64.f) + EPS);
      const float* g = gn;
      if (n < 24) {
#pragma unroll
        for (int j = 0; j < 8; ++j) v[j] = v[j] * rs * g[j] * (0.125f * LOG2E);
        st_bf8(p.Qb + grow * 512 + hd * 128 + c0, v);
      } else {
#pragma unroll
        for (int j = 0; j < 8; ++j) v[j] = v[j] * rs * g[j];
        if (!samp) { st_f8(p.out + O_PK + grow * 512 + hd * 128 + c0, v); st_bf8(p.Kb + grow * 512 + hd * 128 + c0, v); }
        else {
          const int sr = (int)grow - NTOKP, bs = sr >> 5, t = sr & 31;
          st_f8(p.out + O_SK + (size_t)sr * 512 + hd * 128 + c0, v);
          st_bf8(p.Ks + ((size_t)(bs * SKP + PAST + t)) * 512 + hd * 128 + c0, v);
        }
      }
    }
    else if (n < 32) {
      if (!samp) st_f8(p.out + O_PV + grow * 512 + hd * 128 + c0, v);
      else st_f8(p.out + O_SV + (size_t)((int)grow - NTOKP) * 512 + hd * 128 + c0, v);
    }
    else if (n < 36) {
#pragma unroll
      for (int j = 0; j < 8; ++j) v[j] = siluf_(v[j]);
      st_bf8(p.Gb + grow * 512 + hd * 128 + c0, v);
    }
    else if (n < 40) {
      float ss = 0.f;
#pragma unroll
      for (int j = 0; j < 8; ++j) ss += v[j] * v[j];
      ss += __shfl_xor(ss, 1); ss += __shfl_xor(ss, 2); ss += __shfl_xor(ss, 4); ss += __shfl_xor(ss, 8);
      const float rs = rsqrtf(ss * (1.f / 128.f) + EPS);
      const float* g = gn;
#pragma unroll
      for (int j = 0; j < 8; ++j) v[j] = v[j] * rs * g[j] * (0.08838834764831845f * LOG2E);
      st_bf8(p.Qx + grow * 512 + hd * 128 + c0, v);
    }
    else if (n < 44) {
#pragma unroll
      for (int j = 0; j < 8; ++j) v[j] = siluf_(v[j]);
      st_bf8(p.Gx + grow * 512 + hd * 128 + c0, v);
    }
    else {
      if (cgp == 0) {
        float g[8];
#pragma unroll
        for (int j = 0; j < 4; ++j) { g[j] = v[j] + gn[j]; g[4 + j] = logsigmoidf_(v[4 + j] + gn[4 + j]); }
        st_f8(p.gates + grow * 8, g);
      }
    }
  }
}

DEVI void epi_mem(const Params& p, LAS char* lds, int l, int brow, int n, const float (&gk)[8]) {
  const LAS float* Cs = (const LAS float*)lds;
  const int tid = threadIdx.x, cgp = tid & 15, c0 = cgp * 8;
  const int hd = n & 3;
  if (n >= 4) {
    const int b = brow >> 8, m0 = brow & 255;
    store_transposed(lds, p.XVT + ((size_t)((l * 12 + b) * 4 + hd) * 128) * 256 + m0, 256, 1.f);
  }
#pragma unroll 4
  for (int it = 0; it < 8; ++it) {
    const int r = it * 16 + (tid >> 4);
    const size_t grow = (size_t)brow + r;
    float v[8];
#pragma unroll
    for (int j = 0; j < 8; ++j) v[j] = Cs[r * 132 + c0 + j];
    if (n < 4) {
      float ss = 0.f;
#pragma unroll
      for (int j = 0; j < 8; ++j) ss += v[j] * v[j];
      ss += __shfl_xor(ss, 1); ss += __shfl_xor(ss, 2); ss += __shfl_xor(ss, 4); ss += __shfl_xor(ss, 8);
      const float rs = rsqrtf(ss * (1.f / 128.f) + EPS);
      const float* g = gk;
#pragma unroll
      for (int j = 0; j < 8; ++j) v[j] = v[j] * rs * g[j];
      st_f8(p.out + O_PXK + ((size_t)l * 1024 + grow) * 512 + hd * 128 + c0, v);
      const int b = (int)grow >> 8, m = (int)grow & 255;
      st_bf8(p.XK + ((size_t)((l * 12 + b) * 256 + m)) * 512 + hd * 128 + c0, v);
    } else {
      st_f8(p.out + O_PXV + ((size_t)l * 1024 + grow) * 512 + hd * 128 + c0, v);
    }
  }
}

DEVI void load_resid(const Params& p, int layer, int brow, int n, float4 (&ra)[8], float4 (&rb)[8]) {
  const int tid = threadIdx.x, c0 = (tid & 15) * 8;
#pragma unroll
  for (int it = 0; it < 8; ++it) {
    const size_t grow = (size_t)brow + it * 16 + (tid >> 4);
    const float* res;
    if (layer == 0) res = (grow < NTOKP ? p.in[0] + grow * 1024 : p.in[1] + (grow - NTOKP) * 1024) + n * 128 + c0;
    else res = p.out + grow * 1024 + n * 128 + c0;
    ra[it] = reinterpret_cast<const float4*>(res)[0]; rb[it] = reinterpret_cast<const float4*>(res)[1];
  }
}
DEVI void epi_out(const Params& p, LAS char* lds, int layer, int brow, int n, const float4 (&ra)[8], const float4 (&rb)[8]) {
  const LAS float* Cs = (const LAS float*)lds;
  const int tid = threadIdx.x, cgp = tid & 15, c0 = cgp * 8;
#pragma unroll
  for (int q = 0; q < 8; ++q) {
    const int r = q * 16 + (tid >> 4);
    const size_t grow = (size_t)brow + r;
    float v[8];
#pragma unroll
    for (int j = 0; j < 8; ++j) v[j] = Cs[r * 132 + c0 + j];
    v[0] += ra[q].x; v[1] += ra[q].y; v[2] += ra[q].z; v[3] += ra[q].w; v[4] += rb[q].x; v[5] += rb[q].y; v[6] += rb[q].z; v[7] += rb[q].w;
    st_f8(p.out + grow * 1024 + n * 128 + c0, v);
    if (layer == 0) {
      st_bf8(p.xb + grow * 1024 + n * 128 + c0, v);
      float ss = 0.f;
#pragma unroll
      for (int j = 0; j < 8; ++j) ss += v[j] * v[j];
      ss += __shfl_xor(ss, 1); ss += __shfl_xor(ss, 2); ss += __shfl_xor(ss, 4); ss += __shfl_xor(ss, 8);
      if (cgp == 0) atomicAdd(p.ssq1 + grow, ss);
    }
  }
}

DEVI void epi_in_c(const Params& p, LAS char* lds, int brow, int n, const float (&gx)[8]) {
  const LAS float* Cs = (const LAS float*)lds;
  const int tid = threadIdx.x, cgp = tid & 15, c0 = cgp * 8;
  u16* U = p.Qa;
  u16* Gc = p.KaT;
#pragma unroll 4
  for (int it = 0; it < 8; ++it) {
    const int r = it * 16 + (tid >> 4);
    const size_t grow = (size_t)brow + r;
    float v[8];
#pragma unroll
    for (int j = 0; j < 8; ++j) v[j] = Cs[r * 132 + c0 + j];
    if (n < 16) {
      if (cgp < 8) {
        float u[8];
#pragma unroll
        for (int j = 0; j < 8; ++j) u[j] = v[j] * sigmoidf_(Cs[r * 132 + 64 + c0 + j]);
        st_bf8(U + grow * 1024 + n * 64 + c0, u);
        if (grow < NTOKP) { const int t = (int)grow & 8191, b = (int)grow >> 13; if (t >= SEQ - 30) st_f8(p.out + O_PCONV + ((size_t)(b * 30 + t - (SEQ - 30))) * 1024 + n * 64 + c0, u); }
        else { const int sr = (int)grow - NTOKP, t = sr & 31, b = sr >> 5; if (t >= 2) st_f8(p.out + O_SCONV + ((size_t)(b * 30 + t - 2)) * 1024 + n * 64 + c0, u); }
      }
    } else if (n < 24) {
#pragma unroll
      for (int j = 0; j < 8; ++j) v[j] = siluf_(v[j]);
      st_bf8(Gc + grow * 1024 + (n - 16) * 128 + c0, v);
    } else if (n < 28) {
      float ss = 0.f;
#pragma unroll
      for (int j = 0; j < 8; ++j) ss += v[j] * v[j];
      ss += __shfl_xor(ss, 1); ss += __shfl_xor(ss, 2); ss += __shfl_xor(ss, 4); ss += __shfl_xor(ss, 8);
      const float rs = rsqrtf(ss * (1.f / 128.f) + EPS);
      const float* g = gx;
#pragma unroll
      for (int j = 0; j < 8; ++j) v[j] = v[j] * rs * g[j] * (0.08838834764831845f * LOG2E);
      st_bf8(p.Qx + grow * 512 + (n - 24) * 128 + c0, v);
    } else {
#pragma unroll
      for (int j = 0; j < 8; ++j) v[j] = siluf_(v[j]);
      st_bf8(p.Gx + grow * 512 + (n - 28) * 128 + c0, v);
    }
  }
}

DEVI void gemm_core(LAS char* lds, const u16* A0, const u16* A1, const u16* A2, int lda0, int lda1, int lda2, int segK,
                    const u16* Bt, int K, int brow, int bcol, f32x16 (&acc)[4][2]) {
  const int tid = threadIdx.x, lane = tid & 63, w = tid >> 6, wr = w >> 1, wc = w & 1, r = lane & 31, h = lane >> 5;
#pragma unroll
  for (int i = 0; i < 4; ++i)
#pragma unroll
    for (int j = 0; j < 2; ++j)
#pragma unroll
      for (int e = 0; e < 16; ++e) acc[i][j][e] = 0.f;
  const int nkt = K / 64;
  auto stage_part = [=](int kt, int buf, int part) __attribute__((always_inline)) {
    const int k0 = kt * 64;
    const int seg = k0 / segK;
    const u16* Ab = (seg == 0 ? A0 : (seg == 1 ? A1 : A2)) + (k0 - seg * segK);
    const int lda = (seg == 0 ? lda0 : (seg == 1 ? lda1 : lda2));
    LAS char* sa = lds + buf * 49152;
    LAS char* sb = sa + 32768;
#pragma unroll
    for (int q = 0; q < 2; ++q) {
      const int i = 2 * part + q;
      const int pch = i * 256 + tid, row = pch >> 3, lg = (pch & 7) ^ ((row >> 1) & 7);
      glds16(Ab + (size_t)(brow + row) * lda + lg * 8, sa + pch * 16);
    }
    {
      const int pch = part * 256 + tid, row = pch >> 3, lg = (pch & 7) ^ ((row >> 1) & 7);
      glds16(Bt + (size_t)(bcol + row) * K + k0 + lg * 8, sb + pch * 16);
    }
  };
  lds_barrier();
#pragma unroll
  for (int part = 0; part < 4; ++part) stage_part(0, 0, part);
#pragma unroll
  for (int part = 0; part < 4; ++part) stage_part(1, 1, part);
  int buf = 0;
#pragma unroll 2
  for (int kt = 0; kt < nkt; ++kt) {
    if (kt + 1 < nkt) asm volatile("s_waitcnt vmcnt(12)" ::: "memory"); else asm volatile("s_waitcnt vmcnt(0)" ::: "memory");
    asm volatile("s_waitcnt lgkmcnt(0)" ::: "memory");
    __builtin_amdgcn_s_barrier();
    int nb = buf + 2; if (nb >= 3) nb -= 3;
    const bool more = kt + 2 < nkt;
    const LAS char* sa = lds + buf * 49152;
    const LAS char* sb = sa + 32768;
    bf16x8 af[2][4], bfr[2][2];
#pragma unroll
    for (int i = 0; i < 4; ++i) {
      const int row = 32 * (2 * i + wr) + r, ch = h ^ ((row >> 1) & 7);
      af[0][i] = *reinterpret_cast<const LAS bf16x8*>(sa + row * 128 + ch * 16);
    }
#pragma unroll
    for (int j = 0; j < 2; ++j) {
      const int row = 32 * (2 * j + wc) + r, ch = h ^ ((row >> 1) & 7);
      bfr[0][j] = *reinterpret_cast<const LAS bf16x8*>(sb + row * 128 + ch * 16);
    }
#pragma unroll
    for (int ks = 0; ks < 4; ++ks) {
      const int cur = ks & 1, nxt = cur ^ 1;
      if (ks < 3) {
#pragma unroll
        for (int i = 0; i < 4; ++i) {
          const int row = 32 * (2 * i + wr) + r, ch = (2 * (ks + 1) + h) ^ ((row >> 1) & 7);
          af[nxt][i] = *reinterpret_cast<const LAS bf16x8*>(sa + row * 128 + ch * 16);
        }
#pragma unroll
        for (int j = 0; j < 2; ++j) {
          const int row = 32 * (2 * j + wc) + r, ch = (2 * (ks + 1) + h) ^ ((row >> 1) & 7);
          bfr[nxt][j] = *reinterpret_cast<const LAS bf16x8*>(sb + row * 128 + ch * 16);
        }
      }
#pragma unroll
      for (int i = 0; i < 2; ++i)
#pragma unroll
        for (int j = 0; j < 2; ++j) acc[i][j] = mfma32(af[cur][i], bfr[cur][j], acc[i][j]);
      if (more) stage_part(kt + 2, nb, ks);
#pragma unroll
      for (int i = 2; i < 4; ++i)
#pragma unroll
        for (int j = 0; j < 2; ++j) acc[i][j] = mfma32(af[cur][i], bfr[cur][j], acc[i][j]);
    }
    if (++buf == 3) buf = 0;
  }
}

DEVI void stage_all(LAS char* lds, const f32x16 (&acc)[4][2], bool scaled) {
  const int tid = threadIdx.x, lane = tid & 63, w = tid >> 6, wr = w >> 1, wc = w & 1, r = lane & 31, h = lane >> 5;
  const LAS float* RS = (const LAS float*)(lds + 135168);
#pragma unroll
  for (int i = 0; i < 4; ++i) {
    LAS float* Cs = (LAS float*)(lds + (i >> 1) * 67584);
#pragma unroll
    for (int e = 0; e < 16; ++e) {
      const int row = 32 * (2 * (i & 1) + wr) + crow(e, h);
      const float s = scaled ? RS[128 * (i >> 1) + row] : 1.f;
#pragma unroll
      for (int jj = 0; jj < 2; ++jj) Cs[row * 132 + 32 * (2 * jj + wc) + r] = acc[i][jj][e] * s;
    }
  }
}

DEVI void gemm_tile_run(const Params& p, LAS char* lds, int which, int aux, int mt, int n, f32x16 (&acc)[4][2]) {
  const int brow = mt * 256, bcol = n * 128;
  const float* rsc = nullptr; int mode = 0;
  if (which == 0) { gemm_core(lds, p.xb, p.xb, p.xb, 1024, 1024, 1024, 1024, p.WtInA, 1024, brow, bcol, acc); rsc = p.rs0; mode = 1; }
  else if (which == 1) gemm_core(lds, p.Ga, p.Gb, p.Gx, 512, 512, 512, 512, p.WtOutA, 1536, brow, bcol, acc);
  else if (which == 2) { gemm_core(lds, p.xb, p.xb, p.xb, 1024, 1024, 1024, 1024, p.WtInC, 1024, brow, bcol, acc); rsc = p.ssq1; mode = 2; }
  else if (which == 3) gemm_core(lds, p.KaT, p.KaT + 512, p.Gx, 1024, 1024, 512, 512, p.WtOutC, 1536, brow, bcol, acc);
  else { gemm_core(lds, p.memb, p.memb, p.memb, 1024, 1024, 1024, 1024, p.WtMem + (size_t)aux * 1024 * 1024, 1024, brow, bcol, acc); rsc = p.rsmem; mode = 1; }
  lds_barrier();
  if (mode) {
    float sc = rsc[brow + threadIdx.x];
    if (mode == 2) sc = rsqrtf(sc * (1.f / 1024.f) + EPS);
    ((LAS float*)(lds + 135168))[threadIdx.x] = sc;
    lds_barrier();
  }
  if (which == 1 || which == 3) {
    float4 ra0[8], rb0[8], ra1[8], rb1[8];
    load_resid(p, which == 1 ? 0 : 1, brow, n, ra0, rb0);
    load_resid(p, which == 1 ? 0 : 1, brow + 128, n, ra1, rb1);
    stage_all(lds, acc, false);
    lds_barrier();
    epi_out(p, lds, which == 1 ? 0 : 1, brow, n, ra0, rb0);
    epi_out(p, lds + 67584, which == 1 ? 0 : 1, brow + 128, n, ra1, rb1);
    return;
  }
  float gpre[8];
  {
    const int c0 = (threadIdx.x & 15) * 8;
    const float* gp = nullptr;
    if (which == 0) {
      if (n >= 20 && n < 24) gp = p.in[16] + (c0 & 63);
      else if (n >= 24 && n < 28) gp = p.in[17] + (c0 & 63);
      else if (n >= 36 && n < 40) gp = p.in[32] + c0;
    } else if (which == 2) gp = p.in[32] + 128 + c0;
    else gp = p.in[33] + aux * 128 + c0;
#pragma unroll
    for (int j = 0; j < 8; ++j) gpre[j] = gp ? gp[j] : 0.f;
    if (which == 0 && n == 44) {
#pragma unroll
      for (int j = 0; j < 4; ++j) { gpre[j] = p.in[13][j]; gpre[4 + j] = p.in[14][j]; }
    }
  }
  stage_all(lds, acc, mode != 0);
  lds_barrier();
#pragma unroll 1
  for (int sub = 0; sub < 2; ++sub) {
    LAS char* cs = lds + sub * 67584;
    const int sr = brow + 128 * sub;
    if (which == 0) epi_in_a(p, cs, sr, n, gpre);
    else if (which == 2) epi_in_c(p, cs, sr, n, gpre);
    else epi_mem(p, cs, aux, sr, n, gpre);
  }
}

template <int which>
DEVI void phase_gemm(const Params& p, LAS char* lds) {
  constexpr int nN = (which == 0 ? 45 : (which == 2 ? 32 : 8));
  constexpr int ntiles = 128 * nN;
  const int G = gridDim.x;
  const int xcd = blockIdx.x & 7, lb = blockIdx.x >> 3, slots = G >> 3;
  f32x16 acc[4][2];
  int round = 0, t_extra = blockIdx.x, t_mem = G - 1 - (int)blockIdx.x;
  if (which == 0 && G == 256) {
    const int idx = (xcd >= 4) ? lb * 4 + (xcd - 4) : 1 << 20;
    t_extra = idx < 45 ? idx : 1 << 20;
    t_mem = (idx >= 45 && idx < 109) ? idx - 45 : 1 << 20;
  }
  bool main_done = false;
  for (;;) {
    int mt, n;
    if (!main_done) {
      const int q = lb + slots * round; ++round;
      const int L = 32 * (xcd + 8 * (q >> 5)) + (q & 31);
      if (L >= ntiles) { main_done = true; continue; }
      const int mg = L / (4 * nN), rem = L - mg * 4 * nN;
      n = rem >> 2; mt = mg * 4 + (rem & 3);
    } else {
      if (t_extra >= nN) break;
      mt = 128; n = t_extra; t_extra += G;
    }
    gemm_tile_run(p, lds, which, 0, mt, n, acc);
  }
  if (which == 0) {
    for (int t = t_mem; t < 64; t += G) gemm_tile_run(p, lds, 4, t >> 5, (t >> 3) & 3, t & 7, acc);
  }
}

template <bool DIFF>
DEVI void attn_block(LAS char* lds, const u16* Q, const u16* Kg, const u16* VT, int ldv, int j0, int ntiles, int nwact,
                           int qpos0, int nkeys, float slope2, float M2, float lam, const float* subg, u16* G) {
  const int tid = threadIdx.x, lane = tid & 63, w = tid >> 6, r = lane & 31, h = lane >> 5;
  const bool act = w < nwact;
  const int qpos = qpos0 + 32 * w + r;
  const int cw = (qpos0 + 32 * w) >> 6;
  bf16x8 qf[8];
#pragma unroll
  for (int i = 0; i < 8; ++i) qf[i] = ldg8(Q + (size_t)(32 * w + r) * 512 + 16 * i + 8 * h);
  f32x16 O0[4], O1[4];
#pragma unroll
  for (int e = 0; e < 4; ++e)
#pragma unroll
    for (int i = 0; i < 16; ++i) { O0[e][i] = 0.f; O1[e][i] = 0.f; }
  float l0 = 0.f, l1 = 0.f;
  f32x16 cinit, zero16;
#pragma unroll
  for (int i = 0; i < 16; ++i) { cinit[i] = slope2 * (float)klocal(i, h); zero16[i] = 0.f; }
  const float tq = -slope2 * (float)qpos - M2;
  const int prow = pi32(r);

  auto stage = [=](int j, int buf) __attribute__((always_inline)) {
    LAS char* kb = lds + buf * 32768;
#pragma unroll
    for (int i = 0; i < 4; ++i) {
      const int pch = i * 256 + tid;
      { const int row = pch >> 4, ph = pch & 15, lg = ph ^ (row & 15);
        glds16(Kg + (size_t)(j * 64 + row) * 512 + lg * 8, kb + pch * 16); }
      { const int row = pch >> 3, ph = pch & 7, lg = ph ^ ((row >> 1) & 7);
        glds16(VT + (size_t)row * ldv + j * 64 + lg * 8, kb + 16384 + pch * 16); }
    }
  };
  lds_barrier();
  stage(j0, 0);
  asm volatile("s_waitcnt vmcnt(0)" ::: "memory");
  __syncthreads();
  for (int j = j0; j < ntiles; ++j) {
    const int buf = (j - j0) & 1;
    if (j + 1 < ntiles) stage(j + 1, buf ^ 1);
    {
      const LAS char* kb = lds + buf * 32768;
      const LAS char* vb = kb + 16384;
      const bool fast = DIFF && (j < cw);
#pragma unroll
      for (int kt = 0; kt < 2; ++kt) {
        const int krow = 32 * kt + prow;
        const LAS char* krp = kb + krow * 256;
        bf16x8 P0[2], P1[2];
        if (DIFF) {
#pragma unroll
          for (int c = 0; c < 2; ++c) {
            f32x16 s;
            if (fast) {
              s = cinit;
#pragma unroll
              for (int ks = 0; ks < 4; ++ks) {
                const int ch = (2 * (4 * c + ks) + h) ^ (krow & 15);
                s = mfma32(*reinterpret_cast<const LAS bf16x8*>(krp + ch * 16), qf[4 * c + ks], s);
              }
              const float t = tq + slope2 * (float)(j * 64 + kt * 32);
#pragma unroll
              for (int i = 0; i < 16; ++i) s[i] = __builtin_amdgcn_exp2f(s[i] + t);
            } else {
              s = zero16;
#pragma unroll
              for (int ks = 0; ks < 4; ++ks) {
                const int ch = (2 * (4 * c + ks) + h) ^ (krow & 15);
                s = mfma32(*reinterpret_cast<const LAS bf16x8*>(krp + ch * 16), qf[4 * c + ks], s);
              }
#pragma unroll
              for (int i = 0; i < 16; ++i) {
                const int kp = j * 64 + kt * 32 + klocal(i, h);
                const float bias = -slope2 * fabsf((float)(qpos - kp)) - M2;
                s[i] = (kp < nkeys && j <= cw) ? __builtin_amdgcn_exp2f(s[i] + bias) : 0.f;
              }
            }
            float ls = 0.f;
#pragma unroll
            for (int i = 0; i < 16; ++i) ls += s[i];
            if (c == 0) { l0 += ls; P0[0] = pack8(s, 0); P0[1] = pack8(s, 1); }
            else        { l1 += ls; P1[0] = pack8(s, 0); P1[1] = pack8(s, 1); }
          }
        } else {
          f32x16 s = zero16;
#pragma unroll
          for (int ks = 0; ks < 8; ++ks) {
            const int ch = (2 * ks + h) ^ (krow & 15);
            s = mfma32(*reinterpret_cast<const LAS bf16x8*>(krp + ch * 16), qf[ks], s);
          }
          float ls = 0.f;
#pragma unroll
          for (int i = 0; i < 16; ++i) { s[i] = __builtin_amdgcn_exp2f(s[i] - M2); ls += s[i]; }
          l0 += ls; P0[0] = pack8(s, 0); P0[1] = pack8(s, 1);
        }
#pragma unroll
        for (int et = 0; et < 4; ++et) {
          const int vrow = 32 * et + r;
#pragma unroll
          for (int sp = 0; sp < 2; ++sp) {
            const int ch = (2 * (2 * kt + sp) + h) ^ ((vrow >> 1) & 7);
            const bf16x8 vf = *reinterpret_cast<const LAS bf16x8*>(vb + vrow * 128 + ch * 16);
            O0[et] = mfma32(vf, P0[sp], O0[et]);
            if (DIFF) O1[et] = mfma32(vf, P1[sp], O1[et]);
          }
        }
      }
    }
    asm volatile("s_waitcnt vmcnt(0)" ::: "memory");
    __syncthreads();
  }
  if (act) {
    l0 += __shfl_xor(l0, 32);
    const float i0 = 1.f / l0;
    float i1 = 0.f;
    if (DIFF) { l1 += __shfl_xor(l1, 32); i1 = lam / l1; }
    float ss = 0.f;
#pragma unroll
    for (int et = 0; et < 4; ++et)
#pragma unroll
      for (int i = 0; i < 16; ++i) {
        float o = O0[et][i] * i0;
        if (DIFF) o -= O1[et][i] * i1;
        O0[et][i] = o; ss += o * o;
      }
    float rs = 1.f;
    if (DIFF) { ss += __shfl_xor(ss, 32); rs = rsqrtf(ss * (1.f / 128.f) + EPS) * 0.8f; }
    u16* grow = G + (size_t)(32 * w + r) * 512;
    u32x2 gt[16]; float4 sv[16];
#pragma unroll
    for (int q = 0; q < 16; ++q) {
      const int e0 = 32 * (q >> 2) + 8 * (q & 3) + 4 * h;
      gt[q] = *reinterpret_cast<const u32x2*>(grow + e0);
      if (DIFF) sv[q] = *reinterpret_cast<const float4*>(subg + e0); else sv[q] = float4{1.f, 1.f, 1.f, 1.f};
    }
#pragma unroll
    for (int q = 0; q < 16; ++q) {
      const int et = q >> 2, g = q & 3;
      const int e0 = 32 * et + 8 * g + 4 * h;
      const float a0 = O0[et][4 * g + 0] * rs * sv[q].x * bflo(gt[q][0]);
      const float a1 = O0[et][4 * g + 1] * rs * sv[q].y * bfhi(gt[q][0]);
      const float a2 = O0[et][4 * g + 2] * rs * sv[q].z * bflo(gt[q][1]);
      const float a3 = O0[et][4 * g + 3] * rs * sv[q].w * bfhi(gt[q][1]);
      u32x2 o = {cvtpk(a0, a1), cvtpk(a2, a3)};
      *reinterpret_cast<u32x2*>(grow + e0) = o;
    }
  }
}

DEVI float max_abs64(const float* g, int n, int lane) { float v = 0.f; for (int i = lane; i < n; i += 64) v = fmaxf(v, fabsf(g[i])); return wmax(v); }

DEVI float scan_add(float v, int lane) { for (int o = 1; o < 64; o <<= 1) { const float t = __shfl_up(v, o); if (lane >= o) v += t; } return v; }
DEVI float scan_max(float v, int lane) { for (int o = 1; o < 64; o <<= 1) { const float t = __shfl_up(v, o); if (lane >= o) v = fmaxf(v, t); } return v; }
DEVI float bfe(const bf16x8& v, int j) { return __uint_as_float(((unsigned)(u16)v[j]) << 16); }

template <int NT>
DEVI void mlstm_local(LAS char* lds, const float* gates, int hd, const u16* KT, const u16* VT, int ldt,
                            f32x16 (&acc)[4], float& nh, float& bL, float& amax) {
  const int tid = threadIdx.x, lane = tid & 63, w = tid >> 6, r = lane & 31, h = lane >> 5;
  constexpr int L = 32 * NT;
  const float lf = lane < L ? gates[lane * 8 + 4 + hd] : 0.f;
  const float ig = lane < L ? gates[lane * 8 + hd] : -INFINITY;
  const float b = scan_add(lf, lane);
  const float a = ig - b;
  amax = wmax(a);
  bL = __shfl(b, L - 1);
  LAS float* wt = (LAS float*)(lds + 4096) + w * 64;
  wt[lane] = __expf(a - amax);
#pragma unroll
  for (int e = 0; e < 4; ++e)
#pragma unroll
    for (int i = 0; i < 16; ++i) acc[e][i] = 0.f;
  nh = 0.f;
  bf16x8 kfa[2 * NT], vfa[2 * NT][4];
#pragma unroll
  for (int ks = 0; ks < 2 * NT; ++ks) {
    kfa[ks] = ldg8(KT + (size_t)(32 * w + r) * ldt + 16 * ks + 8 * h);
#pragma unroll
    for (int et = 0; et < 4; ++et) vfa[ks][et] = ldg8(VT + (size_t)(32 * et + r) * ldt + 16 * ks + 8 * h);
  }
#pragma unroll
  for (int ks = 0; ks < 2 * NT; ++ks) {
    const bf16x8 kf = kfa[ks];
    float wv[8];
#pragma unroll
    for (int j = 0; j < 8; ++j) { wv[j] = wt[16 * ks + 8 * h + j]; nh += bfe(kf, j) * wv[j]; }
#pragma unroll
    for (int et = 0; et < 4; ++et) {
      const bf16x8 vf = vfa[ks][et];
      u32x4 sv = {cvtpk(bfe(vf, 0) * wv[0], bfe(vf, 1) * wv[1]), cvtpk(bfe(vf, 2) * wv[2], bfe(vf, 3) * wv[3]),
                  cvtpk(bfe(vf, 4) * wv[4], bfe(vf, 5) * wv[5]), cvtpk(bfe(vf, 6) * wv[6], bfe(vf, 7) * wv[7])};
      acc[et] = mfma32(kf, *reinterpret_cast<bf16x8*>(&sv), acc[et]);
    }
  }
  nh += __shfl_xor(nh, 32);
}

template <int NT>
DEVI void mlstm_out(LAS char* lds, const float* gates, int hd, const u16* Qg, const u16* Kg, const u16* VT, int ldv,
                          const u16* CT, const float* n0, float m0, const float* mg, u16* G) {
  const int tid = threadIdx.x, lane = tid & 63, w = tid >> 6, r = lane & 31, h = lane >> 5;
  constexpr int L = 32 * NT;
  const float lf = lane < L ? gates[lane * 8 + 4 + hd] : 0.f;
  const float ig = lane < L ? gates[lane * 8 + hd] : -INFINITY;
  const float b = scan_add(lf, lane);
  const float a = ig - b;
  const float Mrow = fmaxf(m0, scan_max(a, lane));
  const float mt = b + Mrow;
  LAS float* at = (LAS float*)lds + w * 64;
  LAS float* red = (LAS float*)(lds + 1024);
  at[lane] = a;
  const int prow = pi32(r);
#pragma unroll 1
  for (int tt = 0; tt < NT; ++tt) {
    const int t = 32 * tt + r;
    const float Mrow_t = __shfl(Mrow, t), mt_t = __shfl(mt, t);
    const float winter = __expf(m0 - Mrow_t);
    bf16x8 qf[8], cfa[8], kfa[NT][8], vfa[NT][2];
    float4 na[8], nb[8];
#pragma unroll
    for (int i = 0; i < 8; ++i) {
      qf[i] = ldg8(Qg + (size_t)t * 512 + 16 * i + 8 * h);
      na[i] = *reinterpret_cast<const float4*>(n0 + 16 * i + 8 * h); nb[i] = *reinterpret_cast<const float4*>(n0 + 16 * i + 8 * h + 4);
      cfa[i] = ldg8(CT + (size_t)(32 * w + r) * 128 + 16 * i + 8 * h);
    }
#pragma unroll
    for (int st = 0; st < NT; ++st) {
      const int sc = st <= tt ? st : tt;
#pragma unroll
      for (int ks = 0; ks < 8; ++ks) kfa[st][ks] = ldg8(Kg + (size_t)(32 * sc + prow) * 512 + 16 * ks + 8 * h);
#pragma unroll
      for (int sp = 0; sp < 2; ++sp) vfa[st][sp] = ldg8(VT + (size_t)(32 * w + r) * ldv + 32 * sc + 16 * sp + 8 * h);
    }
    float qn = 0.f;
#pragma unroll
    for (int i = 0; i < 8; ++i) {
      qn += bfe(qf[i], 0) * na[i].x + bfe(qf[i], 1) * na[i].y + bfe(qf[i], 2) * na[i].z + bfe(qf[i], 3) * na[i].w
          + bfe(qf[i], 4) * nb[i].x + bfe(qf[i], 5) * nb[i].y + bfe(qf[i], 6) * nb[i].z + bfe(qf[i], 7) * nb[i].w;
    }
    qn += __shfl_xor(qn, 32);
    f32x16 H;
#pragma unroll
    for (int i = 0; i < 16; ++i) H[i] = 0.f;
#pragma unroll
    for (int ks = 0; ks < 8; ++ks) H = mfma32(cfa[ks], qf[ks], H);
#pragma unroll
    for (int i = 0; i < 16; ++i) H[i] *= winter;
    float dsum = 0.f;
#pragma unroll
    for (int st = 0; st < NT; ++st) {
      if (st <= tt) {
        f32x16 S;
#pragma unroll
        for (int i = 0; i < 16; ++i) S[i] = 0.f;
#pragma unroll
        for (int ks = 0; ks < 8; ++ks) S = mfma32(kfa[st][ks], qf[ks], S);
#pragma unroll
        for (int i = 0; i < 16; ++i) {
          const int s_ = 32 * st + klocal(i, h);
          const float wg = (s_ <= t) ? __expf(at[s_] - Mrow_t) : 0.f;
          S[i] *= wg; dsum += S[i];
        }
#pragma unroll
        for (int sp = 0; sp < 2; ++sp) H = mfma32(vfa[st][sp], pack8(S, sp), H);
      }
    }
    dsum += __shfl_xor(dsum, 32);
    const float den = winter * qn + dsum;
    const float inv = 1.f / fmaxf(fabsf(den), __expf(-mt_t));
    float ss = 0.f;
#pragma unroll
    for (int i = 0; i < 16; ++i) { H[i] *= inv; ss += H[i] * H[i]; }
    ss += __shfl_xor(ss, 32);
    if (h == 0) red[w * 64 + t] = ss;
    lds_barrier();
    const float tot = red[t] + red[64 + t] + red[128 + t] + red[192 + t];
    const float rs = rsqrtf(tot * (1.f / 128.f) + EPS);
    u16* grow = G + (size_t)t * 512;
    u32x2 gt[4]; float4 mv[4];
#pragma unroll
    for (int g = 0; g < 4; ++g) {
      const int e0 = 32 * w + 8 * g + 4 * h;
      gt[g] = *reinterpret_cast<const u32x2*>(grow + e0);
      mv[g] = *reinterpret_cast<const float4*>(mg + e0);
    }
#pragma unroll
    for (int g = 0; g < 4; ++g) {
      const int e0 = 32 * w + 8 * g + 4 * h;
      u32x2 o = {cvtpk(H[4 * g + 0] * rs * mv[g].x * bflo(gt[g][0]), H[4 * g + 1] * rs * mv[g].y * bfhi(gt[g][0])),
                 cvtpk(H[4 * g + 2] * rs * mv[g].z * bflo(gt[g][1]), H[4 * g + 3] * rs * mv[g].w * bfhi(gt[g][1]))};
      *reinterpret_cast<u32x2*>(grow + e0) = o;
    }
    lds_barrier();
  }
}

DEVI void m1_item(const Params& p, LAS char* lds, int item) {
  const int tid = threadIdx.x, lane = tid & 63, w = tid >> 6, r = lane & 31, h = lane >> 5;
  const int bh = item >> 7, c = item & 127, b = bh >> 2, hd = bh & 3;
  const size_t row0 = (size_t)b * SEQ + c * 64;
  f32x16 acc[4]; float nh, bL, amax;
  lds_barrier();
  mlstm_local<2>(lds, p.gates + row0 * 8, hd, p.KaT + (size_t)bh * 128 * SEQ + c * 64, p.VaT + (size_t)bh * 128 * SEQ + c * 64, SEQ, acc, nh, bL, amax);
  u16* Chat = p.xb + ((size_t)item * 128) * 128;
#pragma unroll
  for (int et = 0; et < 4; ++et)
#pragma unroll
    for (int g = 0; g < 4; ++g) {
      const int d0 = 32 * w + 8 * g + 4 * h, e = 32 * et + r;
      u32x2 o = {cvtpk(acc[et][4 * g], acc[et][4 * g + 1]), cvtpk(acc[et][4 * g + 2], acc[et][4 * g + 3])};
      *reinterpret_cast<u32x2*>(Chat + (size_t)e * 128 + d0) = o;
    }
  if (h == 0) p.nhat[(size_t)item * 128 + 32 * w + r] = nh;
  if (tid == 0) { p.tabA[item] = bL; p.tabB[item] = bL + amax; }
}

DEVI void phase_scan(const Params& p, LAS char* lds) {
  const int tid = threadIdx.x, lane = tid & 63;
  LAS float* al = (LAS float*)lds; LAS float* be = al + 128; LAS float* ms = al + 256;
  for (int u = blockIdx.x; u < 16 * 32; u += gridDim.x) {
    const int bh = u >> 5, part = u & 31;
    __syncthreads();
    if (tid < 64) {
      const float A0 = p.tabA[bh * 128 + 2 * lane], A1 = p.tabA[bh * 128 + 2 * lane + 1];
      const float B0 = p.tabB[bh * 128 + 2 * lane], B1 = p.tabB[bh * 128 + 2 * lane + 1];
      const float SAi = scan_add(A0 + A1, lane);
      const float SA0 = SAi - A1, SA1 = SAi;
      const float D0 = B0 - SA0, D1 = B1 - SA1;
      const float PMi = scan_max(fmaxf(D0, D1), lane);
      float PMx = __shfl_up(PMi, 1); if (lane == 0) PMx = -INFINITY;
      const float mn0 = SA0 + fmaxf(0.f, fmaxf(PMx, D0));
      const float mn1 = SA1 + fmaxf(0.f, PMi);
      float mprev = __shfl_up(mn1, 1); if (lane == 0) mprev = 0.f;
      al[2 * lane] = __expf(A0 + mprev - mn0); be[2 * lane] = __expf(B0 - mn0);
      al[2 * lane + 1] = __expf(A1 + mn0 - mn1); be[2 * lane + 1] = __expf(B1 - mn1);
      ms[2 * lane] = mprev; ms[2 * lane + 1] = mn0;
      if (lane == 63) ms[128] = mn1;
    }
    __syncthreads();
    if (part == 0) {
      if (tid < 129) p.mtab[bh * 129 + tid] = ms[tid];
      if (tid == 0) p.out[O_PM + bh] = ms[128];
    }
    u16* base = p.xb + (size_t)bh * 128 * 16384 + part * 512 + tid * 2;
    float c0 = 0.f, c1 = 0.f;
    for (int c = 0; c < 128; c += 8) {
      unsigned v[8];
#pragma unroll
      for (int j = 0; j < 8; ++j) v[j] = *reinterpret_cast<const unsigned*>(base + (size_t)(c + j) * 16384);
#pragma unroll
      for (int j = 0; j < 8; ++j) {
        *reinterpret_cast<unsigned*>(base + (size_t)(c + j) * 16384) = cvtpk(c0, c1);
        const float a_ = al[c + j], b_ = be[c + j];
        c0 = a_ * c0 + b_ * bflo(v[j]); c1 = a_ * c1 + b_ * bfhi(v[j]);
      }
    }
    { const int idx = part * 512 + tid * 2, e = idx >> 7, d = idx & 127;
      p.out[O_PC + ((size_t)bh * 128 + d) * 128 + e] = c0;
      p.out[O_PC + ((size_t)bh * 128 + d + 1) * 128 + e] = c1; }
    if (part == 0 && tid < 128) {
      float n = 0.f;
      for (int c = 0; c < 128; c += 16) {
        float nv[16];
#pragma unroll
        for (int j = 0; j < 16; ++j) nv[j] = p.nhat[((size_t)bh * 128 + c + j) * 128 + tid];
#pragma unroll
        for (int j = 0; j < 16; ++j) {
          p.nstate[((size_t)bh * 128 + c + j) * 128 + tid] = n;
          n = al[c + j] * n + be[c + j] * nv[j];
        }
      }
      p.out[O_PN + bh * 128 + tid] = n;
    }
  }
}

DEVI void m3_item(const Params& p, LAS char* lds, int item) {
  const int bh = item >> 7, c = item & 127, b = bh >> 2, hd = bh & 3;
  const size_t row0 = (size_t)b * SEQ + c * 64;
  lds_barrier();
  mlstm_out<2>(lds, p.gates + row0 * 8, hd, p.Qa + row0 * 512 + hd * 128, p.Ka + row0 * 512 + hd * 128,
               p.VaT + (size_t)bh * 128 * SEQ + c * 64, SEQ, p.xb + (size_t)item * 16384, p.nstate + (size_t)item * 128,
               p.mtab[bh * 129 + c], p.in[15] + hd * 128, p.Ga + row0 * 512 + hd * 128);
}

DEVI void ms_item(const Params& p, LAS char* lds, int bh) {
  const int tid = threadIdx.x, lane = tid & 63, w = tid >> 6, r = lane & 31, h = lane >> 5;
  const int b = bh >> 2, hd = bh & 3;
  const size_t row0 = (size_t)NTOKP + b * 32;
  const float m0 = p.in[9][bh];
  const float* n0 = p.in[8] + bh * 128;
  const u16* KTs = p.KaT + (size_t)NTOKP * 512 + (size_t)bh * 128 * 32;
  const u16* VTs = p.VaT + (size_t)NTOKP * 512 + (size_t)bh * 128 * 32;
  lds_barrier();
  mlstm_out<1>(lds, p.gates + row0 * 8, hd, p.Qa + row0 * 512 + hd * 128, p.Ka + row0 * 512 + hd * 128, VTs, 32,
               p.C0sT + (size_t)bh * 16384, n0, m0, p.in[15] + hd * 128, p.Ga + row0 * 512 + hd * 128);
  f32x16 acc[4]; float nh, bL, amax;
  mlstm_local<1>(lds, p.gates + row0 * 8, hd, KTs, VTs, 32, acc, nh, bL, amax);
  const float mlast = bL + fmaxf(m0, amax);
  const float decay = __expf(bL + m0 - mlast), beta = __expf(bL + amax - mlast);
#pragma unroll
  for (int et = 0; et < 4; ++et)
#pragma unroll
    for (int i = 0; i < 16; ++i) {
      const int d = 32 * w + crow(i, h), e = 32 * et + r;
      const size_t o = ((size_t)bh * 128 + d) * 128 + e;
      p.out[O_SC + o] = decay * p.in[7][o] + beta * acc[et][i];
    }
  if (h == 0) { const int d = 32 * w + r; p.out[O_SN + bh * 128 + d] = decay * n0[d] + beta * nh; }
  if (tid == 0) p.out[O_SM + bh] = mlast;
}

DEVI void phase_conv(const Params& p, LAS char* lds) {
  const int tid = threadIdx.x, lane = tid & 63, w = tid >> 6;
  const u16* U = p.Qa; u16* Gc = p.KaT;
  LAS u16* win = (LAS u16*)lds;
  LAS float* cs = (LAS float*)(lds + 40960);
  LAS float* st = (LAS float*)(lds + 40960 + 32768);
  float cw[4][31], cb[4], lg[4], lb[4];
#pragma unroll
  for (int c = 0; c < 4; ++c) {
    const int chn = c * 256 + tid;
#pragma unroll
    for (int j = 0; j < 31; ++j) cw[c][j] = p.in[25][j * 1024 + chn];
    cb[c] = p.in[26][chn]; lg[c] = p.in[27][chn]; lb[c] = p.in[28][chn];
  }
  const int ntile = NTOK / 8;
  auto fetch = [=](int tile, int cgp, u32x4 (&rg)[5]) __attribute__((always_inline)) {
    const int row0 = tile * 8;
    const bool samp = row0 >= NTOKP;
    const int t0 = samp ? ((row0 - NTOKP) & 31) : (row0 & 8191);
    const int bs = samp ? ((row0 - NTOKP) >> 5) : 0;
    const int seqbase = row0 - t0;
#pragma unroll
    for (int q = 0; q < 5; ++q) {
      const int pch = tid + 256 * q, rr = pch >> 5, ch = pch & 31, t = t0 - 30 + rr;
      u32x4 v = {0, 0, 0, 0};
      if (pch < 38 * 32) {
        if (t >= 0) v = *reinterpret_cast<const u32x4*>(U + (size_t)(seqbase + t) * 1024 + cgp * 256 + ch * 8);
        else if (samp) {
          const float4* sc = reinterpret_cast<const float4*>(p.in[10] + ((size_t)(bs * 30 + 30 + t)) * 1024 + cgp * 256 + ch * 8);
          const float4 a = sc[0], c = sc[1];
          v = u32x4{cvtpk(a.x, a.y), cvtpk(a.z, a.w), cvtpk(c.x, c.y), cvtpk(c.z, c.w)};
        }
      }
      rg[q] = v;
    }
  };
  auto commit = [=](int buf, const u32x4 (&rg)[5]) __attribute__((always_inline)) {
#pragma unroll
    for (int q = 0; q < 5; ++q) {
      const int pch = tid + 256 * q;
      if (pch < 38 * 32) *reinterpret_cast<LAS u32x4*>(win + buf * (38 * 256) + (pch >> 5) * 256 + (pch & 31) * 8) = rg[q];
    }
  };
  int tile = blockIdx.x;
  if (tile >= ntile) return;
  u32x4 rg[5];
  __syncthreads();
  fetch(tile, 0, rg);
  commit(0, rg);
  __syncthreads();
  for (; tile < ntile; tile += gridDim.x) {
    const int row0 = tile * 8;
    const int ntl = tile + gridDim.x;
#pragma unroll
    for (int cgp = 0; cgp < 4; ++cgp) {
      const bool more = (cgp < 3) || (ntl < ntile);
      if (more) fetch(cgp < 3 ? tile : ntl, cgp < 3 ? cgp + 1 : 0, rg);
      const LAS u16* wb = win + (cgp & 1) * (38 * 256);
      float wv[38];
#pragma unroll
      for (int rr = 0; rr < 38; ++rr) wv[rr] = bf2f(wb[rr * 256 + tid]);
#pragma unroll
      for (int i = 0; i < 8; ++i) {
        float a = cb[cgp];
#pragma unroll
        for (int j = 0; j < 31; ++j) a += cw[cgp][j] * wv[i + j];
        cs[i * 1024 + cgp * 256 + tid] = a;
      }
      if (more) commit((cgp + 1) & 1, rg);
      lds_barrier();
    }
    u16 gv[4][8];
#pragma unroll
    for (int c = 0; c < 4; ++c)
#pragma unroll
      for (int i = 0; i < 8; ++i) gv[c][i] = Gc[(size_t)(row0 + i) * 1024 + c * 256 + tid];
#pragma unroll
    for (int q = 0; q < 2; ++q) {
      const int i = 2 * w + q;
      float a1 = 0.f, a2 = 0.f;
#pragma unroll
      for (int k = 0; k < 16; ++k) { const float v = cs[i * 1024 + lane + 64 * k]; a1 += v; a2 += v * v; }
      a1 = wsum(a1); a2 = wsum(a2);
      if (lane == 0) {
        const float mu = a1 * (1.f / 1024.f);
        const float var = fmaxf(a2 * (1.f / 1024.f) - mu * mu, 0.f);
        st[2 * i] = mu; st[2 * i + 1] = rsqrtf(var + EPS);
      }
    }
    lds_barrier();
#pragma unroll
    for (int c = 0; c < 4; ++c) {
      const int chn = c * 256 + tid;
#pragma unroll
      for (int i = 0; i < 8; ++i) {
        const float y = (cs[i * 1024 + chn] - st[2 * i]) * st[2 * i + 1] * lg[c] + lb[c];
        Gc[(size_t)(row0 + i) * 1024 + chn] = f2bf(siluf_(y) * bf2f(gv[c][i]));
      }
    }
    lds_barrier();
  }
}

struct AttnConst { float M2d, M2x, lam; };
DEVI AttnConst attn_consts(const Params& p, int layer) {
  const int lane = threadIdx.x & 63;
  AttnConst c;
  const float gq = max_abs64(p.in[16], 64, lane), gk = max_abs64(p.in[17], 64, lane);
  float kd = 0.f, kx = 0.f;
  for (int i = lane; i < (int)gridDim.x * 4; i += 64) { kd = fmaxf(kd, p.kmaxp[i]); kx = fmaxf(kx, p.kmaxp[1024 * (1 + layer) + i]); }
  kd = wmax(kd); kx = wmax(kx);
  c.M2d = (8.f * gq * 0.125f * LOG2E) * fmaxf(8.f * gk, sqrtf(kd)) * 1.01f;
  const float xq = max_abs64(p.in[32] + layer * 128, 128, lane), xk = max_abs64(p.in[33] + layer * 128, 128, lane);
  c.M2x = (11.313708f * xq * 0.08838834764831845f * LOG2E) * fmaxf(11.313708f * xk, sqrtf(kx)) * 1.01f;
  float d1 = p.in[18][lane] * p.in[19][lane], d2 = p.in[20][lane] * p.in[21][lane];
  d1 = wsum(d1); d2 = wsum(d2);
  c.lam = __expf(d1) - __expf(d2) + 0.2f;
  return c;
}

DEVI void cross_item(const Params& p, LAS char* lds, int layer, int it, float M2x) {
  const int hd = it & 3;
  size_t row0; int mb, nw;
  if (it < 1024) { const int rb = it >> 2; row0 = (size_t)rb * 128; mb = rb >> 6; nw = 4; }
  else { const int bs = (it - 1024) >> 2; row0 = (size_t)NTOKP + bs * 32; mb = 4 + bs; nw = 1; }
  attn_block<false>(lds, p.Qx + row0 * 512 + hd * 128, p.XK + ((size_t)(layer * 12 + mb) * 256) * 512 + hd * 128,
                    p.XVT + ((size_t)((layer * 12 + mb) * 4 + hd) * 128) * 256, 256, 0, 4, nw, 0, 256, 0.f, M2x, 0.f, nullptr,
                    p.Gx + row0 * 512 + hd * 128);
}

DEVI void diff_item(const Params& p, LAS char* lds, int it, float M2d, float lam) {
  const bool pr = it < 1024;
  const int hd = pr ? 3 - (it >> 8) : (it - 1024) & 3;
  const int qb = pr ? 63 - ((it >> 2) & 63) : 0;
  const int b = pr ? (it & 3) : (it - 1024) >> 2;
  const int bh = b * 4 + hd;
  const size_t row0 = pr ? (size_t)b * SEQ + qb * 128 : (size_t)NTOKP + b * 32;
  const float slope2 = exp2f(-2.f * (hd + 1)) * LOG2E;
  const u16* Kp = pr ? p.Kb + (size_t)b * SEQ * 512 + hd * 128 : p.Ks + (size_t)b * SKP * 512 + hd * 128;
  const u16* Vp = pr ? p.VbT + (size_t)bh * 128 * SEQ : p.VsT + (size_t)bh * 128 * SKP;
  const int qpos0 = pr ? qb * 128 : PAST;
  const float kcut = (float)qpos0 - (2.f * M2d + 64.f) / slope2;
  int j0 = (int)floorf((kcut - 63.f) * (1.f / 64.f));
  j0 = max(j0, 0);
  attn_block<true>(lds, p.Qb + row0 * 512 + hd * 128, Kp, Vp, pr ? SEQ : SKP, j0, pr ? 2 * qb + 2 : 33, pr ? 4 : 1,
                   qpos0, pr ? SEQ : PAST + 32, slope2, M2d, lam, p.in[22], p.Gb + row0 * 512 + hd * 128);
}

constexpr int NPHASE = 9;
DEVI void run_phase(const Params& p, LAS char* lds, int ph) {
  const int G = gridDim.x, g = blockIdx.x;
  switch (ph) {
    case 0: phase_prep(p); break;
    case 1: phase_gemm<0>(p, lds); break;
    case 2: {
      const AttnConst c = attn_consts(p, 0);
      for (int it = g; it < 1056; it += G) cross_item(p, lds, 0, it, c.M2x);
      for (int it = g; it < 2048; it += G) m1_item(p, lds, it);
    } break;
    case 3: {
      const AttnConst c = attn_consts(p, 0);
      (void)c;
      phase_scan(p, lds);
    } break;
    case 4: {
      const AttnConst c = attn_consts(p, 0);
      unsigned* qhead = reinterpret_cast<unsigned*>(p.kmaxp + 3 * 1024) + 16;
      volatile LAS int* slot = (volatile LAS int*)(lds + LDS_BYTES - 16);
      for (;;) {
        lds_barrier();
        if (threadIdx.x == 0) *slot = (int)__hip_atomic_fetch_add(qhead, 1u, __ATOMIC_RELAXED, __HIP_MEMORY_SCOPE_AGENT);
        lds_barrier();
        const int it = *slot;
        if (it >= 1056) break;
        diff_item(p, lds, it, c.M2d, c.lam);
      }
      for (;;) {
        lds_barrier();
        if (threadIdx.x == 0) *slot = (int)__hip_atomic_fetch_add(qhead + 16, 1u, __ATOMIC_RELAXED, __HIP_MEMORY_SCOPE_AGENT);
        lds_barrier();
        const int it = *slot;
        if (it >= 2048) break;
        m3_item(p, lds, it);
      }
      for (int it = G - 1 - g; it < 32; it += G) ms_item(p, lds, it);
    } break;
    case 5: phase_gemm<1>(p, lds); break;
    case 6: phase_gemm<2>(p, lds); break;
    case 7: {
      const AttnConst c = attn_consts(p, 1);
      phase_conv(p, lds);
      for (int it = g; it < 1056; it += G) cross_item(p, lds, 1, it, c.M2x);
    } break;
    case 8: phase_gemm<3>(p, lds); break;
  }
}

DEVI void grid_bar(unsigned* ctr, unsigned& epoch) {
  asm volatile("s_waitcnt vmcnt(0)" ::: "memory");
  __syncthreads();
  if (threadIdx.x == 0) {
    __builtin_amdgcn_fence(__ATOMIC_RELEASE, "agent");
    asm volatile("s_waitcnt vmcnt(0)" ::: "memory");
    __hip_atomic_fetch_add(ctr, 1u, __ATOMIC_RELAXED, __HIP_MEMORY_SCOPE_AGENT);
    epoch += 1u;
    const unsigned target = epoch * gridDim.x;
    while (__hip_atomic_load(ctr, __ATOMIC_RELAXED, __HIP_MEMORY_SCOPE_AGENT) < target) __builtin_amdgcn_s_sleep(1);
    __builtin_amdgcn_fence(__ATOMIC_ACQUIRE, "agent");
    asm volatile("s_waitcnt vmcnt(0)" ::: "memory");
  }
  __syncthreads();
}

__global__ void __launch_bounds__(256, 1) mega(Params p, int ph_lo, int ph_hi) {
  extern __shared__ __attribute__((aligned(16))) char smem[];
  LAS char* lds = (LAS char*)smem;
  cg::grid_group grid = cg::this_grid();
  unsigned epoch = 0;
  unsigned* ctr = reinterpret_cast<unsigned*>(p.kmaxp + 3 * 1024);
#define RUNPH(k) if (ph_lo <= (k) && (k) < ph_hi) { if ((k) > ph_lo) { if ((k) == 1) grid.sync(); else grid_bar(ctr, epoch); } run_phase(p, lds, (k)); }
  RUNPH(0) RUNPH(1) RUNPH(2) RUNPH(3) RUNPH(4) RUNPH(5) RUNPH(6) RUNPH(7) RUNPH(8)
#undef RUNPH
}

#ifndef MULTI_LAUNCH
#define MULTI_LAUNCH 0
#endif

extern "C" void kernel_launch(void* const* d_in, const int* in_sizes, int n_in, void* d_out, int out_size, void* d_ws, size_t ws_size,
                              hipStream_t stream) {
  static int grid_blocks = 0;
  if (!grid_blocks) {
    int dev = 0, cus = 0, per_cu = 0;
    hipGetDevice(&dev);
    hipDeviceGetAttribute(&cus, hipDeviceAttributeMultiprocessorCount, dev);
    hipFuncSetAttribute((const void*)mega, hipFuncAttributeMaxDynamicSharedMemorySize, LDS_BYTES);
    hipOccupancyMaxActiveBlocksPerMultiprocessor(&per_cu, (const void*)mega, 256, LDS_BYTES);
    if (per_cu < 1) per_cu = 1;
    if (per_cu > 1) per_cu = 1;
    grid_blocks = (cus * per_cu) & ~7;
    if (grid_blocks < 8) grid_blocks = 8;
  }
  Params p{};
  for (int i = 0; i < 34; ++i) p.in[i] = (const float*)d_in[i];
  p.out = (float*)d_out;
  char* ws = (char*)d_ws;
  size_t off = 0;
  auto take = [&](size_t bytes) { char* q = ws + off; off += (bytes + 255) & ~(size_t)255; return q; };
  p.WtInA = (u16*)take((size_t)NPAD_A * 1024 * 2);
  p.WtOutA = (u16*)take((size_t)1024 * 1536 * 2);
  p.WtInC = (u16*)take((size_t)4096 * 1024 * 2);
  p.WtOutC = (u16*)take((size_t)1024 * 1536 * 2);
  p.WtMem = (u16*)take((size_t)2 * 1024 * 1024 * 2);
  p.xb = (u16*)take((size_t)NTOK * 1024 * 2);
  p.memb = (u16*)take((size_t)1024 * 1024 * 2);
  u16* segs = (u16*)take(SEG * 2 * 11);
  p.Qa = segs; p.Ka = segs + SEG; p.KaT = segs + 2 * SEG; p.VaT = segs + 3 * SEG; p.Ga = segs + 4 * SEG; p.Qb = segs + 5 * SEG;
  p.Kb = segs + 6 * SEG; p.VbT = segs + 7 * SEG; p.Gb = segs + 8 * SEG; p.Qx = segs + 9 * SEG; p.Gx = segs + 10 * SEG;
  p.Ks = (u16*)take((size_t)8 * SKP * 512 * 2);
  p.VsT = (u16*)take((size_t)4096 * SKP * 2);
  p.XK = (u16*)take((size_t)2 * 12 * 256 * 512 * 2);
  p.XVT = (u16*)take((size_t)2 * 12 * 256 * 512 * 2);
  p.C0sT = (u16*)take((size_t)32 * 16384 * 2);
  p.rs0 = (float*)take((size_t)NTOK * 4);
  p.ssq1 = (float*)take((size_t)NTOK * 4);
  p.rsmem = (float*)take((size_t)(1024 + 64) * 4);
  p.gates = (float*)take((size_t)NTOK * 8 * 4);
  p.tabA = (float*)take(2048 * 4);
  p.tabB = (float*)take(2048 * 4);
  p.mtab = (float*)take(16 * 129 * 4);
  p.nhat = (float*)take((size_t)2048 * 128 * 4);
  p.nstate = (float*)take((size_t)2048 * 128 * 4);
  p.kmaxp = (float*)take((size_t)3 * 1024 * 4 + 256);
  if (off > ws_size) { fprintf(stderr, "workspace too small: need %zu have %zu\n", off, ws_size); return; }
  (void)hipMemsetAsync(p.kmaxp + 3 * 1024, 0, 256, stream);
#if MULTI_LAUNCH
  for (int ph = 0; ph < NPHASE; ++ph) {
    hipLaunchKernelGGL(mega, dim3(grid_blocks), dim3(256), LDS_BYTES, stream, p, ph, ph + 1);
  }
#else
  int lo = 0, hi = NPHASE;
  void* args[] = {&p, &lo, &hi};
  hipError_t e = hipLaunchCooperativeKernel((const void*)mega, dim3(grid_blocks), dim3(256), args, LDS_BYTES, stream);
  if (e != hipSuccess) fprintf(stderr, "cooperative launch failed: %s (grid %d)\n", hipGetErrorString(e), grid_blocks);
#endif
}
```
